# Optimizing an MI355X kernel written in HIP

```python
import jax, jax.numpy as jnp
from jax import lax
import numpy as np

D_MODEL = 1024
BATCH = 16
SEQ = 256
DEPTH = 2
DEC_BATCH = 4
DEC_SEQ = 2048
PAST_LEN = 256

GRID_W = 64
N_HEADS = 8
N_KV_HEADS = 2
HEAD_DIM = D_MODEL // 16
ATTN_W = N_HEADS * HEAD_DIM
KV_W = N_KV_HEADS * HEAD_DIM
CONV_W = D_MODEL // 4
POOL_W = D_MODEL // 4
POOL_WINDOWS = (2, 4, 8, 16)
POOL_GROUP = POOL_W // len(POOL_WINDOWS)
MIX_W = ATTN_W + CONV_W + POOL_W
SPLIT_SIZES = (ATTN_W, KV_W, KV_W, ATTN_W, CONV_W, CONV_W, CONV_W, CONV_W, POOL_W, POOL_W)
IN_W = sum(SPLIT_SIZES)
SPLIT_IDX = [int(i) for i in np.cumsum(SPLIT_SIZES)[:-1]]
CONV_K = 3
ROPE_THETA = 10000.0
Q_BLOCK = 128
EPS = 1e-6

kernel_name = "hybrid_dit_parallel_heads_step"


def _rmsnorm(x, g):
    xf = x.astype(jnp.float32)
    y = xf * lax.rsqrt(jnp.mean(xf * xf, axis=-1, keepdims=True) + EPS)
    return (y * g.astype(jnp.float32)).astype(x.dtype)


def _rope_angles(n):
    rows = n // GRID_W
    row = jnp.repeat(jnp.arange(rows), GRID_W).astype(jnp.float32)
    col = jnp.tile(jnp.arange(GRID_W), rows).astype(jnp.float32)
    half = HEAD_DIM // 2
    inv = 1.0 / (ROPE_THETA ** (jnp.arange(0, half, 2, dtype=jnp.float32) / half))
    return row[:, None] * inv, col[:, None] * inv


def _rot(x, ang):
    xf = x.astype(jnp.float32)
    x1, x2 = jnp.split(xf, 2, axis=-1)
    cs = jnp.cos(ang)[None, :, None, :]
    sn = jnp.sin(ang)[None, :, None, :]
    return jnp.concatenate([x1 * cs - x2 * sn, x2 * cs + x1 * sn], axis=-1).astype(x.dtype)


def _apply_rope(x, angs):
    half = HEAD_DIM // 2
    return jnp.concatenate([_rot(x[..., :half], angs[0]), _rot(x[..., half:], angs[1])], axis=-1)


def _attend(q, k, v):
    B, S, H, D = q.shape
    KV = k.shape[2]
    G = H // KV
    nb = S // Q_BLOCK
    qb = q.reshape(B, nb, Q_BLOCK, KV, G, D).transpose(1, 0, 2, 3, 4, 5)
    scale = HEAD_DIM ** -0.5

    def one(qblk):
        s = jnp.einsum('bqkgd,btkd->bkgqt', qblk, k).astype(jnp.float32) * scale
        p = jax.nn.softmax(s, axis=-1)
        return jnp.einsum('bkgqt,btkd->bqkgd', p.astype(v.dtype), v)

    o = lax.map(one, qb)
    return o.transpose(1, 0, 2, 3, 4, 5).reshape(B, S, H * D)


def _short_conv(x, w, b):
    n = x.shape[1]
    xp = jnp.pad(x, ((0, 0), (1, 1), (0, 0)))
    return xp[:, 0:n] * w[0] + xp[:, 1:n + 1] * w[1] + xp[:, 2:n + 2] * w[2] + b


def _pool_mix(u, w_pool, scale):
    n = u.shape[1]
    uf = u.astype(jnp.float32)
    cs = jnp.concatenate([jnp.zeros_like(uf[:, :1]), jnp.cumsum(uf, axis=1)], axis=1)
    t = jnp.arange(n)
    outs = []
    for gi, win in enumerate(POOL_WINDOWS):
        sl = slice(gi * POOL_GROUP, (gi + 1) * POOL_GROUP)
        lo = jnp.clip(t - win // 2, 0, n - 1)
        hi = jnp.clip(t - win // 2 + win - 1, 0, n - 1)
        cnt = (hi - lo + 1).astype(jnp.float32)
        d = (cs[:, hi + 1, sl] - cs[:, lo, sl]) / cnt[None, :, None] - uf[:, :, sl]
        outs.append(jnp.einsum('bnc,cd->bnd', d.astype(u.dtype), w_pool[gi]))
    return jnp.concatenate(outs, axis=-1) * scale


def _layer(x, mod, norm_g, w_in, q_g, k_g, conv_w, conv_b, pool_w, pool_scale, w_out,
           angs, ctx_k, ctx_v):
    B, n, _ = x.shape
    shift, scl, gate = jnp.split(mod, 3, axis=-1)
    xn = _rmsnorm(x, norm_g) * (1 + scl) + shift
    proj = xn @ w_in
    q, k, v, z_a, h_c, b_c, c_c, z_c, u_p, z_p = jnp.split(proj, SPLIT_IDX, axis=-1)
    q = _rmsnorm(q.reshape(B, n, N_HEADS, HEAD_DIM), q_g)
    k = _rmsnorm(k.reshape(B, n, N_KV_HEADS, HEAD_DIM), k_g)
    v = v.reshape(B, n, N_KV_HEADS, HEAD_DIM)
    if angs is None:
        k_all, v_all = k, v
    else:
        q = _apply_rope(q, angs)
        k_all = jnp.concatenate([_apply_rope(k, angs), ctx_k], axis=1)
        v_all = jnp.concatenate([v, ctx_v], axis=1)
    attn = _attend(q, k_all, v_all) * jax.nn.silu(z_a)
    conv = b_c * _short_conv(c_c * h_c, conv_w, conv_b) * jax.nn.silu(z_c)
    pool = _pool_mix(u_p, pool_w, pool_scale) * jax.nn.silu(z_p)
    out = jnp.concatenate([attn, conv, pool], axis=-1) @ w_out
    return x + gate * out, k, v


def setup_inputs(seed: int = 0) -> dict:
    key = jax.random.key(seed)
    ks = jax.random.split(key, 20)
    f32 = jnp.float32
    nrm = lambda k, shape, s: jax.random.normal(k, shape, f32) * s
    return {
        "x_prompt": nrm(ks[0], (BATCH, SEQ, D_MODEL), 1.0),
        "x_sample": nrm(ks[1], (DEC_BATCH, DEC_SEQ, D_MODEL), 1.0),
        "cache_k": nrm(ks[2], (DEC_BATCH, DEPTH, PAST_LEN, N_KV_HEADS, HEAD_DIM), 1.0),
        "cache_v": nrm(ks[3], (DEC_BATCH, DEPTH, PAST_LEN, N_KV_HEADS, HEAD_DIM), 1.0),
        "c": nrm(ks[4], (DEC_BATCH, D_MODEL), 1.0),
        "c_ctx": nrm(ks[5], (D_MODEL,), 1.0),
        "norm_g": 1.0 + nrm(ks[6], (DEPTH, D_MODEL), 0.05),
        "w_ada": nrm(ks[7], (DEPTH, D_MODEL, 3 * D_MODEL), 0.5 * D_MODEL ** -0.5),
        "b_ada": nrm(ks[8], (DEPTH, 3 * D_MODEL), 0.02),
        "w_in": nrm(ks[9], (DEPTH, D_MODEL, IN_W), D_MODEL ** -0.5),
        "q_norm_g": 1.0 + nrm(ks[10], (DEPTH, HEAD_DIM), 0.05),
        "k_norm_g": 1.0 + nrm(ks[11], (DEPTH, HEAD_DIM), 0.05),
        "conv_w": nrm(ks[12], (DEPTH, CONV_K, CONV_W), CONV_K ** -0.5),
        "conv_b": nrm(ks[13], (DEPTH, CONV_W), 0.02),
        "pool_w": nrm(ks[14], (DEPTH, len(POOL_WINDOWS), POOL_GROUP, POOL_GROUP), POOL_GROUP ** -0.5),
        "pool_scale": 1.0 + nrm(ks[15], (DEPTH, POOL_W), 0.1),
        "w_out": nrm(ks[16], (DEPTH, MIX_W, D_MODEL), MIX_W ** -0.5),
        "final_g": 1.0 + nrm(ks[17], (D_MODEL,), 0.05),
    }


def reference(x_prompt, x_sample, cache_k, cache_v, c, c_ctx, norm_g, w_ada, b_ada, w_in,
              q_norm_g, k_norm_g, conv_w, conv_b, pool_w, pool_scale, w_out, final_g):
    h = x_prompt
    new_ks, new_vs = [], []
    for l in range(DEPTH):
        mod = (jax.nn.silu(c_ctx) @ w_ada[l] + b_ada[l])[None, None, :]
        h, k_l, v_l = _layer(h, mod, norm_g[l], w_in[l], q_norm_g[l], k_norm_g[l], conv_w[l],
                             conv_b[l], pool_w[l], pool_scale[l], w_out[l], None, None, None)
        new_ks.append(k_l)
        new_vs.append(v_l)
    y_prompt = _rmsnorm(h, final_g)
    new_k = jnp.stack(new_ks, axis=1)
    new_v = jnp.stack(new_vs, axis=1)

    angs = _rope_angles(x_sample.shape[1])
    z = x_sample
    for l in range(DEPTH):
        mod = (jax.nn.silu(c) @ w_ada[l] + b_ada[l])[:, None, :]
        z, _, _ = _layer(z, mod, norm_g[l], w_in[l], q_norm_g[l], k_norm_g[l], conv_w[l],
                         conv_b[l], pool_w[l], pool_scale[l], w_out[l], angs,
                         cache_k[:, l], cache_v[:, l])
    y_sample = _rmsnorm(z, final_g)
    return (y_prompt, y_sample, new_k, new_v)
```

```cpp
#include <hip/hip_runtime.h>
#include <hip/hip_cooperative_groups.h>
#include <cstdint>
#include <cstdio>
namespace cg = cooperative_groups;

#define LAS __attribute__((address_space(3)))
typedef unsigned short bf16_t;
typedef short bf16x8 __attribute__((ext_vector_type(8)));
typedef short s16x4 __attribute__((ext_vector_type(4)));
typedef float f32x4 __attribute__((ext_vector_type(4)));
typedef float f32x16 __attribute__((ext_vector_type(16)));
typedef unsigned u32x4 __attribute__((ext_vector_type(4)));
typedef unsigned u32x2 __attribute__((ext_vector_type(2)));

constexpr int NTOK = 12288, NCTX = 4096, DM = 1024, INW = 2816;
constexpr size_t OUT_NK = 12582912, OUT_NV = 13631488;
constexpr float EPSF = 1e-6f;
constexpr float QSCALE = 0.125f * 1.4426950408889634f;

struct Params {
    const float *x_prompt, *x_sample, *cache_k, *cache_v, *c, *c_ctx, *norm_g, *w_ada, *b_ada, *w_in, *q_g, *k_g, *conv_w, *conv_b,
        *pool_w, *pool_scale, *w_out, *final_g;
    float* out;
    unsigned* bar;
    float* modv;
    float* rope;
    bf16_t* WinT;
    bf16_t* WoutT;
    bf16_t* PoolT;
    bf16_t* kc;
    bf16_t* vc;
    float* h;
    bf16_t* xn;
    bf16_t* proj;
    bf16_t* mix;
    int use_cg;
    int pad;
};

__device__ __forceinline__ unsigned pk_bf16(float lo, float hi) {
    unsigned r;
    asm("v_cvt_pk_bf16_f32 %0, %1, %2" : "=v"(r) : "v"(lo), "v"(hi));
    return r;
}
__device__ __forceinline__ float bf_lo(unsigned u) { return __uint_as_float(u << 16); }
__device__ __forceinline__ float bf_hi(unsigned u) { return __uint_as_float(u & 0xffff0000u); }
__device__ __forceinline__ float silu_f(float z) { return z / (1.0f + __expf(-z)); }
__device__ __forceinline__ int otid() { int t = threadIdx.x; asm volatile("" : "+v"(t)); return t; }

#define XB_TMO 128
#define XB_XCNT(j) (256 + 64 * (j))
#define XB_XSUB(j) (1280 + 64 * (j))
#define XB_XGEN(j) (2304 + 64 * (j))
#define XB_TOP 3328
#define XB_TOPGEN 3392
#define XCD_BAR_WORDS 3456
#define XB_SPIN_CAP (1u << 20)

__device__ __forceinline__ unsigned xb_ld(unsigned* p) { return __hip_atomic_load(p, __ATOMIC_RELAXED, __HIP_MEMORY_SCOPE_AGENT); }
__device__ __forceinline__ unsigned xb_add(unsigned* p, unsigned v) { return __hip_atomic_fetch_add(p, v, __ATOMIC_RELAXED, __HIP_MEMORY_SCOPE_AGENT); }
__device__ __forceinline__ unsigned xb_xcc_id() { return (unsigned)__builtin_amdgcn_s_getreg((3 << 11) | 20) & 0xFu; }
#define XB_SPIN(cond, bar)                                                   \
    do {                                                                     \
        unsigned _sp = 0;                                                    \
        while (cond) {                                                       \
            __builtin_amdgcn_s_sleep(1);                                     \
            if ((++_sp & 255u) == 0u) {                                      \
                if (xb_ld(&(bar)[XB_TMO])) break;                            \
                if (_sp > XB_SPIN_CAP) { atomicAdd(&(bar)[XB_TMO], 1u); break; } \
            }                                                                \
        }                                                                    \
    } while (0)

struct XcdBarrier {
    unsigned* bar;
    unsigned x;
    volatile LAS unsigned* st;
};

__device__ __forceinline__ XcdBarrier xcd_barrier_post(unsigned* bar, volatile LAS unsigned* st) {
    XcdBarrier b;
    b.bar = bar;
    b.x = xb_xcc_id();
    b.st = st;
    if (threadIdx.x == 0) (void)xb_add(&bar[XB_XCNT(b.x)], 1u);
    return b;
}
__device__ __forceinline__ void xcd_barrier_complete(unsigned* bar, unsigned x, unsigned& nloc, unsigned& nx) {
    const unsigned G = gridDim.x * gridDim.y * gridDim.z;
    unsigned sum, cnt, mine, sp = 0u;
    for (;;) {
        sum = 0u; cnt = 0u; mine = 0u;
#pragma unroll
        for (unsigned j = 0; j < 16; ++j) {
            const unsigned c = xb_ld(&bar[XB_XCNT(j)]);
            sum += c; cnt += (c > 0u) ? 1u : 0u; mine = (j == x) ? c : mine;
        }
        if (sum == G) break;
        __builtin_amdgcn_s_sleep(1);
        if ((++sp & 255u) == 0u) {
            if (xb_ld(&bar[XB_TMO])) break;
            if (sp > XB_SPIN_CAP) { atomicAdd(&bar[XB_TMO], 1u); break; }
        }
    }
    nloc = mine > 0u ? mine : 1u;
    nx = cnt > 0u ? cnt : 1u;
}
__device__ __forceinline__ void xcd_barrier(const XcdBarrier& b) {
    asm volatile("s_waitcnt vmcnt(0)" ::: "memory");
    __syncthreads();
    if (threadIdx.x == 0) {
        unsigned* bar = b.bar;
        __builtin_amdgcn_s_waitcnt(0);
        unsigned nloc = b.st[0], nx = b.st[1];
        if (nloc == 0u) { xcd_barrier_complete(bar, b.x, nloc, nx); b.st[0] = nloc; b.st[1] = nx; }
        const unsigned old = xb_add(&bar[XB_XSUB(b.x)], 1u);
        const unsigned gen = old / nloc;
        if (old + 1u == (gen + 1u) * nloc) {
            __builtin_amdgcn_fence(__ATOMIC_RELEASE, "agent");
            asm volatile("s_waitcnt vmcnt(0)" ::: "memory");
            const unsigned og = xb_add(&bar[XB_TOP], 1u);
            const unsigned tg = og / nx;
            if (og + 1u == (tg + 1u) * nx) xb_add(&bar[XB_TOPGEN], 1u);
            else XB_SPIN(xb_ld(&bar[XB_TOPGEN]) == tg, bar);
            __builtin_amdgcn_fence(__ATOMIC_ACQUIRE, "agent");
            xb_add(&bar[XB_XGEN(b.x)], 1u);
            asm volatile("s_waitcnt vmcnt(0)" ::: "memory");
        } else {
            XB_SPIN(xb_ld(&bar[XB_XGEN(b.x)]) == gen, bar);
            __builtin_amdgcn_fence(__ATOMIC_ACQUIRE, "agent");
            asm volatile("s_waitcnt vmcnt(0)" ::: "memory");
        }
    }
    __syncthreads();
}

__device__ __forceinline__ void prep_mod_item(const Params& p, int item, unsigned char* smem) {
    const int tid = otid();
    float* sc = (float*)smem;
    float* red = (float*)(smem + 20480);
    const int l = item / 96, j0 = (item % 96) * 32;
    for (int idx = tid; idx < 5120; idx += 256) {
        const int v = idx >> 10, k = idx & 1023;
        const float cv = (v == 0) ? p.c_ctx[k] : p.c[(v - 1) * 1024 + k];
        sc[idx] = cv / (1.0f + expf(-cv));
    }
    __syncthreads();
    const int cgp = tid & 7, kg = tid >> 3;
    float acc[5][4];
#pragma unroll
    for (int v = 0; v < 5; ++v)
#pragma unroll
        for (int e = 0; e < 4; ++e) acc[v][e] = 0.f;
    const float* wp = p.w_ada + (size_t)l * 1024 * 3072 + j0 + cgp * 4;
#pragma unroll 8
    for (int kk = 0; kk < 32; ++kk) {
        const int k = kk * 32 + kg;
        const f32x4 w = *(const f32x4*)(wp + (size_t)k * 3072);
#pragma unroll
        for (int v = 0; v < 5; ++v) {
            const float s = sc[v * 1024 + k];
#pragma unroll
            for (int e = 0; e < 4; ++e) acc[v][e] += s * w[e];
        }
    }
#pragma unroll
    for (int v = 0; v < 5; ++v)
#pragma unroll
        for (int e = 0; e < 4; ++e) red[kg * 160 + v * 32 + cgp * 4 + e] = acc[v][e];
    __syncthreads();
    if (tid < 160) {
        float s = 0.f;
        for (int g = 0; g < 32; ++g) s += red[g * 160 + tid];
        const int v = tid >> 5, cc = tid & 31;
        p.modv[(size_t)(l * 5 + v) * 3072 + j0 + cc] = s + p.b_ada[l * 3072 + j0 + cc];
    }
    __syncthreads();
}

__device__ __forceinline__ void prep_transpose_tile(const float* src, bf16_t* dst, int N, int k0, int n0, unsigned char* smem) {
    const int tid = otid();
    bf16_t* T = (bf16_t*)smem;
    {
        const int row = tid >> 2, seg = tid & 3;
        const float* s = src + (size_t)(k0 + row) * N + n0 + seg * 16;
        f32x4 v[4];
#pragma unroll
        for (int i = 0; i < 4; ++i) v[i] = *(const f32x4*)(s + i * 4);
#pragma unroll
        for (int i = 0; i < 4; ++i)
#pragma unroll
            for (int e = 0; e < 4; ++e) {
                const unsigned u = pk_bf16(v[i][e], 0.f);
                T[(seg * 16 + i * 4 + e) * 72 + row] = (bf16_t)(u & 0xffffu);
            }
    }
    __syncthreads();
    {
        const int n = tid >> 2, seg = tid & 3;
        const u32x4 a = *(const u32x4*)(T + n * 72 + seg * 16);
        const u32x4 b = *(const u32x4*)(T + n * 72 + seg * 16 + 8);
        bf16_t* d = dst + (size_t)(n0 + n) * 1024 + k0 + seg * 16;
        *(u32x4*)d = a;
        *(u32x4*)(d + 8) = b;
    }
    __syncthreads();
}

__device__ __forceinline__ void phase_prep(const Params& p, unsigned char* smem) {
    const int NMOD = 192, NTI = 2 * 16 * 44, NTO = 2 * 16 * 16;
    for (int it = blockIdx.x; it < NMOD + NTI + NTO; it += gridDim.x) {
        if (it < NMOD) {
            prep_mod_item(p, it, smem);
        } else if (it < NMOD + NTI) {
            const int t = it - NMOD, l = t / 704, r = t % 704, kt = r / 44, nt = r % 44;
            prep_transpose_tile(p.w_in + (size_t)l * 1024 * INW, p.WinT + (size_t)l * INW * 1024, INW, kt * 64, nt * 64, smem);
        } else {
            const int t = it - NMOD - NTI, l = t / 256, r = t % 256, kt = r / 16, nt = r % 16;
            prep_transpose_tile(p.w_out + (size_t)l * 1024 * 1024, p.WoutT + (size_t)l * 1024 * 1024, 1024, kt * 64, nt * 64, smem);
        }
    }
    const int gsz = gridDim.x * 256;
    for (int i = blockIdx.x * 256 + otid(); i < 558080; i += gsz) {
        if (i < 524288) {
            const int which = i >> 18, j = i & 262143;
            const int d = j & 63, t = (j >> 6) & 255, kvh = (j >> 14) & 1, bl = j >> 15;
            const size_t si = ((size_t)(bl * 256 + t) * 2 + kvh) * 64 + d;
            const float v = which ? p.cache_v[si] : p.cache_k[si];
            (which ? p.vc : p.kc)[j] = (bf16_t)(pk_bf16(v, 0.f) & 0xffffu);
        } else if (i < 524288 + 32768) {
            const int j = i - 524288;
            const int cc = j & 63, d = (j >> 6) & 63, lg = j >> 12;
            const float v = p.pool_w[((size_t)lg * 64 + cc) * 64 + d];
            p.PoolT[j] = (bf16_t)(pk_bf16(v, 0.f) & 0xffffu);
        } else {
            const int j = i - 524288 - 32768;
            const int a = j & 15, r = j >> 4;
            const float inv = 1.0f / powf(10000.0f, (float)(2 * a) / 32.0f);
            const float ang = (float)r * inv;
            const float kf = rintf(ang * 0.15915494309189535f);
            float rr = fmaf(-kf, 6.2831854820251465f, ang);
            rr = fmaf(-kf, -1.7484555e-7f, rr);
            p.rope[j] = cosf(rr);
            p.rope[1024 + j] = sinf(rr);
        }
    }
}

__device__ __forceinline__ float wave_sum(float v) {
#pragma unroll
    for (int o = 32; o >= 1; o >>= 1) v += __shfl_xor(v, o);
    return v;
}

__device__ __forceinline__ void phase_xn(const Params& p, int layer) {
    const int tid = otid(), lane = tid & 63, wave = tid >> 6;
    for (int tok = blockIdx.x * 4 + wave; tok < NTOK; tok += gridDim.x * 4) {
        const float* src = layer == 0 ? (tok < NCTX ? p.x_prompt + (size_t)tok * DM : p.x_sample + (size_t)(tok - NCTX) * DM) : p.h + (size_t)tok * DM;
        const int v = tok < NCTX ? 0 : 1 + ((tok - NCTX) >> 11);
        const float* mv = p.modv + (size_t)(layer * 5 + v) * 3072;
        f32x4 x[4];
        float ss = 0.f;
#pragma unroll
        for (int i = 0; i < 4; ++i) {
            x[i] = *(const f32x4*)(src + i * 256 + lane * 4);
            ss += x[i][0] * x[i][0] + x[i][1] * x[i][1] + x[i][2] * x[i][2] + x[i][3] * x[i][3];
        }
        ss = wave_sum(ss);
        const float rstd = rsqrtf(ss * (1.0f / 1024.0f) + EPSF);
#pragma unroll
        for (int i = 0; i < 4; ++i) {
            const int k = i * 256 + lane * 4;
            const f32x4 g = *(const f32x4*)(p.norm_g + layer * 1024 + k);
            const f32x4 sh = *(const f32x4*)(mv + k);
            const f32x4 sc = *(const f32x4*)(mv + 1024 + k);
            float o[4];
#pragma unroll
            for (int e = 0; e < 4; ++e) o[e] = x[i][e] * rstd * g[e] * (1.0f + sc[e]) + sh[e];
            u32x2 w;
            w.x = pk_bf16(o[0], o[1]);
            w.y = pk_bf16(o[2], o[3]);
            *(u32x2*)(p.xn + (size_t)tok * DM + k) = w;
        }
    }
}

__device__ __forceinline__ void phase_final(const Params& p) {
    const int tid = otid(), lane = tid & 63, wave = tid >> 6;
    for (int tok = blockIdx.x * 4 + wave; tok < NTOK; tok += gridDim.x * 4) {
        float* row = p.out + (size_t)tok * DM;
        f32x4 x[4];
        float ss = 0.f;
#pragma unroll
        for (int i = 0; i < 4; ++i) {
            x[i] = *(const f32x4*)(row + i * 256 + lane * 4);
            ss += x[i][0] * x[i][0] + x[i][1] * x[i][1] + x[i][2] * x[i][2] + x[i][3] * x[i][3];
        }
        ss = wave_sum(ss);
        const float rstd = rsqrtf(ss * (1.0f / 1024.0f) + EPSF);
#pragma unroll
        for (int i = 0; i < 4; ++i) {
            const int k = i * 256 + lane * 4;
            const f32x4 g = *(const f32x4*)(p.final_g + k);
            f32x4 o;
#pragma unroll
            for (int e = 0; e < 4; ++e) o[e] = x[i][e] * rstd * g[e];
            *(f32x4*)(row + k) = o;
        }
    }
}

template <int MODE>
__device__ __forceinline__ void gemm_tile(const Params& p, int layer, int mt, int nt, unsigned char* smem) {
    const int tid = otid(), lane = tid & 63, wave = tid >> 6, wm = wave >> 1, wn = wave & 1;
    const int fr = lane & 15, fq = lane >> 4;
    const int m0 = mt * 128, n0 = nt * 128;
    const bf16_t* A = (MODE == 0 ? p.xn : p.mix) + (size_t)m0 * 1024;
    const bf16_t* B = (MODE == 0 ? p.WinT + (size_t)layer * INW * 1024 : p.WoutT + (size_t)layer * 1024 * 1024) + (size_t)n0 * 1024;
    f32x4 acc[4][4];
#pragma unroll
    for (int i = 0; i < 4; ++i)
#pragma unroll
        for (int j = 0; j < 4; ++j) acc[i][j] = (f32x4){0.f, 0.f, 0.f, 0.f};

    const int srow = tid >> 3, scc = tid & 7;
    const bf16_t* ag = A + (size_t)srow * 1024 + scc * 8;
    const bf16_t* bg = B + (size_t)srow * 1024 + scc * 8;
    const int wofs = srow * 128 + ((scc ^ (srow & 7)) * 16);
    u32x4 ra[4], rb[4];
#pragma unroll
    for (int i = 0; i < 4; ++i) {
        ra[i] = *(const u32x4*)(ag + (size_t)i * 32 * 1024);
        rb[i] = *(const u32x4*)(bg + (size_t)i * 32 * 1024);
    }
#pragma unroll
    for (int i = 0; i < 4; ++i) {
        *(u32x4*)(smem + wofs + i * 4096) = ra[i];
        *(u32x4*)(smem + 16384 + wofs + i * 4096) = rb[i];
    }
    __syncthreads();
    const int aro = (wm * 64 + fr) * 128, bro = (wn * 64 + fr) * 128, sw = fr & 7;
    for (int kt = 0; kt < 16; ++kt) {
        const unsigned char* As = smem + (kt & 1) * 32768;
        const unsigned char* Bs = As + 16384;
        if (kt + 1 < 16) {
#pragma unroll
            for (int i = 0; i < 4; ++i) {
                ra[i] = *(const u32x4*)(ag + (size_t)i * 32 * 1024 + (kt + 1) * 64);
                rb[i] = *(const u32x4*)(bg + (size_t)i * 32 * 1024 + (kt + 1) * 64);
            }
        }
#pragma unroll
        for (int kk = 0; kk < 2; ++kk) {
            bf16x8 af[4], bf[4];
            const int co = ((kk * 4 + fq) ^ sw) * 16;
#pragma unroll
            for (int i = 0; i < 4; ++i) {
                af[i] = *(const bf16x8*)(As + aro + i * 2048 + co);
                bf[i] = *(const bf16x8*)(Bs + bro + i * 2048 + co);
            }
#pragma unroll
            for (int mi = 0; mi < 4; ++mi)
#pragma unroll
                for (int ni = 0; ni < 4; ++ni) acc[mi][ni] = __builtin_amdgcn_mfma_f32_16x16x32_bf16(bf[ni], af[mi], acc[mi][ni], 0, 0, 0);
        }
        if (kt + 1 < 16) {
            unsigned char* Aw = smem + ((kt + 1) & 1) * 32768;
#pragma unroll
            for (int i = 0; i < 4; ++i) {
                *(u32x4*)(Aw + wofs + i * 4096) = ra[i];
                *(u32x4*)(Aw + 16384 + wofs + i * 4096) = rb[i];
            }
        }
        __syncthreads();
    }

    const int nw = n0 + wn * 64;
    if (MODE == 0) {
        const bool ctx = m0 < NCTX;
        if (nw < 640) {
            const bool isq = nw < 512;
            const float* gp = (isq ? p.q_g : p.k_g) + layer * 64;
            f32x4 gv[4];
#pragma unroll
            for (int ni = 0; ni < 4; ++ni) gv[ni] = *(const f32x4*)(gp + ni * 16 + fq * 4);
#pragma unroll
            for (int mi = 0; mi < 4; ++mi) {
                const int tok = m0 + wm * 64 + mi * 16 + fr;
                float ss = 0.f;
#pragma unroll
                for (int ni = 0; ni < 4; ++ni)
#pragma unroll
                    for (int e = 0; e < 4; ++e) ss += acc[mi][ni][e] * acc[mi][ni][e];
                ss += __shfl_xor(ss, 16);
                ss += __shfl_xor(ss, 32);
                const float rstd = rsqrtf(ss * (1.0f / 64.0f) + EPSF);
                f32x4 val[4];
#pragma unroll
                for (int ni = 0; ni < 4; ++ni) val[ni] = acc[mi][ni] * rstd * gv[ni];
                if (!isq && ctx) {
                    float* nk = p.out + OUT_NK + ((size_t)((tok >> 8) * 2 + layer) * 256 + (tok & 255)) * 128 + (nw - 512) + fq * 4;
#pragma unroll
                    for (int ni = 0; ni < 4; ++ni) *(f32x4*)(nk + ni * 16) = val[ni];
                }
                if (!ctx) {
                    const int pos = (tok - NCTX) & 2047, prow = pos >> 6, pcol = pos & 63;
                    const f32x4 cr = *(const f32x4*)(p.rope + prow * 16 + fq * 4), sr = *(const f32x4*)(p.rope + 1024 + prow * 16 + fq * 4);
                    const f32x4 cc = *(const f32x4*)(p.rope + pcol * 16 + fq * 4), sn = *(const f32x4*)(p.rope + 1024 + pcol * 16 + fq * 4);
                    const f32x4 a0 = val[0], a1 = val[1], a2 = val[2], a3 = val[3];
                    val[0] = a0 * cr - a1 * sr;
                    val[1] = a1 * cr + a0 * sr;
                    val[2] = a2 * cc - a3 * sn;
                    val[3] = a3 * cc + a2 * sn;
                }
                if (isq) {
#pragma unroll
                    for (int ni = 0; ni < 4; ++ni) val[ni] = val[ni] * QSCALE;
                }
                bf16_t* pr = p.proj + (size_t)tok * INW + nw + fq * 4;
#pragma unroll
                for (int ni = 0; ni < 4; ++ni) {
                    u32x2 w;
                    w.x = pk_bf16(val[ni][0], val[ni][1]);
                    w.y = pk_bf16(val[ni][2], val[ni][3]);
                    *(u32x2*)(pr + ni * 16) = w;
                }
            }
        } else {
            const bool isv = nw < 768;
#pragma unroll
            for (int mi = 0; mi < 4; ++mi) {
                const int tok = m0 + wm * 64 + mi * 16 + fr;
                bf16_t* pr = p.proj + (size_t)tok * INW + nw + fq * 4;
#pragma unroll
                for (int ni = 0; ni < 4; ++ni) {
                    u32x2 w;
                    w.x = pk_bf16(acc[mi][ni][0], acc[mi][ni][1]);
                    w.y = pk_bf16(acc[mi][ni][2], acc[mi][ni][3]);
                    *(u32x2*)(pr + ni * 16) = w;
                }
                if (isv && ctx) {
                    float* nv = p.out + OUT_NV + ((size_t)((tok >> 8) * 2 + layer) * 256 + (tok & 255)) * 128 + (nw - 640) + fq * 4;
#pragma unroll
                    for (int ni = 0; ni < 4; ++ni) *(f32x4*)(nv + ni * 16) = acc[mi][ni];
                }
            }
        }
    } else {
        const int v = m0 < NCTX ? 0 : 1 + ((m0 - NCTX) >> 11);
        const float* gate = p.modv + (size_t)(layer * 5 + v) * 3072 + 2048 + nw + fq * 4;
        f32x4 gt[4];
#pragma unroll
        for (int ni = 0; ni < 4; ++ni) gt[ni] = *(const f32x4*)(gate + ni * 16);
#pragma unroll
        for (int mi = 0; mi < 4; ++mi) {
            const int tok = m0 + wm * 64 + mi * 16 + fr;
            const float* ho = (layer == 0 ? (tok < NCTX ? p.x_prompt + (size_t)tok * DM : p.x_sample + (size_t)(tok - NCTX) * DM) : p.h + (size_t)tok * DM) + nw + fq * 4;
            float* hn = (layer == 0 ? p.h : p.out) + (size_t)tok * DM + nw + fq * 4;
#pragma unroll
            for (int ni = 0; ni < 4; ++ni) {
                const f32x4 o = *(const f32x4*)(ho + ni * 16);
                *(f32x4*)(hn + ni * 16) = o + gt[ni] * acc[mi][ni];
            }
        }
    }
}

template <int MODE>
__device__ __forceinline__ void phase_gemm(const Params& p, int layer, unsigned char* smem) {
    const int NT = MODE == 0 ? 22 : 8;
    const int total = 96 * NT;
    for (int t = blockIdx.x; t < total; t += gridDim.x) gemm_tile<MODE>(p, layer, t / NT, t % NT, smem);
}

__device__ __forceinline__ void attn_unit(const Params& p, int layer, int unit, unsigned char* smem) {
    const int tid = otid(), lane = tid & 63, wave = tid >> 6;
    const int r31 = lane & 31, hh = lane >> 5;
    int b, head, qblk, tokbase, nself, ntiles;
    if (unit < 512) { b = unit >> 7; head = (unit >> 4) & 7; qblk = unit & 15; tokbase = NCTX + b * 2048; nself = 2048; ntiles = 36; }
    else { const int u = unit - 512; b = u >> 4; head = (u >> 1) & 7; qblk = u & 1; tokbase = b * 256; nself = 256; ntiles = 4; }
    const int kvh = head >> 2;
    const int qtok = tokbase + qblk * 128 + wave * 32 + r31;
    bf16x8 qf[4];
    {
        const bf16_t* qp = p.proj + (size_t)qtok * INW + head * 64 + hh * 8;
#pragma unroll
        for (int ks = 0; ks < 4; ++ks) qf[ks] = *(const bf16x8*)(qp + ks * 16);
    }
    const bf16_t* kself = p.proj + (size_t)tokbase * INW + 512 + kvh * 64;
    const bf16_t* vself = p.proj + (size_t)tokbase * INW + 640 + kvh * 64;
    const bf16_t* kcache = p.kc + (size_t)((b * 2 + layer) * 2 + kvh) * 256 * 64;
    const bf16_t* vcache = p.vc + (size_t)((b * 2 + layer) * 2 + kvh) * 256 * 64;
    const int srow = tid >> 3, scc = tid & 7;
    const int kwo = srow * 128 + ((scc ^ ((srow >> 1) & 7)) * 16);
    const int vwo = srow * 192 + scc * 16;
    u32x4 rk[2], rv[2];
    auto gload = [&](int j) {
        const int key0 = j * 64;
#pragma unroll
        for (int i = 0; i < 2; ++i) {
            const int row = srow + 32 * i;
            if (key0 < nself) {
                rk[i] = *(const u32x4*)(kself + (size_t)(key0 + row) * INW + scc * 8);
                rv[i] = *(const u32x4*)(vself + (size_t)(key0 + row) * INW + scc * 8);
            } else {
                rk[i] = *(const u32x4*)(kcache + (size_t)(key0 - nself + row) * 64 + scc * 8);
                rv[i] = *(const u32x4*)(vcache + (size_t)(key0 - nself + row) * 64 + scc * 8);
            }
        }
    };
    auto swrite = [&](int buf) {
        unsigned char* kb = smem + buf * 8192;
        unsigned char* vb = smem + 16384 + buf * 12288;
#pragma unroll
        for (int i = 0; i < 2; ++i) {
            *(u32x4*)(kb + kwo + i * 32 * 128) = rk[i];
            *(u32x4*)(vb + vwo + i * 32 * 192) = rv[i];
        }
    };
    f32x16 o[2];
#pragma unroll
    for (int i = 0; i < 16; ++i) { o[0][i] = 0.f; o[1][i] = 0.f; }
    float mrun = -INFINITY, lrun = 0.f;
    gload(0);
    swrite(0);
    __syncthreads();
    const int kro = r31 * 128, ksw = (r31 >> 1) & 7;
    const int vro = (4 * hh + ((lane & 15) >> 2)) * 192 + (((lane >> 4) & 1) * 16 + 4 * (lane & 3)) * 2;
    for (int j = 0; j < ntiles; ++j) {
        const unsigned char* kb = smem + (j & 1) * 8192;
        const unsigned char* vb = smem + 16384 + (j & 1) * 12288;
        if (j + 1 < ntiles) gload(j + 1);
        f32x16 s[2];
#pragma unroll
        for (int sb = 0; sb < 2; ++sb) {
#pragma unroll
            for (int i = 0; i < 16; ++i) s[sb][i] = 0.f;
#pragma unroll
            for (int ks = 0; ks < 4; ++ks) {
                const bf16x8 kf = *(const bf16x8*)(kb + sb * 4096 + kro + (((ks * 2 + hh) ^ ksw) * 16));
                s[sb] = __builtin_amdgcn_mfma_f32_32x32x16_bf16(kf, qf[ks], s[sb], 0, 0, 0);
            }
        }
        float mloc = s[0][0];
#pragma unroll
        for (int i = 1; i < 16; ++i) mloc = fmaxf(mloc, s[0][i]);
#pragma unroll
        for (int i = 0; i < 16; ++i) mloc = fmaxf(mloc, s[1][i]);
        mloc = fmaxf(mloc, __shfl_xor(mloc, 32));
        const float mnew = fmaxf(mrun, mloc);
        const float alpha = exp2f(mrun - mnew);
        mrun = mnew;
        float lsum = 0.f;
#pragma unroll
        for (int sb = 0; sb < 2; ++sb)
#pragma unroll
            for (int i = 0; i < 16; ++i) { s[sb][i] = exp2f(s[sb][i] - mnew); lsum += s[sb][i]; }
        lrun = lrun * alpha + lsum;
#pragma unroll
        for (int i = 0; i < 16; ++i) { o[0][i] *= alpha; o[1][i] *= alpha; }
#pragma unroll
        for (int sb = 0; sb < 2; ++sb)
#pragma unroll
            for (int s2 = 0; s2 < 2; ++s2) {
                u32x4 pw;
                pw.x = pk_bf16(s[sb][s2 * 8 + 0], s[sb][s2 * 8 + 1]);
                pw.y = pk_bf16(s[sb][s2 * 8 + 2], s[sb][s2 * 8 + 3]);
                pw.z = pk_bf16(s[sb][s2 * 8 + 4], s[sb][s2 * 8 + 5]);
                pw.w = pk_bf16(s[sb][s2 * 8 + 6], s[sb][s2 * 8 + 7]);
                const bf16x8 pf = __builtin_bit_cast(bf16x8, pw);
                const int kbase = (sb * 32 + s2 * 16) * 192;
#pragma unroll
                for (int dt = 0; dt < 2; ++dt) {
                    const LAS unsigned char* va = (const LAS unsigned char*)(vb) + kbase + vro + dt * 64;
                    const s16x4 a0 = __builtin_amdgcn_ds_read_tr16_b64_v4i16((LAS s16x4*)(va));
                    const s16x4 a1 = __builtin_amdgcn_ds_read_tr16_b64_v4i16((LAS s16x4*)(va + 8 * 192));
                    const bf16x8 vf = {a0[0], a0[1], a0[2], a0[3], a1[0], a1[1], a1[2], a1[3]};
                    o[dt] = __builtin_amdgcn_mfma_f32_32x32x16_bf16(vf, pf, o[dt], 0, 0, 0);
                }
            }
        if (j + 1 < ntiles) swrite((j + 1) & 1);
        __syncthreads();
    }
    const float ltot = lrun + __shfl_xor(lrun, 32);
    const float inv = 1.0f / ltot;
    const bf16_t* zp = p.proj + (size_t)qtok * INW + 768 + head * 64;
    bf16_t* mp = p.mix + (size_t)qtok * DM + head * 64;
#pragma unroll
    for (int dt = 0; dt < 2; ++dt)
#pragma unroll
        for (int rq = 0; rq < 4; ++rq) {
            const int d0 = dt * 32 + 8 * rq + 4 * hh;
            const u32x2 zz = *(const u32x2*)(zp + d0);
            const float z0 = bf_lo(zz.x), z1 = bf_hi(zz.x), z2 = bf_lo(zz.y), z3 = bf_hi(zz.y);
            u32x2 w;
            w.x = pk_bf16(o[dt][rq * 4 + 0] * inv * silu_f(z0), o[dt][rq * 4 + 1] * inv * silu_f(z1));
            w.y = pk_bf16(o[dt][rq * 4 + 2] * inv * silu_f(z2), o[dt][rq * 4 + 3] * inv * silu_f(z3));
            *(u32x2*)(mp + d0) = w;
        }
}

__device__ __forceinline__ void unpack8(const u32x4 u, float* f) {
    f[0] = bf_lo(u.x); f[1] = bf_hi(u.x); f[2] = bf_lo(u.y); f[3] = bf_hi(u.y);
    f[4] = bf_lo(u.z); f[5] = bf_hi(u.z); f[6] = bf_lo(u.w); f[7] = bf_hi(u.w);
}

__device__ __forceinline__ void pool_item(const Params& p, int layer, int pi, unsigned char* smem) {
    const int tid = otid(), lane = tid & 63, gi = tid >> 6;
    const int fr = lane & 15, fq = lane >> 4;
    const int T0 = pi * 64;
    int seqstart, seqlen;
    if (T0 < NCTX) { seqstart = T0 & ~255; seqlen = 256; } else { seqstart = NCTX + ((T0 - NCTX) & ~2047); seqlen = 2048; }
    const int toff = T0 - seqstart;
    for (int e = tid; e < 79 * 32; e += 256) {
        const int r = e >> 5, c = e & 31;
        const int s = toff - 8 + r;
        if (s >= 0 && s < seqlen) *(u32x4*)(smem + r * 528 + c * 16) = *(const u32x4*)(p.proj + (size_t)(seqstart + s) * INW + 2304 + c * 8);
    }
    __syncthreads();
    const int win = 2 << gi, half = win >> 1;
    bf16x8 wf[4][2];
    {
        const bf16_t* wp = p.PoolT + (size_t)((layer * 4 + gi) * 64) * 64;
#pragma unroll
        for (int ni = 0; ni < 4; ++ni)
#pragma unroll
            for (int kk = 0; kk < 2; ++kk) wf[ni][kk] = *(const bf16x8*)(wp + (ni * 16 + fr) * 64 + kk * 32 + fq * 8);
    }
#pragma unroll 1
    for (int mi = 0; mi < 4; ++mi) {
        f32x4 acc[4];
#pragma unroll
        for (int j = 0; j < 4; ++j) acc[j] = (f32x4){0.f, 0.f, 0.f, 0.f};
        const int tt = mi * 16 + fr;
        const int ts = toff + tt;
        int lo = ts - half, hi = ts - half + win - 1;
        lo = lo < 0 ? 0 : lo;
        hi = hi > seqlen - 1 ? seqlen - 1 : hi;
        const float rc = 1.0f / (float)(hi - lo + 1);
        const int r0 = lo - toff + 8, r1 = hi - toff + 8, rs = tt + 8;
#pragma unroll
        for (int kk = 0; kk < 2; ++kk) {
            const int co = (gi * 64 + kk * 32 + fq * 8) * 2;
            float sum[8];
#pragma unroll
            for (int e = 0; e < 8; ++e) sum[e] = 0.f;
            for (int r = r0; r <= r1; ++r) {
                float f[8];
                unpack8(*(const u32x4*)(smem + r * 528 + co), f);
#pragma unroll
                for (int e = 0; e < 8; ++e) sum[e] += f[e];
            }
            float us[8];
            unpack8(*(const u32x4*)(smem + rs * 528 + co), us);
            u32x4 dw;
            dw.x = pk_bf16(sum[0] * rc - us[0], sum[1] * rc - us[1]);
            dw.y = pk_bf16(sum[2] * rc - us[2], sum[3] * rc - us[3]);
            dw.z = pk_bf16(sum[4] * rc - us[4], sum[5] * rc - us[5]);
            dw.w = pk_bf16(sum[6] * rc - us[6], sum[7] * rc - us[7]);
            const bf16x8 df = __builtin_bit_cast(bf16x8, dw);
#pragma unroll
            for (int ni = 0; ni < 4; ++ni) acc[ni] = __builtin_amdgcn_mfma_f32_16x16x32_bf16(wf[ni][kk], df, acc[ni], 0, 0, 0);
        }
        const int tok = T0 + tt;
#pragma unroll
        for (int ni = 0; ni < 4; ++ni) {
            const int ch = gi * 64 + ni * 16 + fq * 4;
            const f32x4 ps = *(const f32x4*)(p.pool_scale + layer * 256 + ch);
            const u32x2 zz = *(const u32x2*)(p.proj + (size_t)tok * INW + 2560 + ch);
            u32x2 w;
            w.x = pk_bf16(acc[ni][0] * ps[0] * silu_f(bf_lo(zz.x)), acc[ni][1] * ps[1] * silu_f(bf_hi(zz.x)));
            w.y = pk_bf16(acc[ni][2] * ps[2] * silu_f(bf_lo(zz.y)), acc[ni][3] * ps[3] * silu_f(bf_hi(zz.y)));
            *(u32x2*)(p.mix + (size_t)tok * DM + 768 + ch) = w;
        }
    }
    __syncthreads();
}

__device__ __forceinline__ void conv_item(const Params& p, int layer, int ci) {
    const int tid = otid();
    const int ch = (tid & 31) * 8, tg = tid >> 5;
    const int T0 = ci * 64 + tg * 8;
    int seqstart, seqlen;
    if (T0 < NCTX) { seqstart = T0 & ~255; seqlen = 256; } else { seqstart = NCTX + ((T0 - NCTX) & ~2047); seqlen = 2048; }
    const int seqend = seqstart + seqlen;
    float w0[8], w1[8], w2[8], bb[8];
    {
        const float* cw = p.conv_w + (size_t)layer * 768 + ch;
#pragma unroll
        for (int e = 0; e < 8; ++e) { w0[e] = cw[e]; w1[e] = cw[256 + e]; w2[e] = cw[512 + e]; bb[e] = p.conv_b[layer * 256 + ch + e]; }
    }
    auto ldx = [&](int tok, float* x) {
        if (tok >= seqstart && tok < seqend) {
            float hc[8], cc[8];
            unpack8(*(const u32x4*)(p.proj + (size_t)tok * INW + 1280 + ch), hc);
            unpack8(*(const u32x4*)(p.proj + (size_t)tok * INW + 1792 + ch), cc);
#pragma unroll
            for (int e = 0; e < 8; ++e) x[e] = hc[e] * cc[e];
        } else {
#pragma unroll
            for (int e = 0; e < 8; ++e) x[e] = 0.f;
        }
    };
    float xm[8], x0[8], xp[8];
    ldx(T0 - 1, xm);
    ldx(T0, x0);
    for (int t = 0; t < 8; ++t) {
        const int tok = T0 + t;
        ldx(tok + 1, xp);
        float bc[8], zc[8], o[8];
        unpack8(*(const u32x4*)(p.proj + (size_t)tok * INW + 1536 + ch), bc);
        unpack8(*(const u32x4*)(p.proj + (size_t)tok * INW + 2048 + ch), zc);
#pragma unroll
        for (int e = 0; e < 8; ++e) {
            const float y = xm[e] * w0[e] + x0[e] * w1[e] + xp[e] * w2[e] + bb[e];
            o[e] = bc[e] * y * silu_f(zc[e]);
        }
        u32x4 w;
        w.x = pk_bf16(o[0], o[1]); w.y = pk_bf16(o[2], o[3]); w.z = pk_bf16(o[4], o[5]); w.w = pk_bf16(o[6], o[7]);
        *(u32x4*)(p.mix + (size_t)tok * DM + 512 + ch) = w;
#pragma unroll
        for (int e = 0; e < 8; ++e) { xm[e] = x0[e]; x0[e] = xp[e]; }
    }
}

__device__ __forceinline__ void phase_mixer(const Params& p, int layer, unsigned char* smem) {
    for (int it = blockIdx.x; it < 768 + 192 + 192; it += gridDim.x) {
        if (it < 768) attn_unit(p, layer, it, smem);
        else if (it < 960) pool_item(p, layer, it - 768, smem);
        else conv_item(p, layer, it - 960);
    }
}

__global__ void __launch_bounds__(256, 2) mega(Params p, int lo, int hi) {
    __shared__ __attribute__((aligned(16))) unsigned char smem[65536];
    __shared__ uint4 xbw;
    if (p.use_cg) cg::this_grid().sync();
    if (threadIdx.x == 0) xbw = make_uint4(0u, 0u, 0u, 0u);
    __syncthreads();
    XcdBarrier xb = xcd_barrier_post(p.bar, (volatile LAS unsigned*)&xbw);
    for (int ph = lo; ph < hi; ++ph) {
        if (ph > lo) xcd_barrier(xb);
        if (ph == 0) phase_prep(p, smem);
        else if (ph == 9) phase_final(p);
        else {
            const int layer = (ph - 1) >> 2, ty = (ph - 1) & 3;
            if (ty == 0) phase_xn(p, layer);
            else if (ty == 1) phase_gemm<0>(p, layer, smem);
            else if (ty == 2) phase_mixer(p, layer, smem);
            else phase_gemm<1>(p, layer, smem);
        }
    }
}

#ifndef MK_MULTI
#define MK_MULTI 0
#endif

extern "C" void kernel_launch(void* const* d_in, const int* in_sizes, int n_in, void* d_out, int out_size, void* d_ws, size_t ws_size,
                              hipStream_t stream) {
    static int grid_blocks = 0;
    if (!grid_blocks) {
        int dev = 0, cus = 0, per_cu = 0;
        hipGetDevice(&dev);
        hipDeviceGetAttribute(&cus, hipDeviceAttributeMultiprocessorCount, dev);
        hipOccupancyMaxActiveBlocksPerMultiprocessor(&per_cu, mega, 256, 0);
        if (per_cu > 2) per_cu = 2;
        if (per_cu < 1) per_cu = 1;
        grid_blocks = cus * per_cu;
    }
    Params p{};
    const float* const* in = (const float* const*)d_in;
    p.x_prompt = in[0]; p.x_sample = in[1]; p.cache_k = in[2]; p.cache_v = in[3]; p.c = in[4]; p.c_ctx = in[5]; p.norm_g = in[6];
    p.w_ada = in[7]; p.b_ada = in[8]; p.w_in = in[9]; p.q_g = in[10]; p.k_g = in[11]; p.conv_w = in[12]; p.conv_b = in[13];
    p.pool_w = in[14]; p.pool_scale = in[15]; p.w_out = in[16]; p.final_g = in[17];
    p.out = (float*)d_out;
    unsigned char* ws = (unsigned char*)d_ws;
    size_t off = 0;
    auto take = [&](size_t bytes) { unsigned char* r = ws + off; off += (bytes + 255) & ~(size_t)255; return r; };
    p.bar = (unsigned*)take(XCD_BAR_WORDS * 4);
    p.modv = (float*)take(2 * 5 * 3072 * 4);
    p.rope = (float*)take(2048 * 4);
    p.WinT = (bf16_t*)take((size_t)2 * INW * 1024 * 2);
    p.WoutT = (bf16_t*)take((size_t)2 * 1024 * 1024 * 2);
    p.PoolT = (bf16_t*)take(2 * 4 * 64 * 64 * 2);
    p.kc = (bf16_t*)take(262144 * 2);
    p.vc = (bf16_t*)take(262144 * 2);
    p.h = (float*)take((size_t)NTOK * DM * 4);
    p.xn = (bf16_t*)take((size_t)NTOK * DM * 2);
    p.proj = (bf16_t*)take((size_t)NTOK * INW * 2);
    p.mix = (bf16_t*)take((size_t)NTOK * DM * 2);
    p.use_cg = 0;
    p.pad = 0;
    hipMemsetAsync(p.bar, 0, XCD_BAR_WORDS * 4, stream);
#if MK_MULTI
    for (int ph = 0; ph < 10; ++ph) {
        int lo = ph, hi = ph + 1;
        void* args[] = {&p, &lo, &hi};
        hipError_t e = hipLaunchCooperativeKernel((void*)mega, dim3(grid_blocks), dim3(256), args, 0, stream);
        if (e != hipSuccess) fprintf(stderr, "launch failed: %s\n", hipGetErrorString(e));
    }
#else
    int lo = 0, hi = 10;
    void* args[] = {&p, &lo, &hi};
    hipError_t e = hipLaunchCooperativeKernel((void*)mega, dim3(grid_blocks), dim3(256), args, 0, stream);
    if (e != hipSuccess) fprintf(stderr, "cooperative launch failed: %s (grid %d)\n", hipGetErrorString(e), grid_blocks);
#endif
}
```

```cpp
#include <hip/hip_runtime.h>
#include <hip/hip_cooperative_groups.h>
#include <cstdint>
#include <cstdio>
namespace cg = cooperative_groups;

#define LAS __attribute__((address_space(3)))
typedef unsigned short bf16_t;
typedef short bf16x8 __attribute__((ext_vector_type(8)));
typedef short s16x4 __attribute__((ext_vector_type(4)));
typedef float f32x4 __attribute__((ext_vector_type(4)));
typedef float f32x16 __attribute__((ext_vector_type(16)));
typedef unsigned u32x4 __attribute__((ext_vector_type(4)));
typedef unsigned u32x2 __attribute__((ext_vector_type(2)));

constexpr int NTOK = 12288, NCTX = 4096, DM = 1024, INW = 2816;
constexpr size_t OUT_NK = 12582912, OUT_NV = 13631488;
constexpr float EPSF = 1e-6f;
constexpr float QSCALE = 0.125f * 1.4426950408889634f;

struct Params {
    const float *x_prompt, *x_sample, *cache_k, *cache_v, *c, *c_ctx, *norm_g, *w_ada, *b_ada, *w_in, *q_g, *k_g, *conv_w, *conv_b,
        *pool_w, *pool_scale, *w_out, *final_g;
    float* out;
    unsigned* bar;
    float* modv;
    float* rope;
    bf16_t* WinT;
    bf16_t* WoutT;
    bf16_t* PoolT;
    bf16_t* kc;
    bf16_t* vc;
    float* h;
    bf16_t* xn;
    bf16_t* proj;
    bf16_t* mix;
    int use_cg;
    int pad;
};

__device__ __forceinline__ unsigned pk_bf16(float lo, float hi) {
    unsigned r;
    asm("v_cvt_pk_bf16_f32 %0, %1, %2" : "=v"(r) : "v"(lo), "v"(hi));
    return r;
}
__device__ __forceinline__ float bf_lo(unsigned u) { return __uint_as_float(u << 16); }
__device__ __forceinline__ float bf_hi(unsigned u) { return __uint_as_float(u & 0xffff0000u); }
__device__ __forceinline__ float silu_f(float z) { return z / (1.0f + __expf(-z)); }
__device__ __forceinline__ float max3_f(float a, float b, float c) { float r; asm("v_max3_f32 %0, %1, %2, %3" : "=v"(r) : "v"(a), "v"(b), "v"(c)); return r; }
__device__ __forceinline__ int otid() { int t = threadIdx.x; asm volatile("" : "+v"(t)); return t; }

#define XB_TMO 128
#define XB_XCNT(j) (256 + 64 * (j))
#define XB_XSUB(j) (1280 + 64 * (j))
#define XB_XGEN(j) (2304 + 64 * (j))
#define XB_TOP 3328
#define XB_TOPGEN 3392
#define XCD_BAR_WORDS 3456
#define XB_SPIN_CAP (1u << 20)

__device__ __forceinline__ unsigned xb_ld(unsigned* p) { return __hip_atomic_load(p, __ATOMIC_RELAXED, __HIP_MEMORY_SCOPE_AGENT); }
__device__ __forceinline__ unsigned xb_add(unsigned* p, unsigned v) { return __hip_atomic_fetch_add(p, v, __ATOMIC_RELAXED, __HIP_MEMORY_SCOPE_AGENT); }
__device__ __forceinline__ unsigned xb_xcc_id() { return (unsigned)__builtin_amdgcn_s_getreg((3 << 11) | 20) & 0xFu; }
#define XB_SPIN(cond, bar)                                                   \
    do {                                                                     \
        unsigned _sp = 0;                                                    \
        while (cond) {                                                       \
            __builtin_amdgcn_s_sleep(1);                                     \
            if ((++_sp & 255u) == 0u) {                                      \
                if (xb_ld(&(bar)[XB_TMO])) break;                            \
                if (_sp > XB_SPIN_CAP) { atomicAdd(&(bar)[XB_TMO], 1u); break; } \
            }                                                                \
        }                                                                    \
    } while (0)

struct XcdBarrier {
    unsigned* bar;
    unsigned x;
    volatile LAS unsigned* st;
};

__device__ __forceinline__ XcdBarrier xcd_barrier_post(unsigned* bar, volatile LAS unsigned* st) {
    XcdBarrier b;
    b.bar = bar;
    b.x = xb_xcc_id();
    b.st = st;
    if (threadIdx.x == 0) (void)xb_add(&bar[XB_XCNT(b.x)], 1u);
    return b;
}
__device__ __forceinline__ void xcd_barrier_complete(unsigned* bar, unsigned x, unsigned& nloc, unsigned& nx) {
    const unsigned G = gridDim.x * gridDim.y * gridDim.z;
    unsigned sum, cnt, mine, sp = 0u;
    for (;;) {
        sum = 0u; cnt = 0u; mine = 0u;
#pragma unroll
        for (unsigned j = 0; j < 16; ++j) {
            const unsigned c = xb_ld(&bar[XB_XCNT(j)]);
            sum += c; cnt += (c > 0u) ? 1u : 0u; mine = (j == x) ? c : mine;
        }
        if (sum == G) break;
        __builtin_amdgcn_s_sleep(1);
        if ((++sp & 255u) == 0u) {
            if (xb_ld(&bar[XB_TMO])) break;
            if (sp > XB_SPIN_CAP) { atomicAdd(&bar[XB_TMO], 1u); break; }
        }
    }
    nloc = mine > 0u ? mine : 1u;
    nx = cnt > 0u ? cnt : 1u;
}
__device__ __forceinline__ void xcd_barrier(const XcdBarrier& b) {
    asm volatile("s_waitcnt vmcnt(0)" ::: "memory");
    __syncthreads();
    if (threadIdx.x == 0) {
        unsigned* bar = b.bar;
        __builtin_amdgcn_s_waitcnt(0);
        unsigned nloc = b.st[0], nx = b.st[1];
        if (nloc == 0u) { xcd_barrier_complete(bar, b.x, nloc, nx); b.st[0] = nloc; b.st[1] = nx; }
        const unsigned old = xb_add(&bar[XB_XSUB(b.x)], 1u);
        const unsigned gen = old / nloc;
        if (old + 1u == (gen + 1u) * nloc) {
            __builtin_amdgcn_fence(__ATOMIC_RELEASE, "agent");
            asm volatile("s_waitcnt vmcnt(0)" ::: "memory");
            const unsigned og = xb_add(&bar[XB_TOP], 1u);
            const unsigned tg = og / nx;
            if (og + 1u == (tg + 1u) * nx) xb_add(&bar[XB_TOPGEN], 1u);
            else XB_SPIN(xb_ld(&bar[XB_TOPGEN]) == tg, bar);
            __builtin_amdgcn_fence(__ATOMIC_ACQUIRE, "agent");
            xb_add(&bar[XB_XGEN(b.x)], 1u);
            asm volatile("s_waitcnt vmcnt(0)" ::: "memory");
        } else {
            XB_SPIN(xb_ld(&bar[XB_XGEN(b.x)]) == gen, bar);
            __builtin_amdgcn_fence(__ATOMIC_ACQUIRE, "agent");
            asm volatile("s_waitcnt vmcnt(0)" ::: "memory");
        }
    }
    __syncthreads();
}

__device__ __forceinline__ void prep_mod_item(const Params& p, int item, unsigned char* smem) {
    const int tid = otid();
    float* sc = (float*)smem;
    float* red = (float*)(smem + 20480);
    const int l = item / 96, j0 = (item % 96) * 32;
    for (int idx = tid; idx < 5120; idx += 256) {
        const int v = idx >> 10, k = idx & 1023;
        const float cv = (v == 0) ? p.c_ctx[k] : p.c[(v - 1) * 1024 + k];
        sc[idx] = cv / (1.0f + expf(-cv));
    }
    __syncthreads();
    const int cgp = tid & 7, kg = tid >> 3;
    float acc[5][4];
#pragma unroll
    for (int v = 0; v < 5; ++v)
#pragma unroll
        for (int e = 0; e < 4; ++e) acc[v][e] = 0.f;
    const float* wp = p.w_ada + (size_t)l * 1024 * 3072 + j0 + cgp * 4;
#pragma unroll 8
    for (int kk = 0; kk < 32; ++kk) {
        const int k = kk * 32 + kg;
        const f32x4 w = *(const f32x4*)(wp + (size_t)k * 3072);
#pragma unroll
        for (int v = 0; v < 5; ++v) {
            const float s = sc[v * 1024 + k];
#pragma unroll
            for (int e = 0; e < 4; ++e) acc[v][e] += s * w[e];
        }
    }
#pragma unroll
    for (int v = 0; v < 5; ++v)
#pragma unroll
        for (int e = 0; e < 4; ++e) red[kg * 160 + v * 32 + cgp * 4 + e] = acc[v][e];
    __syncthreads();
    if (tid < 160) {
        float s = 0.f;
        for (int g = 0; g < 32; ++g) s += red[g * 160 + tid];
        const int v = tid >> 5, cc = tid & 31;
        p.modv[(size_t)(l * 5 + v) * 3072 + j0 + cc] = s + p.b_ada[l * 3072 + j0 + cc];
    }
    __syncthreads();
}

__device__ __forceinline__ void prep_transpose_tile(const float* src, bf16_t* dst, int N, int k0, int n0, unsigned char* smem) {
    const int tid = otid();
    bf16_t* T = (bf16_t*)smem;
    {
        const int row = tid >> 2, seg = tid & 3;
        const float* s = src + (size_t)(k0 + row) * N + n0 + seg * 16;
        f32x4 v[4];
#pragma unroll
        for (int i = 0; i < 4; ++i) v[i] = *(const f32x4*)(s + i * 4);
#pragma unroll
        for (int i = 0; i < 4; ++i)
#pragma unroll
            for (int e = 0; e < 4; ++e) {
                const unsigned u = pk_bf16(v[i][e], 0.f);
                T[(seg * 16 + i * 4 + e) * 72 + row] = (bf16_t)(u & 0xffffu);
            }
    }
    __syncthreads();
    {
        const int n = tid >> 2, seg = tid & 3;
        const u32x4 a = *(const u32x4*)(T + n * 72 + seg * 16);
        const u32x4 b = *(const u32x4*)(T + n * 72 + seg * 16 + 8);
        bf16_t* d = dst + (size_t)(n0 + n) * 1024 + k0 + seg * 16;
        *(u32x4*)d = a;
        *(u32x4*)(d + 8) = b;
    }
    __syncthreads();
}

__device__ __forceinline__ void phase_prep(const Params& p, unsigned char* smem) {
    const int NMOD = 192, NTI = 2 * 16 * 44, NTO = 2 * 16 * 16;
    for (int it = blockIdx.x; it < NMOD + NTI + NTO; it += gridDim.x) {
        if (it < NMOD) {
            prep_mod_item(p, it, smem);
        } else if (it < NMOD + NTI) {
            const int t = it - NMOD, l = t / 704, r = t % 704, kt = r / 44, nt = r % 44;
            prep_transpose_tile(p.w_in + (size_t)l * 1024 * INW, p.WinT + (size_t)l * INW * 1024, INW, kt * 64, nt * 64, smem);
        } else {
            const int t = it - NMOD - NTI, l = t / 256, r = t % 256, kt = r / 16, nt = r % 16;
            prep_transpose_tile(p.w_out + (size_t)l * 1024 * 1024, p.WoutT + (size_t)l * 1024 * 1024, 1024, kt * 64, nt * 64, smem);
        }
    }
    const int gsz = gridDim.x * 256;
    for (int i = blockIdx.x * 256 + otid(); i < 558080; i += gsz) {
        if (i < 524288) {
            const int which = i >> 18, j = i & 262143;
            const int d = j & 63, t = (j >> 6) & 255, kvh = (j >> 14) & 1, bl = j >> 15;
            const size_t si = ((size_t)(bl * 256 + t) * 2 + kvh) * 64 + d;
            const float v = which ? p.cache_v[si] : p.cache_k[si];
            (which ? p.vc : p.kc)[j] = (bf16_t)(pk_bf16(v, 0.f) & 0xffffu);
        } else if (i < 524288 + 32768) {
            const int j = i - 524288;
            const int cc = j & 63, d = (j >> 6) & 63, lg = j >> 12;
            const float v = p.pool_w[((size_t)lg * 64 + cc) * 64 + d];
            p.PoolT[j] = (bf16_t)(pk_bf16(v, 0.f) & 0xffffu);
        } else {
            const int j = i - 524288 - 32768;
            const int a = j & 15, r = j >> 4;
            const float inv = 1.0f / powf(10000.0f, (float)(2 * a) / 32.0f);
            const float ang = (float)r * inv;
            const float kf = rintf(ang * 0.15915494309189535f);
            float rr = fmaf(-kf, 6.2831854820251465f, ang);
            rr = fmaf(-kf, -1.7484555e-7f, rr);
            p.rope[j] = cosf(rr);
            p.rope[1024 + j] = sinf(rr);
        }
    }
}

__device__ __forceinline__ float wave_sum(float v) {
#pragma unroll
    for (int o = 32; o >= 1; o >>= 1) v += __shfl_xor(v, o);
    return v;
}

__device__ __forceinline__ void phase_xn(const Params& p, int layer) {
    const int tid = otid(), lane = tid & 63, wave = tid >> 6;
    for (int tok = blockIdx.x * 4 + wave; tok < NTOK; tok += gridDim.x * 4) {
        const float* src = layer == 0 ? (tok < NCTX ? p.x_prompt + (size_t)tok * DM : p.x_sample + (size_t)(tok - NCTX) * DM) : p.h + (size_t)tok * DM;
        const int v = tok < NCTX ? 0 : 1 + ((tok - NCTX) >> 11);
        const float* mv = p.modv + (size_t)(layer * 5 + v) * 3072;
        f32x4 x[4];
        float ss = 0.f;
#pragma unroll
        for (int i = 0; i < 4; ++i) {
            x[i] = *(const f32x4*)(src + i * 256 + lane * 4);
            ss += x[i][0] * x[i][0] + x[i][1] * x[i][1] + x[i][2] * x[i][2] + x[i][3] * x[i][3];
        }
        ss = wave_sum(ss);
        const float rstd = rsqrtf(ss * (1.0f / 1024.0f) + EPSF);
#pragma unroll
        for (int i = 0; i < 4; ++i) {
            const int k = i * 256 + lane * 4;
            const f32x4 g = *(const f32x4*)(p.norm_g + layer * 1024 + k);
            const f32x4 sh = *(const f32x4*)(mv + k);
            const f32x4 sc = *(const f32x4*)(mv + 1024 + k);
            float o[4];
#pragma unroll
            for (int e = 0; e < 4; ++e) o[e] = x[i][e] * rstd * g[e] * (1.0f + sc[e]) + sh[e];
            u32x2 w;
            w.x = pk_bf16(o[0], o[1]);
            w.y = pk_bf16(o[2], o[3]);
            *(u32x2*)(p.xn + (size_t)tok * DM + k) = w;
        }
    }
}

__device__ __forceinline__ void phase_final(const Params& p) {
    const int tid = otid(), lane = tid & 63, wave = tid >> 6;
    for (int tok = blockIdx.x * 4 + wave; tok < NTOK; tok += gridDim.x * 4) {
        float* row = p.out + (size_t)tok * DM;
        f32x4 x[4];
        float ss = 0.f;
#pragma unroll
        for (int i = 0; i < 4; ++i) {
            x[i] = *(const f32x4*)(row + i * 256 + lane * 4);
            ss += x[i][0] * x[i][0] + x[i][1] * x[i][1] + x[i][2] * x[i][2] + x[i][3] * x[i][3];
        }
        ss = wave_sum(ss);
        const float rstd = rsqrtf(ss * (1.0f / 1024.0f) + EPSF);
#pragma unroll
        for (int i = 0; i < 4; ++i) {
            const int k = i * 256 + lane * 4;
            const f32x4 g = *(const f32x4*)(p.final_g + k);
            f32x4 o;
#pragma unroll
            for (int e = 0; e < 4; ++e) o[e] = x[i][e] * rstd * g[e];
            *(f32x4*)(row + k) = o;
        }
    }
}

template <int MODE>
__device__ __forceinline__ void gemm_tile(const Params& p, int layer, int mt, int nt, unsigned char* smem) {
    const int tid = otid(), lane = tid & 63, wave = tid >> 6, wm = wave >> 1, wn = wave & 1;
    const int fr = lane & 15, fq = lane >> 4;
    const int m0 = mt * 128, n0 = nt * 128;
    const bf16_t* A = (MODE == 0 ? p.xn : p.mix) + (size_t)m0 * 1024;
    const bf16_t* B = (MODE == 0 ? p.WinT + (size_t)layer * INW * 1024 : p.WoutT + (size_t)layer * 1024 * 1024) + (size_t)n0 * 1024;
    f32x4 acc[4][4];
#pragma unroll
    for (int i = 0; i < 4; ++i)
#pragma unroll
        for (int j = 0; j < 4; ++j) acc[i][j] = (f32x4){0.f, 0.f, 0.f, 0.f};

    const int srow = tid >> 3, scc = tid & 7;
    const bf16_t* ag = A + (size_t)srow * 1024 + scc * 8;
    const bf16_t* bg = B + (size_t)srow * 1024 + scc * 8;
    const int wofs = srow * 128 + ((scc ^ (srow & 7)) * 16);
    u32x4 raA[4], rbA[4], raB[4], rbB[4];
    auto gload = [&](int kt, u32x4* ra, u32x4* rb) {
#pragma unroll
        for (int i = 0; i < 4; ++i) {
            ra[i] = *(const u32x4*)(ag + (size_t)i * 32 * 1024 + kt * 64);
            rb[i] = *(const u32x4*)(bg + (size_t)i * 32 * 1024 + kt * 64);
        }
    };
    auto swrite = [&](int buf, const u32x4* ra, const u32x4* rb) {
        unsigned char* Aw = smem + buf * 32768;
#pragma unroll
        for (int i = 0; i < 4; ++i) {
            *(u32x4*)(Aw + wofs + i * 4096) = ra[i];
            *(u32x4*)(Aw + 16384 + wofs + i * 4096) = rb[i];
        }
    };
    gload(0, raA, rbA);
    gload(1, raB, rbB);
    swrite(0, raA, rbA);
    __syncthreads();
    const int aro = (wm * 64 + fr) * 128, bro = (wn * 64 + fr) * 128, sw = fr & 7;
    auto step = [&](int kt, u32x4* la, u32x4* lb, const u32x4* wa, const u32x4* wb) {
        const unsigned char* As = smem + (kt & 1) * 32768;
        const unsigned char* Bs = As + 16384;
        bf16x8 af[2][4], bf[2][4];
#pragma unroll
        for (int kk = 0; kk < 2; ++kk) {
            const int co = ((kk * 4 + fq) ^ sw) * 16;
#pragma unroll
            for (int i = 0; i < 4; ++i) {
                af[kk][i] = *(const bf16x8*)(As + aro + i * 2048 + co);
                bf[kk][i] = *(const bf16x8*)(Bs + bro + i * 2048 + co);
            }
        }
        if (kt + 2 < 16) gload(kt + 2, la, lb);
        __builtin_amdgcn_sched_barrier(0);
#pragma unroll
        for (int mi = 0; mi < 4; ++mi)
#pragma unroll
            for (int ni = 0; ni < 4; ++ni) acc[mi][ni] = __builtin_amdgcn_mfma_f32_16x16x32_bf16(bf[0][ni], af[0][mi], acc[mi][ni], 0, 0, 0);
        __builtin_amdgcn_sched_barrier(0);
        if (kt + 1 < 16) swrite((kt + 1) & 1, wa, wb);
        __builtin_amdgcn_sched_barrier(0);
#pragma unroll
        for (int mi = 0; mi < 4; ++mi)
#pragma unroll
            for (int ni = 0; ni < 4; ++ni) acc[mi][ni] = __builtin_amdgcn_mfma_f32_16x16x32_bf16(bf[1][ni], af[1][mi], acc[mi][ni], 0, 0, 0);
        __syncthreads();
    };
    for (int kt = 0; kt < 16; kt += 2) {
        step(kt, raA, rbA, raB, rbB);
        step(kt + 1, raB, rbB, raA, rbA);
    }

    const int nw = n0 + wn * 64;
    if (MODE == 0) {
        const bool ctx = m0 < NCTX;
        if (nw < 640) {
            const bool isq = nw < 512;
            const float* gp = (isq ? p.q_g : p.k_g) + layer * 64;
            f32x4 gv[4];
#pragma unroll
            for (int ni = 0; ni < 4; ++ni) gv[ni] = *(const f32x4*)(gp + ni * 16 + fq * 4);
#pragma unroll
            for (int mi = 0; mi < 4; ++mi) {
                const int tok = m0 + wm * 64 + mi * 16 + fr;
                float ss = 0.f;
#pragma unroll
                for (int ni = 0; ni < 4; ++ni)
#pragma unroll
                    for (int e = 0; e < 4; ++e) ss += acc[mi][ni][e] * acc[mi][ni][e];
                ss += __shfl_xor(ss, 16);
                ss += __shfl_xor(ss, 32);
                const float rstd = rsqrtf(ss * (1.0f / 64.0f) + EPSF);
                f32x4 val[4];
#pragma unroll
                for (int ni = 0; ni < 4; ++ni) val[ni] = acc[mi][ni] * rstd * gv[ni];
                if (!isq && ctx) {
                    float* nk = p.out + OUT_NK + ((size_t)((tok >> 8) * 2 + layer) * 256 + (tok & 255)) * 128 + (nw - 512) + fq * 4;
#pragma unroll
                    for (int ni = 0; ni < 4; ++ni) *(f32x4*)(nk + ni * 16) = val[ni];
                }
                if (!ctx) {
                    const int pos = (tok - NCTX) & 2047, prow = pos >> 6, pcol = pos & 63;
                    const f32x4 cr = *(const f32x4*)(p.rope + prow * 16 + fq * 4), sr = *(const f32x4*)(p.rope + 1024 + prow * 16 + fq * 4);
                    const f32x4 cc = *(const f32x4*)(p.rope + pcol * 16 + fq * 4), sn = *(const f32x4*)(p.rope + 1024 + pcol * 16 + fq * 4);
                    const f32x4 a0 = val[0], a1 = val[1], a2 = val[2], a3 = val[3];
                    val[0] = a0 * cr - a1 * sr;
                    val[1] = a1 * cr + a0 * sr;
                    val[2] = a2 * cc - a3 * sn;
                    val[3] = a3 * cc + a2 * sn;
                }
                if (isq) {
#pragma unroll
                    for (int ni = 0; ni < 4; ++ni) val[ni] = val[ni] * QSCALE;
                }
                bf16_t* pr = p.proj + (size_t)tok * INW + nw + fq * 4;
#pragma unroll
                for (int ni = 0; ni < 4; ++ni) {
                    u32x2 w;
                    w.x = pk_bf16(val[ni][0], val[ni][1]);
                    w.y = pk_bf16(val[ni][2], val[ni][3]);
                    *(u32x2*)(pr + ni * 16) = w;
                }
            }
        } else {
            const bool isv = nw < 768;
#pragma unroll
            for (int mi = 0; mi < 4; ++mi) {
                const int tok = m0 + wm * 64 + mi * 16 + fr;
                bf16_t* pr = p.proj + (size_t)tok * INW + nw + fq * 4;
#pragma unroll
                for (int ni = 0; ni < 4; ++ni) {
                    u32x2 w;
                    w.x = pk_bf16(acc[mi][ni][0], acc[mi][ni][1]);
                    w.y = pk_bf16(acc[mi][ni][2], acc[mi][ni][3]);
                    *(u32x2*)(pr + ni * 16) = w;
                }
                if (isv && ctx) {
                    float* nv = p.out + OUT_NV + ((size_t)((tok >> 8) * 2 + layer) * 256 + (tok & 255)) * 128 + (nw - 640) + fq * 4;
#pragma unroll
                    for (int ni = 0; ni < 4; ++ni) *(f32x4*)(nv + ni * 16) = acc[mi][ni];
                }
            }
        }
    } else {
        const int v = m0 < NCTX ? 0 : 1 + ((m0 - NCTX) >> 11);
        const float* gate = p.modv + (size_t)(layer * 5 + v) * 3072 + 2048 + nw + fq * 4;
        f32x4 gt[4];
#pragma unroll
        for (int ni = 0; ni < 4; ++ni) gt[ni] = *(const f32x4*)(gate + ni * 16);
#pragma unroll
        for (int mi = 0; mi < 4; ++mi) {
            const int tok = m0 + wm * 64 + mi * 16 + fr;
            const float* ho = (layer == 0 ? (tok < NCTX ? p.x_prompt + (size_t)tok * DM : p.x_sample + (size_t)(tok - NCTX) * DM) : p.h + (size_t)tok * DM) + nw + fq * 4;
            float* hn = (layer == 0 ? p.h : p.out) + (size_t)tok * DM + nw + fq * 4;
#pragma unroll
            for (int ni = 0; ni < 4; ++ni) {
                const f32x4 o = *(const f32x4*)(ho + ni * 16);
                *(f32x4*)(hn + ni * 16) = o + gt[ni] * acc[mi][ni];
            }
        }
    }
}

template <int MODE, int MI>
__device__ __forceinline__ void gemm_slice(const Params& p, int layer, int m0, int n0, unsigned char* smem) {
    const int tid = otid(), lane = tid & 63, wn = tid >> 6;
    const int fr = lane & 15, fq = lane >> 4;
    constexpr int NA = MI == 4 ? 2 : 1;
    const bf16_t* A = (MODE == 0 ? p.xn : p.mix) + (size_t)m0 * 1024;
    const bf16_t* B = (MODE == 0 ? p.WinT + (size_t)layer * INW * 1024 : p.WoutT + (size_t)layer * 1024 * 1024) + (size_t)n0 * 1024;
    f32x4 acc[MI][2];
#pragma unroll
    for (int i = 0; i < MI; ++i) { acc[i][0] = (f32x4){0.f, 0.f, 0.f, 0.f}; acc[i][1] = (f32x4){0.f, 0.f, 0.f, 0.f}; }
    const int srow = tid >> 3, scc = tid & 7;
    const bool aon = (MI == 4) || tid < 128;
    const bf16_t* ag = A + (size_t)srow * 1024 + scc * 8;
    const bf16_t* bg = B + (size_t)srow * 1024 + scc * 8;
    const int wofs = srow * 128 + ((scc ^ (srow & 7)) * 16);
    u32x4 ra[NA], rb[4];
    auto gload = [&](int kt) {
#pragma unroll
        for (int i = 0; i < NA; ++i) if (aon) ra[i] = *(const u32x4*)(ag + (size_t)i * 32 * 1024 + kt * 64);
#pragma unroll
        for (int i = 0; i < 4; ++i) rb[i] = *(const u32x4*)(bg + (size_t)i * 32 * 1024 + kt * 64);
    };
    auto swrite = [&](int buf) {
        unsigned char* Aw = smem + buf * 32768;
#pragma unroll
        for (int i = 0; i < NA; ++i) if (aon) *(u32x4*)(Aw + wofs + i * 4096) = ra[i];
#pragma unroll
        for (int i = 0; i < 4; ++i) *(u32x4*)(Aw + 16384 + wofs + i * 4096) = rb[i];
    };
    gload(0);
    swrite(0);
    __syncthreads();
    const int aro = fr * 128, bro = (wn * 32 + fr) * 128, sw = fr & 7;
    for (int kt = 0; kt < 16; ++kt) {
        const unsigned char* As = smem + (kt & 1) * 32768;
        const unsigned char* Bs = As + 16384;
        if (kt + 1 < 16) gload(kt + 1);
#pragma unroll
        for (int kk = 0; kk < 2; ++kk) {
            const int co = ((kk * 4 + fq) ^ sw) * 16;
            bf16x8 af[MI], bf[2];
#pragma unroll
            for (int i = 0; i < MI; ++i) af[i] = *(const bf16x8*)(As + aro + i * 2048 + co);
#pragma unroll
            for (int i = 0; i < 2; ++i) bf[i] = *(const bf16x8*)(Bs + bro + i * 2048 + co);
#pragma unroll
            for (int mi = 0; mi < MI; ++mi)
#pragma unroll
                for (int ni = 0; ni < 2; ++ni) acc[mi][ni] = __builtin_amdgcn_mfma_f32_16x16x32_bf16(bf[ni], af[mi], acc[mi][ni], 0, 0, 0);
        }
        if (kt + 1 < 16) swrite((kt + 1) & 1);
        __syncthreads();
    }
    const int nw = n0 + wn * 32;
    if (MODE == 0) {
#pragma unroll
        for (int mi = 0; mi < MI; ++mi) {
            const int tok = m0 + mi * 16 + fr;
            bf16_t* pr = p.proj + (size_t)tok * INW + nw + fq * 4;
#pragma unroll
            for (int ni = 0; ni < 2; ++ni) {
                u32x2 w;
                w.x = pk_bf16(acc[mi][ni][0], acc[mi][ni][1]);
                w.y = pk_bf16(acc[mi][ni][2], acc[mi][ni][3]);
                *(u32x2*)(pr + ni * 16) = w;
            }
        }
    } else {
        const int v = m0 < NCTX ? 0 : 1 + ((m0 - NCTX) >> 11);
        const float* gate = p.modv + (size_t)(layer * 5 + v) * 3072 + 2048 + nw + fq * 4;
        f32x4 gt[2];
#pragma unroll
        for (int ni = 0; ni < 2; ++ni) gt[ni] = *(const f32x4*)(gate + ni * 16);
#pragma unroll
        for (int mi = 0; mi < MI; ++mi) {
            const int tok = m0 + mi * 16 + fr;
            const float* ho = (layer == 0 ? (tok < NCTX ? p.x_prompt + (size_t)tok * DM : p.x_sample + (size_t)(tok - NCTX) * DM) : p.h + (size_t)tok * DM) + nw + fq * 4;
            float* hn = (layer == 0 ? p.h : p.out) + (size_t)tok * DM + nw + fq * 4;
#pragma unroll
            for (int ni = 0; ni < 2; ++ni) {
                const f32x4 o = *(const f32x4*)(ho + ni * 16);
                *(f32x4*)(hn + ni * 16) = o + gt[ni] * acc[mi][ni];
            }
        }
    }
}

template <int MODE>
__device__ __forceinline__ void phase_gemm(const Params& p, int layer, unsigned char* smem) {
    const int NT = MODE == 0 ? 22 : 8;
    const int total = 96 * NT;
    if (gridDim.x == 512) {
        const int xcd = blockIdx.x & 7, slot = blockIdx.x >> 3;
        const int nfull = MODE == 0 ? 264 : 64;
        for (int idx = slot; idx < nfull; idx += 64) gemm_tile<MODE>(p, layer, xcd * 12 + idx % 12, idx / 12, smem);
        if (MODE == 1) {
            const int idx = 64 + (slot >> 1);
            gemm_slice<1, 4>(p, layer, (xcd * 12 + idx % 12) * 128 + (slot & 1) * 64, (idx / 12) * 128, smem);
        }
    } else {
        for (int t = blockIdx.x; t < total; t += gridDim.x) gemm_tile<MODE>(p, layer, t / NT, t % NT, smem);
    }
}

template <int VAR>
__device__ __forceinline__ void attn_unit(const Params& p, int layer, int unit, unsigned char* smem) {
    const int tid = otid(), lane = tid & 63, wave = tid >> 6;
    const int r31 = lane & 31, hh = lane >> 5;
    int b, head, qblk, tokbase, nself, ntiles;
    if (unit < 512) { b = unit >> 7; head = (unit >> 4) & 7; qblk = unit & 15; tokbase = NCTX + b * 2048; nself = 2048; ntiles = 36; }
    else { const int u = unit - 512; b = u >> 4; head = (u >> 1) & 7; qblk = u & 1; tokbase = b * 256; nself = 256; ntiles = 4; }
    const int kvh = head >> 2;
    const int qtok = tokbase + qblk * 128 + wave * 32 + r31;
    bf16x8 qf[4];
    {
        const bf16_t* qp = p.proj + (size_t)qtok * INW + head * 64 + hh * 8;
#pragma unroll
        for (int ks = 0; ks < 4; ++ks) qf[ks] = *(const bf16x8*)(qp + ks * 16);
    }
    const bf16_t* kself = p.proj + (size_t)tokbase * INW + 512 + kvh * 64;
    const bf16_t* vself = p.proj + (size_t)tokbase * INW + 640 + kvh * 64;
    const bf16_t* kcache = p.kc + (size_t)((b * 2 + layer) * 2 + kvh) * 256 * 64;
    const bf16_t* vcache = p.vc + (size_t)((b * 2 + layer) * 2 + kvh) * 256 * 64;
    const int srow = tid >> 3, scc = tid & 7;
    const int kwo = srow * 128 + ((scc ^ ((srow >> 1) & 7)) * 16);
    const int vwo = srow * 128 + ((scc ^ (((srow >> 1) & 1) << 2)) * 16);
    u32x4 rkA[2], rvA[2], rkB[2], rvB[2];
    auto gload = [&](int j, u32x4* rk, u32x4* rv) {
        const int key0 = j * 64;
#pragma unroll
        for (int i = 0; i < 2; ++i) {
            const int row = srow + 32 * i;
            if (key0 < nself) {
                rk[i] = *(const u32x4*)(kself + (size_t)(key0 + row) * INW + scc * 8);
                rv[i] = *(const u32x4*)(vself + (size_t)(key0 + row) * INW + scc * 8);
            } else {
                rk[i] = *(const u32x4*)(kcache + (size_t)(key0 - nself + row) * 64 + scc * 8);
                rv[i] = *(const u32x4*)(vcache + (size_t)(key0 - nself + row) * 64 + scc * 8);
            }
        }
    };
    auto swrite = [&](int buf, const u32x4* rk, const u32x4* rv) {
        unsigned char* kb = smem + buf * 16384;
        unsigned char* vb = kb + 8192;
#pragma unroll
        for (int i = 0; i < 2; ++i) {
            *(u32x4*)(kb + kwo + i * 32 * 128) = rk[i];
            *(u32x4*)(vb + vwo + i * 32 * 128) = rv[i];
        }
    };
    f32x16 o[2];
#pragma unroll
    for (int i = 0; i < 16; ++i) { o[0][i] = 0.f; o[1][i] = 0.f; }
    float mrun = 0.f, mmax = -1e30f, lrun = 0.f;
    f32x16 negm, zero16;
#pragma unroll
    for (int i = 0; i < 16; ++i) { negm[i] = 0.f; zero16[i] = 0.f; }
    bool shifted = false;
    gload(0, rkA, rvA);
    swrite(0, rkA, rvA);
    if (ntiles > 1) gload(1, rkB, rvB);
    __syncthreads();
    const int kro = r31 * 128, ksw = (r31 >> 1) & 7;
    const int vq = 4 * hh + ((lane & 15) >> 2);
    const int vsw = ((vq >> 1) & 1) << 2;
    const int vcl = ((lane >> 4) & 1) * 2 + ((lane & 3) >> 1);
    const int vro0 = vq * 128 + (((0 * 4 + vcl) ^ vsw) * 16) + (lane & 1) * 8;
    const int vro1 = vq * 128 + (((1 * 4 + vcl) ^ vsw) * 16) + (lane & 1) * 8;
    auto step = [&](int j, u32x4* lk, u32x4* lv, const u32x4* wk, const u32x4* wv) {
        const unsigned char* kb = smem + (j & 1) * 16384;
        const unsigned char* vb = kb + 8192;
        bf16x8 kf[2][4];
#pragma unroll
        for (int sb = 0; sb < 2; ++sb)
#pragma unroll
            for (int ks = 0; ks < 4; ++ks) kf[sb][ks] = *(const bf16x8*)(kb + sb * 4096 + kro + (((ks * 2 + hh) ^ ksw) * 16));
        if (VAR != 1 && j + 2 < ntiles) gload(j + 2, lk, lv);
        __builtin_amdgcn_sched_barrier(0);
        f32x16 s[2];
#pragma unroll
        for (int ks = 0; ks < 4; ++ks)
#pragma unroll
            for (int sb = 0; sb < 2; ++sb) {
                if (ks == 0) {
                    if (shifted) s[sb] = __builtin_amdgcn_mfma_f32_32x32x16_bf16(kf[sb][ks], qf[ks], negm, 0, 0, 0);
                    else s[sb] = __builtin_amdgcn_mfma_f32_32x32x16_bf16(kf[sb][ks], qf[ks], zero16, 0, 0, 0);
                } else s[sb] = __builtin_amdgcn_mfma_f32_32x32x16_bf16(kf[sb][ks], qf[ks], s[sb], 0, 0, 0);
            }
        __builtin_amdgcn_sched_barrier(0);
        bf16x8 vf[2][2][2];
#pragma unroll
        for (int sb = 0; sb < 2; ++sb)
#pragma unroll
            for (int s2 = 0; s2 < 2; ++s2)
#pragma unroll
                for (int dt = 0; dt < 2; ++dt) {
                    const LAS unsigned char* va = (const LAS unsigned char*)(vb) + (sb * 32 + s2 * 16) * 128 + (dt ? vro1 : vro0);
                    const s16x4 a0 = __builtin_amdgcn_ds_read_tr16_b64_v4i16((LAS s16x4*)(va));
                    const s16x4 a1 = __builtin_amdgcn_ds_read_tr16_b64_v4i16((LAS s16x4*)(va + 8 * 128));
                    vf[sb][s2][dt] = (bf16x8){a0[0], a0[1], a0[2], a0[3], a1[0], a1[1], a1[2], a1[3]};
                }
        __builtin_amdgcn_sched_barrier(0);
        float mloc = max3_f(s[0][0], s[1][0], s[0][1]);
        mloc = max3_f(mloc, s[1][1], s[0][2]);
#pragma unroll
        for (int i = 2; i < 16; ++i) mloc = max3_f(mloc, s[1][i], s[0][(i + 1) & 15]);
        float lsum = 0.f;
#pragma unroll
        for (int sb = 0; sb < 2; ++sb)
#pragma unroll
            for (int i = 0; i < 16; ++i) { if (VAR != 2) { s[sb][i] = __builtin_amdgcn_exp2f(s[sb][i]); lsum += s[sb][i]; } }
        lrun += lsum;
        bf16x8 pf[2][2];
#pragma unroll
        for (int sb = 0; sb < 2; ++sb)
#pragma unroll
            for (int s2 = 0; s2 < 2; ++s2) {
                u32x4 pw;
                pw.x = pk_bf16(s[sb][s2 * 8 + 0], s[sb][s2 * 8 + 1]);
                pw.y = pk_bf16(s[sb][s2 * 8 + 2], s[sb][s2 * 8 + 3]);
                pw.z = pk_bf16(s[sb][s2 * 8 + 4], s[sb][s2 * 8 + 5]);
                pw.w = pk_bf16(s[sb][s2 * 8 + 6], s[sb][s2 * 8 + 7]);
                pf[sb][s2] = __builtin_bit_cast(bf16x8, pw);
            }
        __builtin_amdgcn_sched_barrier(0);
#pragma unroll
        for (int sb = 0; sb < 2; ++sb)
#pragma unroll
            for (int s2 = 0; s2 < 2; ++s2)
#pragma unroll
                for (int dt = 0; dt < 2; ++dt) o[dt] = __builtin_amdgcn_mfma_f32_32x32x16_bf16(vf[sb][s2][dt], pf[sb][s2], o[dt], 0, 0, 0);
        __builtin_amdgcn_sched_barrier(0);
        mloc = fmaxf(mloc, __shfl_xor(mloc, 32));
        mmax = fmaxf(mmax, mrun + mloc);
        if (__builtin_expect(__any(fabsf(mmax - mrun) > 40.0f), 0)) {
            asm volatile("" ::: "memory");
            const float alpha = __builtin_amdgcn_exp2f(mrun - mmax);
            mrun = mmax;
            lrun *= alpha;
            shifted = true;
#pragma unroll
            for (int i = 0; i < 16; ++i) { o[0][i] *= alpha; o[1][i] *= alpha; negm[i] = -mrun; }
        }
        if (VAR != 1 && j + 1 < ntiles) swrite((j + 1) & 1, wk, wv);
        __syncthreads();
    };
    for (int j = 0; j < ntiles; j += 2) {
        step(j, rkA, rvA, rkB, rvB);
        step(j + 1, rkB, rvB, rkA, rvA);
    }
    const float ltot = lrun + __shfl_xor(lrun, 32);
    const float inv = 1.0f / ltot;
    const bf16_t* zp = p.proj + (size_t)qtok * INW + 768 + head * 64;
    bf16_t* mp = (VAR == 0 ? p.mix : p.xn) + (size_t)qtok * DM + head * 64;
#pragma unroll
    for (int dt = 0; dt < 2; ++dt)
#pragma unroll
        for (int rq = 0; rq < 4; ++rq) {
            const int d0 = dt * 32 + 8 * rq + 4 * hh;
            const u32x2 zz = *(const u32x2*)(zp + d0);
            const float z0 = bf_lo(zz.x), z1 = bf_hi(zz.x), z2 = bf_lo(zz.y), z3 = bf_hi(zz.y);
            u32x2 w;
            w.x = pk_bf16(o[dt][rq * 4 + 0] * inv * silu_f(z0), o[dt][rq * 4 + 1] * inv * silu_f(z1));
            w.y = pk_bf16(o[dt][rq * 4 + 2] * inv * silu_f(z2), o[dt][rq * 4 + 3] * inv * silu_f(z3));
            *(u32x2*)(mp + d0) = w;
        }
}

__device__ __forceinline__ void unpack8(const u32x4 u, float* f) {
    f[0] = bf_lo(u.x); f[1] = bf_hi(u.x); f[2] = bf_lo(u.y); f[3] = bf_hi(u.y);
    f[4] = bf_lo(u.z); f[5] = bf_hi(u.z); f[6] = bf_lo(u.w); f[7] = bf_hi(u.w);
}

__device__ __forceinline__ void pool_item(const Params& p, int layer, int pi, unsigned char* smem) {
    const int tid = otid(), lane = tid & 63, gi = tid >> 6;
    const int fr = lane & 15, fq = lane >> 4;
    const int T0 = pi * 32;
    int seqstart, seqlen;
    if (T0 < NCTX) { seqstart = T0 & ~255; seqlen = 256; } else { seqstart = NCTX + ((T0 - NCTX) & ~2047); seqlen = 2048; }
    const int toff = T0 - seqstart;
    {
        u32x4 st[6];
#pragma unroll
        for (int i = 0; i < 6; ++i) {
            const int e = tid + 256 * i, r = e >> 5, c = e & 31;
            int sq = toff - 8 + r;
            sq = sq < 0 ? 0 : (sq > seqlen - 1 ? seqlen - 1 : sq);
            if (e < 47 * 32) st[i] = *(const u32x4*)(p.proj + (size_t)(seqstart + sq) * INW + 2304 + c * 8);
        }
#pragma unroll
        for (int i = 0; i < 6; ++i) {
            const int e = tid + 256 * i, r = e >> 5, c = e & 31;
            if (e < 47 * 32) *(u32x4*)(smem + r * 528 + c * 16) = st[i];
        }
    }
    __syncthreads();
    const int win = 2 << gi, half = win >> 1;
    bf16x8 wf[4][2];
    {
        const bf16_t* wp = p.PoolT + (size_t)((layer * 4 + gi) * 64) * 64;
#pragma unroll
        for (int ni = 0; ni < 4; ++ni)
#pragma unroll
            for (int kk = 0; kk < 2; ++kk) wf[ni][kk] = *(const bf16x8*)(wp + (ni * 16 + fr) * 64 + kk * 32 + fq * 8);
    }
#pragma unroll 1
    for (int mi = 0; mi < 2; ++mi) {
        f32x4 acc[4];
#pragma unroll
        for (int j = 0; j < 4; ++j) acc[j] = (f32x4){0.f, 0.f, 0.f, 0.f};
        const int tt = mi * 16 + fr;
        const int ts = toff + tt;
        int lo = ts - half, hi = ts - half + win - 1;
        lo = lo < 0 ? 0 : lo;
        hi = hi > seqlen - 1 ? seqlen - 1 : hi;
        const float rc = 1.0f / (float)(hi - lo + 1);
        const int r0 = lo - toff + 8, r1 = hi - toff + 8, rs = tt + 8;
#pragma unroll
        for (int kk = 0; kk < 2; ++kk) {
            const int co = (gi * 64 + kk * 32 + fq * 8) * 2;
            float sum[8];
#pragma unroll
            for (int e = 0; e < 8; ++e) sum[e] = 0.f;
            for (int r = r0; r <= r1; ++r) {
                float f[8];
                unpack8(*(const u32x4*)(smem + r * 528 + co), f);
#pragma unroll
                for (int e = 0; e < 8; ++e) sum[e] += f[e];
            }
            float us[8];
            unpack8(*(const u32x4*)(smem + rs * 528 + co), us);
            u32x4 dw;
            dw.x = pk_bf16(sum[0] * rc - us[0], sum[1] * rc - us[1]);
            dw.y = pk_bf16(sum[2] * rc - us[2], sum[3] * rc - us[3]);
            dw.z = pk_bf16(sum[4] * rc - us[4], sum[5] * rc - us[5]);
            dw.w = pk_bf16(sum[6] * rc - us[6], sum[7] * rc - us[7]);
            const bf16x8 df = __builtin_bit_cast(bf16x8, dw);
#pragma unroll
            for (int ni = 0; ni < 4; ++ni) acc[ni] = __builtin_amdgcn_mfma_f32_16x16x32_bf16(wf[ni][kk], df, acc[ni], 0, 0, 0);
        }
        const int tok = T0 + tt;
#pragma unroll
        for (int ni = 0; ni < 4; ++ni) {
            const int ch = gi * 64 + ni * 16 + fq * 4;
            const f32x4 ps = *(const f32x4*)(p.pool_scale + layer * 256 + ch);
            const u32x2 zz = *(const u32x2*)(p.proj + (size_t)tok * INW + 2560 + ch);
            u32x2 w;
            w.x = pk_bf16(acc[ni][0] * ps[0] * silu_f(bf_lo(zz.x)), acc[ni][1] * ps[1] * silu_f(bf_hi(zz.x)));
            w.y = pk_bf16(acc[ni][2] * ps[2] * silu_f(bf_lo(zz.y)), acc[ni][3] * ps[3] * silu_f(bf_hi(zz.y)));
            *(u32x2*)(p.mix + (size_t)tok * DM + 768 + ch) = w;
        }
    }
    __syncthreads();
}

__device__ __forceinline__ void conv_item(const Params& p, int layer, int ci) {
    const int tid = otid();
    const int ch = (tid & 31) * 8, tg = tid >> 5;
    const int T0 = ci * 32 + tg * 4;
    int seqstart, seqlen;
    if (T0 < NCTX) { seqstart = T0 & ~255; seqlen = 256; } else { seqstart = NCTX + ((T0 - NCTX) & ~2047); seqlen = 2048; }
    const int seqend = seqstart + seqlen;
    u32x4 rh[6], rc[6], rb[4], rz[4];
#pragma unroll
    for (int i = 0; i < 6; ++i) {
        int tok = T0 - 1 + i;
        tok = tok < seqstart ? seqstart : (tok > seqend - 1 ? seqend - 1 : tok);
        rh[i] = *(const u32x4*)(p.proj + (size_t)tok * INW + 1280 + ch);
        rc[i] = *(const u32x4*)(p.proj + (size_t)tok * INW + 1792 + ch);
    }
#pragma unroll
    for (int i = 0; i < 4; ++i) {
        rb[i] = *(const u32x4*)(p.proj + (size_t)(T0 + i) * INW + 1536 + ch);
        rz[i] = *(const u32x4*)(p.proj + (size_t)(T0 + i) * INW + 2048 + ch);
    }
    float w0[8], w1[8], w2[8], bb[8];
    {
        const float* cw = p.conv_w + (size_t)layer * 768 + ch;
#pragma unroll
        for (int e = 0; e < 8; ++e) { w0[e] = cw[e]; w1[e] = cw[256 + e]; w2[e] = cw[512 + e]; bb[e] = p.conv_b[layer * 256 + ch + e]; }
    }
    float x[6][8];
#pragma unroll
    for (int i = 0; i < 6; ++i) {
        const int tok = T0 - 1 + i;
        const float valid = (tok >= seqstart && tok < seqend) ? 1.0f : 0.0f;
        float hc[8], cc[8];
        unpack8(rh[i], hc);
        unpack8(rc[i], cc);
#pragma unroll
        for (int e = 0; e < 8; ++e) x[i][e] = hc[e] * cc[e] * valid;
    }
#pragma unroll
    for (int t = 0; t < 4; ++t) {
        float bc[8], zc[8], o[8];
        unpack8(rb[t], bc);
        unpack8(rz[t], zc);
#pragma unroll
        for (int e = 0; e < 8; ++e) {
            const float y = x[t][e] * w0[e] + x[t + 1][e] * w1[e] + x[t + 2][e] * w2[e] + bb[e];
            o[e] = bc[e] * y * silu_f(zc[e]);
        }
        u32x4 w;
        w.x = pk_bf16(o[0], o[1]); w.y = pk_bf16(o[2], o[3]); w.z = pk_bf16(o[4], o[5]); w.w = pk_bf16(o[6], o[7]);
        *(u32x4*)(p.mix + (size_t)(T0 + t) * DM + 512 + ch) = w;
    }
}

__device__ __forceinline__ void phase_mixer(const Params& p, int layer, unsigned char* smem) {
    if (gridDim.x == 512) {
        const int b = blockIdx.x;
        attn_unit<0>(p, layer, b, smem);
#ifdef REP_VAR
        attn_unit<REP_VAR>(p, layer, b, smem);
#endif
        if (b < 256) {
            attn_unit<0>(p, layer, 512 + b, smem);
        } else {
#pragma unroll 1
            for (int k = 0; k < 3; ++k) {
                const int idx = (b - 256) + 256 * k;
                if (idx < 384) pool_item(p, layer, idx, smem);
                else conv_item(p, layer, idx - 384);
            }
        }
    } else {
        for (int it = blockIdx.x; it < 768 + 384 + 384; it += gridDim.x) {
            if (it < 768) attn_unit<0>(p, layer, it, smem);
            else if (it < 1152) pool_item(p, layer, it - 768, smem);
            else conv_item(p, layer, it - 1152);
        }
    }
}

__global__ void __launch_bounds__(256, 2) mega(Params p, int lo, int hi) {
    __shared__ __attribute__((aligned(16))) unsigned char smem[65536];
    __shared__ uint4 xbw;
    if (p.use_cg) cg::this_grid().sync();
    if (threadIdx.x == 0) xbw = make_uint4(0u, 0u, 0u, 0u);
    __syncthreads();
    XcdBarrier xb = xcd_barrier_post(p.bar, (volatile LAS unsigned*)&xbw);
    for (int ph = lo; ph < hi; ++ph) {
        if (ph > lo) xcd_barrier(xb);
        int reps = 1;
#ifdef REP_MASK
        {
            const int tyy = ph == 0 ? 4 : ph == 9 ? 5 : ((ph - 1) & 3);
            if ((REP_MASK >> tyy) & 1) reps = 2;
        }
#endif
        for (int rep = 0; rep < reps; ++rep) {
            if (rep > 0) xcd_barrier(xb);
            if (ph == 0) phase_prep(p, smem);
            else if (ph == 9) phase_final(p);
            else {
                const int layer = (ph - 1) >> 2, ty = (ph - 1) & 3;
                if (ty == 0) phase_xn(p, layer);
                else if (ty == 1) phase_gemm<0>(p, layer, smem);
                else if (ty == 2) phase_mixer(p, layer, smem);
                else phase_gemm<1>(p, layer, smem);
            }
        }
    }
}

#ifndef MK_MULTI
#define MK_MULTI 0
#endif

extern "C" void kernel_launch(void* const* d_in, const int* in_sizes, int n_in, void* d_out, int out_size, void* d_ws, size_t ws_size,
                              hipStream_t stream) {
    static int grid_blocks = 0;
    if (!grid_blocks) {
        int dev = 0, cus = 0, per_cu = 0;
        hipGetDevice(&dev);
        hipDeviceGetAttribute(&cus, hipDeviceAttributeMultiprocessorCount, dev);
        hipOccupancyMaxActiveBlocksPerMultiprocessor(&per_cu, mega, 256, 0);
        if (per_cu > 2) per_cu = 2;
        if (per_cu < 1) per_cu = 1;
        grid_blocks = cus * per_cu;
    }
    Params p{};
    const float* const* in = (const float* const*)d_in;
    p.x_prompt = in[0]; p.x_sample = in[1]; p.cache_k = in[2]; p.cache_v = in[3]; p.c = in[4]; p.c_ctx = in[5]; p.norm_g = in[6];
    p.w_ada = in[7]; p.b_ada = in[8]; p.w_in = in[9]; p.q_g = in[10]; p.k_g = in[11]; p.conv_w = in[12]; p.conv_b = in[13];
    p.pool_w = in[14]; p.pool_scale = in[15]; p.w_out = in[16]; p.final_g = in[17];
    p.out = (float*)d_out;
    unsigned char* ws = (unsigned char*)d_ws;
    size_t off = 0;
    auto take = [&](size_t bytes) { unsigned char* r = ws + off; off += (bytes + 255) & ~(size_t)255; return r; };
    p.bar = (unsigned*)take(XCD_BAR_WORDS * 4);
    p.modv = (float*)take(2 * 5 * 3072 * 4);
    p.rope = (float*)take(2048 * 4);
    p.WinT = (bf16_t*)take((size_t)2 * INW * 1024 * 2);
    p.WoutT = (bf16_t*)take((size_t)2 * 1024 * 1024 * 2);
    p.PoolT = (bf16_t*)take(2 * 4 * 64 * 64 * 2);
    p.kc = (bf16_t*)take(262144 * 2);
    p.vc = (bf16_t*)take(262144 * 2);
    p.h = (float*)take((size_t)NTOK * DM * 4);
    p.xn = (bf16_t*)take((size_t)NTOK * DM * 2);
    p.proj = (bf16_t*)take((size_t)NTOK * INW * 2);
    p.mix = (bf16_t*)take((size_t)NTOK * DM * 2);
    p.use_cg = 0;
    p.pad = 0;
    hipMemsetAsync(p.bar, 0, XCD_BAR_WORDS * 4, stream);
#if MK_MULTI
    for (int ph = 0; ph < 10; ++ph) {
        int lo = ph, hi = ph + 1;
        void* args[] = {&p, &lo, &hi};
        hipError_t e = hipLaunchCooperativeKernel((void*)mega, dim3(grid_blocks), dim3(256), args, 0, stream);
        if (e != hipSuccess) fprintf(stderr, "launch failed: %s\n", hipGetErrorString(e));
    }
#else
    int lo = 0, hi = 10;
    void* args[] = {&p, &lo, &hi};
    hipError_t e = hipLaunchCooperativeKernel((void*)mega, dim3(grid_blocks), dim3(256), args, 0, stream);
    if (e != hipSuccess) fprintf(stderr, "cooperative launch failed: %s (grid %d)\n", hipGetErrorString(e), grid_blocks);
#endif
}
```

```cpp
#include <hip/hip_runtime.h>
#include <hip/hip_cooperative_groups.h>
#include <cstdint>
#include <cstdio>
namespace cg = cooperative_groups;

#define LAS __attribute__((address_space(3)))
typedef unsigned short bf16_t;
typedef short bf16x8 __attribute__((ext_vector_type(8)));
typedef short s16x4 __attribute__((ext_vector_type(4)));
typedef float f32x4 __attribute__((ext_vector_type(4)));
typedef float f32x16 __attribute__((ext_vector_type(16)));
typedef unsigned u32x4 __attribute__((ext_vector_type(4)));
typedef unsigned u32x2 __attribute__((ext_vector_type(2)));

constexpr int NTOK = 12288, NCTX = 4096, DM = 1024, INW = 2816;
constexpr size_t OUT_NK = 12582912, OUT_NV = 13631488;
constexpr float EPSF = 1e-6f;
constexpr float QSCALE = 0.125f * 1.4426950408889634f;

struct Params {
    const float *x_prompt, *x_sample, *cache_k, *cache_v, *c, *c_ctx, *norm_g, *w_ada, *b_ada, *w_in, *q_g, *k_g, *conv_w, *conv_b,
        *pool_w, *pool_scale, *w_out, *final_g;
    float* out;
    unsigned* bar;
    float* modv;
    float* rope;
    bf16_t* WinT;
    bf16_t* WoutT;
    bf16_t* PoolT;
    bf16_t* kc;
    bf16_t* vc;
    float* h;
    bf16_t* xn;
    bf16_t* proj;
    bf16_t* mix;
    int use_cg;
    int pad;
};

__device__ __forceinline__ unsigned pk_bf16(float lo, float hi) {
    unsigned r;
    asm("v_cvt_pk_bf16_f32 %0, %1, %2" : "=v"(r) : "v"(lo), "v"(hi));
    return r;
}
__device__ __forceinline__ float bf_lo(unsigned u) { return __uint_as_float(u << 16); }
__device__ __forceinline__ float bf_hi(unsigned u) { return __uint_as_float(u & 0xffff0000u); }
__device__ __forceinline__ float silu_f(float z) { return z / (1.0f + __expf(-z)); }
__device__ __forceinline__ float max3_f(float a, float b, float c) { float r; asm("v_max3_f32 %0, %1, %2, %3" : "=v"(r) : "v"(a), "v"(b), "v"(c)); return r; }
__device__ __forceinline__ int otid() { int t = threadIdx.x; asm volatile("" : "+v"(t)); return t; }

#define XB_TMO 128
#define XB_XCNT(j) (256 + 64 * (j))
#define XB_XSUB(j) (1280 + 64 * (j))
#define XB_XGEN(j) (2304 + 64 * (j))
#define XB_TOP 3328
#define XB_TOPGEN 3392
#define XCD_BAR_WORDS 3456
#define XB_SPIN_CAP (1u << 20)

__device__ __forceinline__ unsigned xb_ld(unsigned* p) { return __hip_atomic_load(p, __ATOMIC_RELAXED, __HIP_MEMORY_SCOPE_AGENT); }
__device__ __forceinline__ unsigned xb_add(unsigned* p, unsigned v) { return __hip_atomic_fetch_add(p, v, __ATOMIC_RELAXED, __HIP_MEMORY_SCOPE_AGENT); }
__device__ __forceinline__ unsigned xb_xcc_id() { return (unsigned)__builtin_amdgcn_s_getreg((3 << 11) | 20) & 0xFu; }
#define XB_SPIN(cond, bar)                                                   \
    do {                                                                     \
        unsigned _sp = 0;                                                    \
        while (cond) {                                                       \
            __builtin_amdgcn_s_sleep(1);                                     \
            if ((++_sp & 255u) == 0u) {                                      \
                if (xb_ld(&(bar)[XB_TMO])) break;                            \
                if (_sp > XB_SPIN_CAP) { atomicAdd(&(bar)[XB_TMO], 1u); break; } \
            }                                                                \
        }                                                                    \
    } while (0)

struct XcdBarrier {
    unsigned* bar;
    unsigned x;
    volatile LAS unsigned* st;
};

__device__ __forceinline__ XcdBarrier xcd_barrier_post(unsigned* bar, volatile LAS unsigned* st) {
    XcdBarrier b;
    b.bar = bar;
    b.x = xb_xcc_id();
    b.st = st;
    if (threadIdx.x == 0) (void)xb_add(&bar[XB_XCNT(b.x)], 1u);
    return b;
}
__device__ __forceinline__ void xcd_barrier_complete(unsigned* bar, unsigned x, unsigned& nloc, unsigned& nx) {
    const unsigned G = gridDim.x * gridDim.y * gridDim.z;
    unsigned sum, cnt, mine, sp = 0u;
    for (;;) {
        sum = 0u; cnt = 0u; mine = 0u;
#pragma unroll
        for (unsigned j = 0; j < 16; ++j) {
            const unsigned c = xb_ld(&bar[XB_XCNT(j)]);
            sum += c; cnt += (c > 0u) ? 1u : 0u; mine = (j == x) ? c : mine;
        }
        if (sum == G) break;
        __builtin_amdgcn_s_sleep(1);
        if ((++sp & 255u) == 0u) {
            if (xb_ld(&bar[XB_TMO])) break;
            if (sp > XB_SPIN_CAP) { atomicAdd(&bar[XB_TMO], 1u); break; }
        }
    }
    nloc = mine > 0u ? mine : 1u;
    nx = cnt > 0u ? cnt : 1u;
}
__device__ __forceinline__ void xcd_barrier(const XcdBarrier& b) {
    asm volatile("s_waitcnt vmcnt(0)" ::: "memory");
    __syncthreads();
    if (threadIdx.x == 0) {
        unsigned* bar = b.bar;
        __builtin_amdgcn_s_waitcnt(0);
        unsigned nloc = b.st[0], nx = b.st[1];
        if (nloc == 0u) { xcd_barrier_complete(bar, b.x, nloc, nx); b.st[0] = nloc; b.st[1] = nx; }
        const unsigned old = xb_add(&bar[XB_XSUB(b.x)], 1u);
        const unsigned gen = old / nloc;
        if (old + 1u == (gen + 1u) * nloc) {
            __builtin_amdgcn_fence(__ATOMIC_RELEASE, "agent");
            asm volatile("s_waitcnt vmcnt(0)" ::: "memory");
            const unsigned og = xb_add(&bar[XB_TOP], 1u);
            const unsigned tg = og / nx;
            if (og + 1u == (tg + 1u) * nx) xb_add(&bar[XB_TOPGEN], 1u);
            else XB_SPIN(xb_ld(&bar[XB_TOPGEN]) == tg, bar);
            __builtin_amdgcn_fence(__ATOMIC_ACQUIRE, "agent");
            xb_add(&bar[XB_XGEN(b.x)], 1u);
            asm volatile("s_waitcnt vmcnt(0)" ::: "memory");
        } else {
            XB_SPIN(xb_ld(&bar[XB_XGEN(b.x)]) == gen, bar);
            __builtin_amdgcn_fence(__ATOMIC_ACQUIRE, "agent");
            asm volatile("s_waitcnt vmcnt(0)" ::: "memory");
        }
    }
    __syncthreads();
}

__device__ __forceinline__ void prep_mod_item(const Params& p, int item, unsigned char* smem) {
    const int tid = otid();
    float* sc = (float*)smem;
    float* red = (float*)(smem + 20480);
    const int l = item / 96, j0 = (item % 96) * 32;
    for (int idx = tid; idx < 5120; idx += 256) {
        const int v = idx >> 10, k = idx & 1023;
        const float cv = (v == 0) ? p.c_ctx[k] : p.c[(v - 1) * 1024 + k];
        sc[idx] = cv / (1.0f + expf(-cv));
    }
    __syncthreads();
    const int cgp = tid & 7, kg = tid >> 3;
    float acc[5][4];
#pragma unroll
    for (int v = 0; v < 5; ++v)
#pragma unroll
        for (int e = 0; e < 4; ++e) acc[v][e] = 0.f;
    const float* wp = p.w_ada + (size_t)l * 1024 * 3072 + j0 + cgp * 4;
#pragma unroll 8
    for (int kk = 0; kk < 32; ++kk) {
        const int k = kk * 32 + kg;
        const f32x4 w = *(const f32x4*)(wp + (size_t)k * 3072);
#pragma unroll
        for (int v = 0; v < 5; ++v) {
            const float s = sc[v * 1024 + k];
#pragma unroll
            for (int e = 0; e < 4; ++e) acc[v][e] += s * w[e];
        }
    }
#pragma unroll
    for (int v = 0; v < 5; ++v)
#pragma unroll
        for (int e = 0; e < 4; ++e) red[kg * 160 + v * 32 + cgp * 4 + e] = acc[v][e];
    __syncthreads();
    if (tid < 160) {
        float s = 0.f;
        for (int g = 0; g < 32; ++g) s += red[g * 160 + tid];
        const int v = tid >> 5, cc = tid & 31;
        p.modv[(size_t)(l * 5 + v) * 3072 + j0 + cc] = s + p.b_ada[l * 3072 + j0 + cc];
    }
    __syncthreads();
}

__device__ __forceinline__ void prep_transpose_tile(const float* src, bf16_t* dst, int N, int k0, int n0, unsigned char* smem) {
    const int tid = otid();
    bf16_t* T = (bf16_t*)smem;
    {
        const int row = tid >> 2, seg = tid & 3;
        const float* s = src + (size_t)(k0 + row) * N + n0 + seg * 16;
        f32x4 v[4];
#pragma unroll
        for (int i = 0; i < 4; ++i) v[i] = *(const f32x4*)(s + i * 4);
#pragma unroll
        for (int i = 0; i < 4; ++i)
#pragma unroll
            for (int e = 0; e < 4; ++e) {
                const unsigned u = pk_bf16(v[i][e], 0.f);
                T[(seg * 16 + i * 4 + e) * 72 + row] = (bf16_t)(u & 0xffffu);
            }
    }
    __syncthreads();
    {
        const int n = tid >> 2, seg = tid & 3;
        const u32x4 a = *(const u32x4*)(T + n * 72 + seg * 16);
        const u32x4 b = *(const u32x4*)(T + n * 72 + seg * 16 + 8);
        bf16_t* d = dst + (size_t)(n0 + n) * 1024 + k0 + seg * 16;
        *(u32x4*)d = a;
        *(u32x4*)(d + 8) = b;
    }
    __syncthreads();
}

__device__ __forceinline__ void phase_prep(const Params& p, unsigned char* smem) {
    const int NMOD = 192, NTI = 2 * 16 * 44, NTO = 2 * 16 * 16;
    for (int it = blockIdx.x; it < NMOD + NTI + NTO; it += gridDim.x) {
        if (it < NMOD) {
            prep_mod_item(p, it, smem);
        } else if (it < NMOD + NTI) {
            const int t = it - NMOD, l = t / 704, r = t % 704, kt = r / 44, nt = r % 44;
            prep_transpose_tile(p.w_in + (size_t)l * 1024 * INW, p.WinT + (size_t)l * INW * 1024, INW, kt * 64, nt * 64, smem);
        } else {
            const int t = it - NMOD - NTI, l = t / 256, r = t % 256, kt = r / 16, nt = r % 16;
            prep_transpose_tile(p.w_out + (size_t)l * 1024 * 1024, p.WoutT + (size_t)l * 1024 * 1024, 1024, kt * 64, nt * 64, smem);
        }
    }
    const int gsz = gridDim.x * 256;
    for (int i = blockIdx.x * 256 + otid(); i < 558080; i += gsz) {
        if (i < 524288) {
            const int which = i >> 18, j = i & 262143;
            const int d = j & 63, t = (j >> 6) & 255, kvh = (j >> 14) & 1, bl = j >> 15;
            const size_t si = ((size_t)(bl * 256 + t) * 2 + kvh) * 64 + d;
            const float v = which ? p.cache_v[si] : p.cache_k[si];
            (which ? p.vc : p.kc)[j] = (bf16_t)(pk_bf16(v, 0.f) & 0xffffu);
        } else if (i < 524288 + 32768) {
            const int j = i - 524288;
            const int cc = j & 63, d = (j >> 6) & 63, lg = j >> 12;
            const float v = p.pool_w[((size_t)lg * 64 + cc) * 64 + d];
            p.PoolT[j] = (bf16_t)(pk_bf16(v, 0.f) & 0xffffu);
        } else {
            const int j = i - 524288 - 32768;
            const int a = j & 15, r = j >> 4;
            const float inv = 1.0f / powf(10000.0f, (float)(2 * a) / 32.0f);
            const float ang = (float)r * inv;
            const float kf = rintf(ang * 0.15915494309189535f);
            float rr = fmaf(-kf, 6.2831854820251465f, ang);
            rr = fmaf(-kf, -1.7484555e-7f, rr);
            p.rope[j] = cosf(rr);
            p.rope[1024 + j] = sinf(rr);
        }
    }
}

__device__ __forceinline__ float wave_sum(float v) {
#pragma unroll
    for (int o = 32; o >= 1; o >>= 1) v += __shfl_xor(v, o);
    return v;
}

__device__ __forceinline__ void phase_xn(const Params& p, int layer) {
    const int tid = otid(), lane = tid & 63, wave = tid >> 6;
    for (int tok = blockIdx.x * 4 + wave; tok < NTOK; tok += gridDim.x * 4) {
        const float* src = layer == 0 ? (tok < NCTX ? p.x_prompt + (size_t)tok * DM : p.x_sample + (size_t)(tok - NCTX) * DM) : p.h + (size_t)tok * DM;
        const int v = tok < NCTX ? 0 : 1 + ((tok - NCTX) >> 11);
        const float* mv = p.modv + (size_t)(layer * 5 + v) * 3072;
        f32x4 x[4];
        float ss = 0.f;
#pragma unroll
        for (int i = 0; i < 4; ++i) {
            x[i] = *(const f32x4*)(src + i * 256 + lane * 4);
            ss += x[i][0] * x[i][0] + x[i][1] * x[i][1] + x[i][2] * x[i][2] + x[i][3] * x[i][3];
        }
        ss = wave_sum(ss);
        const float rstd = rsqrtf(ss * (1.0f / 1024.0f) + EPSF);
#pragma unroll
        for (int i = 0; i < 4; ++i) {
            const int k = i * 256 + lane * 4;
            const f32x4 g = *(const f32x4*)(p.norm_g + layer * 1024 + k);
            const f32x4 sh = *(const f32x4*)(mv + k);
            const f32x4 sc = *(const f32x4*)(mv + 1024 + k);
            float o[4];
#pragma unroll
            for (int e = 0; e < 4; ++e) o[e] = x[i][e] * rstd * g[e] * (1.0f + sc[e]) + sh[e];
            u32x2 w;
            w.x = pk_bf16(o[0], o[1]);
            w.y = pk_bf16(o[2], o[3]);
            *(u32x2*)(p.xn + (size_t)tok * DM + k) = w;
        }
    }
}

__device__ __forceinline__ void phase_final(const Params& p) {
    const int tid = otid(), lane = tid & 63, wave = tid >> 6;
    for (int tok = blockIdx.x * 4 + wave; tok < NTOK; tok += gridDim.x * 4) {
        float* row = p.out + (size_t)tok * DM;
        f32x4 x[4];
        float ss = 0.f;
#pragma unroll
        for (int i = 0; i < 4; ++i) {
            x[i] = *(const f32x4*)(row + i * 256 + lane * 4);
            ss += x[i][0] * x[i][0] + x[i][1] * x[i][1] + x[i][2] * x[i][2] + x[i][3] * x[i][3];
        }
        ss = wave_sum(ss);
        const float rstd = rsqrtf(ss * (1.0f / 1024.0f) + EPSF);
#pragma unroll
        for (int i = 0; i < 4; ++i) {
            const int k = i * 256 + lane * 4;
            const f32x4 g = *(const f32x4*)(p.final_g + k);
            f32x4 o;
#pragma unroll
            for (int e = 0; e < 4; ++e) o[e] = x[i][e] * rstd * g[e];
            *(f32x4*)(row + k) = o;
        }
    }
}

template <int MODE>
__device__ __forceinline__ void gemm_tile(const Params& p, int layer, int mt, int nt, unsigned char* smem) {
    const int tid = otid(), lane = tid & 63, wave = tid >> 6, wm = wave >> 1, wn = wave & 1;
    const int fr = lane & 15, fq = lane >> 4;
    const int m0 = mt * 128, n0 = nt * 128;
    const bf16_t* A = (MODE == 0 ? p.xn : p.mix) + (size_t)m0 * 1024;
    const bf16_t* B = (MODE == 0 ? p.WinT + (size_t)layer * INW * 1024 : p.WoutT + (size_t)layer * 1024 * 1024) + (size_t)n0 * 1024;
    f32x4 acc[4][4];
#pragma unroll
    for (int i = 0; i < 4; ++i)
#pragma unroll
        for (int j = 0; j < 4; ++j) acc[i][j] = (f32x4){0.f, 0.f, 0.f, 0.f};

    const int srow = tid >> 3, scc = tid & 7;
    const bf16_t* ag = A + (size_t)srow * 1024 + scc * 8;
    const bf16_t* bg = B + (size_t)srow * 1024 + scc * 8;
    const int wofs = srow * 128 + ((scc ^ (srow & 7)) * 16);
    u32x4 raA[4], rbA[4], raB[4], rbB[4];
    auto gload = [&](int kt, u32x4* ra, u32x4* rb) {
#pragma unroll
        for (int i = 0; i < 4; ++i) {
            ra[i] = *(const u32x4*)(ag + (size_t)i * 32 * 1024 + kt * 64);
            rb[i] = *(const u32x4*)(bg + (size_t)i * 32 * 1024 + kt * 64);
        }
    };
    auto swrite = [&](int buf, const u32x4* ra, const u32x4* rb) {
        unsigned char* Aw = smem + buf * 32768;
#pragma unroll
        for (int i = 0; i < 4; ++i) {
            *(u32x4*)(Aw + wofs + i * 4096) = ra[i];
            *(u32x4*)(Aw + 16384 + wofs + i * 4096) = rb[i];
        }
    };
    gload(0, raA, rbA);
    gload(1, raB, rbB);
    swrite(0, raA, rbA);
    __syncthreads();
    const int aro = (wm * 64 + fr) * 128, bro = (wn * 64 + fr) * 128, sw = fr & 7;
    auto step = [&](int kt, u32x4* la, u32x4* lb, const u32x4* wa, const u32x4* wb) {
        const unsigned char* As = smem + (kt & 1) * 32768;
        const unsigned char* Bs = As + 16384;
        bf16x8 af[2][4], bf[2][4];
#pragma unroll
        for (int kk = 0; kk < 2; ++kk) {
            const int co = ((kk * 4 + fq) ^ sw) * 16;
#pragma unroll
            for (int i = 0; i < 4; ++i) {
                af[kk][i] = *(const bf16x8*)(As + aro + i * 2048 + co);
                bf[kk][i] = *(const bf16x8*)(Bs + bro + i * 2048 + co);
            }
        }
        if (kt + 2 < 16) gload(kt + 2, la, lb);
        __builtin_amdgcn_sched_barrier(0);
#pragma unroll
        for (int mi = 0; mi < 4; ++mi)
#pragma unroll
            for (int ni = 0; ni < 4; ++ni) acc[mi][ni] = __builtin_amdgcn_mfma_f32_16x16x32_bf16(bf[0][ni], af[0][mi], acc[mi][ni], 0, 0, 0);
        __builtin_amdgcn_sched_barrier(0);
        if (kt + 1 < 16) swrite((kt + 1) & 1, wa, wb);
        __builtin_amdgcn_sched_barrier(0);
#pragma unroll
        for (int mi = 0; mi < 4; ++mi)
#pragma unroll
            for (int ni = 0; ni < 4; ++ni) acc[mi][ni] = __builtin_amdgcn_mfma_f32_16x16x32_bf16(bf[1][ni], af[1][mi], acc[mi][ni], 0, 0, 0);
        __syncthreads();
    };
    for (int kt = 0; kt < 16; kt += 2) {
        step(kt, raA, rbA, raB, rbB);
        step(kt + 1, raB, rbB, raA, rbA);
    }

    const int nw = n0 + wn * 64;
    if (MODE == 0) {
        const bool ctx = m0 < NCTX;
        if (nw < 640) {
            const bool isq = nw < 512;
            const float* gp = (isq ? p.q_g : p.k_g) + layer * 64;
            f32x4 gv[4];
#pragma unroll
            for (int ni = 0; ni < 4; ++ni) gv[ni] = *(const f32x4*)(gp + ni * 16 + fq * 4);
#pragma unroll
            for (int mi = 0; mi < 4; ++mi) {
                const int tok = m0 + wm * 64 + mi * 16 + fr;
                float ss = 0.f;
#pragma unroll
                for (int ni = 0; ni < 4; ++ni)
#pragma unroll
                    for (int e = 0; e < 4; ++e) ss += acc[mi][ni][e] * acc[mi][ni][e];
                ss += __shfl_xor(ss, 16);
                ss += __shfl_xor(ss, 32);
                const float rstd = rsqrtf(ss * (1.0f / 64.0f) + EPSF);
                f32x4 val[4];
#pragma unroll
                for (int ni = 0; ni < 4; ++ni) val[ni] = acc[mi][ni] * rstd * gv[ni];
                if (!isq && ctx) {
                    float* nk = p.out + OUT_NK + ((size_t)((tok >> 8) * 2 + layer) * 256 + (tok & 255)) * 128 + (nw - 512) + fq * 4;
#pragma unroll
                    for (int ni = 0; ni < 4; ++ni) *(f32x4*)(nk + ni * 16) = val[ni];
                }
                if (!ctx) {
                    const int pos = (tok - NCTX) & 2047, prow = pos >> 6, pcol = pos & 63;
                    const f32x4 cr = *(const f32x4*)(p.rope + prow * 16 + fq * 4), sr = *(const f32x4*)(p.rope + 1024 + prow * 16 + fq * 4);
                    const f32x4 cc = *(const f32x4*)(p.rope + pcol * 16 + fq * 4), sn = *(const f32x4*)(p.rope + 1024 + pcol * 16 + fq * 4);
                    const f32x4 a0 = val[0], a1 = val[1], a2 = val[2], a3 = val[3];
                    val[0] = a0 * cr - a1 * sr;
                    val[1] = a1 * cr + a0 * sr;
                    val[2] = a2 * cc - a3 * sn;
                    val[3] = a3 * cc + a2 * sn;
                }
                if (isq) {
#pragma unroll
                    for (int ni = 0; ni < 4; ++ni) val[ni] = val[ni] * QSCALE;
                }
                bf16_t* pr = p.proj + (size_t)tok * INW + nw + fq * 4;
#pragma unroll
                for (int ni = 0; ni < 4; ++ni) {
                    u32x2 w;
                    w.x = pk_bf16(val[ni][0], val[ni][1]);
                    w.y = pk_bf16(val[ni][2], val[ni][3]);
                    *(u32x2*)(pr + ni * 16) = w;
                }
            }
        } else {
            const bool isv = nw < 768;
#pragma unroll
            for (int mi = 0; mi < 4; ++mi) {
                const int tok = m0 + wm * 64 + mi * 16 + fr;
                bf16_t* pr = p.proj + (size_t)tok * INW + nw + fq * 4;
#pragma unroll
                for (int ni = 0; ni < 4; ++ni) {
                    u32x2 w;
                    w.x = pk_bf16(acc[mi][ni][0], acc[mi][ni][1]);
                    w.y = pk_bf16(acc[mi][ni][2], acc[mi][ni][3]);
                    *(u32x2*)(pr + ni * 16) = w;
                }
                if (isv && ctx) {
                    float* nv = p.out + OUT_NV + ((size_t)((tok >> 8) * 2 + layer) * 256 + (tok & 255)) * 128 + (nw - 640) + fq * 4;
#pragma unroll
                    for (int ni = 0; ni < 4; ++ni) *(f32x4*)(nv + ni * 16) = acc[mi][ni];
                }
            }
        }
    } else {
        const int v = m0 < NCTX ? 0 : 1 + ((m0 - NCTX) >> 11);
        const float* gate = p.modv + (size_t)(layer * 5 + v) * 3072 + 2048 + nw + fq * 4;
        f32x4 gt[4];
#pragma unroll
        for (int ni = 0; ni < 4; ++ni) gt[ni] = *(const f32x4*)(gate + ni * 16);
#pragma unroll
        for (int mi = 0; mi < 4; ++mi) {
            const int tok = m0 + wm * 64 + mi * 16 + fr;
            const float* ho = (layer == 0 ? (tok < NCTX ? p.x_prompt + (size_t)tok * DM : p.x_sample + (size_t)(tok - NCTX) * DM) : p.h + (size_t)tok * DM) + nw + fq * 4;
            float* hn = (layer == 0 ? p.h : p.out) + (size_t)tok * DM + nw + fq * 4;
#pragma unroll
            for (int ni = 0; ni < 4; ++ni) {
                const f32x4 o = *(const f32x4*)(ho + ni * 16);
                *(f32x4*)(hn + ni * 16) = o + gt[ni] * acc[mi][ni];
            }
        }
    }
}

template <int MODE>
__device__ __forceinline__ void phase_gemm(const Params& p, int layer, unsigned char* smem) {
    const int NT = MODE == 0 ? 22 : 8;
    const int total = 96 * NT;
    if ((gridDim.x & 7) == 0) {
        const int xcd = blockIdx.x & 7, slot = blockIdx.x >> 3, nslots = gridDim.x >> 3;
        for (int idx = slot; idx < 12 * NT; idx += nslots) gemm_tile<MODE>(p, layer, xcd * 12 + idx % 12, idx / 12, smem);
    } else {
        for (int t = blockIdx.x; t < total; t += gridDim.x) gemm_tile<MODE>(p, layer, t / NT, t % NT, smem);
    }
}

template <int VAR>
__device__ __forceinline__ void attn_unit(const Params& p, int layer, int unit, unsigned char* smem) {
    const int tid = otid(), lane = tid & 63, wave = tid >> 6;
    const int r31 = lane & 31, hh = lane >> 5;
    int b, head, qblk, tokbase, nself, ntiles;
    if (unit < 512) { b = unit >> 7; head = (unit >> 4) & 7; qblk = unit & 15; tokbase = NCTX + b * 2048; nself = 2048; ntiles = 36; }
    else { const int u = unit - 512; b = u >> 4; head = (u >> 1) & 7; qblk = u & 1; tokbase = b * 256; nself = 256; ntiles = 4; }
    const int kvh = head >> 2;
    const int qtok = tokbase + qblk * 128 + wave * 32 + r31;
    bf16x8 qf[4];
    {
        const bf16_t* qp = p.proj + (size_t)qtok * INW + head * 64 + hh * 8;
#pragma unroll
        for (int ks = 0; ks < 4; ++ks) qf[ks] = *(const bf16x8*)(qp + ks * 16);
    }
    const bf16_t* kself = p.proj + (size_t)tokbase * INW + 512 + kvh * 64;
    const bf16_t* vself = p.proj + (size_t)tokbase * INW + 640 + kvh * 64;
    const bf16_t* kcache = p.kc + (size_t)((b * 2 + layer) * 2 + kvh) * 256 * 64;
    const bf16_t* vcache = p.vc + (size_t)((b * 2 + layer) * 2 + kvh) * 256 * 64;
    const int srow = tid >> 3, scc = tid & 7;
    const int kwo = srow * 128 + ((scc ^ ((srow >> 1) & 7)) * 16);
    const int vwo = srow * 128 + ((scc ^ (((srow >> 1) & 1) << 2)) * 16);
    u32x4 rkA[2], rvA[2], rkB[2], rvB[2];
    auto gload = [&](int j, u32x4* rk, u32x4* rv) {
        const int key0 = j * 64;
#pragma unroll
        for (int i = 0; i < 2; ++i) {
            const int row = srow + 32 * i;
            if (key0 < nself) {
                rk[i] = *(const u32x4*)(kself + (size_t)(key0 + row) * INW + scc * 8);
                rv[i] = *(const u32x4*)(vself + (size_t)(key0 + row) * INW + scc * 8);
            } else {
                rk[i] = *(const u32x4*)(kcache + (size_t)(key0 - nself + row) * 64 + scc * 8);
                rv[i] = *(const u32x4*)(vcache + (size_t)(key0 - nself + row) * 64 + scc * 8);
            }
        }
    };
    auto swrite = [&](int buf, const u32x4* rk, const u32x4* rv) {
        unsigned char* kb = smem + buf * 16384;
        unsigned char* vb = kb + 8192;
#pragma unroll
        for (int i = 0; i < 2; ++i) {
            *(u32x4*)(kb + kwo + i * 32 * 128) = rk[i];
            *(u32x4*)(vb + vwo + i * 32 * 128) = rv[i];
        }
    };
    f32x16 o[2];
#pragma unroll
    for (int i = 0; i < 16; ++i) { o[0][i] = 0.f; o[1][i] = 0.f; }
    float mrun = 0.f, mmax = -1e30f, lrun = 0.f;
    f32x16 negm, zero16;
#pragma unroll
    for (int i = 0; i < 16; ++i) { negm[i] = 0.f; zero16[i] = 0.f; }
    bool shifted = false;
    gload(0, rkA, rvA);
    swrite(0, rkA, rvA);
    if (ntiles > 1) gload(1, rkB, rvB);
    __syncthreads();
    const int kro = r31 * 128, ksw = (r31 >> 1) & 7;
    const int vq = 4 * hh + ((lane & 15) >> 2);
    const int vsw = ((vq >> 1) & 1) << 2;
    const int vcl = ((lane >> 4) & 1) * 2 + ((lane & 3) >> 1);
    const int vro0 = vq * 128 + (((0 * 4 + vcl) ^ vsw) * 16) + (lane & 1) * 8;
    const int vro1 = vq * 128 + (((1 * 4 + vcl) ^ vsw) * 16) + (lane & 1) * 8;
    auto step = [&](int j, u32x4* lk, u32x4* lv, const u32x4* wk, const u32x4* wv) {
        const unsigned char* kb = smem + (j & 1) * 16384;
        const unsigned char* vb = kb + 8192;
        bf16x8 kf[2][4];
#pragma unroll
        for (int sb = 0; sb < 2; ++sb)
#pragma unroll
            for (int ks = 0; ks < 4; ++ks) kf[sb][ks] = *(const bf16x8*)(kb + sb * 4096 + kro + (((ks * 2 + hh) ^ ksw) * 16));
        if (VAR != 1 && j + 2 < ntiles) gload(j + 2, lk, lv);
        __builtin_amdgcn_sched_barrier(0);
        f32x16 s[2];
#pragma unroll
        for (int ks = 0; ks < 4; ++ks)
#pragma unroll
            for (int sb = 0; sb < 2; ++sb) {
                if (ks == 0) {
                    if (shifted) s[sb] = __builtin_amdgcn_mfma_f32_32x32x16_bf16(kf[sb][ks], qf[ks], negm, 0, 0, 0);
                    else s[sb] = __builtin_amdgcn_mfma_f32_32x32x16_bf16(kf[sb][ks], qf[ks], zero16, 0, 0, 0);
                } else s[sb] = __builtin_amdgcn_mfma_f32_32x32x16_bf16(kf[sb][ks], qf[ks], s[sb], 0, 0, 0);
            }
        __builtin_amdgcn_sched_barrier(0);
        bf16x8 vf[2][2][2];
#pragma unroll
        for (int sb = 0; sb < 2; ++sb)
#pragma unroll
            for (int s2 = 0; s2 < 2; ++s2)
#pragma unroll
                for (int dt = 0; dt < 2; ++dt) {
                    const LAS unsigned char* va = (const LAS unsigned char*)(vb) + (sb * 32 + s2 * 16) * 128 + (dt ? vro1 : vro0);
                    const s16x4 a0 = __builtin_amdgcn_ds_read_tr16_b64_v4i16((LAS s16x4*)(va));
                    const s16x4 a1 = __builtin_amdgcn_ds_read_tr16_b64_v4i16((LAS s16x4*)(va + 8 * 128));
                    vf[sb][s2][dt] = (bf16x8){a0[0], a0[1], a0[2], a0[3], a1[0], a1[1], a1[2], a1[3]};
                }
        __builtin_amdgcn_sched_barrier(0);
        float mloc = max3_f(s[0][0], s[1][0], s[0][1]);
        mloc = max3_f(mloc, s[1][1], s[0][2]);
#pragma unroll
        for (int i = 2; i < 16; ++i) mloc = max3_f(mloc, s[1][i], s[0][(i + 1) & 15]);
        float lsum = 0.f;
#pragma unroll
        for (int sb = 0; sb < 2; ++sb)
#pragma unroll
            for (int i = 0; i < 16; ++i) { if (VAR != 2) { s[sb][i] = __builtin_amdgcn_exp2f(s[sb][i]); lsum += s[sb][i]; } }
        lrun += lsum;
        bf16x8 pf[2][2];
#pragma unroll
        for (int sb = 0; sb < 2; ++sb)
#pragma unroll
            for (int s2 = 0; s2 < 2; ++s2) {
                u32x4 pw;
                pw.x = pk_bf16(s[sb][s2 * 8 + 0], s[sb][s2 * 8 + 1]);
                pw.y = pk_bf16(s[sb][s2 * 8 + 2], s[sb][s2 * 8 + 3]);
                pw.z = pk_bf16(s[sb][s2 * 8 + 4], s[sb][s2 * 8 + 5]);
                pw.w = pk_bf16(s[sb][s2 * 8 + 6], s[sb][s2 * 8 + 7]);
                pf[sb][s2] = __builtin_bit_cast(bf16x8, pw);
            }
        __builtin_amdgcn_sched_barrier(0);
#pragma unroll
        for (int sb = 0; sb < 2; ++sb)
#pragma unroll
            for (int s2 = 0; s2 < 2; ++s2)
#pragma unroll
                for (int dt = 0; dt < 2; ++dt) o[dt] = __builtin_amdgcn_mfma_f32_32x32x16_bf16(vf[sb][s2][dt], pf[sb][s2], o[dt], 0, 0, 0);
        __builtin_amdgcn_sched_barrier(0);
        mloc = fmaxf(mloc, __shfl_xor(mloc, 32));
        mmax = fmaxf(mmax, mrun + mloc);
        if (__builtin_expect(__any(fabsf(mmax - mrun) > 40.0f), 0)) {
            asm volatile("" ::: "memory");
            const float alpha = __builtin_amdgcn_exp2f(mrun - mmax);
            mrun = mmax;
            lrun *= alpha;
            shifted = true;
#pragma unroll
            for (int i = 0; i < 16; ++i) { o[0][i] *= alpha; o[1][i] *= alpha; negm[i] = -mrun; }
        }
        if (VAR != 1 && j + 1 < ntiles) swrite((j + 1) & 1, wk, wv);
        __syncthreads();
    };
    for (int j = 0; j < ntiles; j += 2) {
        step(j, rkA, rvA, rkB, rvB);
        step(j + 1, rkB, rvB, rkA, rvA);
    }
    const float ltot = lrun + __shfl_xor(lrun, 32);
    const float inv = 1.0f / ltot;
    const bf16_t* zp = p.proj + (size_t)qtok * INW + 768 + head * 64;
    bf16_t* mp = (VAR == 0 ? p.mix : p.xn) + (size_t)qtok * DM + head * 64;
#pragma unroll
    for (int dt = 0; dt < 2; ++dt)
#pragma unroll
        for (int rq = 0; rq < 4; ++rq) {
            const int d0 = dt * 32 + 8 * rq + 4 * hh;
            const u32x2 zz = *(const u32x2*)(zp + d0);
            const float z0 = bf_lo(zz.x), z1 = bf_hi(zz.x), z2 = bf_lo(zz.y), z3 = bf_hi(zz.y);
            u32x2 w;
            w.x = pk_bf16(o[dt][rq * 4 + 0] * inv * silu_f(z0), o[dt][rq * 4 + 1] * inv * silu_f(z1));
            w.y = pk_bf16(o[dt][rq * 4 + 2] * inv * silu_f(z2), o[dt][rq * 4 + 3] * inv * silu_f(z3));
            *(u32x2*)(mp + d0) = w;
        }
}

__device__ __forceinline__ void unpack8(const u32x4 u, float* f) {
    f[0] = bf_lo(u.x); f[1] = bf_hi(u.x); f[2] = bf_lo(u.y); f[3] = bf_hi(u.y);
    f[4] = bf_lo(u.z); f[5] = bf_hi(u.z); f[6] = bf_lo(u.w); f[7] = bf_hi(u.w);
}

__device__ __forceinline__ void pool_item(const Params& p, int layer, int pi, unsigned char* smem) {
    const int tid = otid(), lane = tid & 63, gi = tid >> 6;
    const int fr = lane & 15, fq = lane >> 4;
    const int T0 = pi * 64;
    int seqstart, seqlen;
    if (T0 < NCTX) { seqstart = T0 & ~255; seqlen = 256; } else { seqstart = NCTX + ((T0 - NCTX) & ~2047); seqlen = 2048; }
    const int toff = T0 - seqstart;
    for (int e = tid; e < 79 * 32; e += 256) {
        const int r = e >> 5, c = e & 31;
        const int s = toff - 8 + r;
        if (s >= 0 && s < seqlen) *(u32x4*)(smem + r * 528 + c * 16) = *(const u32x4*)(p.proj + (size_t)(seqstart + s) * INW + 2304 + c * 8);
    }
    __syncthreads();
    const int win = 2 << gi, half = win >> 1;
    bf16x8 wf[4][2];
    {
        const bf16_t* wp = p.PoolT + (size_t)((layer * 4 + gi) * 64) * 64;
#pragma unroll
        for (int ni = 0; ni < 4; ++ni)
#pragma unroll
            for (int kk = 0; kk < 2; ++kk) wf[ni][kk] = *(const bf16x8*)(wp + (ni * 16 + fr) * 64 + kk * 32 + fq * 8);
    }
#pragma unroll 1
    for (int mi = 0; mi < 4; ++mi) {
        f32x4 acc[4];
#pragma unroll
        for (int j = 0; j < 4; ++j) acc[j] = (f32x4){0.f, 0.f, 0.f, 0.f};
        const int tt = mi * 16 + fr;
        const int ts = toff + tt;
        int lo = ts - half, hi = ts - half + win - 1;
        lo = lo < 0 ? 0 : lo;
        hi = hi > seqlen - 1 ? seqlen - 1 : hi;
        const float rc = 1.0f / (float)(hi - lo + 1);
        const int r0 = lo - toff + 8, r1 = hi - toff + 8, rs = tt + 8;
#pragma unroll
        for (int kk = 0; kk < 2; ++kk) {
            const int co = (gi * 64 + kk * 32 + fq * 8) * 2;
            float sum[8];
#pragma unroll
            for (int e = 0; e < 8; ++e) sum[e] = 0.f;
            for (int r = r0; r <= r1; ++r) {
                float f[8];
                unpack8(*(const u32x4*)(smem + r * 528 + co), f);
#pragma unroll
                for (int e = 0; e < 8; ++e) sum[e] += f[e];
            }
            float us[8];
            unpack8(*(const u32x4*)(smem + rs * 528 + co), us);
            u32x4 dw;
            dw.x = pk_bf16(sum[0] * rc - us[0], sum[1] * rc - us[1]);
            dw.y = pk_bf16(sum[2] * rc - us[2], sum[3] * rc - us[3]);
            dw.z = pk_bf16(sum[4] * rc - us[4], sum[5] * rc - us[5]);
            dw.w = pk_bf16(sum[6] * rc - us[6], sum[7] * rc - us[7]);
            const bf16x8 df = __builtin_bit_cast(bf16x8, dw);
#pragma unroll
            for (int ni = 0; ni < 4; ++ni) acc[ni] = __builtin_amdgcn_mfma_f32_16x16x32_bf16(wf[ni][kk], df, acc[ni], 0, 0, 0);
        }
        const int tok = T0 + tt;
#pragma unroll
        for (int ni = 0; ni < 4; ++ni) {
            const int ch = gi * 64 + ni * 16 + fq * 4;
            const f32x4 ps = *(const f32x4*)(p.pool_scale + layer * 256 + ch);
            const u32x2 zz = *(const u32x2*)(p.proj + (size_t)tok * INW + 2560 + ch);
            u32x2 w;
            w.x = pk_bf16(acc[ni][0] * ps[0] * silu_f(bf_lo(zz.x)), acc[ni][1] * ps[1] * silu_f(bf_hi(zz.x)));
            w.y = pk_bf16(acc[ni][2] * ps[2] * silu_f(bf_lo(zz.y)), acc[ni][3] * ps[3] * silu_f(bf_hi(zz.y)));
            *(u32x2*)(p.mix + (size_t)tok * DM + 768 + ch) = w;
        }
    }
    __syncthreads();
}

__device__ __forceinline__ void conv_item(const Params& p, int layer, int ci) {
    const int tid = otid();
    const int ch = (tid & 31) * 8, tg = tid >> 5;
    const int T0 = ci * 64 + tg * 8;
    int seqstart, seqlen;
    if (T0 < NCTX) { seqstart = T0 & ~255; seqlen = 256; } else { seqstart = NCTX + ((T0 - NCTX) & ~2047); seqlen = 2048; }
    const int seqend = seqstart + seqlen;
    float w0[8], w1[8], w2[8], bb[8];
    {
        const float* cw = p.conv_w + (size_t)layer * 768 + ch;
#pragma unroll
        for (int e = 0; e < 8; ++e) { w0[e] = cw[e]; w1[e] = cw[256 + e]; w2[e] = cw[512 + e]; bb[e] = p.conv_b[layer * 256 + ch + e]; }
    }
    auto ldx = [&](int tok, float* x) {
        if (tok >= seqstart && tok < seqend) {
            float hc[8], cc[8];
            unpack8(*(const u32x4*)(p.proj + (size_t)tok * INW + 1280 + ch), hc);
            unpack8(*(const u32x4*)(p.proj + (size_t)tok * INW + 1792 + ch), cc);
#pragma unroll
            for (int e = 0; e < 8; ++e) x[e] = hc[e] * cc[e];
        } else {
#pragma unroll
            for (int e = 0; e < 8; ++e) x[e] = 0.f;
        }
    };
    float xm[8], x0[8], xp[8];
    ldx(T0 - 1, xm);
    ldx(T0, x0);
    for (int t = 0; t < 8; ++t) {
        const int tok = T0 + t;
        ldx(tok + 1, xp);
        float bc[8], zc[8], o[8];
        unpack8(*(const u32x4*)(p.proj + (size_t)tok * INW + 1536 + ch), bc);
        unpack8(*(const u32x4*)(p.proj + (size_t)tok * INW + 2048 + ch), zc);
#pragma unroll
        for (int e = 0; e < 8; ++e) {
            const float y = xm[e] * w0[e] + x0[e] * w1[e] + xp[e] * w2[e] + bb[e];
            o[e] = bc[e] * y * silu_f(zc[e]);
        }
        u32x4 w;
        w.x = pk_bf16(o[0], o[1]); w.y = pk_bf16(o[2], o[3]); w.z = pk_bf16(o[4], o[5]); w.w = pk_bf16(o[6], o[7]);
        *(u32x4*)(p.mix + (size_t)tok * DM + 512 + ch) = w;
#pragma unroll
        for (int e = 0; e < 8; ++e) { xm[e] = x0[e]; x0[e] = xp[e]; }
    }
}

__device__ __forceinline__ void phase_mixer(const Params& p, int layer, unsigned char* smem) {
    for (int it = blockIdx.x; it < 768 + 192 + 192; it += gridDim.x) {
        if (it < 768) {
            attn_unit<0>(p, layer, it, smem);
        }
        else if (it < 960) pool_item(p, layer, it - 768, smem);
        else conv_item(p, layer, it - 960);
    }
}

__global__ void __launch_bounds__(256, 2) mega(Params p, int lo, int hi) {
    __shared__ __attribute__((aligned(16))) unsigned char smem[65536];
    __shared__ uint4 xbw;
    if (p.use_cg) cg::this_grid().sync();
    if (threadIdx.x == 0) xbw = make_uint4(0u, 0u, 0u, 0u);
    __syncthreads();
    XcdBarrier xb = xcd_barrier_post(p.bar, (volatile LAS unsigned*)&xbw);
    for (int ph = lo; ph < hi; ++ph) {
        if (ph > lo) xcd_barrier(xb);
        if (ph == 0) phase_prep(p, smem);
        else if (ph == 9) phase_final(p);
        else {
            const int layer = (ph - 1) >> 2, ty = (ph - 1) & 3;
            if (ty == 0) phase_xn(p, layer);
            else if (ty == 1) phase_gemm<0>(p, layer, smem);
            else if (ty == 2) phase_mixer(p, layer, smem);
            else phase_gemm<1>(p, layer, smem);
        }
    }
}

#ifndef MK_MULTI
#define MK_MULTI 0
#endif

extern "C" void kernel_launch(void* const* d_in, const int* in_sizes, int n_in, void* d_out, int out_size, void* d_ws, size_t ws_size,
                              hipStream_t stream) {
    static int grid_blocks = 0;
    if (!grid_blocks) {
        int dev = 0, cus = 0, per_cu = 0;
        hipGetDevice(&dev);
        hipDeviceGetAttribute(&cus, hipDeviceAttributeMultiprocessorCount, dev);
        hipOccupancyMaxActiveBlocksPerMultiprocessor(&per_cu, mega, 256, 0);
        if (per_cu > 2) per_cu = 2;
        if (per_cu < 1) per_cu = 1;
        grid_blocks = cus * per_cu;
    }
    Params p{};
    const float* const* in = (const float* const*)d_in;
    p.x_prompt = in[0]; p.x_sample = in[1]; p.cache_k = in[2]; p.cache_v = in[3]; p.c = in[4]; p.c_ctx = in[5]; p.norm_g = in[6];
    p.w_ada = in[7]; p.b_ada = in[8]; p.w_in = in[9]; p.q_g = in[10]; p.k_g = in[11]; p.conv_w = in[12]; p.conv_b = in[13];
    p.pool_w = in[14]; p.pool_scale = in[15]; p.w_out = in[16]; p.final_g = in[17];
    p.out = (float*)d_out;
    unsigned char* ws = (unsigned char*)d_ws;
    size_t off = 0;
    auto take = [&](size_t bytes) { unsigned char* r = ws + off; off += (bytes + 255) & ~(size_t)255; return r; };
    p.bar = (unsigned*)take(XCD_BAR_WORDS * 4);
    p.modv = (float*)take(2 * 5 * 3072 * 4);
    p.rope = (float*)take(2048 * 4);
    p.WinT = (bf16_t*)take((size_t)2 * INW * 1024 * 2);
    p.WoutT = (bf16_t*)take((size_t)2 * 1024 * 1024 * 2);
    p.PoolT = (bf16_t*)take(2 * 4 * 64 * 64 * 2);
    p.kc = (bf16_t*)take(262144 * 2);
    p.vc = (bf16_t*)take(262144 * 2);
    p.h = (float*)take((size_t)NTOK * DM * 4);
    p.xn = (bf16_t*)take((size_t)NTOK * DM * 2);
    p.proj = (bf16_t*)take((size_t)NTOK * INW * 2);
    p.mix = (bf16_t*)take((size_t)NTOK * DM * 2);
    p.use_cg = 0;
    p.pad = 0;
    hipMemsetAsync(p.bar, 0, XCD_BAR_WORDS * 4, stream);
#if MK_MULTI
    for (int ph = 0; ph < 10; ++ph) {
        int lo = ph, hi = ph + 1;
        void* args[] = {&p, &lo, &hi};
        hipError_t e = hipLaunchCooperativeKernel((void*)mega, dim3(grid_blocks), dim3(256), args, 0, stream);
        if (e != hipSuccess) fprintf(stderr, "launch failed: %s\n", hipGetErrorString(e));
    }
#else
    int lo = 0, hi = 10;
    void* args[] = {&p, &lo, &hi};
    hipError_t e = hipLaunchCooperativeKernel((void*)mega, dim3(grid_blocks), dim3(256), args, 0, stream);
    if (e != hipSuccess) fprintf(stderr, "cooperative launch failed: %s (grid %d)\n", hipGetErrorString(e), grid_blocks);
#endif
}
```

```cpp
#include <hip/hip_runtime.h>
#include <hip/hip_cooperative_groups.h>
#include <cstdint>
#include <cstdio>
namespace cg = cooperative_groups;

#define LAS __attribute__((address_space(3)))
typedef unsigned short bf16_t;
typedef short bf16x8 __attribute__((ext_vector_type(8)));
typedef short s16x4 __attribute__((ext_vector_type(4)));
typedef float f32x4 __attribute__((ext_vector_type(4)));
typedef float f32x16 __attribute__((ext_vector_type(16)));
typedef unsigned u32x4 __attribute__((ext_vector_type(4)));
typedef unsigned u32x2 __attribute__((ext_vector_type(2)));

constexpr int NTOK = 12288, NCTX = 4096, DM = 1024, INW = 2816;
constexpr size_t OUT_NK = 12582912, OUT_NV = 13631488;
constexpr float EPSF = 1e-6f;
constexpr float QSCALE = 0.125f * 1.4426950408889634f;

struct Params {
    const float *x_prompt, *x_sample, *cache_k, *cache_v, *c, *c_ctx, *norm_g, *w_ada, *b_ada, *w_in, *q_g, *k_g, *conv_w, *conv_b,
        *pool_w, *pool_scale, *w_out, *final_g;
    float* out;
    unsigned* bar;
    float* modv;
    float* rope;
    bf16_t* WinT;
    bf16_t* WoutT;
    bf16_t* PoolT;
    bf16_t* kc;
    bf16_t* vc;
    float* h;
    bf16_t* xn;
    bf16_t* proj;
    bf16_t* mix;
    int use_cg;
    int pad;
};

__device__ __forceinline__ unsigned pk_bf16(float lo, float hi) {
    unsigned r;
    asm("v_cvt_pk_bf16_f32 %0, %1, %2" : "=v"(r) : "v"(lo), "v"(hi));
    return r;
}
__device__ __forceinline__ float bf_lo(unsigned u) { return __uint_as_float(u << 16); }
__device__ __forceinline__ float bf_hi(unsigned u) { return __uint_as_float(u & 0xffff0000u); }
__device__ __forceinline__ float silu_f(float z) { return z / (1.0f + __expf(-z)); }
__device__ __forceinline__ float max3_f(float a, float b, float c) { float r; asm("v_max3_f32 %0, %1, %2, %3" : "=v"(r) : "v"(a), "v"(b), "v"(c)); return r; }
__device__ __forceinline__ int otid() { int t = threadIdx.x; asm volatile("" : "+v"(t)); return t; }

#define XB_TMO 128
#define XB_XCNT(j) (256 + 64 * (j))
#define XB_XSUB(j) (1280 + 64 * (j))
#define XB_XGEN(j) (2304 + 64 * (j))
#define XB_TOP 3328
#define XB_TOPGEN 3392
#define XCD_BAR_WORDS 3456
#define XB_SPIN_CAP (1u << 20)

__device__ __forceinline__ unsigned xb_ld(unsigned* p) { return __hip_atomic_load(p, __ATOMIC_RELAXED, __HIP_MEMORY_SCOPE_AGENT); }
__device__ __forceinline__ unsigned xb_add(unsigned* p, unsigned v) { return __hip_atomic_fetch_add(p, v, __ATOMIC_RELAXED, __HIP_MEMORY_SCOPE_AGENT); }
__device__ __forceinline__ unsigned xb_xcc_id() { return (unsigned)__builtin_amdgcn_s_getreg((3 << 11) | 20) & 0xFu; }
#define XB_SPIN(cond, bar)                                                   \
    do {                                                                     \
        unsigned _sp = 0;                                                    \
        while (cond) {                                                       \
            __builtin_amdgcn_s_sleep(1);                                     \
            if ((++_sp & 255u) == 0u) {                                      \
                if (xb_ld(&(bar)[XB_TMO])) break;                            \
                if (_sp > XB_SPIN_CAP) { atomicAdd(&(bar)[XB_TMO], 1u); break; } \
            }                                                                \
        }                                                                    \
    } while (0)

struct XcdBarrier {
    unsigned* bar;
    unsigned x;
    volatile LAS unsigned* st;
};

__device__ __forceinline__ XcdBarrier xcd_barrier_post(unsigned* bar, volatile LAS unsigned* st) {
    XcdBarrier b;
    b.bar = bar;
    b.x = xb_xcc_id();
    b.st = st;
    if (threadIdx.x == 0) (void)xb_add(&bar[XB_XCNT(b.x)], 1u);
    return b;
}
__device__ __forceinline__ void xcd_barrier_complete(unsigned* bar, unsigned x, unsigned& nloc, unsigned& nx) {
    const unsigned G = gridDim.x * gridDim.y * gridDim.z;
    unsigned sum, cnt, mine, sp = 0u;
    for (;;) {
        sum = 0u; cnt = 0u; mine = 0u;
#pragma unroll
        for (unsigned j = 0; j < 16; ++j) {
            const unsigned c = xb_ld(&bar[XB_XCNT(j)]);
            sum += c; cnt += (c > 0u) ? 1u : 0u; mine = (j == x) ? c : mine;
        }
        if (sum == G) break;
        __builtin_amdgcn_s_sleep(1);
        if ((++sp & 255u) == 0u) {
            if (xb_ld(&bar[XB_TMO])) break;
            if (sp > XB_SPIN_CAP) { atomicAdd(&bar[XB_TMO], 1u); break; }
        }
    }
    nloc = mine > 0u ? mine : 1u;
    nx = cnt > 0u ? cnt : 1u;
}
__device__ __forceinline__ void xcd_barrier(const XcdBarrier& b) {
    asm volatile("s_waitcnt vmcnt(0)" ::: "memory");
    __syncthreads();
    if (threadIdx.x == 0) {
        unsigned* bar = b.bar;
        __builtin_amdgcn_s_waitcnt(0);
        unsigned nloc = b.st[0], nx = b.st[1];
        if (nloc == 0u) { xcd_barrier_complete(bar, b.x, nloc, nx); b.st[0] = nloc; b.st[1] = nx; }
        const unsigned old = xb_add(&bar[XB_XSUB(b.x)], 1u);
        const unsigned gen = old / nloc;
        if (old + 1u == (gen + 1u) * nloc) {
            __builtin_amdgcn_fence(__ATOMIC_RELEASE, "agent");
            asm volatile("s_waitcnt vmcnt(0)" ::: "memory");
            const unsigned og = xb_add(&bar[XB_TOP], 1u);
            const unsigned tg = og / nx;
            if (og + 1u == (tg + 1u) * nx) xb_add(&bar[XB_TOPGEN], 1u);
            else XB_SPIN(xb_ld(&bar[XB_TOPGEN]) == tg, bar);
            __builtin_amdgcn_fence(__ATOMIC_ACQUIRE, "agent");
            xb_add(&bar[XB_XGEN(b.x)], 1u);
            asm volatile("s_waitcnt vmcnt(0)" ::: "memory");
        } else {
            XB_SPIN(xb_ld(&bar[XB_XGEN(b.x)]) == gen, bar);
            __builtin_amdgcn_fence(__ATOMIC_ACQUIRE, "agent");
            asm volatile("s_waitcnt vmcnt(0)" ::: "memory");
        }
    }
    __syncthreads();
}

__device__ __forceinline__ void prep_mod_item(const Params& p, int item, unsigned char* smem) {
    const int tid = otid();
    float* sc = (float*)smem;
    float* red = (float*)(smem + 20480);
    const int l = item / 96, j0 = (item % 96) * 32;
    for (int idx = tid; idx < 5120; idx += 256) {
        const int v = idx >> 10, k = idx & 1023;
        const float cv = (v == 0) ? p.c_ctx[k] : p.c[(v - 1) * 1024 + k];
        sc[idx] = cv / (1.0f + expf(-cv));
    }
    __syncthreads();
    const int cgp = tid & 7, kg = tid >> 3;
    float acc[5][4];
#pragma unroll
    for (int v = 0; v < 5; ++v)
#pragma unroll
        for (int e = 0; e < 4; ++e) acc[v][e] = 0.f;
    const float* wp = p.w_ada + (size_t)l * 1024 * 3072 + j0 + cgp * 4;
#pragma unroll 8
    for (int kk = 0; kk < 32; ++kk) {
        const int k = kk * 32 + kg;
        const f32x4 w = *(const f32x4*)(wp + (size_t)k * 3072);
#pragma unroll
        for (int v = 0; v < 5; ++v) {
            const float s = sc[v * 1024 + k];
#pragma unroll
            for (int e = 0; e < 4; ++e) acc[v][e] += s * w[e];
        }
    }
#pragma unroll
    for (int v = 0; v < 5; ++v)
#pragma unroll
        for (int e = 0; e < 4; ++e) red[kg * 160 + v * 32 + cgp * 4 + e] = acc[v][e];
    __syncthreads();
    if (tid < 160) {
        float s = 0.f;
        for (int g = 0; g < 32; ++g) s += red[g * 160 + tid];
        const int v = tid >> 5, cc = tid & 31;
        p.modv[(size_t)(l * 5 + v) * 3072 + j0 + cc] = s + p.b_ada[l * 3072 + j0 + cc];
    }
    __syncthreads();
}

__device__ __forceinline__ void prep_transpose_tile(const float* src, bf16_t* dst, int N, int k0, int n0, unsigned char* smem) {
    const int tid = otid();
    bf16_t* T = (bf16_t*)smem;
    {
        const int row = tid >> 2, seg = tid & 3;
        const float* s = src + (size_t)(k0 + row) * N + n0 + seg * 16;
        f32x4 v[4];
#pragma unroll
        for (int i = 0; i < 4; ++i) v[i] = *(const f32x4*)(s + i * 4);
#pragma unroll
        for (int i = 0; i < 4; ++i)
#pragma unroll
            for (int e = 0; e < 4; ++e) {
                const unsigned u = pk_bf16(v[i][e], 0.f);
                T[(seg * 16 + i * 4 + e) * 72 + row] = (bf16_t)(u & 0xffffu);
            }
    }
    __syncthreads();
    {
        const int n = tid >> 2, seg = tid & 3;
        const u32x4 a = *(const u32x4*)(T + n * 72 + seg * 16);
        const u32x4 b = *(const u32x4*)(T + n * 72 + seg * 16 + 8);
        bf16_t* d = dst + (size_t)(n0 + n) * 1024 + k0 + seg * 16;
        *(u32x4*)d = a;
        *(u32x4*)(d + 8) = b;
    }
    __syncthreads();
}

__device__ __forceinline__ void phase_prep(const Params& p, unsigned char* smem) {
    const int NMOD = 192, NTI = 2 * 16 * 44, NTO = 2 * 16 * 16;
    for (int it = blockIdx.x; it < NMOD + NTI + NTO; it += gridDim.x) {
        if (it < NMOD) {
            prep_mod_item(p, it, smem);
        } else if (it < NMOD + NTI) {
            const int t = it - NMOD, l = t / 704, r = t % 704, kt = r / 44, nt = r % 44;
            prep_transpose_tile(p.w_in + (size_t)l * 1024 * INW, p.WinT + (size_t)l * INW * 1024, INW, kt * 64, nt * 64, smem);
        } else {
            const int t = it - NMOD - NTI, l = t / 256, r = t % 256, kt = r / 16, nt = r % 16;
            prep_transpose_tile(p.w_out + (size_t)l * 1024 * 1024, p.WoutT + (size_t)l * 1024 * 1024, 1024, kt * 64, nt * 64, smem);
        }
    }
    const int gsz = gridDim.x * 256;
    for (int i = blockIdx.x * 256 + otid(); i < 558080; i += gsz) {
        if (i < 524288) {
            const int which = i >> 18, j = i & 262143;
            const int d = j & 63, t = (j >> 6) & 255, kvh = (j >> 14) & 1, bl = j >> 15;
            const size_t si = ((size_t)(bl * 256 + t) * 2 + kvh) * 64 + d;
            const float v = which ? p.cache_v[si] : p.cache_k[si];
            (which ? p.vc : p.kc)[j] = (bf16_t)(pk_bf16(v, 0.f) & 0xffffu);
        } else if (i < 524288 + 32768) {
            const int j = i - 524288;
            const int cc = j & 63, d = (j >> 6) & 63, lg = j >> 12;
            const float v = p.pool_w[((size_t)lg * 64 + cc) * 64 + d];
            p.PoolT[j] = (bf16_t)(pk_bf16(v, 0.f) & 0xffffu);
        } else {
            const int j = i - 524288 - 32768;
            const int a = j & 15, r = j >> 4;
            const float inv = 1.0f / powf(10000.0f, (float)(2 * a) / 32.0f);
            const float ang = (float)r * inv;
            const float kf = rintf(ang * 0.15915494309189535f);
            float rr = fmaf(-kf, 6.2831854820251465f, ang);
            rr = fmaf(-kf, -1.7484555e-7f, rr);
            p.rope[j] = cosf(rr);
            p.rope[1024 + j] = sinf(rr);
        }
    }
}

__device__ __forceinline__ float wave_sum(float v) {
#pragma unroll
    for (int o = 32; o >= 1; o >>= 1) v += __shfl_xor(v, o);
    return v;
}

__device__ __forceinline__ void phase_xn(const Params& p, int layer) {
    const int tid = otid(), lane = tid & 63, wave = tid >> 6;
    for (int tok = blockIdx.x * 4 + wave; tok < NTOK; tok += gridDim.x * 4) {
        const float* src = layer == 0 ? (tok < NCTX ? p.x_prompt + (size_t)tok * DM : p.x_sample + (size_t)(tok - NCTX) * DM) : p.h + (size_t)tok * DM;
        const int v = tok < NCTX ? 0 : 1 + ((tok - NCTX) >> 11);
        const float* mv = p.modv + (size_t)(layer * 5 + v) * 3072;
        f32x4 x[4];
        float ss = 0.f;
#pragma unroll
        for (int i = 0; i < 4; ++i) {
            x[i] = *(const f32x4*)(src + i * 256 + lane * 4);
            ss += x[i][0] * x[i][0] + x[i][1] * x[i][1] + x[i][2] * x[i][2] + x[i][3] * x[i][3];
        }
        ss = wave_sum(ss);
        const float rstd = rsqrtf(ss * (1.0f / 1024.0f) + EPSF);
#pragma unroll
        for (int i = 0; i < 4; ++i) {
            const int k = i * 256 + lane * 4;
            const f32x4 g = *(const f32x4*)(p.norm_g + layer * 1024 + k);
            const f32x4 sh = *(const f32x4*)(mv + k);
            const f32x4 sc = *(const f32x4*)(mv + 1024 + k);
            float o[4];
#pragma unroll
            for (int e = 0; e < 4; ++e) o[e] = x[i][e] * rstd * g[e] * (1.0f + sc[e]) + sh[e];
            u32x2 w;
            w.x = pk_bf16(o[0], o[1]);
            w.y = pk_bf16(o[2], o[3]);
            *(u32x2*)(p.xn + (size_t)tok * DM + k) = w;
        }
    }
}

__device__ __forceinline__ void phase_final(const Params& p) {
    const int tid = otid(), lane = tid & 63, wave = tid >> 6;
    for (int tok = blockIdx.x * 4 + wave; tok < NTOK; tok += gridDim.x * 4) {
        float* row = p.out + (size_t)tok * DM;
        f32x4 x[4];
        float ss = 0.f;
#pragma unroll
        for (int i = 0; i < 4; ++i) {
            x[i] = *(const f32x4*)(row + i * 256 + lane * 4);
            ss += x[i][0] * x[i][0] + x[i][1] * x[i][1] + x[i][2] * x[i][2] + x[i][3] * x[i][3];
        }
        ss = wave_sum(ss);
        const float rstd = rsqrtf(ss * (1.0f / 1024.0f) + EPSF);
#pragma unroll
        for (int i = 0; i < 4; ++i) {
            const int k = i * 256 + lane * 4;
            const f32x4 g = *(const f32x4*)(p.final_g + k);
            f32x4 o;
#pragma unroll
            for (int e = 0; e < 4; ++e) o[e] = x[i][e] * rstd * g[e];
            *(f32x4*)(row + k) = o;
        }
    }
}

template <int MODE, int MI>
__device__ __forceinline__ void gemm_epilogue(const Params& p, int layer, int mw, int nw, f32x4 (&acc)[MI][4], int fr, int fq) {
    if (MODE == 0) {
        const bool ctx = mw < NCTX;
        if (nw < 640) {
            const bool isq = nw < 512;
            const float* gp = (isq ? p.q_g : p.k_g) + layer * 64;
            f32x4 gv[4];
#pragma unroll
            for (int ni = 0; ni < 4; ++ni) gv[ni] = *(const f32x4*)(gp + ni * 16 + fq * 4);
#pragma unroll
            for (int mi = 0; mi < MI; ++mi) {
                const int tok = mw + mi * 16 + fr;
                float ss = 0.f;
#pragma unroll
                for (int ni = 0; ni < 4; ++ni)
#pragma unroll
                    for (int e = 0; e < 4; ++e) ss += acc[mi][ni][e] * acc[mi][ni][e];
                ss += __shfl_xor(ss, 16);
                ss += __shfl_xor(ss, 32);
                const float rstd = rsqrtf(ss * (1.0f / 64.0f) + EPSF);
                f32x4 val[4];
#pragma unroll
                for (int ni = 0; ni < 4; ++ni) val[ni] = acc[mi][ni] * rstd * gv[ni];
                if (!isq && ctx) {
                    float* nk = p.out + OUT_NK + ((size_t)((tok >> 8) * 2 + layer) * 256 + (tok & 255)) * 128 + (nw - 512) + fq * 4;
#pragma unroll
                    for (int ni = 0; ni < 4; ++ni) *(f32x4*)(nk + ni * 16) = val[ni];
                }
                if (!ctx) {
                    const int pos = (tok - NCTX) & 2047, prow = pos >> 6, pcol = pos & 63;
                    const f32x4 cr = *(const f32x4*)(p.rope + prow * 16 + fq * 4), sr = *(const f32x4*)(p.rope + 1024 + prow * 16 + fq * 4);
                    const f32x4 cc = *(const f32x4*)(p.rope + pcol * 16 + fq * 4), sn = *(const f32x4*)(p.rope + 1024 + pcol * 16 + fq * 4);
                    const f32x4 a0 = val[0], a1 = val[1], a2 = val[2], a3 = val[3];
                    val[0] = a0 * cr - a1 * sr;
                    val[1] = a1 * cr + a0 * sr;
                    val[2] = a2 * cc - a3 * sn;
                    val[3] = a3 * cc + a2 * sn;
                }
                if (isq) {
#pragma unroll
                    for (int ni = 0; ni < 4; ++ni) val[ni] = val[ni] * QSCALE;
                }
                bf16_t* pr = p.proj + (size_t)tok * INW + nw + fq * 4;
#pragma unroll
                for (int ni = 0; ni < 4; ++ni) {
                    u32x2 w;
                    w.x = pk_bf16(val[ni][0], val[ni][1]);
                    w.y = pk_bf16(val[ni][2], val[ni][3]);
                    *(u32x2*)(pr + ni * 16) = w;
                }
            }
        } else {
            const bool isv = nw < 768;
#pragma unroll
            for (int mi = 0; mi < MI; ++mi) {
                const int tok = mw + mi * 16 + fr;
                bf16_t* pr = p.proj + (size_t)tok * INW + nw + fq * 4;
#pragma unroll
                for (int ni = 0; ni < 4; ++ni) {
                    u32x2 w;
                    w.x = pk_bf16(acc[mi][ni][0], acc[mi][ni][1]);
                    w.y = pk_bf16(acc[mi][ni][2], acc[mi][ni][3]);
                    *(u32x2*)(pr + ni * 16) = w;
                }
                if (isv && ctx) {
                    float* nv = p.out + OUT_NV + ((size_t)((tok >> 8) * 2 + layer) * 256 + (tok & 255)) * 128 + (nw - 640) + fq * 4;
#pragma unroll
                    for (int ni = 0; ni < 4; ++ni) *(f32x4*)(nv + ni * 16) = acc[mi][ni];
                }
            }
        }
    } else {
        const int v = mw < NCTX ? 0 : 1 + ((mw - NCTX) >> 11);
        const float* gate = p.modv + (size_t)(layer * 5 + v) * 3072 + 2048 + nw + fq * 4;
        f32x4 gt[4];
#pragma unroll
        for (int ni = 0; ni < 4; ++ni) gt[ni] = *(const f32x4*)(gate + ni * 16);
#pragma unroll
        for (int mi = 0; mi < MI; ++mi) {
            const int tok = mw + mi * 16 + fr;
            const float* ho = (layer == 0 ? (tok < NCTX ? p.x_prompt + (size_t)tok * DM : p.x_sample + (size_t)(tok - NCTX) * DM) : p.h + (size_t)tok * DM) + nw + fq * 4;
            float* hn = (layer == 0 ? p.h : p.out) + (size_t)tok * DM + nw + fq * 4;
#pragma unroll
            for (int ni = 0; ni < 4; ++ni) {
                const f32x4 o = *(const f32x4*)(ho + ni * 16);
                *(f32x4*)(hn + ni * 16) = o + gt[ni] * acc[mi][ni];
            }
        }
    }
}

template <int MODE>
__device__ __forceinline__ void gemm_tile(const Params& p, int layer, int mt, int nt, unsigned char* smem) {
    const int tid = otid(), lane = tid & 63, wave = tid >> 6, wm = wave >> 1, wn = wave & 1;
    const int fr = lane & 15, fq = lane >> 4;
    const int m0 = mt * 128, n0 = nt * 128;
    const bf16_t* A = (MODE == 0 ? p.xn : p.mix) + (size_t)m0 * 1024;
    const bf16_t* B = (MODE == 0 ? p.WinT + (size_t)layer * INW * 1024 : p.WoutT + (size_t)layer * 1024 * 1024) + (size_t)n0 * 1024;
    f32x4 acc[4][4];
#pragma unroll
    for (int i = 0; i < 4; ++i)
#pragma unroll
        for (int j = 0; j < 4; ++j) acc[i][j] = (f32x4){0.f, 0.f, 0.f, 0.f};

    const int srow = tid >> 3, scc = tid & 7;
    const bf16_t* ag = A + (size_t)srow * 1024 + scc * 8;
    const bf16_t* bg = B + (size_t)srow * 1024 + scc * 8;
    const int wofs = srow * 128 + ((scc ^ (srow & 7)) * 16);
    u32x4 raA[4], rbA[4], raB[4], rbB[4];
    auto gload = [&](int kt, u32x4* ra, u32x4* rb) {
#pragma unroll
        for (int i = 0; i < 4; ++i) {
            ra[i] = *(const u32x4*)(ag + (size_t)i * 32 * 1024 + kt * 64);
            rb[i] = *(const u32x4*)(bg + (size_t)i * 32 * 1024 + kt * 64);
        }
    };
    auto swrite = [&](int buf, const u32x4* ra, const u32x4* rb) {
        unsigned char* Aw = smem + buf * 32768;
#pragma unroll
        for (int i = 0; i < 4; ++i) {
            *(u32x4*)(Aw + wofs + i * 4096) = ra[i];
            *(u32x4*)(Aw + 16384 + wofs + i * 4096) = rb[i];
        }
    };
    gload(0, raA, rbA);
    gload(1, raB, rbB);
    swrite(0, raA, rbA);
    __syncthreads();
    const int aro = (wm * 64 + fr) * 128, bro = (wn * 64 + fr) * 128, sw = fr & 7;
    auto step = [&](int kt, u32x4* la, u32x4* lb, const u32x4* wa, const u32x4* wb) {
        const unsigned char* As = smem + (kt & 1) * 32768;
        const unsigned char* Bs = As + 16384;
        bf16x8 af[2][4], bf[2][4];
#pragma unroll
        for (int kk = 0; kk < 2; ++kk) {
            const int co = ((kk * 4 + fq) ^ sw) * 16;
#pragma unroll
            for (int i = 0; i < 4; ++i) {
                af[kk][i] = *(const bf16x8*)(As + aro + i * 2048 + co);
                bf[kk][i] = *(const bf16x8*)(Bs + bro + i * 2048 + co);
            }
        }
        if (kt + 2 < 16) gload(kt + 2, la, lb);
        __builtin_amdgcn_sched_barrier(0);
#pragma unroll
        for (int mi = 0; mi < 4; ++mi)
#pragma unroll
            for (int ni = 0; ni < 4; ++ni) acc[mi][ni] = __builtin_amdgcn_mfma_f32_16x16x32_bf16(bf[0][ni], af[0][mi], acc[mi][ni], 0, 0, 0);
        __builtin_amdgcn_sched_barrier(0);
        if (kt + 1 < 16) swrite((kt + 1) & 1, wa, wb);
        __builtin_amdgcn_sched_barrier(0);
#pragma unroll
        for (int mi = 0; mi < 4; ++mi)
#pragma unroll
            for (int ni = 0; ni < 4; ++ni) acc[mi][ni] = __builtin_amdgcn_mfma_f32_16x16x32_bf16(bf[1][ni], af[1][mi], acc[mi][ni], 0, 0, 0);
        __syncthreads();
    };
    for (int kt = 0; kt < 16; kt += 2) {
        step(kt, raA, rbA, raB, rbB);
        step(kt + 1, raB, rbB, raA, rbA);
    }

    gemm_epilogue<MODE, 4>(p, layer, m0 + wm * 64, n0 + wn * 64, acc, fr, fq);
}

template <int MODE>
__device__ __forceinline__ void gemm_tile256(const Params& p, int layer, int mt, int nt, unsigned char* smem) {
    const int tid = otid(), lane = tid & 63, wave = tid >> 6, wm = wave >> 1, wn = wave & 1;
    const int fr = lane & 15, fq = lane >> 4;
    const int m0 = mt * 256, n0 = nt * 128;
    const bf16_t* A = (MODE == 0 ? p.xn : p.mix) + (size_t)m0 * 1024;
    const bf16_t* B = (MODE == 0 ? p.WinT + (size_t)layer * INW * 1024 : p.WoutT + (size_t)layer * 1024 * 1024) + (size_t)n0 * 1024;
    f32x4 acc[8][4];
#pragma unroll
    for (int i = 0; i < 8; ++i)
#pragma unroll
        for (int j = 0; j < 4; ++j) acc[i][j] = (f32x4){0.f, 0.f, 0.f, 0.f};
    const int srow = tid >> 2, scc = tid & 3;
    const bf16_t* ag = A + (size_t)srow * 1024 + scc * 8;
    const bf16_t* bg = B + (size_t)srow * 1024 + scc * 8;
    const int wofs = srow * 64 + ((scc ^ ((4 - ((srow >> 2) & 3)) & 3)) * 16);
    u32x4 raA[4], rbA[2], raB[4], rbB[2];
    auto gload = [&](int kt, u32x4* ra, u32x4* rb) {
#pragma unroll
        for (int i = 0; i < 4; ++i) ra[i] = *(const u32x4*)(ag + (size_t)i * 64 * 1024 + kt * 32);
#pragma unroll
        for (int i = 0; i < 2; ++i) rb[i] = *(const u32x4*)(bg + (size_t)i * 64 * 1024 + kt * 32);
    };
    auto swrite = [&](int buf, const u32x4* ra, const u32x4* rb) {
        unsigned char* Aw = smem + buf * 24576;
#pragma unroll
        for (int i = 0; i < 4; ++i) *(u32x4*)(Aw + wofs + i * 4096) = ra[i];
#pragma unroll
        for (int i = 0; i < 2; ++i) *(u32x4*)(Aw + 16384 + wofs + i * 4096) = rb[i];
    };
    gload(0, raA, rbA);
    gload(1, raB, rbB);
    swrite(0, raA, rbA);
    __syncthreads();
    const int co = (fq ^ ((4 - ((fr >> 2) & 3)) & 3)) * 16;
    const int aro = (wm * 128 + fr) * 64 + co, bro = (wn * 64 + fr) * 64 + co;
    auto step = [&](int kt, u32x4* la, u32x4* lb, const u32x4* wa, const u32x4* wb) {
        const unsigned char* As = smem + (kt & 1) * 24576;
        const unsigned char* Bs = As + 16384;
        bf16x8 af[8], bf[4];
#pragma unroll
        for (int i = 0; i < 4; ++i) bf[i] = *(const bf16x8*)(Bs + bro + i * 1024);
#pragma unroll
        for (int i = 0; i < 8; ++i) af[i] = *(const bf16x8*)(As + aro + i * 1024);
        if (kt + 2 < 32) gload(kt + 2, la, lb);
        __builtin_amdgcn_sched_barrier(0);
#pragma unroll
        for (int mi = 0; mi < 4; ++mi)
#pragma unroll
            for (int ni = 0; ni < 4; ++ni) acc[mi][ni] = __builtin_amdgcn_mfma_f32_16x16x32_bf16(bf[ni], af[mi], acc[mi][ni], 0, 0, 0);
        __builtin_amdgcn_sched_barrier(0);
        if (kt + 1 < 32) swrite((kt + 1) & 1, wa, wb);
        __builtin_amdgcn_sched_barrier(0);
#pragma unroll
        for (int mi = 4; mi < 8; ++mi)
#pragma unroll
            for (int ni = 0; ni < 4; ++ni) acc[mi][ni] = __builtin_amdgcn_mfma_f32_16x16x32_bf16(bf[ni], af[mi], acc[mi][ni], 0, 0, 0);
        __syncthreads();
    };
    for (int kt = 0; kt < 32; kt += 2) {
        step(kt, raA, rbA, raB, rbB);
        step(kt + 1, raB, rbB, raA, rbA);
    }
    gemm_epilogue<MODE, 8>(p, layer, m0 + wm * 128, n0 + wn * 64, acc, fr, fq);
}

template <int MODE>
__device__ __forceinline__ void phase_gemm(const Params& p, int layer, unsigned char* smem) {
    const int NT = MODE == 0 ? 22 : 8;
    const int total = 96 * NT;
    if (gridDim.x == 512) {
        const int xcd = blockIdx.x & 7, slot = blockIdx.x >> 3;
        if (MODE == 0) {
            for (int idx = slot; idx < 128; idx += 64) gemm_tile256<MODE>(p, layer, xcd * 6 + idx % 6, idx / 6, smem);
            if (slot < 8) gemm_tile<MODE>(p, layer, (xcd * 6 + 2 + (slot >> 1)) * 2 + (slot & 1), 21, smem);
        } else {
            if (slot < 32) gemm_tile256<MODE>(p, layer, xcd * 6 + slot % 6, slot / 6, smem);
            else {
                const int d = 32 + ((slot - 32) >> 1);
                gemm_tile<MODE>(p, layer, (xcd * 6 + d % 6) * 2 + (slot & 1), d / 6, smem);
            }
        }
    } else {
        for (int t = blockIdx.x; t < total; t += gridDim.x) gemm_tile<MODE>(p, layer, t / NT, t % NT, smem);
    }
}

template <int VAR>
__device__ __forceinline__ void attn_unit(const Params& p, int layer, int unit, unsigned char* smem) {
    const int tid = otid(), lane = tid & 63, wave = tid >> 6;
    const int r31 = lane & 31, hh = lane >> 5;
    int b, head, qblk, tokbase, nself, ntiles;
    if (unit < 512) { b = unit >> 7; head = (unit >> 4) & 7; qblk = unit & 15; tokbase = NCTX + b * 2048; nself = 2048; ntiles = 36; }
    else { const int u = unit - 512; b = u >> 4; head = (u >> 1) & 7; qblk = u & 1; tokbase = b * 256; nself = 256; ntiles = 4; }
    const int kvh = head >> 2;
    const int qtok = tokbase + qblk * 128 + wave * 32 + r31;
    bf16x8 qf[4];
    {
        const bf16_t* qp = p.proj + (size_t)qtok * INW + head * 64 + hh * 8;
#pragma unroll
        for (int ks = 0; ks < 4; ++ks) qf[ks] = *(const bf16x8*)(qp + ks * 16);
    }
    const bf16_t* kself = p.proj + (size_t)tokbase * INW + 512 + kvh * 64;
    const bf16_t* vself = p.proj + (size_t)tokbase * INW + 640 + kvh * 64;
    const bf16_t* kcache = p.kc + (size_t)((b * 2 + layer) * 2 + kvh) * 256 * 64;
    const bf16_t* vcache = p.vc + (size_t)((b * 2 + layer) * 2 + kvh) * 256 * 64;
    const int srow = tid >> 3, scc = tid & 7;
    const int kwo = srow * 128 + ((scc ^ ((srow >> 1) & 7)) * 16);
    const int vwo = srow * 128 + ((scc ^ (((srow >> 1) & 1) << 2)) * 16);
    u32x4 rkA[2], rvA[2], rkB[2], rvB[2];
    auto gload = [&](int j, u32x4* rk, u32x4* rv) {
        const int key0 = j * 64;
#pragma unroll
        for (int i = 0; i < 2; ++i) {
            const int row = srow + 32 * i;
            if (key0 < nself) {
                rk[i] = *(const u32x4*)(kself + (size_t)(key0 + row) * INW + scc * 8);
                rv[i] = *(const u32x4*)(vself + (size_t)(key0 + row) * INW + scc * 8);
            } else {
                rk[i] = *(const u32x4*)(kcache + (size_t)(key0 - nself + row) * 64 + scc * 8);
                rv[i] = *(const u32x4*)(vcache + (size_t)(key0 - nself + row) * 64 + scc * 8);
            }
        }
    };
    auto swrite = [&](int buf, const u32x4* rk, const u32x4* rv) {
        unsigned char* kb = smem + buf * 16384;
        unsigned char* vb = kb + 8192;
#pragma unroll
        for (int i = 0; i < 2; ++i) {
            *(u32x4*)(kb + kwo + i * 32 * 128) = rk[i];
            *(u32x4*)(vb + vwo + i * 32 * 128) = rv[i];
        }
    };
    f32x16 o[2];
#pragma unroll
    for (int i = 0; i < 16; ++i) { o[0][i] = 0.f; o[1][i] = 0.f; }
    float mrun = 0.f, mmax = -1e30f, lrun = 0.f;
    f32x16 negm, zero16;
#pragma unroll
    for (int i = 0; i < 16; ++i) { negm[i] = 0.f; zero16[i] = 0.f; }
    bool shifted = false;
    gload(0, rkA, rvA);
    swrite(0, rkA, rvA);
    if (ntiles > 1) gload(1, rkB, rvB);
    __syncthreads();
    const int kro = r31 * 128, ksw = (r31 >> 1) & 7;
    const int vq = 4 * hh + ((lane & 15) >> 2);
    const int vsw = ((vq >> 1) & 1) << 2;
    const int vcl = ((lane >> 4) & 1) * 2 + ((lane & 3) >> 1);
    const int vro0 = vq * 128 + (((0 * 4 + vcl) ^ vsw) * 16) + (lane & 1) * 8;
    const int vro1 = vq * 128 + (((1 * 4 + vcl) ^ vsw) * 16) + (lane & 1) * 8;
    auto step = [&](int j, u32x4* lk, u32x4* lv, const u32x4* wk, const u32x4* wv) {
        const unsigned char* kb = smem + (j & 1) * 16384;
        const unsigned char* vb = kb + 8192;
        bf16x8 kf[2][4];
#pragma unroll
        for (int sb = 0; sb < 2; ++sb)
#pragma unroll
            for (int ks = 0; ks < 4; ++ks) kf[sb][ks] = *(const bf16x8*)(kb + sb * 4096 + kro + (((ks * 2 + hh) ^ ksw) * 16));
        if (VAR != 1 && j + 2 < ntiles) gload(j + 2, lk, lv);
        __builtin_amdgcn_sched_barrier(0);
        f32x16 s[2];
#pragma unroll
        for (int ks = 0; ks < 4; ++ks)
#pragma unroll
            for (int sb = 0; sb < 2; ++sb) {
                if (ks == 0) {
                    if (shifted) s[sb] = __builtin_amdgcn_mfma_f32_32x32x16_bf16(kf[sb][ks], qf[ks], negm, 0, 0, 0);
                    else s[sb] = __builtin_amdgcn_mfma_f32_32x32x16_bf16(kf[sb][ks], qf[ks], zero16, 0, 0, 0);
                } else s[sb] = __builtin_amdgcn_mfma_f32_32x32x16_bf16(kf[sb][ks], qf[ks], s[sb], 0, 0, 0);
            }
        __builtin_amdgcn_sched_barrier(0);
        bf16x8 vf[2][2][2];
#pragma unroll
        for (int sb = 0; sb < 2; ++sb)
#pragma unroll
            for (int s2 = 0; s2 < 2; ++s2)
#pragma unroll
                for (int dt = 0; dt < 2; ++dt) {
                    const LAS unsigned char* va = (const LAS unsigned char*)(vb) + (sb * 32 + s2 * 16) * 128 + (dt ? vro1 : vro0);
                    const s16x4 a0 = __builtin_amdgcn_ds_read_tr16_b64_v4i16((LAS s16x4*)(va));
                    const s16x4 a1 = __builtin_amdgcn_ds_read_tr16_b64_v4i16((LAS s16x4*)(va + 8 * 128));
                    vf[sb][s2][dt] = (bf16x8){a0[0], a0[1], a0[2], a0[3], a1[0], a1[1], a1[2], a1[3]};
                }
        __builtin_amdgcn_sched_barrier(0);
        float mloc = max3_f(s[0][0], s[1][0], s[0][1]);
        mloc = max3_f(mloc, s[1][1], s[0][2]);
#pragma unroll
        for (int i = 2; i < 16; ++i) mloc = max3_f(mloc, s[1][i], s[0][(i + 1) & 15]);
        float lsum = 0.f;
#pragma unroll
        for (int sb = 0; sb < 2; ++sb)
#pragma unroll
            for (int i = 0; i < 16; ++i) { if (VAR != 2) { s[sb][i] = __builtin_amdgcn_exp2f(s[sb][i]); lsum += s[sb][i]; } }
        lrun += lsum;
        bf16x8 pf[2][2];
#pragma unroll
        for (int sb = 0; sb < 2; ++sb)
#pragma unroll
            for (int s2 = 0; s2 < 2; ++s2) {
                u32x4 pw;
                pw.x = pk_bf16(s[sb][s2 * 8 + 0], s[sb][s2 * 8 + 1]);
                pw.y = pk_bf16(s[sb][s2 * 8 + 2], s[sb][s2 * 8 + 3]);
                pw.z = pk_bf16(s[sb][s2 * 8 + 4], s[sb][s2 * 8 + 5]);
                pw.w = pk_bf16(s[sb][s2 * 8 + 6], s[sb][s2 * 8 + 7]);
                pf[sb][s2] = __builtin_bit_cast(bf16x8, pw);
            }
        __builtin_amdgcn_sched_barrier(0);
#pragma unroll
        for (int sb = 0; sb < 2; ++sb)
#pragma unroll
            for (int s2 = 0; s2 < 2; ++s2)
#pragma unroll
                for (int dt = 0; dt < 2; ++dt) o[dt] = __builtin_amdgcn_mfma_f32_32x32x16_bf16(vf[sb][s2][dt], pf[sb][s2], o[dt], 0, 0, 0);
        __builtin_amdgcn_sched_barrier(0);
        mloc = fmaxf(mloc, __shfl_xor(mloc, 32));
        mmax = fmaxf(mmax, mrun + mloc);
        if (__builtin_expect(__any(fabsf(mmax - mrun) > 40.0f), 0)) {
            asm volatile("" ::: "memory");
            const float alpha = __builtin_amdgcn_exp2f(mrun - mmax);
            mrun = mmax;
            lrun *= alpha;
            shifted = true;
#pragma unroll
            for (int i = 0; i < 16; ++i) { o[0][i] *= alpha; o[1][i] *= alpha; negm[i] = -mrun; }
        }
        if (VAR != 1 && j + 1 < ntiles) swrite((j + 1) & 1, wk, wv);
        __syncthreads();
    };
    for (int j = 0; j < ntiles; j += 2) {
        step(j, rkA, rvA, rkB, rvB);
        step(j + 1, rkB, rvB, rkA, rvA);
    }
    const float ltot = lrun + __shfl_xor(lrun, 32);
    const float inv = 1.0f / ltot;
    const bf16_t* zp = p.proj + (size_t)qtok * INW + 768 + head * 64;
    bf16_t* mp = (VAR == 0 ? p.mix : p.xn) + (size_t)qtok * DM + head * 64;
#pragma unroll
    for (int dt = 0; dt < 2; ++dt)
#pragma unroll
        for (int rq = 0; rq < 4; ++rq) {
            const int d0 = dt * 32 + 8 * rq + 4 * hh;
            const u32x2 zz = *(const u32x2*)(zp + d0);
            const float z0 = bf_lo(zz.x), z1 = bf_hi(zz.x), z2 = bf_lo(zz.y), z3 = bf_hi(zz.y);
            u32x2 w;
            w.x = pk_bf16(o[dt][rq * 4 + 0] * inv * silu_f(z0), o[dt][rq * 4 + 1] * inv * silu_f(z1));
            w.y = pk_bf16(o[dt][rq * 4 + 2] * inv * silu_f(z2), o[dt][rq * 4 + 3] * inv * silu_f(z3));
            *(u32x2*)(mp + d0) = w;
        }
}

__device__ __forceinline__ void unpack8(const u32x4 u, float* f) {
    f[0] = bf_lo(u.x); f[1] = bf_hi(u.x); f[2] = bf_lo(u.y); f[3] = bf_hi(u.y);
    f[4] = bf_lo(u.z); f[5] = bf_hi(u.z); f[6] = bf_lo(u.w); f[7] = bf_hi(u.w);
}

__device__ __forceinline__ void pool_item(const Params& p, int layer, int pi, unsigned char* smem) {
    const int tid = otid(), lane = tid & 63, gi = tid >> 6;
    const int fr = lane & 15, fq = lane >> 4;
    const int T0 = pi * 64;
    int seqstart, seqlen;
    if (T0 < NCTX) { seqstart = T0 & ~255; seqlen = 256; } else { seqstart = NCTX + ((T0 - NCTX) & ~2047); seqlen = 2048; }
    const int toff = T0 - seqstart;
    for (int e = tid; e < 79 * 32; e += 256) {
        const int r = e >> 5, c = e & 31;
        const int s = toff - 8 + r;
        if (s >= 0 && s < seqlen) *(u32x4*)(smem + r * 528 + c * 16) = *(const u32x4*)(p.proj + (size_t)(seqstart + s) * INW + 2304 + c * 8);
    }
    __syncthreads();
    const int win = 2 << gi, half = win >> 1;
    bf16x8 wf[4][2];
    {
        const bf16_t* wp = p.PoolT + (size_t)((layer * 4 + gi) * 64) * 64;
#pragma unroll
        for (int ni = 0; ni < 4; ++ni)
#pragma unroll
            for (int kk = 0; kk < 2; ++kk) wf[ni][kk] = *(const bf16x8*)(wp + (ni * 16 + fr) * 64 + kk * 32 + fq * 8);
    }
#pragma unroll 1
    for (int mi = 0; mi < 4; ++mi) {
        f32x4 acc[4];
#pragma unroll
        for (int j = 0; j < 4; ++j) acc[j] = (f32x4){0.f, 0.f, 0.f, 0.f};
        const int tt = mi * 16 + fr;
        const int ts = toff + tt;
        int lo = ts - half, hi = ts - half + win - 1;
        lo = lo < 0 ? 0 : lo;
        hi = hi > seqlen - 1 ? seqlen - 1 : hi;
        const float rc = 1.0f / (float)(hi - lo + 1);
        const int r0 = lo - toff + 8, r1 = hi - toff + 8, rs = tt + 8;
#pragma unroll
        for (int kk = 0; kk < 2; ++kk) {
            const int co = (gi * 64 + kk * 32 + fq * 8) * 2;
            float sum[8];
#pragma unroll
            for (int e = 0; e < 8; ++e) sum[e] = 0.f;
            for (int r = r0; r <= r1; ++r) {
                float f[8];
                unpack8(*(const u32x4*)(smem + r * 528 + co), f);
#pragma unroll
                for (int e = 0; e < 8; ++e) sum[e] += f[e];
            }
            float us[8];
            unpack8(*(const u32x4*)(smem + rs * 528 + co), us);
            u32x4 dw;
            dw.x = pk_bf16(sum[0] * rc - us[0], sum[1] * rc - us[1]);
            dw.y = pk_bf16(sum[2] * rc - us[2], sum[3] * rc - us[3]);
            dw.z = pk_bf16(sum[4] * rc - us[4], sum[5] * rc - us[5]);
            dw.w = pk_bf16(sum[6] * rc - us[6], sum[7] * rc - us[7]);
            const bf16x8 df = __builtin_bit_cast(bf16x8, dw);
#pragma unroll
            for (int ni = 0; ni < 4; ++ni) acc[ni] = __builtin_amdgcn_mfma_f32_16x16x32_bf16(wf[ni][kk], df, acc[ni], 0, 0, 0);
        }
        const int tok = T0 + tt;
#pragma unroll
        for (int ni = 0; ni < 4; ++ni) {
            const int ch = gi * 64 + ni * 16 + fq * 4;
            const f32x4 ps = *(const f32x4*)(p.pool_scale + layer * 256 + ch);
            const u32x2 zz = *(const u32x2*)(p.proj + (size_t)tok * INW + 2560 + ch);
            u32x2 w;
            w.x = pk_bf16(acc[ni][0] * ps[0] * silu_f(bf_lo(zz.x)), acc[ni][1] * ps[1] * silu_f(bf_hi(zz.x)));
            w.y = pk_bf16(acc[ni][2] * ps[2] * silu_f(bf_lo(zz.y)), acc[ni][3] * ps[3] * silu_f(bf_hi(zz.y)));
            *(u32x2*)(p.mix + (size_t)tok * DM + 768 + ch) = w;
        }
    }
    __syncthreads();
}

__device__ __forceinline__ void conv_item(const Params& p, int layer, int ci) {
    const int tid = otid();
    const int ch = (tid & 31) * 8, tg = tid >> 5;
    const int T0 = ci * 64 + tg * 8;
    int seqstart, seqlen;
    if (T0 < NCTX) { seqstart = T0 & ~255; seqlen = 256; } else { seqstart = NCTX + ((T0 - NCTX) & ~2047); seqlen = 2048; }
    const int seqend = seqstart + seqlen;
    float w0[8], w1[8], w2[8], bb[8];
    {
        const float* cw = p.conv_w + (size_t)layer * 768 + ch;
#pragma unroll
        for (int e = 0; e < 8; ++e) { w0[e] = cw[e]; w1[e] = cw[256 + e]; w2[e] = cw[512 + e]; bb[e] = p.conv_b[layer * 256 + ch + e]; }
    }
    auto ldx = [&](int tok, float* x) {
        if (tok >= seqstart && tok < seqend) {
            float hc[8], cc[8];
            unpack8(*(const u32x4*)(p.proj + (size_t)tok * INW + 1280 + ch), hc);
            unpack8(*(const u32x4*)(p.proj + (size_t)tok * INW + 1792 + ch), cc);
#pragma unroll
            for (int e = 0; e < 8; ++e) x[e] = hc[e] * cc[e];
        } else {
#pragma unroll
            for (int e = 0; e < 8; ++e) x[e] = 0.f;
        }
    };
    float xm[8], x0[8], xp[8];
    ldx(T0 - 1, xm);
    ldx(T0, x0);
    for (int t = 0; t < 8; ++t) {
        const int tok = T0 + t;
        ldx(tok + 1, xp);
        float bc[8], zc[8], o[8];
        unpack8(*(const u32x4*)(p.proj + (size_t)tok * INW + 1536 + ch), bc);
        unpack8(*(const u32x4*)(p.proj + (size_t)tok * INW + 2048 + ch), zc);
#pragma unroll
        for (int e = 0; e < 8; ++e) {
            const float y = xm[e] * w0[e] + x0[e] * w1[e] + xp[e] * w2[e] + bb[e];
            o[e] = bc[e] * y * silu_f(zc[e]);
        }
        u32x4 w;
        w.x = pk_bf16(o[0], o[1]); w.y = pk_bf16(o[2], o[3]); w.z = pk_bf16(o[4], o[5]); w.w = pk_bf16(o[6], o[7]);
        *(u32x4*)(p.mix + (size_t)tok * DM + 512 + ch) = w;
#pragma unroll
        for (int e = 0; e < 8; ++e) { xm[e] = x0[e]; x0[e] = xp[e]; }
    }
}

__device__ __forceinline__ void phase_mixer(const Params& p, int layer, unsigned char* smem) {
    for (int it = blockIdx.x; it < 768 + 192 + 192; it += gridDim.x) {
        if (it < 768) {
            attn_unit<0>(p, layer, it, smem);
        }
        else if (it < 960) pool_item(p, layer, it - 768, smem);
        else conv_item(p, layer, it - 960);
    }
}

__global__ void __launch_bounds__(256, 2) mega(Params p, int lo, int hi) {
    __shared__ __attribute__((aligned(16))) unsigned char smem[65536];
    __shared__ uint4 xbw;
    if (p.use_cg) cg::this_grid().sync();
    if (threadIdx.x == 0) xbw = make_uint4(0u, 0u, 0u, 0u);
    __syncthreads();
    XcdBarrier xb = xcd_barrier_post(p.bar, (volatile LAS unsigned*)&xbw);
    for (int ph = lo; ph < hi; ++ph) {
        if (ph > lo) xcd_barrier(xb);
        if (ph == 0) phase_prep(p, smem);
        else if (ph == 9) phase_final(p);
        else {
            const int layer = (ph - 1) >> 2, ty = (ph - 1) & 3;
            if (ty == 0) phase_xn(p, layer);
            else if (ty == 1) phase_gemm<0>(p, layer, smem);
            else if (ty == 2) phase_mixer(p, layer, smem);
            else phase_gemm<1>(p, layer, smem);
        }
    }
}

#ifndef MK_MULTI
#define MK_MULTI 0
#endif

extern "C" void kernel_launch(void* const* d_in, const int* in_sizes, int n_in, void* d_out, int out_size, void* d_ws, size_t ws_size,
                              hipStream_t stream) {
    static int grid_blocks = 0;
    if (!grid_blocks) {
        int dev = 0, cus = 0, per_cu = 0;
        hipGetDevice(&dev);
        hipDeviceGetAttribute(&cus, hipDeviceAttributeMultiprocessorCount, dev);
        hipOccupancyMaxActiveBlocksPerMultiprocessor(&per_cu, mega, 256, 0);
        if (per_cu > 2) per_cu = 2;
        if (per_cu < 1) per_cu = 1;
        grid_blocks = cus * per_cu;
    }
    Params p{};
    const float* const* in = (const float* const*)d_in;
    p.x_prompt = in[0]; p.x_sample = in[1]; p.cache_k = in[2]; p.cache_v = in[3]; p.c = in[4]; p.c_ctx = in[5]; p.norm_g = in[6];
    p.w_ada = in[7]; p.b_ada = in[8]; p.w_in = in[9]; p.q_g = in[10]; p.k_g = in[11]; p.conv_w = in[12]; p.conv_b = in[13];
    p.pool_w = in[14]; p.pool_scale = in[15]; p.w_out = in[16]; p.final_g = in[17];
    p.out = (float*)d_out;
    unsigned char* ws = (unsigned char*)d_ws;
    size_t off = 0;
    auto take = [&](size_t bytes) { unsigned char* r = ws + off; off += (bytes + 255) & ~(size_t)255; return r; };
    p.bar = (unsigned*)take(XCD_BAR_WORDS * 4);
    p.modv = (float*)take(2 * 5 * 3072 * 4);
    p.rope = (float*)take(2048 * 4);
    p.WinT = (bf16_t*)take((size_t)2 * INW * 1024 * 2);
    p.WoutT = (bf16_t*)take((size_t)2 * 1024 * 1024 * 2);
    p.PoolT = (bf16_t*)take(2 * 4 * 64 * 64 * 2);
    p.kc = (bf16_t*)take(262144 * 2);
    p.vc = (bf16_t*)take(262144 * 2);
    p.h = (float*)take((size_t)NTOK * DM * 4);
    p.xn = (bf16_t*)take((size_t)NTOK * DM * 2);
    p.proj = (bf16_t*)take((size_t)NTOK * INW * 2);
    p.mix = (bf16_t*)take((size_t)NTOK * DM * 2);
    p.use_cg = 0;
    p.pad = 0;
    hipMemsetAsync(p.bar, 0, XCD_BAR_WORDS * 4, stream);
#if MK_MULTI
    for (int ph = 0; ph < 10; ++ph) {
        int lo = ph, hi = ph + 1;
        void* args[] = {&p, &lo, &hi};
        hipError_t e = hipLaunchCooperativeKernel((void*)mega, dim3(grid_blocks), dim3(256), args, 0, stream);
        if (e != hipSuccess) fprintf(stderr, "launch failed: %s\n", hipGetErrorString(e));
    }
#else
    int lo = 0, hi = 10;
    void* args[] = {&p, &lo, &hi};
    hipError_t e = hipLaunchCooperativeKernel((void*)mega, dim3(grid_blocks), dim3(256), args, 0, stream);
    if (e != hipSuccess) fprintf(stderr, "cooperative launch failed: %s (grid %d)\n", hipGetErrorString(e), grid_blocks);
#endif
}
```

```cpp
#include <hip/hip_runtime.h>
#include <hip/hip_cooperative_groups.h>
#include <cstdint>
#include <cstdio>
namespace cg = cooperative_groups;

#define LAS __attribute__((address_space(3)))
typedef unsigned short bf16_t;
typedef short bf16x8 __attribute__((ext_vector_type(8)));
typedef short s16x4 __attribute__((ext_vector_type(4)));
typedef float f32x4 __attribute__((ext_vector_type(4)));
typedef float f32x16 __attribute__((ext_vector_type(16)));
typedef unsigned u32x4 __attribute__((ext_vector_type(4)));
typedef unsigned u32x2 __attribute__((ext_vector_type(2)));

constexpr int NTOK = 12288, NCTX = 4096, DM = 1024, INW = 2816;
constexpr size_t OUT_NK = 12582912, OUT_NV = 13631488;
constexpr float EPSF = 1e-6f;
constexpr float QSCALE = 0.125f * 1.4426950408889634f;

struct Params {
    const float *x_prompt, *x_sample, *cache_k, *cache_v, *c, *c_ctx, *norm_g, *w_ada, *b_ada, *w_in, *q_g, *k_g, *conv_w, *conv_b,
        *pool_w, *pool_scale, *w_out, *final_g;
    float* out;
    unsigned* bar;
    float* modv;
    float* rope;
    bf16_t* WinT;
    bf16_t* WoutT;
    bf16_t* PoolT;
    bf16_t* kc;
    bf16_t* vc;
    float* h;
    bf16_t* xn;
    bf16_t* proj;
    bf16_t* mix;
    int use_cg;
    int pad;
};

__device__ __forceinline__ unsigned pk_bf16(float lo, float hi) {
    unsigned r;
    asm("v_cvt_pk_bf16_f32 %0, %1, %2" : "=v"(r) : "v"(lo), "v"(hi));
    return r;
}
__device__ __forceinline__ float bf_lo(unsigned u) { return __uint_as_float(u << 16); }
__device__ __forceinline__ float bf_hi(unsigned u) { return __uint_as_float(u & 0xffff0000u); }
__device__ __forceinline__ float silu_f(float z) { return z / (1.0f + __expf(-z)); }
__device__ __forceinline__ float max3_f(float a, float b, float c) { float r; asm("v_max3_f32 %0, %1, %2, %3" : "=v"(r) : "v"(a), "v"(b), "v"(c)); return r; }
__device__ __forceinline__ int otid() { int t = threadIdx.x; asm volatile("" : "+v"(t)); return t; }

#define XB_TMO 128
#define XB_XCNT(j) (256 + 64 * (j))
#define XB_XSUB(j) (1280 + 64 * (j))
#define XB_XGEN(j) (2304 + 64 * (j))
#define XB_TOP 3328
#define XB_TOPGEN 3392
#define XCD_BAR_WORDS 3456
#define XB_SPIN_CAP (1u << 20)

__device__ __forceinline__ unsigned xb_ld(unsigned* p) { return __hip_atomic_load(p, __ATOMIC_RELAXED, __HIP_MEMORY_SCOPE_AGENT); }
__device__ __forceinline__ unsigned xb_add(unsigned* p, unsigned v) { return __hip_atomic_fetch_add(p, v, __ATOMIC_RELAXED, __HIP_MEMORY_SCOPE_AGENT); }
__device__ __forceinline__ unsigned xb_xcc_id() { return (unsigned)__builtin_amdgcn_s_getreg((3 << 11) | 20) & 0xFu; }
#define XB_SPIN(cond, bar)                                                   \
    do {                                                                     \
        unsigned _sp = 0;                                                    \
        while (cond) {                                                       \
            __builtin_amdgcn_s_sleep(1);                                     \
            if ((++_sp & 255u) == 0u) {                                      \
                if (xb_ld(&(bar)[XB_TMO])) break;                            \
                if (_sp > XB_SPIN_CAP) { atomicAdd(&(bar)[XB_TMO], 1u); break; } \
            }                                                                \
        }                                                                    \
    } while (0)

struct XcdBarrier {
    unsigned* bar;
    unsigned x;
    volatile LAS unsigned* st;
};

__device__ __forceinline__ XcdBarrier xcd_barrier_post(unsigned* bar, volatile LAS unsigned* st) {
    XcdBarrier b;
    b.bar = bar;
    b.x = xb_xcc_id();
    b.st = st;
    if (threadIdx.x == 0) (void)xb_add(&bar[XB_XCNT(b.x)], 1u);
    return b;
}
__device__ __forceinline__ void xcd_barrier_complete(unsigned* bar, unsigned x, unsigned& nloc, unsigned& nx) {
    const unsigned G = gridDim.x * gridDim.y * gridDim.z;
    unsigned sum, cnt, mine, sp = 0u;
    for (;;) {
        sum = 0u; cnt = 0u; mine = 0u;
#pragma unroll
        for (unsigned j = 0; j < 16; ++j) {
            const unsigned c = xb_ld(&bar[XB_XCNT(j)]);
            sum += c; cnt += (c > 0u) ? 1u : 0u; mine = (j == x) ? c : mine;
        }
        if (sum == G) break;
        __builtin_amdgcn_s_sleep(1);
        if ((++sp & 255u) == 0u) {
            if (xb_ld(&bar[XB_TMO])) break;
            if (sp > XB_SPIN_CAP) { atomicAdd(&bar[XB_TMO], 1u); break; }
        }
    }
    nloc = mine > 0u ? mine : 1u;
    nx = cnt > 0u ? cnt : 1u;
}
__device__ __forceinline__ void xcd_barrier(const XcdBarrier& b) {
    asm volatile("s_waitcnt vmcnt(0)" ::: "memory");
    __syncthreads();
    if (threadIdx.x == 0) {
        unsigned* bar = b.bar;
        __builtin_amdgcn_s_waitcnt(0);
        unsigned nloc = b.st[0], nx = b.st[1];
        if (nloc == 0u) { xcd_barrier_complete(bar, b.x, nloc, nx); b.st[0] = nloc; b.st[1] = nx; }
        const unsigned old = xb_add(&bar[XB_XSUB(b.x)], 1u);
        const unsigned gen = old / nloc;
        if (old + 1u == (gen + 1u) * nloc) {
            __builtin_amdgcn_fence(__ATOMIC_RELEASE, "agent");
            asm volatile("s_waitcnt vmcnt(0)" ::: "memory");
            const unsigned og = xb_add(&bar[XB_TOP], 1u);
            const unsigned tg = og / nx;
            if (og + 1u == (tg + 1u) * nx) xb_add(&bar[XB_TOPGEN], 1u);
            else XB_SPIN(xb_ld(&bar[XB_TOPGEN]) == tg, bar);
            __builtin_amdgcn_fence(__ATOMIC_ACQUIRE, "agent");
            xb_add(&bar[XB_XGEN(b.x)], 1u);
            asm volatile("s_waitcnt vmcnt(0)" ::: "memory");
        } else {
            XB_SPIN(xb_ld(&bar[XB_XGEN(b.x)]) == gen, bar);
            __builtin_amdgcn_fence(__ATOMIC_ACQUIRE, "agent");
            asm volatile("s_waitcnt vmcnt(0)" ::: "memory");
        }
    }
    __syncthreads();
}

__device__ __forceinline__ void prep_mod_item(const Params& p, int item, unsigned char* smem) {
    const int tid = otid();
    float* sc = (float*)smem;
    float* red = (float*)(smem + 20480);
    const int l = item / 96, j0 = (item % 96) * 32;
    for (int idx = tid; idx < 5120; idx += 256) {
        const int v = idx >> 10, k = idx & 1023;
        const float cv = (v == 0) ? p.c_ctx[k] : p.c[(v - 1) * 1024 + k];
        sc[idx] = cv / (1.0f + expf(-cv));
    }
    __syncthreads();
    const int cgp = tid & 7, kg = tid >> 3;
    float acc[5][4];
#pragma unroll
    for (int v = 0; v < 5; ++v)
#pragma unroll
        for (int e = 0; e < 4; ++e) acc[v][e] = 0.f;
    const float* wp = p.w_ada + (size_t)l * 1024 * 3072 + j0 + cgp * 4;
#pragma unroll 8
    for (int kk = 0; kk < 32; ++kk) {
        const int k = kk * 32 + kg;
        const f32x4 w = *(const f32x4*)(wp + (size_t)k * 3072);
#pragma unroll
        for (int v = 0; v < 5; ++v) {
            const float s = sc[v * 1024 + k];
#pragma unroll
            for (int e = 0; e < 4; ++e) acc[v][e] += s * w[e];
        }
    }
#pragma unroll
    for (int v = 0; v < 5; ++v)
#pragma unroll
        for (int e = 0; e < 4; ++e) red[kg * 160 + v * 32 + cgp * 4 + e] = acc[v][e];
    __syncthreads();
    if (tid < 160) {
        float s = 0.f;
        for (int g = 0; g < 32; ++g) s += red[g * 160 + tid];
        const int v = tid >> 5, cc = tid & 31;
        p.modv[(size_t)(l * 5 + v) * 3072 + j0 + cc] = s + p.b_ada[l * 3072 + j0 + cc];
    }
    __syncthreads();
}

__device__ __forceinline__ void prep_transpose_tile(const float* src, bf16_t* dst, int N, int k0, int n0, unsigned char* smem) {
    const int tid = otid();
    bf16_t* T = (bf16_t*)smem;
    {
        const int row = tid >> 2, seg = tid & 3;
        const float* s = src + (size_t)(k0 + row) * N + n0 + seg * 16;
        f32x4 v[4];
#pragma unroll
        for (int i = 0; i < 4; ++i) v[i] = *(const f32x4*)(s + i * 4);
#pragma unroll
        for (int i = 0; i < 4; ++i)
#pragma unroll
            for (int e = 0; e < 4; ++e) {
                const unsigned u = pk_bf16(v[i][e], 0.f);
                T[(seg * 16 + i * 4 + e) * 72 + row] = (bf16_t)(u & 0xffffu);
            }
    }
    __syncthreads();
    {
        const int n = tid >> 2, seg = tid & 3;
        const u32x4 a = *(const u32x4*)(T + n * 72 + seg * 16);
        const u32x4 b = *(const u32x4*)(T + n * 72 + seg * 16 + 8);
        bf16_t* d = dst + (size_t)(n0 + n) * 1024 + k0 + seg * 16;
        *(u32x4*)d = a;
        *(u32x4*)(d + 8) = b;
    }
    __syncthreads();
}

__device__ __forceinline__ void phase_prep(const Params& p, unsigned char* smem) {
    const int NMOD = 192, NTI = 2 * 16 * 44, NTO = 2 * 16 * 16;
    for (int it = blockIdx.x; it < NMOD + NTI + NTO; it += gridDim.x) {
        if (it < NMOD) {
            prep_mod_item(p, it, smem);
        } else if (it < NMOD + NTI) {
            const int t = it - NMOD, l = t / 704, r = t % 704, kt = r / 44, nt = r % 44;
            prep_transpose_tile(p.w_in + (size_t)l * 1024 * INW, p.WinT + (size_t)l * INW * 1024, INW, kt * 64, nt * 64, smem);
        } else {
            const int t = it - NMOD - NTI, l = t / 256, r = t % 256, kt = r / 16, nt = r % 16;
            prep_transpose_tile(p.w_out + (size_t)l * 1024 * 1024, p.WoutT + (size_t)l * 1024 * 1024, 1024, kt * 64, nt * 64, smem);
        }
    }
    const int gsz = gridDim.x * 256;
    for (int i = blockIdx.x * 256 + otid(); i < 558080; i += gsz) {
        if (i < 524288) {
            const int which = i >> 18, j = i & 262143;
            const int d = j & 63, t = (j >> 6) & 255, kvh = (j >> 14) & 1, bl = j >> 15;
            const size_t si = ((size_t)(bl * 256 + t) * 2 + kvh) * 64 + d;
            const float v = which ? p.cache_v[si] : p.cache_k[si];
            (which ? p.vc : p.kc)[j] = (bf16_t)(pk_bf16(v, 0.f) & 0xffffu);
        } else if (i < 524288 + 32768) {
            const int j = i - 524288;
            const int cc = j & 63, d = (j >> 6) & 63, lg = j >> 12;
            const float v = p.pool_w[((size_t)lg * 64 + cc) * 64 + d];
            p.PoolT[j] = (bf16_t)(pk_bf16(v, 0.f) & 0xffffu);
        } else {
            const int j = i - 524288 - 32768;
            const int a = j & 15, r = j >> 4;
            const float inv = 1.0f / powf(10000.0f, (float)(2 * a) / 32.0f);
            const float ang = (float)r * inv;
            const float kf = rintf(ang * 0.15915494309189535f);
            float rr = fmaf(-kf, 6.2831854820251465f, ang);
            rr = fmaf(-kf, -1.7484555e-7f, rr);
            p.rope[j] = cosf(rr);
            p.rope[1024 + j] = sinf(rr);
        }
    }
}

__device__ __forceinline__ float wave_sum(float v) {
#pragma unroll
    for (int o = 32; o >= 1; o >>= 1) v += __shfl_xor(v, o);
    return v;
}

__device__ __forceinline__ void phase_xn(const Params& p, int layer) {
    const int tid = otid(), lane = tid & 63, wave = tid >> 6;
    for (int tok = blockIdx.x * 4 + wave; tok < NTOK; tok += gridDim.x * 4) {
        const float* src = layer == 0 ? (tok < NCTX ? p.x_prompt + (size_t)tok * DM : p.x_sample + (size_t)(tok - NCTX) * DM) : p.h + (size_t)tok * DM;
        const int v = tok < NCTX ? 0 : 1 + ((tok - NCTX) >> 11);
        const float* mv = p.modv + (size_t)(layer * 5 + v) * 3072;
        f32x4 x[4];
        float ss = 0.f;
#pragma unroll
        for (int i = 0; i < 4; ++i) {
            x[i] = *(const f32x4*)(src + i * 256 + lane * 4);
            ss += x[i][0] * x[i][0] + x[i][1] * x[i][1] + x[i][2] * x[i][2] + x[i][3] * x[i][3];
        }
        ss = wave_sum(ss);
        const float rstd = rsqrtf(ss * (1.0f / 1024.0f) + EPSF);
#pragma unroll
        for (int i = 0; i < 4; ++i) {
            const int k = i * 256 + lane * 4;
            const f32x4 g = *(const f32x4*)(p.norm_g + layer * 1024 + k);
            const f32x4 sh = *(const f32x4*)(mv + k);
            const f32x4 sc = *(const f32x4*)(mv + 1024 + k);
            float o[4];
#pragma unroll
            for (int e = 0; e < 4; ++e) o[e] = x[i][e] * rstd * g[e] * (1.0f + sc[e]) + sh[e];
            u32x2 w;
            w.x = pk_bf16(o[0], o[1]);
            w.y = pk_bf16(o[2], o[3]);
            *(u32x2*)(p.xn + (size_t)tok * DM + k) = w;
        }
    }
}

__device__ __forceinline__ void phase_final(const Params& p) {
    const int tid = otid(), lane = tid & 63, wave = tid >> 6;
    for (int tok = blockIdx.x * 4 + wave; tok < NTOK; tok += gridDim.x * 4) {
        float* row = p.out + (size_t)tok * DM;
        f32x4 x[4];
        float ss = 0.f;
#pragma unroll
        for (int i = 0; i < 4; ++i) {
            x[i] = *(const f32x4*)(row + i * 256 + lane * 4);
            ss += x[i][0] * x[i][0] + x[i][1] * x[i][1] + x[i][2] * x[i][2] + x[i][3] * x[i][3];
        }
        ss = wave_sum(ss);
        const float rstd = rsqrtf(ss * (1.0f / 1024.0f) + EPSF);
#pragma unroll
        for (int i = 0; i < 4; ++i) {
            const int k = i * 256 + lane * 4;
            const f32x4 g = *(const f32x4*)(p.final_g + k);
            f32x4 o;
#pragma unroll
            for (int e = 0; e < 4; ++e) o[e] = x[i][e] * rstd * g[e];
            *(f32x4*)(row + k) = o;
        }
    }
}

template <int MODE, int MI>
__device__ __forceinline__ void gemm_epilogue(const Params& p, int layer, int mw, int nw, f32x4 (&acc)[MI][4], int fr, int fq) {
    if (MODE == 0) {
        const bool ctx = mw < NCTX;
        if (nw < 640) {
            const bool isq = nw < 512;
            const float* gp = (isq ? p.q_g : p.k_g) + layer * 64;
            f32x4 gv[4];
#pragma unroll
            for (int ni = 0; ni < 4; ++ni) gv[ni] = *(const f32x4*)(gp + ni * 16 + fq * 4);
#pragma unroll
            for (int mi = 0; mi < MI; ++mi) {
                const int tok = mw + mi * 16 + fr;
                float ss = 0.f;
#pragma unroll
                for (int ni = 0; ni < 4; ++ni)
#pragma unroll
                    for (int e = 0; e < 4; ++e) ss += acc[mi][ni][e] * acc[mi][ni][e];
                ss += __shfl_xor(ss, 16);
                ss += __shfl_xor(ss, 32);
                const float rstd = rsqrtf(ss * (1.0f / 64.0f) + EPSF);
                f32x4 val[4];
#pragma unroll
                for (int ni = 0; ni < 4; ++ni) val[ni] = acc[mi][ni] * rstd * gv[ni];
                if (!isq && ctx) {
                    float* nk = p.out + OUT_NK + ((size_t)((tok >> 8) * 2 + layer) * 256 + (tok & 255)) * 128 + (nw - 512) + fq * 4;
#pragma unroll
                    for (int ni = 0; ni < 4; ++ni) *(f32x4*)(nk + ni * 16) = val[ni];
                }
                if (!ctx) {
                    const int pos = (tok - NCTX) & 2047, prow = pos >> 6, pcol = pos & 63;
                    const f32x4 cr = *(const f32x4*)(p.rope + prow * 16 + fq * 4), sr = *(const f32x4*)(p.rope + 1024 + prow * 16 + fq * 4);
                    const f32x4 cc = *(const f32x4*)(p.rope + pcol * 16 + fq * 4), sn = *(const f32x4*)(p.rope + 1024 + pcol * 16 + fq * 4);
                    const f32x4 a0 = val[0], a1 = val[1], a2 = val[2], a3 = val[3];
                    val[0] = a0 * cr - a1 * sr;
                    val[1] = a1 * cr + a0 * sr;
                    val[2] = a2 * cc - a3 * sn;
                    val[3] = a3 * cc + a2 * sn;
                }
                if (isq) {
#pragma unroll
                    for (int ni = 0; ni < 4; ++ni) val[ni] = val[ni] * QSCALE;
                }
                bf16_t* pr = p.proj + (size_t)tok * INW + nw + fq * 4;
#pragma unroll
                for (int ni = 0; ni < 4; ++ni) {
                    u32x2 w;
                    w.x = pk_bf16(val[ni][0], val[ni][1]);
                    w.y = pk_bf16(val[ni][2], val[ni][3]);
                    *(u32x2*)(pr + ni * 16) = w;
                }
            }
        } else {
            const bool isv = nw < 768;
#pragma unroll
            for (int mi = 0; mi < MI; ++mi) {
                const int tok = mw + mi * 16 + fr;
                bf16_t* pr = p.proj + (size_t)tok * INW + nw + fq * 4;
#pragma unroll
                for (int ni = 0; ni < 4; ++ni) {
                    u32x2 w;
                    w.x = pk_bf16(acc[mi][ni][0], acc[mi][ni][1]);
                    w.y = pk_bf16(acc[mi][ni][2], acc[mi][ni][3]);
                    *(u32x2*)(pr + ni * 16) = w;
                }
                if (isv && ctx) {
                    float* nv = p.out + OUT_NV + ((size_t)((tok >> 8) * 2 + layer) * 256 + (tok & 255)) * 128 + (nw - 640) + fq * 4;
#pragma unroll
                    for (int ni = 0; ni < 4; ++ni) *(f32x4*)(nv + ni * 16) = acc[mi][ni];
                }
            }
        }
    } else {
        const int v = mw < NCTX ? 0 : 1 + ((mw - NCTX) >> 11);
        const float* gate = p.modv + (size_t)(layer * 5 + v) * 3072 + 2048 + nw + fq * 4;
        f32x4 gt[4];
#pragma unroll
        for (int ni = 0; ni < 4; ++ni) gt[ni] = *(const f32x4*)(gate + ni * 16);
#pragma unroll
        for (int mi = 0; mi < MI; ++mi) {
            const int tok = mw + mi * 16 + fr;
            const float* ho = (layer == 0 ? (tok < NCTX ? p.x_prompt + (size_t)tok * DM : p.x_sample + (size_t)(tok - NCTX) * DM) : p.h + (size_t)tok * DM) + nw + fq * 4;
            float* hn = (layer == 0 ? p.h : p.out) + (size_t)tok * DM + nw + fq * 4;
#pragma unroll
            for (int ni = 0; ni < 4; ++ni) {
                const f32x4 o = *(const f32x4*)(ho + ni * 16);
                *(f32x4*)(hn + ni * 16) = o + gt[ni] * acc[mi][ni];
            }
        }
    }
}

template <int MODE>
__device__ __forceinline__ void gemm_tile(const Params& p, int layer, int mt, int nt, unsigned char* smem) {
    const int tid = otid(), lane = tid & 63, wave = tid >> 6, wm = wave >> 1, wn = wave & 1;
    const int fr = lane & 15, fq = lane >> 4;
    const int m0 = mt * 128, n0 = nt * 128;
    const bf16_t* A = (MODE == 0 ? p.xn : p.mix) + (size_t)m0 * 1024;
    const bf16_t* B = (MODE == 0 ? p.WinT + (size_t)layer * INW * 1024 : p.WoutT + (size_t)layer * 1024 * 1024) + (size_t)n0 * 1024;
    f32x4 acc[4][4];
#pragma unroll
    for (int i = 0; i < 4; ++i)
#pragma unroll
        for (int j = 0; j < 4; ++j) acc[i][j] = (f32x4){0.f, 0.f, 0.f, 0.f};

    const int srow = tid >> 3, scc = tid & 7;
    const bf16_t* ag = A + (size_t)srow * 1024 + scc * 8;
    const bf16_t* bg = B + (size_t)srow * 1024 + scc * 8;
    const int wofs = srow * 128 + ((scc ^ (srow & 7)) * 16);
    u32x4 raA[4], rbA[4], raB[4], rbB[4];
    auto gload = [&](int kt, u32x4* ra, u32x4* rb) {
#pragma unroll
        for (int i = 0; i < 4; ++i) {
            ra[i] = *(const u32x4*)(ag + (size_t)i * 32 * 1024 + kt * 64);
            rb[i] = *(const u32x4*)(bg + (size_t)i * 32 * 1024 + kt * 64);
        }
    };
    auto swrite = [&](int buf, const u32x4* ra, const u32x4* rb) {
        unsigned char* Aw = smem + buf * 32768;
#pragma unroll
        for (int i = 0; i < 4; ++i) {
            *(u32x4*)(Aw + wofs + i * 4096) = ra[i];
            *(u32x4*)(Aw + 16384 + wofs + i * 4096) = rb[i];
        }
    };
    gload(0, raA, rbA);
    gload(1, raB, rbB);
    swrite(0, raA, rbA);
    __syncthreads();
    const int aro = (wm * 64 + fr) * 128, bro = (wn * 64 + fr) * 128, sw = fr & 7;
    auto step = [&](int kt, u32x4* la, u32x4* lb, const u32x4* wa, const u32x4* wb) {
        const unsigned char* As = smem + (kt & 1) * 32768;
        const unsigned char* Bs = As + 16384;
        bf16x8 af[2][4], bf[2][4];
#pragma unroll
        for (int kk = 0; kk < 2; ++kk) {
            const int co = ((kk * 4 + fq) ^ sw) * 16;
#pragma unroll
            for (int i = 0; i < 4; ++i) {
                af[kk][i] = *(const bf16x8*)(As + aro + i * 2048 + co);
                bf[kk][i] = *(const bf16x8*)(Bs + bro + i * 2048 + co);
            }
        }
        if (kt + 2 < 16) gload(kt + 2, la, lb);
        __builtin_amdgcn_sched_barrier(0);
#pragma unroll
        for (int mi = 0; mi < 4; ++mi)
#pragma unroll
            for (int ni = 0; ni < 4; ++ni) acc[mi][ni] = __builtin_amdgcn_mfma_f32_16x16x32_bf16(bf[0][ni], af[0][mi], acc[mi][ni], 0, 0, 0);
        __builtin_amdgcn_sched_barrier(0);
        if (kt + 1 < 16) swrite((kt + 1) & 1, wa, wb);
        __builtin_amdgcn_sched_barrier(0);
#pragma unroll
        for (int mi = 0; mi < 4; ++mi)
#pragma unroll
            for (int ni = 0; ni < 4; ++ni) acc[mi][ni] = __builtin_amdgcn_mfma_f32_16x16x32_bf16(bf[1][ni], af[1][mi], acc[mi][ni], 0, 0, 0);
        __syncthreads();
    };
    for (int kt = 0; kt < 16; kt += 2) {
        step(kt, raA, rbA, raB, rbB);
        step(kt + 1, raB, rbB, raA, rbA);
    }

    gemm_epilogue<MODE, 4>(p, layer, m0 + wm * 64, n0 + wn * 64, acc, fr, fq);
}

template <int MODE>
__device__ __forceinline__ void gemm_tile256(const Params& p, int layer, int mt, int nt, unsigned char* smem) {
    const int tid = otid(), lane = tid & 63, wave = tid >> 6, wm = wave >> 1, wn = wave & 1;
    const int fr = lane & 15, fq = lane >> 4;
    const int m0 = mt * 256, n0 = nt * 128;
    const bf16_t* A = (MODE == 0 ? p.xn : p.mix) + (size_t)m0 * 1024;
    const bf16_t* B = (MODE == 0 ? p.WinT + (size_t)layer * INW * 1024 : p.WoutT + (size_t)layer * 1024 * 1024) + (size_t)n0 * 1024;
    f32x4 acc[8][4];
#pragma unroll
    for (int i = 0; i < 8; ++i)
#pragma unroll
        for (int j = 0; j < 4; ++j) acc[i][j] = (f32x4){0.f, 0.f, 0.f, 0.f};
    const int srow = tid >> 2, scc = tid & 3;
    const bf16_t* ag = A + (size_t)srow * 1024 + scc * 8;
    const bf16_t* bg = B + (size_t)srow * 1024 + scc * 8;
    const int wofs = srow * 64 + ((scc ^ ((4 - ((srow >> 2) & 3)) & 3)) * 16);
    u32x4 raA[4], rbA[2], raB[4], rbB[2];
    auto gload = [&](int kt, u32x4* ra, u32x4* rb) {
#pragma unroll
        for (int i = 0; i < 4; ++i) ra[i] = *(const u32x4*)(ag + (size_t)i * 64 * 1024 + kt * 32);
#pragma unroll
        for (int i = 0; i < 2; ++i) rb[i] = *(const u32x4*)(bg + (size_t)i * 64 * 1024 + kt * 32);
    };
    auto swrite = [&](int buf, const u32x4* ra, const u32x4* rb) {
        unsigned char* Aw = smem + buf * 24576;
#pragma unroll
        for (int i = 0; i < 4; ++i) *(u32x4*)(Aw + wofs + i * 4096) = ra[i];
#pragma unroll
        for (int i = 0; i < 2; ++i) *(u32x4*)(Aw + 16384 + wofs + i * 4096) = rb[i];
    };
    gload(0, raA, rbA);
    gload(1, raB, rbB);
    swrite(0, raA, rbA);
    __syncthreads();
    const int co = (fq ^ ((4 - ((fr >> 2) & 3)) & 3)) * 16;
    const int aro = (wm * 128 + fr) * 64 + co, bro = (wn * 64 + fr) * 64 + co;
    auto step = [&](int kt, u32x4* la, u32x4* lb, const u32x4* wa, const u32x4* wb) {
        const unsigned char* As = smem + (kt & 1) * 24576;
        const unsigned char* Bs = As + 16384;
        bf16x8 af[8], bf[4];
#pragma unroll
        for (int i = 0; i < 4; ++i) bf[i] = *(const bf16x8*)(Bs + bro + i * 1024);
#pragma unroll
        for (int i = 0; i < 8; ++i) af[i] = *(const bf16x8*)(As + aro + i * 1024);
        if (kt + 2 < 32) gload(kt + 2, la, lb);
        __builtin_amdgcn_sched_barrier(0);
#pragma unroll
        for (int mi = 0; mi < 4; ++mi)
#pragma unroll
            for (int ni = 0; ni < 4; ++ni) acc[mi][ni] = __builtin_amdgcn_mfma_f32_16x16x32_bf16(bf[ni], af[mi], acc[mi][ni], 0, 0, 0);
        __builtin_amdgcn_sched_barrier(0);
        if (kt + 1 < 32) swrite((kt + 1) & 1, wa, wb);
        __builtin_amdgcn_sched_barrier(0);
#pragma unroll
        for (int mi = 4; mi < 8; ++mi)
#pragma unroll
            for (int ni = 0; ni < 4; ++ni) acc[mi][ni] = __builtin_amdgcn_mfma_f32_16x16x32_bf16(bf[ni], af[mi], acc[mi][ni], 0, 0, 0);
        __syncthreads();
    };
    for (int kt = 0; kt < 32; kt += 2) {
        step(kt, raA, rbA, raB, rbB);
        step(kt + 1, raB, rbB, raA, rbA);
    }
    gemm_epilogue<MODE, 8>(p, layer, m0 + wm * 128, n0 + wn * 64, acc, fr, fq);
}

template <int MODE>
__device__ __forceinline__ void gemm_tile256_dma(const Params& p, int layer, int mt, int nt, unsigned char* smem) {
    const int tid = otid(), lane = tid & 63, wave = tid >> 6, wm = wave >> 1, wn = wave & 1;
    const int fr = lane & 15, fq = lane >> 4;
    const int m0 = mt * 256, n0 = nt * 128;
    const bf16_t* A = (MODE == 0 ? p.xn : p.mix) + (size_t)m0 * 1024;
    const bf16_t* B = (MODE == 0 ? p.WinT + (size_t)layer * INW * 1024 : p.WoutT + (size_t)layer * 1024 * 1024) + (size_t)n0 * 1024;
    f32x4 acc[8][4];
#pragma unroll
    for (int i = 0; i < 8; ++i)
#pragma unroll
        for (int j = 0; j < 4; ++j) acc[i][j] = (f32x4){0.f, 0.f, 0.f, 0.f};
    const int lrow = lane >> 2, lc = (lane & 3) ^ ((4 - ((lane >> 4) & 3)) & 3);
    const bf16_t* agp = A + (size_t)(wave * 64 + lrow) * 1024 + lc * 8;
    const bf16_t* bgp = B + (size_t)(wave * 32 + lrow) * 1024 + lc * 8;
    LAS unsigned char* lbase = (LAS unsigned char*)smem;
    const int la_off = wave * 4096 + lane * 16, lb_off = 16384 + wave * 2048 + lane * 16;
    auto dma = [&](int kt, int stage) {
        LAS unsigned char* sb = lbase + stage * 24576;
#pragma unroll
        for (int i = 0; i < 4; ++i)
            __builtin_amdgcn_global_load_lds((const void*)(agp + (size_t)i * 16 * 1024 + kt * 32), (LAS void*)(sb + la_off + i * 1024), 16, 0, 0);
#pragma unroll
        for (int i = 0; i < 2; ++i)
            __builtin_amdgcn_global_load_lds((const void*)(bgp + (size_t)i * 16 * 1024 + kt * 32), (LAS void*)(sb + lb_off + i * 1024), 16, 0, 0);
    };
    dma(0, 0);
    dma(1, 1);
    asm volatile("s_waitcnt vmcnt(6)" ::: "memory");
    __builtin_amdgcn_s_barrier();
    const int co = (fq ^ ((4 - ((fr >> 2) & 3)) & 3)) * 16;
    const int aro = (wm * 128 + fr) * 64 + co, bro = 16384 + (wn * 64 + fr) * 64 + co;
    int st = 0, st2 = 2;
    const unsigned lds0 = (unsigned)(uintptr_t)lbase;
#pragma unroll 1
    for (int kt = 0; kt < 32; ++kt) {
        const unsigned sa = lds0 + st * 24576 + aro, sbb = lds0 + st * 24576 + bro;
        bf16x8 af[8], bf[4];
#define FRAG_RD(dst, addr, OFF) asm volatile("ds_read_b128 %0, %1 offset:" #OFF : "=v"(dst) : "v"(addr))
        FRAG_RD(bf[0], sbb, 0); FRAG_RD(bf[1], sbb, 1024); FRAG_RD(bf[2], sbb, 2048); FRAG_RD(bf[3], sbb, 3072);
        FRAG_RD(af[0], sa, 0); FRAG_RD(af[1], sa, 1024); FRAG_RD(af[2], sa, 2048); FRAG_RD(af[3], sa, 3072);
        FRAG_RD(af[4], sa, 4096); FRAG_RD(af[5], sa, 5120); FRAG_RD(af[6], sa, 6144); FRAG_RD(af[7], sa, 7168);
#undef FRAG_RD
        asm volatile("s_waitcnt lgkmcnt(0)" ::: "memory");
        __builtin_amdgcn_sched_barrier(0);
        if (kt + 2 < 32) dma(kt + 2, st2);
        __builtin_amdgcn_sched_barrier(0);
#pragma unroll
        for (int mi = 0; mi < 8; ++mi)
#pragma unroll
            for (int ni = 0; ni < 4; ++ni) acc[mi][ni] = __builtin_amdgcn_mfma_f32_16x16x32_bf16(bf[ni], af[mi], acc[mi][ni], 0, 0, 0);
        __builtin_amdgcn_sched_barrier(0);
        if (kt + 2 < 32) asm volatile("s_waitcnt vmcnt(6)" ::: "memory");
        else asm volatile("s_waitcnt vmcnt(0)" ::: "memory");
        __builtin_amdgcn_s_barrier();
        st = st == 2 ? 0 : st + 1;
        st2 = st2 == 2 ? 0 : st2 + 1;
    }
    gemm_epilogue<MODE, 8>(p, layer, m0 + wm * 128, n0 + wn * 64, acc, fr, fq);
}

template <int MODE>
__device__ __forceinline__ void phase_gemm(const Params& p, int layer, unsigned char* smem) {
    const int NT = MODE == 0 ? 22 : 8;
    const int total = 96 * NT;
    if (gridDim.x == 512) {
        const int xcd = blockIdx.x & 7, slot = blockIdx.x >> 3;
        if (MODE == 0) {
            for (int idx = slot; idx < 128; idx += 64) gemm_tile256_dma<MODE>(p, layer, xcd * 6 + idx % 6, idx / 6, smem);
            if (slot < 8) gemm_tile<MODE>(p, layer, (xcd * 6 + 2 + (slot >> 1)) * 2 + (slot & 1), 21, smem);
        } else {
            if (slot < 32) gemm_tile256_dma<MODE>(p, layer, xcd * 6 + slot % 6, slot / 6, smem);
            else {
                const int d = 32 + ((slot - 32) >> 1);
                gemm_tile<MODE>(p, layer, (xcd * 6 + d % 6) * 2 + (slot & 1), d / 6, smem);
            }
        }
    } else {
        for (int t = blockIdx.x; t < total; t += gridDim.x) gemm_tile<MODE>(p, layer, t / NT, t % NT, smem);
    }
}

template <int VAR>
__device__ __forceinline__ void attn_unit(const Params& p, int layer, int unit, unsigned char* smem) {
    const int tid = otid(), lane = tid & 63, wave = tid >> 6;
    const int r31 = lane & 31, hh = lane >> 5;
    int b, head, qblk, tokbase, nself, ntiles;
    if (unit < 512) { b = unit >> 7; head = (unit >> 4) & 7; qblk = unit & 15; tokbase = NCTX + b * 2048; nself = 2048; ntiles = 36; }
    else { const int u = unit - 512; b = u >> 4; head = (u >> 1) & 7; qblk = u & 1; tokbase = b * 256; nself = 256; ntiles = 4; }
    const int kvh = head >> 2;
    const int qtok = tokbase + qblk * 128 + wave * 32 + r31;
    bf16x8 qf[4];
    {
        const bf16_t* qp = p.proj + (size_t)qtok * INW + head * 64 + hh * 8;
#pragma unroll
        for (int ks = 0; ks < 4; ++ks) qf[ks] = *(const bf16x8*)(qp + ks * 16);
    }
    const bf16_t* kself = p.proj + (size_t)tokbase * INW + 512 + kvh * 64;
    const bf16_t* vself = p.proj + (size_t)tokbase * INW + 640 + kvh * 64;
    const bf16_t* kcache = p.kc + (size_t)((b * 2 + layer) * 2 + kvh) * 256 * 64;
    const bf16_t* vcache = p.vc + (size_t)((b * 2 + layer) * 2 + kvh) * 256 * 64;
    const int srow = tid >> 3, scc = tid & 7;
    const int kwo = srow * 128 + ((scc ^ ((srow >> 1) & 7)) * 16);
    const int vwo = srow * 128 + ((scc ^ (((srow >> 1) & 1) << 2)) * 16);
    u32x4 rkA[2], rvA[2], rkB[2], rvB[2];
    auto gload = [&](int j, u32x4* rk, u32x4* rv) {
        const int key0 = j * 64;
#pragma unroll
        for (int i = 0; i < 2; ++i) {
            const int row = srow + 32 * i;
            if (key0 < nself) {
                rk[i] = *(const u32x4*)(kself + (size_t)(key0 + row) * INW + scc * 8);
                rv[i] = *(const u32x4*)(vself + (size_t)(key0 + row) * INW + scc * 8);
            } else {
                rk[i] = *(const u32x4*)(kcache + (size_t)(key0 - nself + row) * 64 + scc * 8);
                rv[i] = *(const u32x4*)(vcache + (size_t)(key0 - nself + row) * 64 + scc * 8);
            }
        }
    };
    auto swrite = [&](int buf, const u32x4* rk, const u32x4* rv) {
        unsigned char* kb = smem + buf * 16384;
        unsigned char* vb = kb + 8192;
#pragma unroll
        for (int i = 0; i < 2; ++i) {
            *(u32x4*)(kb + kwo + i * 32 * 128) = rk[i];
            *(u32x4*)(vb + vwo + i * 32 * 128) = rv[i];
        }
    };
    f32x16 o[2];
#pragma unroll
    for (int i = 0; i < 16; ++i) { o[0][i] = 0.f; o[1][i] = 0.f; }
    float mrun = 0.f, mmax = -1e30f, lrun = 0.f;
    f32x16 negm, zero16;
#pragma unroll
    for (int i = 0; i < 16; ++i) { negm[i] = 0.f; zero16[i] = 0.f; }
    bool shifted = false;
    gload(0, rkA, rvA);
    swrite(0, rkA, rvA);
    if (ntiles > 1) gload(1, rkB, rvB);
    __syncthreads();
    const int kro = r31 * 128, ksw = (r31 >> 1) & 7;
    const int vq = 4 * hh + ((lane & 15) >> 2);
    const int vsw = ((vq >> 1) & 1) << 2;
    const int vcl = ((lane >> 4) & 1) * 2 + ((lane & 3) >> 1);
    const int vro0 = vq * 128 + (((0 * 4 + vcl) ^ vsw) * 16) + (lane & 1) * 8;
    const int vro1 = vq * 128 + (((1 * 4 + vcl) ^ vsw) * 16) + (lane & 1) * 8;
    auto step = [&](int j, u32x4* lk, u32x4* lv, const u32x4* wk, const u32x4* wv) {
        const unsigned char* kb = smem + (j & 1) * 16384;
        const unsigned char* vb = kb + 8192;
        bf16x8 kf[2][4];
#pragma unroll
        for (int sb = 0; sb < 2; ++sb)
#pragma unroll
            for (int ks = 0; ks < 4; ++ks) kf[sb][ks] = *(const bf16x8*)(kb + sb * 4096 + kro + (((ks * 2 + hh) ^ ksw) * 16));
        if (VAR != 1 && j + 2 < ntiles) gload(j + 2, lk, lv);
        __builtin_amdgcn_sched_barrier(0);
        f32x16 s[2];
#pragma unroll
        for (int ks = 0; ks < 4; ++ks)
#pragma unroll
            for (int sb = 0; sb < 2; ++sb) {
                if (ks == 0) {
                    if (shifted) s[sb] = __builtin_amdgcn_mfma_f32_32x32x16_bf16(kf[sb][ks], qf[ks], negm, 0, 0, 0);
                    else s[sb] = __builtin_amdgcn_mfma_f32_32x32x16_bf16(kf[sb][ks], qf[ks], zero16, 0, 0, 0);
                } else s[sb] = __builtin_amdgcn_mfma_f32_32x32x16_bf16(kf[sb][ks], qf[ks], s[sb], 0, 0, 0);
            }
        __builtin_amdgcn_sched_barrier(0);
        bf16x8 vf[2][2][2];
#pragma unroll
        for (int sb = 0; sb < 2; ++sb)
#pragma unroll
            for (int s2 = 0; s2 < 2; ++s2)
#pragma unroll
                for (int dt = 0; dt < 2; ++dt) {
                    const LAS unsigned char* va = (const LAS unsigned char*)(vb) + (sb * 32 + s2 * 16) * 128 + (dt ? vro1 : vro0);
                    const s16x4 a0 = __builtin_amdgcn_ds_read_tr16_b64_v4i16((LAS s16x4*)(va));
                    const s16x4 a1 = __builtin_amdgcn_ds_read_tr16_b64_v4i16((LAS s16x4*)(va + 8 * 128));
                    vf[sb][s2][dt] = (bf16x8){a0[0], a0[1], a0[2], a0[3], a1[0], a1[1], a1[2], a1[3]};
                }
        __builtin_amdgcn_sched_barrier(0);
        float mloc = max3_f(s[0][0], s[1][0], s[0][1]);
        mloc = max3_f(mloc, s[1][1], s[0][2]);
#pragma unroll
        for (int i = 2; i < 16; ++i) mloc = max3_f(mloc, s[1][i], s[0][(i + 1) & 15]);
        float lsum = 0.f;
#pragma unroll
        for (int sb = 0; sb < 2; ++sb)
#pragma unroll
            for (int i = 0; i < 16; ++i) { if (VAR != 2) { s[sb][i] = __builtin_amdgcn_exp2f(s[sb][i]); lsum += s[sb][i]; } }
        lrun += lsum;
        bf16x8 pf[2][2];
#pragma unroll
        for (int sb = 0; sb < 2; ++sb)
#pragma unroll
            for (int s2 = 0; s2 < 2; ++s2) {
                u32x4 pw;
                pw.x = pk_bf16(s[sb][s2 * 8 + 0], s[sb][s2 * 8 + 1]);
                pw.y = pk_bf16(s[sb][s2 * 8 + 2], s[sb][s2 * 8 + 3]);
                pw.z = pk_bf16(s[sb][s2 * 8 + 4], s[sb][s2 * 8 + 5]);
                pw.w = pk_bf16(s[sb][s2 * 8 + 6], s[sb][s2 * 8 + 7]);
                pf[sb][s2] = __builtin_bit_cast(bf16x8, pw);
            }
        __builtin_amdgcn_sched_barrier(0);
#pragma unroll
        for (int sb = 0; sb < 2; ++sb)
#pragma unroll
            for (int s2 = 0; s2 < 2; ++s2)
#pragma unroll
                for (int dt = 0; dt < 2; ++dt) o[dt] = __builtin_amdgcn_mfma_f32_32x32x16_bf16(vf[sb][s2][dt], pf[sb][s2], o[dt], 0, 0, 0);
        __builtin_amdgcn_sched_barrier(0);
        mloc = fmaxf(mloc, __shfl_xor(mloc, 32));
        mmax = fmaxf(mmax, mrun + mloc);
        if (__builtin_expect(__any(fabsf(mmax - mrun) > 40.0f), 0)) {
            asm volatile("" ::: "memory");
            const float alpha = __builtin_amdgcn_exp2f(mrun - mmax);
            mrun = mmax;
            lrun *= alpha;
            shifted = true;
#pragma unroll
            for (int i = 0; i < 16; ++i) { o[0][i] *= alpha; o[1][i] *= alpha; negm[i] = -mrun; }
        }
        if (VAR != 1 && j + 1 < ntiles) swrite((j + 1) & 1, wk, wv);
        __syncthreads();
    };
    for (int j = 0; j < ntiles; j += 2) {
        step(j, rkA, rvA, rkB, rvB);
        step(j + 1, rkB, rvB, rkA, rvA);
    }
    const float ltot = lrun + __shfl_xor(lrun, 32);
    const float inv = 1.0f / ltot;
    const bf16_t* zp = p.proj + (size_t)qtok * INW + 768 + head * 64;
    bf16_t* mp = (VAR == 0 ? p.mix : p.xn) + (size_t)qtok * DM + head * 64;
#pragma unroll
    for (int dt = 0; dt < 2; ++dt)
#pragma unroll
        for (int rq = 0; rq < 4; ++rq) {
            const int d0 = dt * 32 + 8 * rq + 4 * hh;
            const u32x2 zz = *(const u32x2*)(zp + d0);
            const float z0 = bf_lo(zz.x), z1 = bf_hi(zz.x), z2 = bf_lo(zz.y), z3 = bf_hi(zz.y);
            u32x2 w;
            w.x = pk_bf16(o[dt][rq * 4 + 0] * inv * silu_f(z0), o[dt][rq * 4 + 1] * inv * silu_f(z1));
            w.y = pk_bf16(o[dt][rq * 4 + 2] * inv * silu_f(z2), o[dt][rq * 4 + 3] * inv * silu_f(z3));
            *(u32x2*)(mp + d0) = w;
        }
}

__device__ __forceinline__ void unpack8(const u32x4 u, float* f) {
    f[0] = bf_lo(u.x); f[1] = bf_hi(u.x); f[2] = bf_lo(u.y); f[3] = bf_hi(u.y);
    f[4] = bf_lo(u.z); f[5] = bf_hi(u.z); f[6] = bf_lo(u.w); f[7] = bf_hi(u.w);
}

__device__ __forceinline__ void pool_item(const Params& p, int layer, int pi, unsigned char* smem) {
    const int tid = otid(), lane = tid & 63, gi = tid >> 6;
    const int fr = lane & 15, fq = lane >> 4;
    const int T0 = pi * 64;
    int seqstart, seqlen;
    if (T0 < NCTX) { seqstart = T0 & ~255; seqlen = 256; } else { seqstart = NCTX + ((T0 - NCTX) & ~2047); seqlen = 2048; }
    const int toff = T0 - seqstart;
    for (int e = tid; e < 79 * 32; e += 256) {
        const int r = e >> 5, c = e & 31;
        const int s = toff - 8 + r;
        if (s >= 0 && s < seqlen) *(u32x4*)(smem + r * 528 + c * 16) = *(const u32x4*)(p.proj + (size_t)(seqstart + s) * INW + 2304 + c * 8);
    }
    __syncthreads();
    const int win = 2 << gi, half = win >> 1;
    bf16x8 wf[4][2];
    {
        const bf16_t* wp = p.PoolT + (size_t)((layer * 4 + gi) * 64) * 64;
#pragma unroll
        for (int ni = 0; ni < 4; ++ni)
#pragma unroll
            for (int kk = 0; kk < 2; ++kk) wf[ni][kk] = *(const bf16x8*)(wp + (ni * 16 + fr) * 64 + kk * 32 + fq * 8);
    }
#pragma unroll 1
    for (int mi = 0; mi < 4; ++mi) {
        f32x4 acc[4];
#pragma unroll
        for (int j = 0; j < 4; ++j) acc[j] = (f32x4){0.f, 0.f, 0.f, 0.f};
        const int tt = mi * 16 + fr;
        const int ts = toff + tt;
        int lo = ts - half, hi = ts - half + win - 1;
        lo = lo < 0 ? 0 : lo;
        hi = hi > seqlen - 1 ? seqlen - 1 : hi;
        const float rc = 1.0f / (float)(hi - lo + 1);
        const int r0 = lo - toff + 8, r1 = hi - toff + 8, rs = tt + 8;
#pragma unroll
        for (int kk = 0; kk < 2; ++kk) {
            const int co = (gi * 64 + kk * 32 + fq * 8) * 2;
            float sum[8];
#pragma unroll
            for (int e = 0; e < 8; ++e) sum[e] = 0.f;
            for (int r = r0; r <= r1; ++r) {
                float f[8];
                unpack8(*(const u32x4*)(smem + r * 528 + co), f);
#pragma unroll
                for (int e = 0; e < 8; ++e) sum[e] += f[e];
            }
            float us[8];
            unpack8(*(const u32x4*)(smem + rs * 528 + co), us);
            u32x4 dw;
            dw.x = pk_bf16(sum[0] * rc - us[0], sum[1] * rc - us[1]);
            dw.y = pk_bf16(sum[2] * rc - us[2], sum[3] * rc - us[3]);
            dw.z = pk_bf16(sum[4] * rc - us[4], sum[5] * rc - us[5]);
            dw.w = pk_bf16(sum[6] * rc - us[6], sum[7] * rc - us[7]);
            const bf16x8 df = __builtin_bit_cast(bf16x8, dw);
#pragma unroll
            for (int ni = 0; ni < 4; ++ni) acc[ni] = __builtin_amdgcn_mfma_f32_16x16x32_bf16(wf[ni][kk], df, acc[ni], 0, 0, 0);
        }
        const int tok = T0 + tt;
#pragma unroll
        for (int ni = 0; ni < 4; ++ni) {
            const int ch = gi * 64 + ni * 16 + fq * 4;
            const f32x4 ps = *(const f32x4*)(p.pool_scale + layer * 256 + ch);
            const u32x2 zz = *(const u32x2*)(p.proj + (size_t)tok * INW + 2560 + ch);
            u32x2 w;
            w.x = pk_bf16(acc[ni][0] * ps[0] * silu_f(bf_lo(zz.x)), acc[ni][1] * ps[1] * silu_f(bf_hi(zz.x)));
            w.y = pk_bf16(acc[ni][2] * ps[2] * silu_f(bf_lo(zz.y)), acc[ni][3] * ps[3] * silu_f(bf_hi(zz.y)));
            *(u32x2*)(p.mix + (size_t)tok * DM + 768 + ch) = w;
        }
    }
    __syncthreads();
}

__device__ __forceinline__ void conv_item(const Params& p, int layer, int ci) {
    const int tid = otid();
    const int ch = (tid & 31) * 8, tg = tid >> 5;
    const int T0 = ci * 64 + tg * 8;
    int seqstart, seqlen;
    if (T0 < NCTX) { seqstart = T0 & ~255; seqlen = 256; } else { seqstart = NCTX + ((T0 - NCTX) & ~2047); seqlen = 2048; }
    const int seqend = seqstart + seqlen;
    float w0[8], w1[8], w2[8], bb[8];
    {
        const float* cw = p.conv_w + (size_t)layer * 768 + ch;
#pragma unroll
        for (int e = 0; e < 8; ++e) { w0[e] = cw[e]; w1[e] = cw[256 + e]; w2[e] = cw[512 + e]; bb[e] = p.conv_b[layer * 256 + ch + e]; }
    }
    auto ldx = [&](int tok, float* x) {
        if (tok >= seqstart && tok < seqend) {
            float hc[8], cc[8];
            unpack8(*(const u32x4*)(p.proj + (size_t)tok * INW + 1280 + ch), hc);
            unpack8(*(const u32x4*)(p.proj + (size_t)tok * INW + 1792 + ch), cc);
#pragma unroll
            for (int e = 0; e < 8; ++e) x[e] = hc[e] * cc[e];
        } else {
#pragma unroll
            for (int e = 0; e < 8; ++e) x[e] = 0.f;
        }
    };
    float xm[8], x0[8], xp[8];
    ldx(T0 - 1, xm);
    ldx(T0, x0);
    for (int t = 0; t < 8; ++t) {
        const int tok = T0 + t;
        ldx(tok + 1, xp);
        float bc[8], zc[8], o[8];
        unpack8(*(const u32x4*)(p.proj + (size_t)tok * INW + 1536 + ch), bc);
        unpack8(*(const u32x4*)(p.proj + (size_t)tok * INW + 2048 + ch), zc);
#pragma unroll
        for (int e = 0; e < 8; ++e) {
            const float y = xm[e] * w0[e] + x0[e] * w1[e] + xp[e] * w2[e] + bb[e];
            o[e] = bc[e] * y * silu_f(zc[e]);
        }
        u32x4 w;
        w.x = pk_bf16(o[0], o[1]); w.y = pk_bf16(o[2], o[3]); w.z = pk_bf16(o[4], o[5]); w.w = pk_bf16(o[6], o[7]);
        *(u32x4*)(p.mix + (size_t)tok * DM + 512 + ch) = w;
#pragma unroll
        for (int e = 0; e < 8; ++e) { xm[e] = x0[e]; x0[e] = xp[e]; }
    }
}

__device__ __forceinline__ void phase_mixer(const Params& p, int layer, unsigned char* smem) {
    for (int it = blockIdx.x; it < 768 + 192 + 192; it += gridDim.x) {
        if (it < 768) {
            attn_unit<0>(p, layer, it, smem);
        }
        else if (it < 960) pool_item(p, layer, it - 768, smem);
        else conv_item(p, layer, it - 960);
    }
}

__global__ void __launch_bounds__(256, 2) mega(Params p, int lo, int hi) {
    __shared__ __attribute__((aligned(16))) unsigned char smem[73728];
    __shared__ uint4 xbw;
    if (p.use_cg) cg::this_grid().sync();
    if (threadIdx.x == 0) xbw = make_uint4(0u, 0u, 0u, 0u);
    __syncthreads();
    XcdBarrier xb = xcd_barrier_post(p.bar, (volatile LAS unsigned*)&xbw);
    for (int ph = lo; ph < hi; ++ph) {
        if (ph > lo) xcd_barrier(xb);
        if (ph == 0) phase_prep(p, smem);
        else if (ph == 9) phase_final(p);
        else {
            const int layer = (ph - 1) >> 2, ty = (ph - 1) & 3;
            if (ty == 0) phase_xn(p, layer);
            else if (ty == 1) phase_gemm<0>(p, layer, smem);
            else if (ty == 2) phase_mixer(p, layer, smem);
            else phase_gemm<1>(p, layer, smem);
        }
    }
}

#ifndef MK_MULTI
#define MK_MULTI 0
#endif

extern "C" void kernel_launch(void* const* d_in, const int* in_sizes, int n_in, void* d_out, int out_size, void* d_ws, size_t ws_size,
                              hipStream_t stream) {
    static int grid_blocks = 0;
    if (!grid_blocks) {
        int dev = 0, cus = 0, per_cu = 0;
        hipGetDevice(&dev);
        hipDeviceGetAttribute(&cus, hipDeviceAttributeMultiprocessorCount, dev);
        hipOccupancyMaxActiveBlocksPerMultiprocessor(&per_cu, mega, 256, 0);
        if (per_cu > 2) per_cu = 2;
        if (per_cu < 1) per_cu = 1;
        grid_blocks = cus * per_cu;
    }
    Params p{};
    const float* const* in = (const float* const*)d_in;
    p.x_prompt = in[0]; p.x_sample = in[1]; p.cache_k = in[2]; p.cache_v = in[3]; p.c = in[4]; p.c_ctx = in[5]; p.norm_g = in[6];
    p.w_ada = in[7]; p.b_ada = in[8]; p.w_in = in[9]; p.q_g = in[10]; p.k_g = in[11]; p.conv_w = in[12]; p.conv_b = in[13];
    p.pool_w = in[14]; p.pool_scale = in[15]; p.w_out = in[16]; p.final_g = in[17];
    p.out = (float*)d_out;
    unsigned char* ws = (unsigned char*)d_ws;
    size_t off = 0;
    auto take = [&](size_t bytes) { unsigned char* r = ws + off; off += (bytes + 255) & ~(size_t)255; return r; };
    p.bar = (unsigned*)take(XCD_BAR_WORDS * 4);
    p.modv = (float*)take(2 * 5 * 3072 * 4);
    p.rope = (float*)take(2048 * 4);
    p.WinT = (bf16_t*)take((size_t)2 * INW * 1024 * 2);
    p.WoutT = (bf16_t*)take((size_t)2 * 1024 * 1024 * 2);
    p.PoolT = (bf16_t*)take(2 * 4 * 64 * 64 * 2);
    p.kc = (bf16_t*)take(262144 * 2);
    p.vc = (bf16_t*)take(262144 * 2);
    p.h = (float*)take((size_t)NTOK * DM * 4);
    p.xn = (bf16_t*)take((size_t)NTOK * DM * 2);
    p.proj = (bf16_t*)take((size_t)NTOK * INW * 2);
    p.mix = (bf16_t*)take((size_t)NTOK * DM * 2);
    p.use_cg = 0;
    p.pad = 0;
    hipMemsetAsync(p.bar, 0, XCD_BAR_WORDS * 4, stream);
#if MK_MULTI
    for (int ph = 0; ph < 10; ++ph) {
        int lo = ph, hi = ph + 1;
        void* args[] = {&p, &lo, &hi};
        hipError_t e = hipLaunchCooperativeKernel((void*)mega, dim3(grid_blocks), dim3(256), args, 0, stream);
        if (e != hipSuccess) fprintf(stderr, "launch failed: %s\n", hipGetErrorString(e));
    }
#else
    int lo = 0, hi = 10;
    void* args[] = {&p, &lo, &hi};
    hipError_t e = hipLaunchCooperativeKernel((void*)mega, dim3(grid_blocks), dim3(256), args, 0, stream);
    if (e != hipSuccess) fprintf(stderr, "cooperative launch failed: %s (grid %d)\n", hipGetErrorString(e), grid_blocks);
#endif
}
```

```cpp
#include <hip/hip_runtime.h>
#include <hip/hip_cooperative_groups.h>
#include <cstdint>
#include <cstdio>
namespace cg = cooperative_groups;

#define LAS __attribute__((address_space(3)))
typedef unsigned short bf16_t;
typedef short bf16x8 __attribute__((ext_vector_type(8)));
typedef short s16x4 __attribute__((ext_vector_type(4)));
typedef float f32x4 __attribute__((ext_vector_type(4)));
typedef float f32x16 __attribute__((ext_vector_type(16)));
typedef unsigned u32x4 __attribute__((ext_vector_type(4)));
typedef unsigned u32x2 __attribute__((ext_vector_type(2)));

constexpr int NTOK = 12288, NCTX = 4096, DM = 1024, INW = 2816;
constexpr size_t OUT_NK = 12582912, OUT_NV = 13631488;
constexpr float EPSF = 1e-6f;
constexpr float QSCALE = 0.125f * 1.4426950408889634f;

struct Params {
    const float *x_prompt, *x_sample, *cache_k, *cache_v, *c, *c_ctx, *norm_g, *w_ada, *b_ada, *w_in, *q_g, *k_g, *conv_w, *conv_b,
        *pool_w, *pool_scale, *w_out, *final_g;
    float* out;
    unsigned* bar;
    float* modv;
    float* rope;
    bf16_t* WinT;
    bf16_t* WoutT;
    bf16_t* PoolT;
    bf16_t* kc;
    bf16_t* vc;
    float* h;
    bf16_t* xn;
    bf16_t* proj;
    bf16_t* mix;
    int use_cg;
    int pad;
};

__device__ __forceinline__ unsigned pk_bf16(float lo, float hi) {
    unsigned r;
    asm("v_cvt_pk_bf16_f32 %0, %1, %2" : "=v"(r) : "v"(lo), "v"(hi));
    return r;
}
__device__ __forceinline__ float bf_lo(unsigned u) { return __uint_as_float(u << 16); }
__device__ __forceinline__ float bf_hi(unsigned u) { return __uint_as_float(u & 0xffff0000u); }
__device__ __forceinline__ float silu_f(float z) { return z / (1.0f + __expf(-z)); }
__device__ __forceinline__ float max3_f(float a, float b, float c) { float r; asm("v_max3_f32 %0, %1, %2, %3" : "=v"(r) : "v"(a), "v"(b), "v"(c)); return r; }
__device__ __forceinline__ int otid() { int t = threadIdx.x; asm volatile("" : "+v"(t)); return t; }

#define XB_TMO 128
#define XB_XCNT(j) (256 + 64 * (j))
#define XB_XSUB(j) (1280 + 64 * (j))
#define XB_XGEN(j) (2304 + 64 * (j))
#define XB_TOP 3328
#define XB_TOPGEN 3392
#define XCD_BAR_WORDS 3456
#define XB_SPIN_CAP (1u << 20)

__device__ __forceinline__ unsigned xb_ld(unsigned* p) { return __hip_atomic_load(p, __ATOMIC_RELAXED, __HIP_MEMORY_SCOPE_AGENT); }
__device__ __forceinline__ unsigned xb_add(unsigned* p, unsigned v) { return __hip_atomic_fetch_add(p, v, __ATOMIC_RELAXED, __HIP_MEMORY_SCOPE_AGENT); }
__device__ __forceinline__ unsigned xb_xcc_id() { return (unsigned)__builtin_amdgcn_s_getreg((3 << 11) | 20) & 0xFu; }
#define XB_SPIN(cond, bar)                                                   \
    do {                                                                     \
        unsigned _sp = 0;                                                    \
        while (cond) {                                                       \
            __builtin_amdgcn_s_sleep(1);                                     \
            if ((++_sp & 255u) == 0u) {                                      \
                if (xb_ld(&(bar)[XB_TMO])) break;                            \
                if (_sp > XB_SPIN_CAP) { atomicAdd(&(bar)[XB_TMO], 1u); break; } \
            }                                                                \
        }                                                                    \
    } while (0)

struct XcdBarrier {
    unsigned* bar;
    unsigned x;
    volatile LAS unsigned* st;
};

__device__ __forceinline__ XcdBarrier xcd_barrier_post(unsigned* bar, volatile LAS unsigned* st) {
    XcdBarrier b;
    b.bar = bar;
    b.x = xb_xcc_id();
    b.st = st;
    if (threadIdx.x == 0) (void)xb_add(&bar[XB_XCNT(b.x)], 1u);
    return b;
}
__device__ __forceinline__ void xcd_barrier_complete(unsigned* bar, unsigned x, unsigned& nloc, unsigned& nx) {
    const unsigned G = gridDim.x * gridDim.y * gridDim.z;
    unsigned sum, cnt, mine, sp = 0u;
    for (;;) {
        sum = 0u; cnt = 0u; mine = 0u;
#pragma unroll
        for (unsigned j = 0; j < 16; ++j) {
            const unsigned c = xb_ld(&bar[XB_XCNT(j)]);
            sum += c; cnt += (c > 0u) ? 1u : 0u; mine = (j == x) ? c : mine;
        }
        if (sum == G) break;
        __builtin_amdgcn_s_sleep(1);
        if ((++sp & 255u) == 0u) {
            if (xb_ld(&bar[XB_TMO])) break;
            if (sp > XB_SPIN_CAP) { atomicAdd(&bar[XB_TMO], 1u); break; }
        }
    }
    nloc = mine > 0u ? mine : 1u;
    nx = cnt > 0u ? cnt : 1u;
}
__device__ __forceinline__ void xcd_barrier(const XcdBarrier& b) {
    asm volatile("s_waitcnt vmcnt(0)" ::: "memory");
    __syncthreads();
    if (threadIdx.x == 0) {
        unsigned* bar = b.bar;
        __builtin_amdgcn_s_waitcnt(0);
        unsigned nloc = b.st[0], nx = b.st[1];
        if (nloc == 0u) { xcd_barrier_complete(bar, b.x, nloc, nx); b.st[0] = nloc; b.st[1] = nx; }
        const unsigned old = xb_add(&bar[XB_XSUB(b.x)], 1u);
        const unsigned gen = old / nloc;
        if (old + 1u == (gen + 1u) * nloc) {
            __builtin_amdgcn_fence(__ATOMIC_RELEASE, "agent");
            asm volatile("s_waitcnt vmcnt(0)" ::: "memory");
            const unsigned og = xb_add(&bar[XB_TOP], 1u);
            const unsigned tg = og / nx;
            if (og + 1u == (tg + 1u) * nx) xb_add(&bar[XB_TOPGEN], 1u);
            else XB_SPIN(xb_ld(&bar[XB_TOPGEN]) == tg, bar);
            __builtin_amdgcn_fence(__ATOMIC_ACQUIRE, "agent");
            xb_add(&bar[XB_XGEN(b.x)], 1u);
            asm volatile("s_waitcnt vmcnt(0)" ::: "memory");
        } else {
            XB_SPIN(xb_ld(&bar[XB_XGEN(b.x)]) == gen, bar);
            __builtin_amdgcn_fence(__ATOMIC_ACQUIRE, "agent");
            asm volatile("s_waitcnt vmcnt(0)" ::: "memory");
        }
    }
    __syncthreads();
}

__device__ __forceinline__ void prep_mod_item(const Params& p, int item, unsigned char* smem) {
    const int tid = otid();
    float* sc = (float*)smem;
    float* red = (float*)(smem + 20480);
    const int l = item / 96, j0 = (item % 96) * 32;
    for (int idx = tid; idx < 5120; idx += 256) {
        const int v = idx >> 10, k = idx & 1023;
        const float cv = (v == 0) ? p.c_ctx[k] : p.c[(v - 1) * 1024 + k];
        sc[idx] = cv / (1.0f + expf(-cv));
    }
    __syncthreads();
    const int cgp = tid & 7, kg = tid >> 3;
    float acc[5][4];
#pragma unroll
    for (int v = 0; v < 5; ++v)
#pragma unroll
        for (int e = 0; e < 4; ++e) acc[v][e] = 0.f;
    const float* wp = p.w_ada + (size_t)l * 1024 * 3072 + j0 + cgp * 4;
    f32x4 wreg[32];
#pragma unroll
    for (int kk = 0; kk < 32; ++kk) wreg[kk] = *(const f32x4*)(wp + (size_t)(kk * 32 + kg) * 3072);
#pragma unroll
    for (int kk = 0; kk < 32; ++kk) {
        const int k = kk * 32 + kg;
        const f32x4 w = wreg[kk];
#pragma unroll
        for (int v = 0; v < 5; ++v) {
            const float s = sc[v * 1024 + k];
#pragma unroll
            for (int e = 0; e < 4; ++e) acc[v][e] += s * w[e];
        }
    }
#pragma unroll
    for (int v = 0; v < 5; ++v)
#pragma unroll
        for (int e = 0; e < 4; ++e) red[kg * 160 + v * 32 + cgp * 4 + e] = acc[v][e];
    __syncthreads();
    if (tid < 160) {
        float s = 0.f;
        for (int g = 0; g < 32; ++g) s += red[g * 160 + tid];
        const int v = tid >> 5, cc = tid & 31;
        p.modv[(size_t)(l * 5 + v) * 3072 + j0 + cc] = s + p.b_ada[l * 3072 + j0 + cc];
    }
    __syncthreads();
}

__device__ __forceinline__ void prep_transpose_item(const float* src, bf16_t* dst, int N, int k0, int n0) {
    const int n = n0 + otid();
    const float* sp = src + (size_t)k0 * N + n;
    float v[64];
#pragma unroll
    for (int i = 0; i < 64; ++i) v[i] = sp[(size_t)i * N];
    bf16_t* d = dst + (size_t)n * 1024 + k0;
#pragma unroll
    for (int c = 0; c < 8; ++c) {
        u32x4 w;
        w.x = pk_bf16(v[c * 8 + 0], v[c * 8 + 1]);
        w.y = pk_bf16(v[c * 8 + 2], v[c * 8 + 3]);
        w.z = pk_bf16(v[c * 8 + 4], v[c * 8 + 5]);
        w.w = pk_bf16(v[c * 8 + 6], v[c * 8 + 7]);
        *(u32x4*)(d + c * 8) = w;
    }
}

__device__ __forceinline__ void phase_prep(const Params& p, unsigned char* smem) {
    for (int it = (int)gridDim.x - 1 - (int)blockIdx.x; it < 192; it += gridDim.x) prep_mod_item(p, it, smem);
    const int NTI = 2 * 11 * 16, NTO = 2 * 4 * 16;
    for (int it = blockIdx.x; it < NTI + NTO; it += gridDim.x) {
        if (it < NTI) {
            const int l = it / 176, r = it % 176, kt = r / 11, nt = r % 11;
            prep_transpose_item(p.w_in + (size_t)l * 1024 * INW, p.WinT + (size_t)l * INW * 1024, INW, kt * 64, nt * 256);
        } else {
            const int t = it - NTI, l = t / 64, r = t % 64, kt = r / 4, nt = r % 4;
            prep_transpose_item(p.w_out + (size_t)l * 1024 * 1024, p.WoutT + (size_t)l * 1024 * 1024, 1024, kt * 64, nt * 256);
        }
    }
    const int gsz = gridDim.x * 256;
    for (int i = blockIdx.x * 256 + otid(); i < 131072; i += gsz) {
        const int which = i >> 16, j4 = (i & 65535) * 4;
        const int d = j4 & 63, t = (j4 >> 6) & 255, kvh = (j4 >> 14) & 1, bl = j4 >> 15;
        const size_t si = ((size_t)(bl * 256 + t) * 2 + kvh) * 64 + d;
        const f32x4 v = *(const f32x4*)((which ? p.cache_v : p.cache_k) + si);
        u32x2 w;
        w.x = pk_bf16(v[0], v[1]);
        w.y = pk_bf16(v[2], v[3]);
        *(u32x2*)((which ? p.vc : p.kc) + j4) = w;
    }
    for (int j = blockIdx.x * 256 + otid(); j < 32768; j += gsz) {
        const int cc = j & 63, d = (j >> 6) & 63, lg = j >> 12;
        const float v = p.pool_w[((size_t)lg * 64 + cc) * 64 + d];
        p.PoolT[j] = (bf16_t)(pk_bf16(v, 0.f) & 0xffffu);
    }
    for (int j = blockIdx.x * 256 + otid(); j < 1024; j += gsz) {
        const int a = j & 15, r = j >> 4;
        const float inv = 1.0f / powf(10000.0f, (float)(2 * a) / 32.0f);
        const float ang = (float)r * inv;
        const float kf = rintf(ang * 0.15915494309189535f);
        float rr = fmaf(-kf, 6.2831854820251465f, ang);
        rr = fmaf(-kf, -1.7484555e-7f, rr);
        p.rope[j] = cosf(rr);
        p.rope[1024 + j] = sinf(rr);
    }
}

__device__ __forceinline__ float wave_sum(float v) {
#pragma unroll
    for (int o = 32; o >= 1; o >>= 1) v += __shfl_xor(v, o);
    return v;
}

__device__ __forceinline__ void phase_xn(const Params& p, int layer) {
    const int tid = otid(), lane = tid & 63, wave = tid >> 6;
    const int nw = gridDim.x * 4, w = blockIdx.x * 4 + wave;
    for (int t0 = w * 6; t0 < NTOK; t0 += nw * 6) {
        f32x4 x[6][4];
#pragma unroll
        for (int u = 0; u < 6; ++u) {
            const int tok = t0 + u;
            const float* src = layer == 0 ? (tok < NCTX ? p.x_prompt + (size_t)tok * DM : p.x_sample + (size_t)(tok - NCTX) * DM) : p.h + (size_t)tok * DM;
#pragma unroll
            for (int i = 0; i < 4; ++i) x[u][i] = *(const f32x4*)(src + i * 256 + lane * 4);
        }
#pragma unroll
        for (int u = 0; u < 6; ++u) {
            const int tok = t0 + u;
            const int v = tok < NCTX ? 0 : 1 + ((tok - NCTX) >> 11);
            const float* mv = p.modv + (size_t)(layer * 5 + v) * 3072;
            float ss = 0.f;
#pragma unroll
            for (int i = 0; i < 4; ++i) ss += x[u][i][0] * x[u][i][0] + x[u][i][1] * x[u][i][1] + x[u][i][2] * x[u][i][2] + x[u][i][3] * x[u][i][3];
            ss = wave_sum(ss);
            const float rstd = rsqrtf(ss * (1.0f / 1024.0f) + EPSF);
#pragma unroll
            for (int i = 0; i < 4; ++i) {
                const int k = i * 256 + lane * 4;
                const f32x4 g = *(const f32x4*)(p.norm_g + layer * 1024 + k);
                const f32x4 sh = *(const f32x4*)(mv + k);
                const f32x4 sc = *(const f32x4*)(mv + 1024 + k);
                float o[4];
#pragma unroll
                for (int e = 0; e < 4; ++e) o[e] = x[u][i][e] * rstd * g[e] * (1.0f + sc[e]) + sh[e];
                u32x2 wv;
                wv.x = pk_bf16(o[0], o[1]);
                wv.y = pk_bf16(o[2], o[3]);
                *(u32x2*)(p.xn + (size_t)tok * DM + k) = wv;
            }
        }
    }
}

__device__ __forceinline__ void phase_final(const Params& p) {
    const int tid = otid(), lane = tid & 63, wave = tid >> 6;
    const int nw = gridDim.x * 4, w = blockIdx.x * 4 + wave;
    f32x4 g[4];
#pragma unroll
    for (int i = 0; i < 4; ++i) g[i] = *(const f32x4*)(p.final_g + i * 256 + lane * 4);
    for (int t0 = w * 6; t0 < NTOK; t0 += nw * 6) {
        f32x4 x[6][4];
#pragma unroll
        for (int u = 0; u < 6; ++u)
#pragma unroll
            for (int i = 0; i < 4; ++i) x[u][i] = *(const f32x4*)(p.out + (size_t)(t0 + u) * DM + i * 256 + lane * 4);
#pragma unroll
        for (int u = 0; u < 6; ++u) {
            float* row = p.out + (size_t)(t0 + u) * DM;
            float ss = 0.f;
#pragma unroll
            for (int i = 0; i < 4; ++i) ss += x[u][i][0] * x[u][i][0] + x[u][i][1] * x[u][i][1] + x[u][i][2] * x[u][i][2] + x[u][i][3] * x[u][i][3];
            ss = wave_sum(ss);
            const float rstd = rsqrtf(ss * (1.0f / 1024.0f) + EPSF);
#pragma unroll
            for (int i = 0; i < 4; ++i) *(f32x4*)(row + i * 256 + lane * 4) = x[u][i] * rstd * g[i];
        }
    }
}

template <int MODE, int MI, int STG = 0>
__device__ __forceinline__ void gemm_epilogue(const Params& p, int layer, int mw, int nw, f32x4 (&acc)[MI][4], int fr, int fq,
                                              unsigned char* ct = nullptr, int m0t = 0, int n0t = 0) {
    if (MODE == 0) {
        const bool ctx = mw < NCTX;
        if (nw < 640) {
            const bool isq = nw < 512;
            const float* gp = (isq ? p.q_g : p.k_g) + layer * 64;
            f32x4 gv[4];
#pragma unroll
            for (int ni = 0; ni < 4; ++ni) gv[ni] = *(const f32x4*)(gp + ni * 16 + fq * 4);
#pragma unroll
            for (int mi = 0; mi < MI; ++mi) {
                const int tok = mw + mi * 16 + fr;
                float ss = 0.f;
#pragma unroll
                for (int ni = 0; ni < 4; ++ni)
#pragma unroll
                    for (int e = 0; e < 4; ++e) ss += acc[mi][ni][e] * acc[mi][ni][e];
                ss += __shfl_xor(ss, 16);
                ss += __shfl_xor(ss, 32);
                const float rstd = rsqrtf(ss * (1.0f / 64.0f) + EPSF);
                f32x4 val[4];
#pragma unroll
                for (int ni = 0; ni < 4; ++ni) val[ni] = acc[mi][ni] * rstd * gv[ni];
                if (!isq && ctx) {
                    float* nk = p.out + OUT_NK + ((size_t)((tok >> 8) * 2 + layer) * 256 + (tok & 255)) * 128 + (nw - 512) + fq * 4;
#pragma unroll
                    for (int ni = 0; ni < 4; ++ni) *(f32x4*)(nk + ni * 16) = val[ni];
                }
                if (!ctx) {
                    const int pos = (tok - NCTX) & 2047, prow = pos >> 6, pcol = pos & 63;
                    const f32x4 cr = *(const f32x4*)(p.rope + prow * 16 + fq * 4), sr = *(const f32x4*)(p.rope + 1024 + prow * 16 + fq * 4);
                    const f32x4 cc = *(const f32x4*)(p.rope + pcol * 16 + fq * 4), sn = *(const f32x4*)(p.rope + 1024 + pcol * 16 + fq * 4);
                    const f32x4 a0 = val[0], a1 = val[1], a2 = val[2], a3 = val[3];
                    val[0] = a0 * cr - a1 * sr;
                    val[1] = a1 * cr + a0 * sr;
                    val[2] = a2 * cc - a3 * sn;
                    val[3] = a3 * cc + a2 * sn;
                }
                if (isq) {
#pragma unroll
                    for (int ni = 0; ni < 4; ++ni) val[ni] = val[ni] * QSCALE;
                }
                bf16_t* pr = p.proj + (size_t)tok * INW + nw + fq * 4;
#pragma unroll
                for (int ni = 0; ni < 4; ++ni) {
                    u32x2 w;
                    w.x = pk_bf16(val[ni][0], val[ni][1]);
                    w.y = pk_bf16(val[ni][2], val[ni][3]);
                    if (STG) *(u32x2*)(ct + (tok - m0t) * 272 + (nw - n0t + fq * 4 + ni * 16) * 2) = w;
                    else *(u32x2*)(pr + ni * 16) = w;
                }
            }
        } else {
            const bool isv = nw < 768;
#pragma unroll
            for (int mi = 0; mi < MI; ++mi) {
                const int tok = mw + mi * 16 + fr;
                bf16_t* pr = p.proj + (size_t)tok * INW + nw + fq * 4;
#pragma unroll
                for (int ni = 0; ni < 4; ++ni) {
                    u32x2 w;
                    w.x = pk_bf16(acc[mi][ni][0], acc[mi][ni][1]);
                    w.y = pk_bf16(acc[mi][ni][2], acc[mi][ni][3]);
                    if (STG) *(u32x2*)(ct + (tok - m0t) * 272 + (nw - n0t + fq * 4 + ni * 16) * 2) = w;
                    else *(u32x2*)(pr + ni * 16) = w;
                }
                if (isv && ctx) {
                    float* nv = p.out + OUT_NV + ((size_t)((tok >> 8) * 2 + layer) * 256 + (tok & 255)) * 128 + (nw - 640) + fq * 4;
#pragma unroll
                    for (int ni = 0; ni < 4; ++ni) *(f32x4*)(nv + ni * 16) = acc[mi][ni];
                }
            }
        }
    } else {
        const int v = mw < NCTX ? 0 : 1 + ((mw - NCTX) >> 11);
        const float* gate = p.modv + (size_t)(layer * 5 + v) * 3072 + 2048 + nw + fq * 4;
        f32x4 gt[4];
#pragma unroll
        for (int ni = 0; ni < 4; ++ni) gt[ni] = *(const f32x4*)(gate + ni * 16);
#pragma unroll
        for (int mi = 0; mi < MI; ++mi) {
            const int tok = mw + mi * 16 + fr;
            const float* ho = (layer == 0 ? (tok < NCTX ? p.x_prompt + (size_t)tok * DM : p.x_sample + (size_t)(tok - NCTX) * DM) : p.h + (size_t)tok * DM) + nw + fq * 4;
            float* hn = (layer == 0 ? p.h : p.out) + (size_t)tok * DM + nw + fq * 4;
#pragma unroll
            for (int ni = 0; ni < 4; ++ni) {
                const f32x4 o = *(const f32x4*)(ho + ni * 16);
                *(f32x4*)(hn + ni * 16) = o + gt[ni] * acc[mi][ni];
            }
        }
    }
}

template <int MODE>
__device__ __forceinline__ void gemm_tile(const Params& p, int layer, int mt, int nt, unsigned char* smem) {
    const int tid = otid(), lane = tid & 63, wave = tid >> 6, wm = wave >> 1, wn = wave & 1;
    const int fr = lane & 15, fq = lane >> 4;
    const int m0 = mt * 128, n0 = nt * 128;
    const bf16_t* A = (MODE == 0 ? p.xn : p.mix) + (size_t)m0 * 1024;
    const bf16_t* B = (MODE == 0 ? p.WinT + (size_t)layer * INW * 1024 : p.WoutT + (size_t)layer * 1024 * 1024) + (size_t)n0 * 1024;
    f32x4 acc[4][4];
#pragma unroll
    for (int i = 0; i < 4; ++i)
#pragma unroll
        for (int j = 0; j < 4; ++j) acc[i][j] = (f32x4){0.f, 0.f, 0.f, 0.f};

    const int srow = tid >> 3, scc = tid & 7;
    const bf16_t* ag = A + (size_t)srow * 1024 + scc * 8;
    const bf16_t* bg = B + (size_t)srow * 1024 + scc * 8;
    const int wofs = srow * 128 + ((scc ^ (srow & 7)) * 16);
    u32x4 raA[4], rbA[4], raB[4], rbB[4];
    auto gload = [&](int kt, u32x4* ra, u32x4* rb) {
#pragma unroll
        for (int i = 0; i < 4; ++i) {
            ra[i] = *(const u32x4*)(ag + (size_t)i * 32 * 1024 + kt * 64);
            rb[i] = *(const u32x4*)(bg + (size_t)i * 32 * 1024 + kt * 64);
        }
    };
    auto swrite = [&](int buf, const u32x4* ra, const u32x4* rb) {
        unsigned char* Aw = smem + buf * 32768;
#pragma unroll
        for (int i = 0; i < 4; ++i) {
            *(u32x4*)(Aw + wofs + i * 4096) = ra[i];
            *(u32x4*)(Aw + 16384 + wofs + i * 4096) = rb[i];
        }
    };
    gload(0, raA, rbA);
    gload(1, raB, rbB);
    swrite(0, raA, rbA);
    __syncthreads();
    const int aro = (wm * 64 + fr) * 128, bro = (wn * 64 + fr) * 128, sw = fr & 7;
    auto step = [&](int kt, u32x4* la, u32x4* lb, const u32x4* wa, const u32x4* wb) {
        const unsigned char* As = smem + (kt & 1) * 32768;
        const unsigned char* Bs = As + 16384;
        bf16x8 af[2][4], bf[2][4];
#pragma unroll
        for (int kk = 0; kk < 2; ++kk) {
            const int co = ((kk * 4 + fq) ^ sw) * 16;
#pragma unroll
            for (int i = 0; i < 4; ++i) {
                af[kk][i] = *(const bf16x8*)(As + aro + i * 2048 + co);
                bf[kk][i] = *(const bf16x8*)(Bs + bro + i * 2048 + co);
            }
        }
        if (kt + 2 < 16) gload(kt + 2, la, lb);
        __builtin_amdgcn_sched_barrier(0);
#pragma unroll
        for (int mi = 0; mi < 4; ++mi)
#pragma unroll
            for (int ni = 0; ni < 4; ++ni) acc[mi][ni] = __builtin_amdgcn_mfma_f32_16x16x32_bf16(bf[0][ni], af[0][mi], acc[mi][ni], 0, 0, 0);
        __builtin_amdgcn_sched_barrier(0);
        if (kt + 1 < 16) swrite((kt + 1) & 1, wa, wb);
        __builtin_amdgcn_sched_barrier(0);
#pragma unroll
        for (int mi = 0; mi < 4; ++mi)
#pragma unroll
            for (int ni = 0; ni < 4; ++ni) acc[mi][ni] = __builtin_amdgcn_mfma_f32_16x16x32_bf16(bf[1][ni], af[1][mi], acc[mi][ni], 0, 0, 0);
        __syncthreads();
    };
    for (int kt = 0; kt < 16; kt += 2) {
        step(kt, raA, rbA, raB, rbB);
        step(kt + 1, raB, rbB, raA, rbA);
    }

    gemm_epilogue<MODE, 4>(p, layer, m0 + wm * 64, n0 + wn * 64, acc, fr, fq);
}

template <int MODE>
__device__ __forceinline__ void gemm_tile256(const Params& p, int layer, int mt, int nt, unsigned char* smem) {
    const int tid = otid(), lane = tid & 63, wave = tid >> 6, wm = wave >> 1, wn = wave & 1;
    const int fr = lane & 15, fq = lane >> 4;
    const int m0 = mt * 256, n0 = nt * 128;
    const bf16_t* A = (MODE == 0 ? p.xn : p.mix) + (size_t)m0 * 1024;
    const bf16_t* B = (MODE == 0 ? p.WinT + (size_t)layer * INW * 1024 : p.WoutT + (size_t)layer * 1024 * 1024) + (size_t)n0 * 1024;
    f32x4 acc[8][4];
#pragma unroll
    for (int i = 0; i < 8; ++i)
#pragma unroll
        for (int j = 0; j < 4; ++j) acc[i][j] = (f32x4){0.f, 0.f, 0.f, 0.f};
    const int srow = tid >> 2, scc = tid & 3;
    const bf16_t* ag = A + (size_t)srow * 1024 + scc * 8;
    const bf16_t* bg = B + (size_t)srow * 1024 + scc * 8;
    const int wofs = srow * 64 + ((scc ^ ((4 - ((srow >> 2) & 3)) & 3)) * 16);
    u32x4 raA[4], rbA[2], raB[4], rbB[2];
    auto gload = [&](int kt, u32x4* ra, u32x4* rb) {
#pragma unroll
        for (int i = 0; i < 4; ++i) ra[i] = *(const u32x4*)(ag + (size_t)i * 64 * 1024 + kt * 32);
#pragma unroll
        for (int i = 0; i < 2; ++i) rb[i] = *(const u32x4*)(bg + (size_t)i * 64 * 1024 + kt * 32);
    };
    auto swrite = [&](int buf, const u32x4* ra, const u32x4* rb) {
        unsigned char* Aw = smem + buf * 24576;
#pragma unroll
        for (int i = 0; i < 4; ++i) *(u32x4*)(Aw + wofs + i * 4096) = ra[i];
#pragma unroll
        for (int i = 0; i < 2; ++i) *(u32x4*)(Aw + 16384 + wofs + i * 4096) = rb[i];
    };
    gload(0, raA, rbA);
    gload(1, raB, rbB);
    swrite(0, raA, rbA);
    __syncthreads();
    const int co = (fq ^ ((4 - ((fr >> 2) & 3)) & 3)) * 16;
    const int aro = (wm * 128 + fr) * 64 + co, bro = (wn * 64 + fr) * 64 + co;
    auto step = [&](int kt, u32x4* la, u32x4* lb, const u32x4* wa, const u32x4* wb) {
        const unsigned char* As = smem + (kt & 1) * 24576;
        const unsigned char* Bs = As + 16384;
        bf16x8 af[8], bf[4];
#pragma unroll
        for (int i = 0; i < 4; ++i) bf[i] = *(const bf16x8*)(Bs + bro + i * 1024);
#pragma unroll
        for (int i = 0; i < 8; ++i) af[i] = *(const bf16x8*)(As + aro + i * 1024);
        if (kt + 2 < 32) gload(kt + 2, la, lb);
        __builtin_amdgcn_sched_barrier(0);
#pragma unroll
        for (int mi = 0; mi < 4; ++mi)
#pragma unroll
            for (int ni = 0; ni < 4; ++ni) acc[mi][ni] = __builtin_amdgcn_mfma_f32_16x16x32_bf16(bf[ni], af[mi], acc[mi][ni], 0, 0, 0);
        __builtin_amdgcn_sched_barrier(0);
        if (kt + 1 < 32) swrite((kt + 1) & 1, wa, wb);
        __builtin_amdgcn_sched_barrier(0);
#pragma unroll
        for (int mi = 4; mi < 8; ++mi)
#pragma unroll
            for (int ni = 0; ni < 4; ++ni) acc[mi][ni] = __builtin_amdgcn_mfma_f32_16x16x32_bf16(bf[ni], af[mi], acc[mi][ni], 0, 0, 0);
        __syncthreads();
    };
    for (int kt = 0; kt < 32; kt += 2) {
        step(kt, raA, rbA, raB, rbB);
        step(kt + 1, raB, rbB, raA, rbA);
    }
    gemm_epilogue<MODE, 8>(p, layer, m0 + wm * 128, n0 + wn * 64, acc, fr, fq);
}

template <int MODE>
__device__ __forceinline__ void gemm_tile256_dma(const Params& p, int layer, int mt, int nt, unsigned char* smem) {
    const int tid = otid(), lane = tid & 63, wave = tid >> 6, wm = wave >> 1, wn = wave & 1;
    const int fr = lane & 15, fq = lane >> 4;
    const int m0 = mt * 256, n0 = nt * 128;
    const bf16_t* A = (MODE == 0 ? p.xn : p.mix) + (size_t)m0 * 1024;
    const bf16_t* B = (MODE == 0 ? p.WinT + (size_t)layer * INW * 1024 : p.WoutT + (size_t)layer * 1024 * 1024) + (size_t)n0 * 1024;
    f32x4 acc[8][4];
#pragma unroll
    for (int i = 0; i < 8; ++i)
#pragma unroll
        for (int j = 0; j < 4; ++j) acc[i][j] = (f32x4){0.f, 0.f, 0.f, 0.f};
    const int lrow = lane >> 2, lc = (lane & 3) ^ ((4 - ((lane >> 4) & 3)) & 3);
    const bf16_t* agp = A + (size_t)(wave * 64 + lrow) * 1024 + lc * 8;
    const bf16_t* bgp = B + (size_t)(wave * 32 + lrow) * 1024 + lc * 8;
    LAS unsigned char* lbase = (LAS unsigned char*)smem;
    const int la_off = wave * 4096 + lane * 16, lb_off = 16384 + wave * 2048 + lane * 16;
    auto dma = [&](int kt, int stage) {
        LAS unsigned char* sb = lbase + stage * 24576;
#pragma unroll
        for (int i = 0; i < 4; ++i)
            __builtin_amdgcn_global_load_lds((const void*)(agp + (size_t)i * 16 * 1024 + kt * 32), (LAS void*)(sb + la_off + i * 1024), 16, 0, 0);
#pragma unroll
        for (int i = 0; i < 2; ++i)
            __builtin_amdgcn_global_load_lds((const void*)(bgp + (size_t)i * 16 * 1024 + kt * 32), (LAS void*)(sb + lb_off + i * 1024), 16, 0, 0);
    };
    dma(0, 0);
    dma(1, 1);
    asm volatile("s_waitcnt vmcnt(6)" ::: "memory");
    __builtin_amdgcn_s_barrier();
    const int co = (fq ^ ((4 - ((fr >> 2) & 3)) & 3)) * 16;
    const int aro = (wm * 128 + fr) * 64 + co, bro = 16384 + (wn * 64 + fr) * 64 + co;
    int st = 0, st2 = 2;
    const unsigned lds0 = (unsigned)(uintptr_t)lbase;
#pragma unroll 1
    for (int kt = 0; kt < 32; ++kt) {
        const unsigned sa = lds0 + st * 24576 + aro, sbb = lds0 + st * 24576 + bro;
        bf16x8 af[8], bf[4];
#define FRAG_RD(dst, addr, OFF) asm volatile("ds_read_b128 %0, %1 offset:" #OFF : "=&v"(dst) : "v"(addr))
        FRAG_RD(bf[0], sbb, 0); FRAG_RD(bf[1], sbb, 1024); FRAG_RD(bf[2], sbb, 2048); FRAG_RD(bf[3], sbb, 3072);
        FRAG_RD(af[0], sa, 0); FRAG_RD(af[1], sa, 1024); FRAG_RD(af[2], sa, 2048); FRAG_RD(af[3], sa, 3072);
        FRAG_RD(af[4], sa, 4096); FRAG_RD(af[5], sa, 5120); FRAG_RD(af[6], sa, 6144); FRAG_RD(af[7], sa, 7168);
#undef FRAG_RD
        __builtin_amdgcn_sched_barrier(0);
        if (kt + 2 < 32) dma(kt + 2, st2);
        __builtin_amdgcn_sched_barrier(0);
        asm volatile("s_waitcnt lgkmcnt(4)" ::: "memory");
        __builtin_amdgcn_sched_barrier(0);
#pragma unroll
        for (int mi = 0; mi < 4; ++mi)
#pragma unroll
            for (int ni = 0; ni < 4; ++ni) acc[mi][ni] = __builtin_amdgcn_mfma_f32_16x16x32_bf16(bf[ni], af[mi], acc[mi][ni], 0, 0, 0);
        __builtin_amdgcn_sched_barrier(0);
        asm volatile("s_waitcnt lgkmcnt(0)" ::: "memory");
        __builtin_amdgcn_sched_barrier(0);
#pragma unroll
        for (int mi = 4; mi < 8; ++mi)
#pragma unroll
            for (int ni = 0; ni < 4; ++ni) acc[mi][ni] = __builtin_amdgcn_mfma_f32_16x16x32_bf16(bf[ni], af[mi], acc[mi][ni], 0, 0, 0);
        __builtin_amdgcn_sched_barrier(0);
        if (kt + 2 < 32) asm volatile("s_waitcnt vmcnt(6)" ::: "memory");
        else asm volatile("s_waitcnt vmcnt(0)" ::: "memory");
        __builtin_amdgcn_s_barrier();
        st = st == 2 ? 0 : st + 1;
        st2 = st2 == 2 ? 0 : st2 + 1;
    }
    if (MODE == 0) {
        gemm_epilogue<0, 8, 1>(p, layer, m0 + wm * 128, n0 + wn * 64, acc, fr, fq, smem, m0, n0);
        __syncthreads();
        u32x4 cv[16];
#pragma unroll
        for (int i = 0; i < 16; ++i) { const int e = tid + 256 * i; cv[i] = *(const u32x4*)(smem + (e >> 4) * 272 + (e & 15) * 16); }
#pragma unroll
        for (int i = 0; i < 16; ++i) { const int e = tid + 256 * i; *(u32x4*)(p.proj + (size_t)(m0 + (e >> 4)) * INW + n0 + (e & 15) * 8) = cv[i]; }
        __syncthreads();
    } else {
#pragma unroll 1
        for (int pass = 0; pass < 2; ++pass) {
            if (wm == pass) {
#pragma unroll
                for (int mi = 0; mi < 8; ++mi)
#pragma unroll
                    for (int ni = 0; ni < 4; ++ni) *(f32x4*)(smem + (mi * 16 + fr) * 528 + (wn * 64 + ni * 16 + fq * 4) * 4) = acc[mi][ni];
            }
            __syncthreads();
            const int rbase = m0 + pass * 128;
            const int c4 = (tid & 31) * 4;
            f32x4 ho[16];
#pragma unroll
            for (int i = 0; i < 16; ++i) {
                const int tok = rbase + (tid >> 5) + 8 * i;
                const float* hp = (layer == 0 ? (tok < NCTX ? p.x_prompt + (size_t)tok * DM : p.x_sample + (size_t)(tok - NCTX) * DM) : p.h + (size_t)tok * DM) + n0 + c4;
                ho[i] = *(const f32x4*)hp;
            }
            const int v = rbase < NCTX ? 0 : 1 + ((rbase - NCTX) >> 11);
            const f32x4 gt = *(const f32x4*)(p.modv + (size_t)(layer * 5 + v) * 3072 + 2048 + n0 + c4);
#pragma unroll
            for (int i = 0; i < 16; ++i) {
                const int row = (tid >> 5) + 8 * i, tok = rbase + row;
                const f32x4 a = *(const f32x4*)(smem + row * 528 + c4 * 4);
                *(f32x4*)((layer == 0 ? p.h : p.out) + (size_t)tok * DM + n0 + c4) = ho[i] + gt * a;
            }
            __syncthreads();
        }
    }
}

template <int MODE>
__device__ __forceinline__ void phase_gemm(const Params& p, int layer, unsigned char* smem) {
    const int NT = MODE == 0 ? 22 : 8;
    const int total = 96 * NT;
    if (gridDim.x == 512) {
        const int xcd = blockIdx.x & 7, slot = blockIdx.x >> 3;
        if (MODE == 0) {
            for (int idx = slot; idx < 128; idx += 64) gemm_tile256_dma<MODE>(p, layer, xcd * 6 + idx % 6, idx / 6, smem);
            if (slot < 8) gemm_tile<MODE>(p, layer, (xcd * 6 + 2 + (slot >> 1)) * 2 + (slot & 1), 21, smem);
        } else {
            if (slot < 32) gemm_tile256_dma<MODE>(p, layer, xcd * 6 + slot % 6, slot / 6, smem);
            else {
                const int d = 32 + ((slot - 32) >> 1);
                gemm_tile<MODE>(p, layer, (xcd * 6 + d % 6) * 2 + (slot & 1), d / 6, smem);
            }
        }
    } else {
        for (int t = blockIdx.x; t < total; t += gridDim.x) gemm_tile<MODE>(p, layer, t / NT, t % NT, smem);
    }
}

template <int VAR>
__device__ __forceinline__ void attn_unit(const Params& p, int layer, int unit, unsigned char* smem) {
    const int tid = otid(), lane = tid & 63, wave = tid >> 6;
    const int r31 = lane & 31, hh = lane >> 5;
    int b, head, qblk, tokbase, nself, ntiles;
    if (unit < 512) { b = unit >> 7; head = (unit >> 4) & 7; qblk = unit & 15; tokbase = NCTX + b * 2048; nself = 2048; ntiles = 36; }
    else { const int u = unit - 512; b = u >> 4; head = (u >> 1) & 7; qblk = u & 1; tokbase = b * 256; nself = 256; ntiles = 4; }
    const int kvh = head >> 2;
    const int qtok = tokbase + qblk * 128 + wave * 32 + r31;
    bf16x8 qf[4];
    {
        const bf16_t* qp = p.proj + (size_t)qtok * INW + head * 64 + hh * 8;
#pragma unroll
        for (int ks = 0; ks < 4; ++ks) qf[ks] = *(const bf16x8*)(qp + ks * 16);
    }
    const bf16_t* kself = p.proj + (size_t)tokbase * INW + 512 + kvh * 64;
    const bf16_t* vself = p.proj + (size_t)tokbase * INW + 640 + kvh * 64;
    const bf16_t* kcache = p.kc + (size_t)((b * 2 + layer) * 2 + kvh) * 256 * 64;
    const bf16_t* vcache = p.vc + (size_t)((b * 2 + layer) * 2 + kvh) * 256 * 64;
    const int srow = tid >> 3, scc = tid & 7;
    const int kwo = srow * 128 + ((scc ^ ((srow >> 1) & 7)) * 16);
    const int vwo = srow * 128 + ((scc ^ (((srow >> 1) & 1) << 2)) * 16);
    u32x4 rkA[2], rvA[2], rkB[2], rvB[2];
    auto gload = [&](int j, u32x4* rk, u32x4* rv) {
        const int key0 = j * 64;
#pragma unroll
        for (int i = 0; i < 2; ++i) {
            const int row = srow + 32 * i;
            if (key0 < nself) {
                rk[i] = *(const u32x4*)(kself + (size_t)(key0 + row) * INW + scc * 8);
                rv[i] = *(const u32x4*)(vself + (size_t)(key0 + row) * INW + scc * 8);
            } else {
                rk[i] = *(const u32x4*)(kcache + (size_t)(key0 - nself + row) * 64 + scc * 8);
                rv[i] = *(const u32x4*)(vcache + (size_t)(key0 - nself + row) * 64 + scc * 8);
            }
        }
    };
    auto swrite = [&](int buf, const u32x4* rk, const u32x4* rv) {
        unsigned char* kb = smem + buf * 16384;
        unsigned char* vb = kb + 8192;
#pragma unroll
        for (int i = 0; i < 2; ++i) {
            *(u32x4*)(kb + kwo + i * 32 * 128) = rk[i];
            *(u32x4*)(vb + vwo + i * 32 * 128) = rv[i];
        }
    };
    f32x16 o[2];
#pragma unroll
    for (int i = 0; i < 16; ++i) { o[0][i] = 0.f; o[1][i] = 0.f; }
    float mrun = 0.f, mmax = -1e30f, lrun = 0.f;
    f32x16 negm, zero16;
#pragma unroll
    for (int i = 0; i < 16; ++i) { negm[i] = 0.f; zero16[i] = 0.f; }
    bool shifted = false;
    gload(0, rkA, rvA);
    swrite(0, rkA, rvA);
    if (ntiles > 1) gload(1, rkB, rvB);
    __syncthreads();
    const int kro = r31 * 128, ksw = (r31 >> 1) & 7;
    const int vq = 4 * hh + ((lane & 15) >> 2);
    const int vsw = ((vq >> 1) & 1) << 2;
    const int vcl = ((lane >> 4) & 1) * 2 + ((lane & 3) >> 1);
    const int vro0 = vq * 128 + (((0 * 4 + vcl) ^ vsw) * 16) + (lane & 1) * 8;
    const int vro1 = vq * 128 + (((1 * 4 + vcl) ^ vsw) * 16) + (lane & 1) * 8;
    auto step = [&](int j, u32x4* lk, u32x4* lv, const u32x4* wk, const u32x4* wv) {
        const unsigned char* kb = smem + (j & 1) * 16384;
        const unsigned char* vb = kb + 8192;
        bf16x8 kf[2][4];
#pragma unroll
        for (int sb = 0; sb < 2; ++sb)
#pragma unroll
            for (int ks = 0; ks < 4; ++ks) kf[sb][ks] = *(const bf16x8*)(kb + sb * 4096 + kro + (((ks * 2 + hh) ^ ksw) * 16));
        if (VAR != 1 && j + 2 < ntiles) gload(j + 2, lk, lv);
        __builtin_amdgcn_sched_barrier(0);
        f32x16 s[2];
#pragma unroll
        for (int ks = 0; ks < 4; ++ks)
#pragma unroll
            for (int sb = 0; sb < 2; ++sb) {
                if (ks == 0) {
                    if (shifted) s[sb] = __builtin_amdgcn_mfma_f32_32x32x16_bf16(kf[sb][ks], qf[ks], negm, 0, 0, 0);
                    else s[sb] = __builtin_amdgcn_mfma_f32_32x32x16_bf16(kf[sb][ks], qf[ks], zero16, 0, 0, 0);
                } else s[sb] = __builtin_amdgcn_mfma_f32_32x32x16_bf16(kf[sb][ks], qf[ks], s[sb], 0, 0, 0);
            }
        __builtin_amdgcn_sched_barrier(0);
        bf16x8 vf[2][2][2];
#pragma unroll
        for (int sb = 0; sb < 2; ++sb)
#pragma unroll
            for (int s2 = 0; s2 < 2; ++s2)
#pragma unroll
                for (int dt = 0; dt < 2; ++dt) {
                    const LAS unsigned char* va = (const LAS unsigned char*)(vb) + (sb * 32 + s2 * 16) * 128 + (dt ? vro1 : vro0);
                    const s16x4 a0 = __builtin_amdgcn_ds_read_tr16_b64_v4i16((LAS s16x4*)(va));
                    const s16x4 a1 = __builtin_amdgcn_ds_read_tr16_b64_v4i16((LAS s16x4*)(va + 8 * 128));
                    vf[sb][s2][dt] = (bf16x8){a0[0], a0[1], a0[2], a0[3], a1[0], a1[1], a1[2], a1[3]};
                }
        __builtin_amdgcn_sched_barrier(0);
        float mloc = max3_f(s[0][0], s[1][0], s[0][1]);
        mloc = max3_f(mloc, s[1][1], s[0][2]);
#pragma unroll
        for (int i = 2; i < 16; ++i) mloc = max3_f(mloc, s[1][i], s[0][(i + 1) & 15]);
        float lsum = 0.f;
#pragma unroll
        for (int sb = 0; sb < 2; ++sb)
#pragma unroll
            for (int i = 0; i < 16; ++i) { if (VAR != 2) { s[sb][i] = __builtin_amdgcn_exp2f(s[sb][i]); lsum += s[sb][i]; } }
        lrun += lsum;
        bf16x8 pf[2][2];
#pragma unroll
        for (int sb = 0; sb < 2; ++sb)
#pragma unroll
            for (int s2 = 0; s2 < 2; ++s2) {
                u32x4 pw;
                pw.x = pk_bf16(s[sb][s2 * 8 + 0], s[sb][s2 * 8 + 1]);
                pw.y = pk_bf16(s[sb][s2 * 8 + 2], s[sb][s2 * 8 + 3]);
                pw.z = pk_bf16(s[sb][s2 * 8 + 4], s[sb][s2 * 8 + 5]);
                pw.w = pk_bf16(s[sb][s2 * 8 + 6], s[sb][s2 * 8 + 7]);
                pf[sb][s2] = __builtin_bit_cast(bf16x8, pw);
            }
        __builtin_amdgcn_sched_barrier(0);
#pragma unroll
        for (int sb = 0; sb < 2; ++sb)
#pragma unroll
            for (int s2 = 0; s2 < 2; ++s2)
#pragma unroll
                for (int dt = 0; dt < 2; ++dt) o[dt] = __builtin_amdgcn_mfma_f32_32x32x16_bf16(vf[sb][s2][dt], pf[sb][s2], o[dt], 0, 0, 0);
        __builtin_amdgcn_sched_barrier(0);
        mloc = fmaxf(mloc, __shfl_xor(mloc, 32));
        mmax = fmaxf(mmax, mrun + mloc);
        if (__builtin_expect(__any(fabsf(mmax - mrun) > 40.0f), 0)) {
            asm volatile("" ::: "memory");
            const float alpha = __builtin_amdgcn_exp2f(mrun - mmax);
            mrun = mmax;
            lrun *= alpha;
            shifted = true;
#pragma unroll
            for (int i = 0; i < 16; ++i) { o[0][i] *= alpha; o[1][i] *= alpha; negm[i] = -mrun; }
        }
        if (VAR != 1 && j + 1 < ntiles) swrite((j + 1) & 1, wk, wv);
        __syncthreads();
    };
    for (int j = 0; j < ntiles; j += 2) {
        step(j, rkA, rvA, rkB, rvB);
        step(j + 1, rkB, rvB, rkA, rvA);
    }
    const float ltot = lrun + __shfl_xor(lrun, 32);
    const float inv = 1.0f / ltot;
    const bf16_t* zp = p.proj + (size_t)qtok * INW + 768 + head * 64;
    bf16_t* mp = (VAR == 0 ? p.mix : p.xn) + (size_t)qtok * DM + head * 64;
#pragma unroll
    for (int dt = 0; dt < 2; ++dt)
#pragma unroll
        for (int rq = 0; rq < 4; ++rq) {
            const int d0 = dt * 32 + 8 * rq + 4 * hh;
            const u32x2 zz = *(const u32x2*)(zp + d0);
            const float z0 = bf_lo(zz.x), z1 = bf_hi(zz.x), z2 = bf_lo(zz.y), z3 = bf_hi(zz.y);
            u32x2 w;
            w.x = pk_bf16(o[dt][rq * 4 + 0] * inv * silu_f(z0), o[dt][rq * 4 + 1] * inv * silu_f(z1));
            w.y = pk_bf16(o[dt][rq * 4 + 2] * inv * silu_f(z2), o[dt][rq * 4 + 3] * inv * silu_f(z3));
            *(u32x2*)(mp + d0) = w;
        }
}

__device__ __forceinline__ void unpack8(const u32x4 u, float* f) {
    f[0] = bf_lo(u.x); f[1] = bf_hi(u.x); f[2] = bf_lo(u.y); f[3] = bf_hi(u.y);
    f[4] = bf_lo(u.z); f[5] = bf_hi(u.z); f[6] = bf_lo(u.w); f[7] = bf_hi(u.w);
}

__device__ __forceinline__ void pool_item(const Params& p, int layer, int pi, unsigned char* smem) {
    const int tid = otid(), lane = tid & 63, gi = tid >> 6;
    const int fr = lane & 15, fq = lane >> 4;
    const int T0 = pi * 64;
    int seqstart, seqlen;
    if (T0 < NCTX) { seqstart = T0 & ~255; seqlen = 256; } else { seqstart = NCTX + ((T0 - NCTX) & ~2047); seqlen = 2048; }
    const int toff = T0 - seqstart;
    for (int e = tid; e < 79 * 32; e += 256) {
        const int r = e >> 5, c = e & 31;
        const int s = toff - 8 + r;
        if (s >= 0 && s < seqlen) *(u32x4*)(smem + r * 528 + c * 16) = *(const u32x4*)(p.proj + (size_t)(seqstart + s) * INW + 2304 + c * 8);
    }
    __syncthreads();
    const int win = 2 << gi, half = win >> 1;
    bf16x8 wf[4][2];
    {
        const bf16_t* wp = p.PoolT + (size_t)((layer * 4 + gi) * 64) * 64;
#pragma unroll
        for (int ni = 0; ni < 4; ++ni)
#pragma unroll
            for (int kk = 0; kk < 2; ++kk) wf[ni][kk] = *(const bf16x8*)(wp + (ni * 16 + fr) * 64 + kk * 32 + fq * 8);
    }
#pragma unroll 1
    for (int mi = 0; mi < 4; ++mi) {
        f32x4 acc[4];
#pragma unroll
        for (int j = 0; j < 4; ++j) acc[j] = (f32x4){0.f, 0.f, 0.f, 0.f};
        const int tt = mi * 16 + fr;
        const int ts = toff + tt;
        int lo = ts - half, hi = ts - half + win - 1;
        lo = lo < 0 ? 0 : lo;
        hi = hi > seqlen - 1 ? seqlen - 1 : hi;
        const float rc = 1.0f / (float)(hi - lo + 1);
        const int r0 = lo - toff + 8, r1 = hi - toff + 8, rs = tt + 8;
#pragma unroll
        for (int kk = 0; kk < 2; ++kk) {
            const int co = (gi * 64 + kk * 32 + fq * 8) * 2;
            float sum[8];
#pragma unroll
            for (int e = 0; e < 8; ++e) sum[e] = 0.f;
            for (int r = r0; r <= r1; ++r) {
                float f[8];
                unpack8(*(const u32x4*)(smem + r * 528 + co), f);
#pragma unroll
                for (int e = 0; e < 8; ++e) sum[e] += f[e];
            }
            float us[8];
            unpack8(*(const u32x4*)(smem + rs * 528 + co), us);
            u32x4 dw;
            dw.x = pk_bf16(sum[0] * rc - us[0], sum[1] * rc - us[1]);
            dw.y = pk_bf16(sum[2] * rc - us[2], sum[3] * rc - us[3]);
            dw.z = pk_bf16(sum[4] * rc - us[4], sum[5] * rc - us[5]);
            dw.w = pk_bf16(sum[6] * rc - us[6], sum[7] * rc - us[7]);
            const bf16x8 df = __builtin_bit_cast(bf16x8, dw);
#pragma unroll
            for (int ni = 0; ni < 4; ++ni) acc[ni] = __builtin_amdgcn_mfma_f32_16x16x32_bf16(wf[ni][kk], df, acc[ni], 0, 0, 0);
        }
        const int tok = T0 + tt;
#pragma unroll
        for (int ni = 0; ni < 4; ++ni) {
            const int ch = gi * 64 + ni * 16 + fq * 4;
            const f32x4 ps = *(const f32x4*)(p.pool_scale + layer * 256 + ch);
            const u32x2 zz = *(const u32x2*)(p.proj + (size_t)tok * INW + 2560 + ch);
            u32x2 w;
            w.x = pk_bf16(acc[ni][0] * ps[0] * silu_f(bf_lo(zz.x)), acc[ni][1] * ps[1] * silu_f(bf_hi(zz.x)));
            w.y = pk_bf16(acc[ni][2] * ps[2] * silu_f(bf_lo(zz.y)), acc[ni][3] * ps[3] * silu_f(bf_hi(zz.y)));
            *(u32x2*)(p.mix + (size_t)tok * DM + 768 + ch) = w;
        }
    }
    __syncthreads();
}

__device__ __forceinline__ void conv_item(const Params& p, int layer, int ci) {
    const int tid = otid();
    const int ch = (tid & 31) * 8, tg = tid >> 5;
    const int T0 = ci * 64 + tg * 8;
    int seqstart, seqlen;
    if (T0 < NCTX) { seqstart = T0 & ~255; seqlen = 256; } else { seqstart = NCTX + ((T0 - NCTX) & ~2047); seqlen = 2048; }
    const int seqend = seqstart + seqlen;
    float w0[8], w1[8], w2[8], bb[8];
    {
        const float* cw = p.conv_w + (size_t)layer * 768 + ch;
#pragma unroll
        for (int e = 0; e < 8; ++e) { w0[e] = cw[e]; w1[e] = cw[256 + e]; w2[e] = cw[512 + e]; bb[e] = p.conv_b[layer * 256 + ch + e]; }
    }
    auto ldx = [&](int tok, float* x) {
        if (tok >= seqstart && tok < seqend) {
            float hc[8], cc[8];
            unpack8(*(const u32x4*)(p.proj + (size_t)tok * INW + 1280 + ch), hc);
            unpack8(*(const u32x4*)(p.proj + (size_t)tok * INW + 1792 + ch), cc);
#pragma unroll
            for (int e = 0; e < 8; ++e) x[e] = hc[e] * cc[e];
        } else {
#pragma unroll
            for (int e = 0; e < 8; ++e) x[e] = 0.f;
        }
    };
    float xm[8], x0[8], xp[8];
    ldx(T0 - 1, xm);
    ldx(T0, x0);
    for (int t = 0; t < 8; ++t) {
        const int tok = T0 + t;
        ldx(tok + 1, xp);
        float bc[8], zc[8], o[8];
        unpack8(*(const u32x4*)(p.proj + (size_t)tok * INW + 1536 + ch), bc);
        unpack8(*(const u32x4*)(p.proj + (size_t)tok * INW + 2048 + ch), zc);
#pragma unroll
        for (int e = 0; e < 8; ++e) {
            const float y = xm[e] * w0[e] + x0[e] * w1[e] + xp[e] * w2[e] + bb[e];
            o[e] = bc[e] * y * silu_f(zc[e]);
        }
        u32x4 w;
        w.x = pk_bf16(o[0], o[1]); w.y = pk_bf16(o[2], o[3]); w.z = pk_bf16(o[4], o[5]); w.w = pk_bf16(o[6], o[7]);
        *(u32x4*)(p.mix + (size_t)tok * DM + 512 + ch) = w;
#pragma unroll
        for (int e = 0; e < 8; ++e) { xm[e] = x0[e]; x0[e] = xp[e]; }
    }
}

__device__ __forceinline__ void phase_mixer(const Params& p, int layer, unsigned char* smem) {
    for (int it = blockIdx.x; it < 768 + 192 + 192; it += gridDim.x) {
        if (it < 768) {
            attn_unit<0>(p, layer, it, smem);
        }
        else if (it < 960) pool_item(p, layer, it - 768, smem);
        else conv_item(p, layer, it - 960);
    }
}

__global__ void __launch_bounds__(256, 2) mega(Params p, int lo, int hi) {
    __shared__ __attribute__((aligned(16))) unsigned char smem[73728];
    __shared__ uint4 xbw;
    if (p.use_cg) cg::this_grid().sync();
    if (threadIdx.x == 0) xbw = make_uint4(0u, 0u, 0u, 0u);
    __syncthreads();
    XcdBarrier xb = xcd_barrier_post(p.bar, (volatile LAS unsigned*)&xbw);
    for (int ph = lo; ph < hi; ++ph) {
        if (ph > lo) xcd_barrier(xb);
        if (ph == 0) phase_prep(p, smem);
        else if (ph == 9) phase_final(p);
        else {
            const int layer = (ph - 1) >> 2, ty = (ph - 1) & 3;
            if (ty == 0) phase_xn(p, layer);
            else if (ty == 1) phase_gemm<0>(p, layer, smem);
            else if (ty == 2) phase_mixer(p, layer, smem);
            else phase_gemm<1>(p, layer, smem);
        }
    }
}

#ifndef MK_MULTI
#define MK_MULTI 0
#endif

extern "C" void kernel_launch(void* const* d_in, const int* in_sizes, int n_in, void* d_out, int out_size, void* d_ws, size_t ws_size,
                              hipStream_t stream) {
    static int grid_blocks = 0;
    if (!grid_blocks) {
        int dev = 0, cus = 0, per_cu = 0;
        hipGetDevice(&dev);
        hipDeviceGetAttribute(&cus, hipDeviceAttributeMultiprocessorCount, dev);
        hipOccupancyMaxActiveBlocksPerMultiprocessor(&per_cu, mega, 256, 0);
        if (per_cu > 2) per_cu = 2;
        if (per_cu < 1) per_cu = 1;
        grid_blocks = cus * per_cu;
    }
    Params p{};
    const float* const* in = (const float* const*)d_in;
    p.x_prompt = in[0]; p.x_sample = in[1]; p.cache_k = in[2]; p.cache_v = in[3]; p.c = in[4]; p.c_ctx = in[5]; p.norm_g = in[6];
    p.w_ada = in[7]; p.b_ada = in[8]; p.w_in = in[9]; p.q_g = in[10]; p.k_g = in[11]; p.conv_w = in[12]; p.conv_b = in[13];
    p.pool_w = in[14]; p.pool_scale = in[15]; p.w_out = in[16]; p.final_g = in[17];
    p.out = (float*)d_out;
    unsigned char* ws = (unsigned char*)d_ws;
    size_t off = 0;
    auto take = [&](size_t bytes) { unsigned char* r = ws + off; off += (bytes + 255) & ~(size_t)255; return r; };
    p.bar = (unsigned*)take(XCD_BAR_WORDS * 4);
    p.modv = (float*)take(2 * 5 * 3072 * 4);
    p.rope = (float*)take(2048 * 4);
    p.WinT = (bf16_t*)take((size_t)2 * INW * 1024 * 2);
    p.WoutT = (bf16_t*)take((size_t)2 * 1024 * 1024 * 2);
    p.PoolT = (bf16_t*)take(2 * 4 * 64 * 64 * 2);
    p.kc = (bf16_t*)take(262144 * 2);
    p.vc = (bf16_t*)take(262144 * 2);
    p.h = (float*)take((size_t)NTOK * DM * 4);
    p.xn = (bf16_t*)take((size_t)NTOK * DM * 2);
    p.proj = (bf16_t*)take((size_t)NTOK * INW * 2);
    p.mix = (bf16_t*)take((size_t)NTOK * DM * 2);
    p.use_cg = 0;
    p.pad = 0;
    hipMemsetAsync(p.bar, 0, XCD_BAR_WORDS * 4, stream);
#if MK_MULTI
    for (int ph = 0; ph < 10; ++ph) {
        int lo = ph, hi = ph + 1;
        void* args[] = {&p, &lo, &hi};
        hipError_t e = hipLaunchCooperativeKernel((void*)mega, dim3(grid_blocks), dim3(256), args, 0, stream);
        if (e != hipSuccess) fprintf(stderr, "launch failed: %s\n", hipGetErrorString(e));
    }
#else
    int lo = 0, hi = 10;
    void* args[] = {&p, &lo, &hi};
    hipError_t e = hipLaunchCooperativeKernel((void*)mega, dim3(grid_blocks), dim3(256), args, 0, stream);
    if (e != hipSuccess) fprintf(stderr, "cooperative launch failed: %s (grid %d)\n", hipGetErrorString(e), grid_blocks);
#endif
}
```

```cpp
#include <hip/hip_runtime.h>
#include <hip/hip_cooperative_groups.h>
#include <cstdint>
#include <cstdio>
namespace cg = cooperative_groups;

#define LAS __attribute__((address_space(3)))
typedef unsigned short bf16_t;
typedef short bf16x8 __attribute__((ext_vector_type(8)));
typedef short s16x4 __attribute__((ext_vector_type(4)));
typedef float f32x4 __attribute__((ext_vector_type(4)));
typedef float f32x16 __attribute__((ext_vector_type(16)));
typedef unsigned u32x4 __attribute__((ext_vector_type(4)));
typedef unsigned u32x2 __attribute__((ext_vector_type(2)));

constexpr int NTOK = 12288, NCTX = 4096, DM = 1024, INW = 2816;
constexpr size_t OUT_NK = 12582912, OUT_NV = 13631488;
constexpr float EPSF = 1e-6f;
constexpr float QSCALE = 0.125f * 1.4426950408889634f;

struct Params {
    const float *x_prompt, *x_sample, *cache_k, *cache_v, *c, *c_ctx, *norm_g, *w_ada, *b_ada, *w_in, *q_g, *k_g, *conv_w, *conv_b,
        *pool_w, *pool_scale, *w_out, *final_g;
    float* out;
    unsigned* bar;
    float* modv;
    float* rope;
    bf16_t* WinT;
    bf16_t* WoutT;
    bf16_t* PoolT;
    bf16_t* kc;
    bf16_t* vc;
    float* h;
    bf16_t* xn;
    bf16_t* proj;
    bf16_t* mix;
    int use_cg;
    int pad;
};

__device__ __forceinline__ unsigned pk_bf16(float lo, float hi) {
    unsigned r;
    asm("v_cvt_pk_bf16_f32 %0, %1, %2" : "=v"(r) : "v"(lo), "v"(hi));
    return r;
}
__device__ __forceinline__ float bf_lo(unsigned u) { return __uint_as_float(u << 16); }
__device__ __forceinline__ float bf_hi(unsigned u) { return __uint_as_float(u & 0xffff0000u); }
__device__ __forceinline__ float silu_f(float z) { return z / (1.0f + __expf(-z)); }
__device__ __forceinline__ float max3_f(float a, float b, float c) { float r; asm("v_max3_f32 %0, %1, %2, %3" : "=v"(r) : "v"(a), "v"(b), "v"(c)); return r; }
__device__ __forceinline__ int otid() { int t = threadIdx.x; asm volatile("" : "+v"(t)); return t; }

#define XB_TMO 128
#define XB_XCNT(j) (256 + 64 * (j))
#define XB_XSUB(j) (1280 + 64 * (j))
#define XB_XGEN(j) (2304 + 64 * (j))
#define XB_TOP 3328
#define XB_TOPGEN 3392
#define XCD_BAR_WORDS 3456
#define XB_SPIN_CAP (1u << 20)

__device__ __forceinline__ unsigned xb_ld(unsigned* p) { return __hip_atomic_load(p, __ATOMIC_RELAXED, __HIP_MEMORY_SCOPE_AGENT); }
__device__ __forceinline__ unsigned xb_add(unsigned* p, unsigned v) { return __hip_atomic_fetch_add(p, v, __ATOMIC_RELAXED, __HIP_MEMORY_SCOPE_AGENT); }
__device__ __forceinline__ unsigned xb_xcc_id() { return (unsigned)__builtin_amdgcn_s_getreg((3 << 11) | 20) & 0xFu; }
#define XB_SPIN(cond, bar)                                                   \
    do {                                                                     \
        unsigned _sp = 0;                                                    \
        while (cond) {                                                       \
            __builtin_amdgcn_s_sleep(1);                                     \
            if ((++_sp & 255u) == 0u) {                                      \
                if (xb_ld(&(bar)[XB_TMO])) break;                            \
                if (_sp > XB_SPIN_CAP) { atomicAdd(&(bar)[XB_TMO], 1u); break; } \
            }                                                                \
        }                                                                    \
    } while (0)

struct XcdBarrier {
    unsigned* bar;
    unsigned x;
    volatile LAS unsigned* st;
};

__device__ __forceinline__ XcdBarrier xcd_barrier_post(unsigned* bar, volatile LAS unsigned* st) {
    XcdBarrier b;
    b.bar = bar;
    b.x = xb_xcc_id();
    b.st = st;
    if (threadIdx.x == 0) (void)xb_add(&bar[XB_XCNT(b.x)], 1u);
    return b;
}
__device__ __forceinline__ void xcd_barrier_complete(unsigned* bar, unsigned x, unsigned& nloc, unsigned& nx) {
    const unsigned G = gridDim.x * gridDim.y * gridDim.z;
    unsigned sum, cnt, mine, sp = 0u;
    for (;;) {
        sum = 0u; cnt = 0u; mine = 0u;
#pragma unroll
        for (unsigned j = 0; j < 16; ++j) {
            const unsigned c = xb_ld(&bar[XB_XCNT(j)]);
            sum += c; cnt += (c > 0u) ? 1u : 0u; mine = (j == x) ? c : mine;
        }
        if (sum == G) break;
        __builtin_amdgcn_s_sleep(1);
        if ((++sp & 255u) == 0u) {
            if (xb_ld(&bar[XB_TMO])) break;
            if (sp > XB_SPIN_CAP) { atomicAdd(&bar[XB_TMO], 1u); break; }
        }
    }
    nloc = mine > 0u ? mine : 1u;
    nx = cnt > 0u ? cnt : 1u;
}
__device__ __forceinline__ void xcd_barrier(const XcdBarrier& b) {
    asm volatile("s_waitcnt vmcnt(0)" ::: "memory");
    __syncthreads();
    if (threadIdx.x == 0) {
        unsigned* bar = b.bar;
        __builtin_amdgcn_s_waitcnt(0);
        unsigned nloc = b.st[0], nx = b.st[1];
        if (nloc == 0u) { xcd_barrier_complete(bar, b.x, nloc, nx); b.st[0] = nloc; b.st[1] = nx; }
        const unsigned old = xb_add(&bar[XB_XSUB(b.x)], 1u);
        const unsigned gen = old / nloc;
        if (old + 1u == (gen + 1u) * nloc) {
            __builtin_amdgcn_fence(__ATOMIC_RELEASE, "agent");
            asm volatile("s_waitcnt vmcnt(0)" ::: "memory");
            const unsigned og = xb_add(&bar[XB_TOP], 1u);
            const unsigned tg = og / nx;
            if (og + 1u == (tg + 1u) * nx) xb_add(&bar[XB_TOPGEN], 1u);
            else XB_SPIN(xb_ld(&bar[XB_TOPGEN]) == tg, bar);
            __builtin_amdgcn_fence(__ATOMIC_ACQUIRE, "agent");
            xb_add(&bar[XB_XGEN(b.x)], 1u);
            asm volatile("s_waitcnt vmcnt(0)" ::: "memory");
        } else {
            XB_SPIN(xb_ld(&bar[XB_XGEN(b.x)]) == gen, bar);
            __builtin_amdgcn_fence(__ATOMIC_ACQUIRE, "agent");
            asm volatile("s_waitcnt vmcnt(0)" ::: "memory");
        }
    }
    __syncthreads();
}

__device__ __forceinline__ void prep_mod_item(const Params& p, int item, unsigned char* smem) {
    const int tid = otid();
    float* sc = (float*)smem;
    float* red = (float*)(smem + 20480);
    const int l = item / 96, j0 = (item % 96) * 32;
    for (int idx = tid; idx < 5120; idx += 256) {
        const int v = idx >> 10, k = idx & 1023;
        const float cv = (v == 0) ? p.c_ctx[k] : p.c[(v - 1) * 1024 + k];
        sc[idx] = cv / (1.0f + expf(-cv));
    }
    __syncthreads();
    const int cgp = tid & 7, kg = tid >> 3;
    float acc[5][4];
#pragma unroll
    for (int v = 0; v < 5; ++v)
#pragma unroll
        for (int e = 0; e < 4; ++e) acc[v][e] = 0.f;
    const float* wp = p.w_ada + (size_t)l * 1024 * 3072 + j0 + cgp * 4;
    f32x4 wreg[32];
#pragma unroll
    for (int kk = 0; kk < 32; ++kk) wreg[kk] = *(const f32x4*)(wp + (size_t)(kk * 32 + kg) * 3072);
#pragma unroll
    for (int kk = 0; kk < 32; ++kk) {
        const int k = kk * 32 + kg;
        const f32x4 w = wreg[kk];
#pragma unroll
        for (int v = 0; v < 5; ++v) {
            const float s = sc[v * 1024 + k];
#pragma unroll
            for (int e = 0; e < 4; ++e) acc[v][e] += s * w[e];
        }
    }
#pragma unroll
    for (int v = 0; v < 5; ++v)
#pragma unroll
        for (int e = 0; e < 4; ++e) red[kg * 160 + v * 32 + cgp * 4 + e] = acc[v][e];
    __syncthreads();
    if (tid < 160) {
        float s = 0.f;
        for (int g = 0; g < 32; ++g) s += red[g * 160 + tid];
        const int v = tid >> 5, cc = tid & 31;
        p.modv[(size_t)(l * 5 + v) * 3072 + j0 + cc] = s + p.b_ada[l * 3072 + j0 + cc];
    }
    __syncthreads();
}

__device__ __forceinline__ void prep_transpose_item(const float* src, bf16_t* dst, int N, int k0, int n0) {
    const int n = n0 + otid();
    const float* sp = src + (size_t)k0 * N + n;
    float v[64];
#pragma unroll
    for (int i = 0; i < 64; ++i) v[i] = sp[(size_t)i * N];
    bf16_t* d = dst + (size_t)n * 1024 + k0;
#pragma unroll
    for (int c = 0; c < 8; ++c) {
        u32x4 w;
        w.x = pk_bf16(v[c * 8 + 0], v[c * 8 + 1]);
        w.y = pk_bf16(v[c * 8 + 2], v[c * 8 + 3]);
        w.z = pk_bf16(v[c * 8 + 4], v[c * 8 + 5]);
        w.w = pk_bf16(v[c * 8 + 6], v[c * 8 + 7]);
        *(u32x4*)(d + c * 8) = w;
    }
}

__device__ __forceinline__ void phase_prep(const Params& p, unsigned char* smem) {
    for (int it = (int)gridDim.x - 1 - (int)blockIdx.x; it < 192; it += gridDim.x) prep_mod_item(p, it, smem);
    const int NTI = 2 * 11 * 16, NTO = 2 * 4 * 16;
    for (int it = blockIdx.x; it < NTI + NTO; it += gridDim.x) {
        if (it < NTI) {
            const int l = it / 176, r = it % 176, kt = r / 11, nt = r % 11;
            prep_transpose_item(p.w_in + (size_t)l * 1024 * INW, p.WinT + (size_t)l * INW * 1024, INW, kt * 64, nt * 256);
        } else {
            const int t = it - NTI, l = t / 64, r = t % 64, kt = r / 4, nt = r % 4;
            prep_transpose_item(p.w_out + (size_t)l * 1024 * 1024, p.WoutT + (size_t)l * 1024 * 1024, 1024, kt * 64, nt * 256);
        }
    }
    const int gsz = gridDim.x * 256;
    for (int i = blockIdx.x * 256 + otid(); i < 131072; i += gsz) {
        const int which = i >> 16, j4 = (i & 65535) * 4;
        const int d = j4 & 63, t = (j4 >> 6) & 255, kvh = (j4 >> 14) & 1, bl = j4 >> 15;
        const size_t si = ((size_t)(bl * 256 + t) * 2 + kvh) * 64 + d;
        const f32x4 v = *(const f32x4*)((which ? p.cache_v : p.cache_k) + si);
        u32x2 w;
        w.x = pk_bf16(v[0], v[1]);
        w.y = pk_bf16(v[2], v[3]);
        *(u32x2*)((which ? p.vc : p.kc) + j4) = w;
    }
    for (int j = blockIdx.x * 256 + otid(); j < 32768; j += gsz) {
        const int cc = j & 63, d = (j >> 6) & 63, lg = j >> 12;
        const float v = p.pool_w[((size_t)lg * 64 + cc) * 64 + d];
        p.PoolT[j] = (bf16_t)(pk_bf16(v, 0.f) & 0xffffu);
    }
    for (int j = blockIdx.x * 256 + otid(); j < 1024; j += gsz) {
        const int a = j & 15, r = j >> 4;
        const float inv = 1.0f / powf(10000.0f, (float)(2 * a) / 32.0f);
        const float ang = (float)r * inv;
        const float kf = rintf(ang * 0.15915494309189535f);
        float rr = fmaf(-kf, 6.2831854820251465f, ang);
        rr = fmaf(-kf, -1.7484555e-7f, rr);
        p.rope[j] = cosf(rr);
        p.rope[1024 + j] = sinf(rr);
    }
}

__device__ __forceinline__ float wave_sum(float v) {
#pragma unroll
    for (int o = 32; o >= 1; o >>= 1) v += __shfl_xor(v, o);
    return v;
}

__device__ __forceinline__ void phase_xn(const Params& p, int layer) {
    const int tid = otid(), lane = tid & 63, wave = tid >> 6;
    const int nw = gridDim.x * 4, w = blockIdx.x * 4 + wave;
    for (int t0 = w * 6; t0 < NTOK; t0 += nw * 6) {
        f32x4 x[6][4];
#pragma unroll
        for (int u = 0; u < 6; ++u) {
            const int tok = t0 + u;
            const float* src = layer == 0 ? (tok < NCTX ? p.x_prompt + (size_t)tok * DM : p.x_sample + (size_t)(tok - NCTX) * DM) : p.h + (size_t)tok * DM;
#pragma unroll
            for (int i = 0; i < 4; ++i) x[u][i] = *(const f32x4*)(src + i * 256 + lane * 4);
        }
#pragma unroll
        for (int u = 0; u < 6; ++u) {
            const int tok = t0 + u;
            const int v = tok < NCTX ? 0 : 1 + ((tok - NCTX) >> 11);
            const float* mv = p.modv + (size_t)(layer * 5 + v) * 3072;
            float ss = 0.f;
#pragma unroll
            for (int i = 0; i < 4; ++i) ss += x[u][i][0] * x[u][i][0] + x[u][i][1] * x[u][i][1] + x[u][i][2] * x[u][i][2] + x[u][i][3] * x[u][i][3];
            ss = wave_sum(ss);
            const float rstd = rsqrtf(ss * (1.0f / 1024.0f) + EPSF);
#pragma unroll
            for (int i = 0; i < 4; ++i) {
                const int k = i * 256 + lane * 4;
                const f32x4 g = *(const f32x4*)(p.norm_g + layer * 1024 + k);
                const f32x4 sh = *(const f32x4*)(mv + k);
                const f32x4 sc = *(const f32x4*)(mv + 1024 + k);
                float o[4];
#pragma unroll
                for (int e = 0; e < 4; ++e) o[e] = x[u][i][e] * rstd * g[e] * (1.0f + sc[e]) + sh[e];
                u32x2 wv;
                wv.x = pk_bf16(o[0], o[1]);
                wv.y = pk_bf16(o[2], o[3]);
                *(u32x2*)(p.xn + (size_t)tok * DM + k) = wv;
            }
        }
    }
}

__device__ __forceinline__ void phase_final(const Params& p) {
    const int tid = otid(), lane = tid & 63, wave = tid >> 6;
    const int nw = gridDim.x * 4, w = blockIdx.x * 4 + wave;
    f32x4 g[4];
#pragma unroll
    for (int i = 0; i < 4; ++i) g[i] = *(const f32x4*)(p.final_g + i * 256 + lane * 4);
    for (int t0 = w * 6; t0 < NTOK; t0 += nw * 6) {
        f32x4 x[6][4];
#pragma unroll
        for (int u = 0; u < 6; ++u)
#pragma unroll
            for (int i = 0; i < 4; ++i) x[u][i] = *(const f32x4*)(p.out + (size_t)(t0 + u) * DM + i * 256 + lane * 4);
#pragma unroll
        for (int u = 0; u < 6; ++u) {
            float* row = p.out + (size_t)(t0 + u) * DM;
            float ss = 0.f;
#pragma unroll
            for (int i = 0; i < 4; ++i) ss += x[u][i][0] * x[u][i][0] + x[u][i][1] * x[u][i][1] + x[u][i][2] * x[u][i][2] + x[u][i][3] * x[u][i][3];
            ss = wave_sum(ss);
            const float rstd = rsqrtf(ss * (1.0f / 1024.0f) + EPSF);
#pragma unroll
            for (int i = 0; i < 4; ++i) *(f32x4*)(row + i * 256 + lane * 4) = x[u][i] * rstd * g[i];
        }
    }
}

template <int MODE, int MI, int STG = 0>
__device__ __forceinline__ void gemm_epilogue(const Params& p, int layer, int mw, int nw, f32x4 (&acc)[MI][4], int fr, int fq,
                                              unsigned char* ct = nullptr, int m0t = 0, int n0t = 0) {
    if (MODE == 0) {
        const bool ctx = mw < NCTX;
        if (nw < 640) {
            const bool isq = nw < 512;
            const float* gp = (isq ? p.q_g : p.k_g) + layer * 64;
            f32x4 gv[4];
#pragma unroll
            for (int ni = 0; ni < 4; ++ni) gv[ni] = *(const f32x4*)(gp + ni * 16 + fq * 4);
#pragma unroll
            for (int mi = 0; mi < MI; ++mi) {
                const int tok = mw + mi * 16 + fr;
                float ss = 0.f;
#pragma unroll
                for (int ni = 0; ni < 4; ++ni)
#pragma unroll
                    for (int e = 0; e < 4; ++e) ss += acc[mi][ni][e] * acc[mi][ni][e];
                ss += __shfl_xor(ss, 16);
                ss += __shfl_xor(ss, 32);
                const float rstd = rsqrtf(ss * (1.0f / 64.0f) + EPSF);
                f32x4 val[4];
#pragma unroll
                for (int ni = 0; ni < 4; ++ni) val[ni] = acc[mi][ni] * rstd * gv[ni];
                if (!isq && ctx) {
                    float* nk = p.out + OUT_NK + ((size_t)((tok >> 8) * 2 + layer) * 256 + (tok & 255)) * 128 + (nw - 512) + fq * 4;
#pragma unroll
                    for (int ni = 0; ni < 4; ++ni) *(f32x4*)(nk + ni * 16) = val[ni];
                }
                if (!ctx) {
                    const int pos = (tok - NCTX) & 2047, prow = pos >> 6, pcol = pos & 63;
                    const f32x4 cr = *(const f32x4*)(p.rope + prow * 16 + fq * 4), sr = *(const f32x4*)(p.rope + 1024 + prow * 16 + fq * 4);
                    const f32x4 cc = *(const f32x4*)(p.rope + pcol * 16 + fq * 4), sn = *(const f32x4*)(p.rope + 1024 + pcol * 16 + fq * 4);
                    const f32x4 a0 = val[0], a1 = val[1], a2 = val[2], a3 = val[3];
                    val[0] = a0 * cr - a1 * sr;
                    val[1] = a1 * cr + a0 * sr;
                    val[2] = a2 * cc - a3 * sn;
                    val[3] = a3 * cc + a2 * sn;
                }
                if (isq) {
#pragma unroll
                    for (int ni = 0; ni < 4; ++ni) val[ni] = val[ni] * QSCALE;
                }
                bf16_t* pr = p.proj + (size_t)tok * INW + nw + fq * 4;
#pragma unroll
                for (int ni = 0; ni < 4; ++ni) {
                    u32x2 w;
                    w.x = pk_bf16(val[ni][0], val[ni][1]);
                    w.y = pk_bf16(val[ni][2], val[ni][3]);
                    if (STG) *(u32x2*)(ct + (tok - m0t) * 272 + (nw - n0t + fq * 4 + ni * 16) * 2) = w;
                    else *(u32x2*)(pr + ni * 16) = w;
                }
            }
        } else {
            const bool isv = nw < 768;
#pragma unroll
            for (int mi = 0; mi < MI; ++mi) {
                const int tok = mw + mi * 16 + fr;
                bf16_t* pr = p.proj + (size_t)tok * INW + nw + fq * 4;
#pragma unroll
                for (int ni = 0; ni < 4; ++ni) {
                    u32x2 w;
                    w.x = pk_bf16(acc[mi][ni][0], acc[mi][ni][1]);
                    w.y = pk_bf16(acc[mi][ni][2], acc[mi][ni][3]);
                    if (STG) *(u32x2*)(ct + (tok - m0t) * 272 + (nw - n0t + fq * 4 + ni * 16) * 2) = w;
                    else *(u32x2*)(pr + ni * 16) = w;
                }
                if (isv && ctx) {
                    float* nv = p.out + OUT_NV + ((size_t)((tok >> 8) * 2 + layer) * 256 + (tok & 255)) * 128 + (nw - 640) + fq * 4;
#pragma unroll
                    for (int ni = 0; ni < 4; ++ni) *(f32x4*)(nv + ni * 16) = acc[mi][ni];
                }
            }
        }
    } else {
        const int v = mw < NCTX ? 0 : 1 + ((mw - NCTX) >> 11);
        const float* gate = p.modv + (size_t)(layer * 5 + v) * 3072 + 2048 + nw + fq * 4;
        f32x4 gt[4];
#pragma unroll
        for (int ni = 0; ni < 4; ++ni) gt[ni] = *(const f32x4*)(gate + ni * 16);
#pragma unroll
        for (int mi = 0; mi < MI; ++mi) {
            const int tok = mw + mi * 16 + fr;
            const float* ho = (layer == 0 ? (tok < NCTX ? p.x_prompt + (size_t)tok * DM : p.x_sample + (size_t)(tok - NCTX) * DM) : p.h + (size_t)tok * DM) + nw + fq * 4;
            float* hn = (layer == 0 ? p.h : p.out) + (size_t)tok * DM + nw + fq * 4;
#pragma unroll
            for (int ni = 0; ni < 4; ++ni) {
                const f32x4 o = *(const f32x4*)(ho + ni * 16);
                *(f32x4*)(hn + ni * 16) = o + gt[ni] * acc[mi][ni];
            }
        }
    }
}

template <int MODE>
__device__ __forceinline__ void gemm_tile(const Params& p, int layer, int mt, int nt, unsigned char* smem) {
    const int tid = otid(), lane = tid & 63, wave = tid >> 6, wm = wave >> 1, wn = wave & 1;
    const int fr = lane & 15, fq = lane >> 4;
    const int m0 = mt * 128, n0 = nt * 128;
    const bf16_t* A = (MODE == 0 ? p.xn : p.mix) + (size_t)m0 * 1024;
    const bf16_t* B = (MODE == 0 ? p.WinT + (size_t)layer * INW * 1024 : p.WoutT + (size_t)layer * 1024 * 1024) + (size_t)n0 * 1024;
    f32x4 acc[4][4];
#pragma unroll
    for (int i = 0; i < 4; ++i)
#pragma unroll
        for (int j = 0; j < 4; ++j) acc[i][j] = (f32x4){0.f, 0.f, 0.f, 0.f};

    const int srow = tid >> 3, scc = tid & 7;
    const bf16_t* ag = A + (size_t)srow * 1024 + scc * 8;
    const bf16_t* bg = B + (size_t)srow * 1024 + scc * 8;
    const int wofs = srow * 128 + ((scc ^ (srow & 7)) * 16);
    u32x4 raA[4], rbA[4], raB[4], rbB[4];
    auto gload = [&](int kt, u32x4* ra, u32x4* rb) {
#pragma unroll
        for (int i = 0; i < 4; ++i) {
            ra[i] = *(const u32x4*)(ag + (size_t)i * 32 * 1024 + kt * 64);
            rb[i] = *(const u32x4*)(bg + (size_t)i * 32 * 1024 + kt * 64);
        }
    };
    auto swrite = [&](int buf, const u32x4* ra, const u32x4* rb) {
        unsigned char* Aw = smem + buf * 32768;
#pragma unroll
        for (int i = 0; i < 4; ++i) {
            *(u32x4*)(Aw + wofs + i * 4096) = ra[i];
            *(u32x4*)(Aw + 16384 + wofs + i * 4096) = rb[i];
        }
    };
    gload(0, raA, rbA);
    gload(1, raB, rbB);
    swrite(0, raA, rbA);
    __syncthreads();
    const int aro = (wm * 64 + fr) * 128, bro = (wn * 64 + fr) * 128, sw = fr & 7;
    auto step = [&](int kt, u32x4* la, u32x4* lb, const u32x4* wa, const u32x4* wb) {
        const unsigned char* As = smem + (kt & 1) * 32768;
        const unsigned char* Bs = As + 16384;
        bf16x8 af[2][4], bf[2][4];
#pragma unroll
        for (int kk = 0; kk < 2; ++kk) {
            const int co = ((kk * 4 + fq) ^ sw) * 16;
#pragma unroll
            for (int i = 0; i < 4; ++i) {
                af[kk][i] = *(const bf16x8*)(As + aro + i * 2048 + co);
                bf[kk][i] = *(const bf16x8*)(Bs + bro + i * 2048 + co);
            }
        }
        if (kt + 2 < 16) gload(kt + 2, la, lb);
        __builtin_amdgcn_sched_barrier(0);
#pragma unroll
        for (int mi = 0; mi < 4; ++mi)
#pragma unroll
            for (int ni = 0; ni < 4; ++ni) acc[mi][ni] = __builtin_amdgcn_mfma_f32_16x16x32_bf16(bf[0][ni], af[0][mi], acc[mi][ni], 0, 0, 0);
        __builtin_amdgcn_sched_barrier(0);
        if (kt + 1 < 16) swrite((kt + 1) & 1, wa, wb);
        __builtin_amdgcn_sched_barrier(0);
#pragma unroll
        for (int mi = 0; mi < 4; ++mi)
#pragma unroll
            for (int ni = 0; ni < 4; ++ni) acc[mi][ni] = __builtin_amdgcn_mfma_f32_16x16x32_bf16(bf[1][ni], af[1][mi], acc[mi][ni], 0, 0, 0);
        __syncthreads();
    };
    for (int kt = 0; kt < 16; kt += 2) {
        step(kt, raA, rbA, raB, rbB);
        step(kt + 1, raB, rbB, raA, rbA);
    }

    gemm_epilogue<MODE, 4>(p, layer, m0 + wm * 64, n0 + wn * 64, acc, fr, fq);
}

template <int MODE>
__device__ __forceinline__ void gemm_tile256(const Params& p, int layer, int mt, int nt, unsigned char* smem) {
    const int tid = otid(), lane = tid & 63, wave = tid >> 6, wm = wave >> 1, wn = wave & 1;
    const int fr = lane & 15, fq = lane >> 4;
    const int m0 = mt * 256, n0 = nt * 128;
    const bf16_t* A = (MODE == 0 ? p.xn : p.mix) + (size_t)m0 * 1024;
    const bf16_t* B = (MODE == 0 ? p.WinT + (size_t)layer * INW * 1024 : p.WoutT + (size_t)layer * 1024 * 1024) + (size_t)n0 * 1024;
    f32x4 acc[8][4];
#pragma unroll
    for (int i = 0; i < 8; ++i)
#pragma unroll
        for (int j = 0; j < 4; ++j) acc[i][j] = (f32x4){0.f, 0.f, 0.f, 0.f};
    const int srow = tid >> 2, scc = tid & 3;
    const bf16_t* ag = A + (size_t)srow * 1024 + scc * 8;
    const bf16_t* bg = B + (size_t)srow * 1024 + scc * 8;
    const int wofs = srow * 64 + ((scc ^ ((4 - ((srow >> 2) & 3)) & 3)) * 16);
    u32x4 raA[4], rbA[2], raB[4], rbB[2];
    auto gload = [&](int kt, u32x4* ra, u32x4* rb) {
#pragma unroll
        for (int i = 0; i < 4; ++i) ra[i] = *(const u32x4*)(ag + (size_t)i * 64 * 1024 + kt * 32);
#pragma unroll
        for (int i = 0; i < 2; ++i) rb[i] = *(const u32x4*)(bg + (size_t)i * 64 * 1024 + kt * 32);
    };
    auto swrite = [&](int buf, const u32x4* ra, const u32x4* rb) {
        unsigned char* Aw = smem + buf * 24576;
#pragma unroll
        for (int i = 0; i < 4; ++i) *(u32x4*)(Aw + wofs + i * 4096) = ra[i];
#pragma unroll
        for (int i = 0; i < 2; ++i) *(u32x4*)(Aw + 16384 + wofs + i * 4096) = rb[i];
    };
    gload(0, raA, rbA);
    gload(1, raB, rbB);
    swrite(0, raA, rbA);
    __syncthreads();
    const int co = (fq ^ ((4 - ((fr >> 2) & 3)) & 3)) * 16;
    const int aro = (wm * 128 + fr) * 64 + co, bro = (wn * 64 + fr) * 64 + co;
    auto step = [&](int kt, u32x4* la, u32x4* lb, const u32x4* wa, const u32x4* wb) {
        const unsigned char* As = smem + (kt & 1) * 24576;
        const unsigned char* Bs = As + 16384;
        bf16x8 af[8], bf[4];
#pragma unroll
        for (int i = 0; i < 4; ++i) bf[i] = *(const bf16x8*)(Bs + bro + i * 1024);
#pragma unroll
        for (int i = 0; i < 8; ++i) af[i] = *(const bf16x8*)(As + aro + i * 1024);
        if (kt + 2 < 32) gload(kt + 2, la, lb);
        __builtin_amdgcn_sched_barrier(0);
#pragma unroll
        for (int mi = 0; mi < 4; ++mi)
#pragma unroll
            for (int ni = 0; ni < 4; ++ni) acc[mi][ni] = __builtin_amdgcn_mfma_f32_16x16x32_bf16(bf[ni], af[mi], acc[mi][ni], 0, 0, 0);
        __builtin_amdgcn_sched_barrier(0);
        if (kt + 1 < 32) swrite((kt + 1) & 1, wa, wb);
        __builtin_amdgcn_sched_barrier(0);
#pragma unroll
        for (int mi = 4; mi < 8; ++mi)
#pragma unroll
            for (int ni = 0; ni < 4; ++ni) acc[mi][ni] = __builtin_amdgcn_mfma_f32_16x16x32_bf16(bf[ni], af[mi], acc[mi][ni], 0, 0, 0);
        __syncthreads();
    };
    for (int kt = 0; kt < 32; kt += 2) {
        step(kt, raA, rbA, raB, rbB);
        step(kt + 1, raB, rbB, raA, rbA);
    }
    gemm_epilogue<MODE, 8>(p, layer, m0 + wm * 128, n0 + wn * 64, acc, fr, fq);
}

template <int MODE>
__device__ __forceinline__ void gemm_tile256_dma(const Params& p, int layer, int mt, int nt, unsigned char* smem) {
    const int tid = otid(), lane = tid & 63, wave = tid >> 6, wm = wave >> 1, wn = wave & 1;
    const int fr = lane & 15, fq = lane >> 4;
    const int m0 = mt * 256, n0 = nt * 128;
    const bf16_t* A = (MODE == 0 ? p.xn : p.mix) + (size_t)m0 * 1024;
    const bf16_t* B = (MODE == 0 ? p.WinT + (size_t)layer * INW * 1024 : p.WoutT + (size_t)layer * 1024 * 1024) + (size_t)n0 * 1024;
    f32x4 acc[8][4];
#pragma unroll
    for (int i = 0; i < 8; ++i)
#pragma unroll
        for (int j = 0; j < 4; ++j) acc[i][j] = (f32x4){0.f, 0.f, 0.f, 0.f};
    const int lrow = lane >> 2, lc = (lane & 3) ^ ((4 - ((lane >> 4) & 3)) & 3);
    const bf16_t* agp = A + (size_t)(wave * 64 + lrow) * 1024 + lc * 8;
    const bf16_t* bgp = B + (size_t)(wave * 32 + lrow) * 1024 + lc * 8;
    LAS unsigned char* lbase = (LAS unsigned char*)smem;
    const int la_off = wave * 4096 + lane * 16, lb_off = 16384 + wave * 2048 + lane * 16;
    auto dma = [&](int kt, int stage) {
        LAS unsigned char* sb = lbase + stage * 24576;
#pragma unroll
        for (int i = 0; i < 4; ++i)
            __builtin_amdgcn_global_load_lds((const void*)(agp + (size_t)i * 16 * 1024 + kt * 32), (LAS void*)(sb + la_off + i * 1024), 16, 0, 0);
#pragma unroll
        for (int i = 0; i < 2; ++i)
            __builtin_amdgcn_global_load_lds((const void*)(bgp + (size_t)i * 16 * 1024 + kt * 32), (LAS void*)(sb + lb_off + i * 1024), 16, 0, 0);
    };
    dma(0, 0);
    dma(1, 1);
    asm volatile("s_waitcnt vmcnt(6)" ::: "memory");
    __builtin_amdgcn_s_barrier();
    const int co = (fq ^ ((4 - ((fr >> 2) & 3)) & 3)) * 16;
    const int aro = (wm * 128 + fr) * 64 + co, bro = 16384 + (wn * 64 + fr) * 64 + co;
    int st = 0, st2 = 2;
    const unsigned lds0 = (unsigned)(uintptr_t)lbase;
#pragma unroll 1
    for (int kt = 0; kt < 32; ++kt) {
        const unsigned sa = lds0 + st * 24576 + aro, sbb = lds0 + st * 24576 + bro;
        bf16x8 af[8], bf[4];
#define FRAG_RD(dst, addr, OFF) asm volatile("ds_read_b128 %0, %1 offset:" #OFF : "=&v"(dst) : "v"(addr))
        FRAG_RD(bf[0], sbb, 0); FRAG_RD(bf[1], sbb, 1024); FRAG_RD(bf[2], sbb, 2048); FRAG_RD(bf[3], sbb, 3072);
        FRAG_RD(af[0], sa, 0); FRAG_RD(af[1], sa, 1024); FRAG_RD(af[2], sa, 2048); FRAG_RD(af[3], sa, 3072);
        FRAG_RD(af[4], sa, 4096); FRAG_RD(af[5], sa, 5120); FRAG_RD(af[6], sa, 6144); FRAG_RD(af[7], sa, 7168);
#undef FRAG_RD
        __builtin_amdgcn_sched_barrier(0);
        if (kt + 2 < 32) dma(kt + 2, st2);
        __builtin_amdgcn_sched_barrier(0);
        asm volatile("s_waitcnt lgkmcnt(4)" ::: "memory");
        __builtin_amdgcn_sched_barrier(0);
#pragma unroll
        for (int mi = 0; mi < 4; ++mi)
#pragma unroll
            for (int ni = 0; ni < 4; ++ni) acc[mi][ni] = __builtin_amdgcn_mfma_f32_16x16x32_bf16(bf[ni], af[mi], acc[mi][ni], 0, 0, 0);
        __builtin_amdgcn_sched_barrier(0);
        asm volatile("s_waitcnt lgkmcnt(0)" ::: "memory");
        __builtin_amdgcn_sched_barrier(0);
#pragma unroll
        for (int mi = 4; mi < 8; ++mi)
#pragma unroll
            for (int ni = 0; ni < 4; ++ni) acc[mi][ni] = __builtin_amdgcn_mfma_f32_16x16x32_bf16(bf[ni], af[mi], acc[mi][ni], 0, 0, 0);
        __builtin_amdgcn_sched_barrier(0);
        if (kt + 2 < 32) asm volatile("s_waitcnt vmcnt(6)" ::: "memory");
        else asm volatile("s_waitcnt vmcnt(0)" ::: "memory");
        __builtin_amdgcn_s_barrier();
        st = st == 2 ? 0 : st + 1;
        st2 = st2 == 2 ? 0 : st2 + 1;
    }
    if (MODE == 0) {
        gemm_epilogue<0, 8, 1>(p, layer, m0 + wm * 128, n0 + wn * 64, acc, fr, fq, smem, m0, n0);
        __syncthreads();
        u32x4 cv[16];
#pragma unroll
        for (int i = 0; i < 16; ++i) { const int e = tid + 256 * i; cv[i] = *(const u32x4*)(smem + (e >> 4) * 272 + (e & 15) * 16); }
#pragma unroll
        for (int i = 0; i < 16; ++i) { const int e = tid + 256 * i; *(u32x4*)(p.proj + (size_t)(m0 + (e >> 4)) * INW + n0 + (e & 15) * 8) = cv[i]; }
        __syncthreads();
    } else {
#pragma unroll 1
        for (int pass = 0; pass < 2; ++pass) {
            if (wm == pass) {
#pragma unroll
                for (int mi = 0; mi < 8; ++mi)
#pragma unroll
                    for (int ni = 0; ni < 4; ++ni) *(f32x4*)(smem + (mi * 16 + fr) * 528 + (wn * 64 + ni * 16 + fq * 4) * 4) = acc[mi][ni];
            }
            __syncthreads();
            const int rbase = m0 + pass * 128;
            const int c4 = (tid & 31) * 4;
            f32x4 ho[16];
#pragma unroll
            for (int i = 0; i < 16; ++i) {
                const int tok = rbase + (tid >> 5) + 8 * i;
                const float* hp = (layer == 0 ? (tok < NCTX ? p.x_prompt + (size_t)tok * DM : p.x_sample + (size_t)(tok - NCTX) * DM) : p.h + (size_t)tok * DM) + n0 + c4;
                ho[i] = *(const f32x4*)hp;
            }
            const int v = rbase < NCTX ? 0 : 1 + ((rbase - NCTX) >> 11);
            const f32x4 gt = *(const f32x4*)(p.modv + (size_t)(layer * 5 + v) * 3072 + 2048 + n0 + c4);
#pragma unroll
            for (int i = 0; i < 16; ++i) {
                const int row = (tid >> 5) + 8 * i, tok = rbase + row;
                const f32x4 a = *(const f32x4*)(smem + row * 528 + c4 * 4);
                *(f32x4*)((layer == 0 ? p.h : p.out) + (size_t)tok * DM + n0 + c4) = ho[i] + gt * a;
            }
            __syncthreads();
        }
    }
}

__device__ __forceinline__ void gemm_piece64_dma(const Params& p, int layer, int m0, int n0, unsigned char* smem) {
    const int tid = otid(), lane = tid & 63, wave = tid >> 6, wm = wave >> 1, wn = wave & 1;
    const int fr = lane & 15, fq = lane >> 4;
    const bf16_t* A = p.xn + (size_t)m0 * 1024;
    const bf16_t* B = p.WinT + (size_t)layer * INW * 1024 + (size_t)n0 * 1024;
    f32x4 acc[2][4];
#pragma unroll
    for (int i = 0; i < 2; ++i)
#pragma unroll
        for (int j = 0; j < 4; ++j) acc[i][j] = (f32x4){0.f, 0.f, 0.f, 0.f};
    const int lrow = lane >> 2, lc = (lane & 3) ^ ((4 - ((lane >> 4) & 3)) & 3);
    const bf16_t* agp = A + (size_t)(wave * 16 + lrow) * 1024 + lc * 8;
    const bf16_t* bgp = B + (size_t)(wave * 32 + lrow) * 1024 + lc * 8;
    LAS unsigned char* lbase = (LAS unsigned char*)smem;
    const int la_off = wave * 1024 + lane * 16, lb_off = 4096 + wave * 2048 + lane * 16;
    auto dma = [&](int kt, int stage) {
        LAS unsigned char* sb = lbase + stage * 12288;
        __builtin_amdgcn_global_load_lds((const void*)(agp + kt * 32), (LAS void*)(sb + la_off), 16, 0, 0);
#pragma unroll
        for (int i = 0; i < 2; ++i)
            __builtin_amdgcn_global_load_lds((const void*)(bgp + (size_t)i * 16 * 1024 + kt * 32), (LAS void*)(sb + lb_off + i * 1024), 16, 0, 0);
    };
    dma(0, 0);
    dma(1, 1);
    asm volatile("s_waitcnt vmcnt(3)" ::: "memory");
    __builtin_amdgcn_s_barrier();
    const int co = (fq ^ ((4 - ((fr >> 2) & 3)) & 3)) * 16;
    const int aro = (wm * 32 + fr) * 64 + co, bro = 4096 + (wn * 64 + fr) * 64 + co;
    int st = 0, st2 = 2;
    const unsigned lds0 = (unsigned)(uintptr_t)lbase;
#pragma unroll 1
    for (int kt = 0; kt < 32; ++kt) {
        const unsigned sa = lds0 + st * 12288 + aro, sbb = lds0 + st * 12288 + bro;
        bf16x8 af[2], bf[4];
#define FRAG_RD(dst, addr, OFF) asm volatile("ds_read_b128 %0, %1 offset:" #OFF : "=&v"(dst) : "v"(addr))
        FRAG_RD(bf[0], sbb, 0); FRAG_RD(bf[1], sbb, 1024); FRAG_RD(bf[2], sbb, 2048); FRAG_RD(bf[3], sbb, 3072);
        FRAG_RD(af[0], sa, 0); FRAG_RD(af[1], sa, 1024);
#undef FRAG_RD
        __builtin_amdgcn_sched_barrier(0);
        if (kt + 2 < 32) dma(kt + 2, st2);
        __builtin_amdgcn_sched_barrier(0);
        asm volatile("s_waitcnt lgkmcnt(0)" ::: "memory");
        __builtin_amdgcn_sched_barrier(0);
#pragma unroll
        for (int mi = 0; mi < 2; ++mi)
#pragma unroll
            for (int ni = 0; ni < 4; ++ni) acc[mi][ni] = __builtin_amdgcn_mfma_f32_16x16x32_bf16(bf[ni], af[mi], acc[mi][ni], 0, 0, 0);
        __builtin_amdgcn_sched_barrier(0);
        if (kt + 2 < 32) asm volatile("s_waitcnt vmcnt(3)" ::: "memory");
        else asm volatile("s_waitcnt vmcnt(0)" ::: "memory");
        __builtin_amdgcn_s_barrier();
        st = st == 2 ? 0 : st + 1;
        st2 = st2 == 2 ? 0 : st2 + 1;
    }
    gemm_epilogue<0, 2, 1>(p, layer, m0 + wm * 32, n0 + wn * 64, acc, fr, fq, smem, m0, n0);
    __syncthreads();
    u32x4 cv[4];
#pragma unroll
    for (int i = 0; i < 4; ++i) { const int e = tid + 256 * i; cv[i] = *(const u32x4*)(smem + (e >> 4) * 272 + (e & 15) * 16); }
#pragma unroll
    for (int i = 0; i < 4; ++i) { const int e = tid + 256 * i; *(u32x4*)(p.proj + (size_t)(m0 + (e >> 4)) * INW + n0 + (e & 15) * 8) = cv[i]; }
    __syncthreads();
}

template <int MODE>
__device__ __forceinline__ void phase_gemm(const Params& p, int layer, unsigned char* smem) {
    const int NT = MODE == 0 ? 22 : 8;
    const int total = 96 * NT;
    if (gridDim.x == 512) {
        const int xcd = blockIdx.x & 7, slot = blockIdx.x >> 3;
        if (MODE == 0) {
            for (int idx = slot; idx < 128; idx += 64) gemm_tile256_dma<MODE>(p, layer, xcd * 6 + idx % 6, idx / 6, smem);
            if (slot < 16) gemm_piece64_dma(p, layer, (xcd * 6 + 2 + (slot >> 2)) * 256 + (slot & 3) * 64, 21 * 128, smem);
        } else {
            if (slot < 32) gemm_tile256_dma<MODE>(p, layer, xcd * 6 + slot % 6, slot / 6, smem);
            else {
                const int d = 32 + ((slot - 32) >> 1);
                gemm_tile<MODE>(p, layer, (xcd * 6 + d % 6) * 2 + (slot & 1), d / 6, smem);
            }
        }
    } else {
        for (int t = blockIdx.x; t < total; t += gridDim.x) gemm_tile<MODE>(p, layer, t / NT, t % NT, smem);
    }
}

template <int VAR>
__device__ __forceinline__ void attn_unit(const Params& p, int layer, int unit, unsigned char* smem) {
    const int tid = otid(), lane = tid & 63, wave = tid >> 6;
    const int r31 = lane & 31, hh = lane >> 5;
    int b, head, qblk, tokbase, nself, ntiles;
    if (unit < 512) { b = unit >> 7; head = (unit >> 4) & 7; qblk = unit & 15; tokbase = NCTX + b * 2048; nself = 2048; ntiles = 36; }
    else { const int u = unit - 512; b = u >> 4; head = (u >> 1) & 7; qblk = u & 1; tokbase = b * 256; nself = 256; ntiles = 4; }
    const int kvh = head >> 2;
    const int qtok = tokbase + qblk * 128 + wave * 32 + r31;
    bf16x8 qf[4];
    {
        const bf16_t* qp = p.proj + (size_t)qtok * INW + head * 64 + hh * 8;
#pragma unroll
        for (int ks = 0; ks < 4; ++ks) qf[ks] = *(const bf16x8*)(qp + ks * 16);
    }
    const bf16_t* kself = p.proj + (size_t)tokbase * INW + 512 + kvh * 64;
    const bf16_t* vself = p.proj + (size_t)tokbase * INW + 640 + kvh * 64;
    const bf16_t* kcache = p.kc + (size_t)((b * 2 + layer) * 2 + kvh) * 256 * 64;
    const bf16_t* vcache = p.vc + (size_t)((b * 2 + layer) * 2 + kvh) * 256 * 64;
    const int srow = tid >> 3, scc = tid & 7;
    const int kwo = srow * 128 + ((scc ^ ((srow >> 1) & 7)) * 16);
    const int vwo = srow * 128 + ((scc ^ (((srow >> 1) & 1) << 2)) * 16);
    u32x4 rkA[2], rvA[2], rkB[2], rvB[2];
    auto gload = [&](int j, u32x4* rk, u32x4* rv) {
        const int key0 = j * 64;
#pragma unroll
        for (int i = 0; i < 2; ++i) {
            const int row = srow + 32 * i;
            if (key0 < nself) {
                rk[i] = *(const u32x4*)(kself + (size_t)(key0 + row) * INW + scc * 8);
                rv[i] = *(const u32x4*)(vself + (size_t)(key0 + row) * INW + scc * 8);
            } else {
                rk[i] = *(const u32x4*)(kcache + (size_t)(key0 - nself + row) * 64 + scc * 8);
                rv[i] = *(const u32x4*)(vcache + (size_t)(key0 - nself + row) * 64 + scc * 8);
            }
        }
    };
    auto swrite = [&](int buf, const u32x4* rk, const u32x4* rv) {
        unsigned char* kb = smem + buf * 16384;
        unsigned char* vb = kb + 8192;
#pragma unroll
        for (int i = 0; i < 2; ++i) {
            *(u32x4*)(kb + kwo + i * 32 * 128) = rk[i];
            *(u32x4*)(vb + vwo + i * 32 * 128) = rv[i];
        }
    };
    f32x16 o[2];
#pragma unroll
    for (int i = 0; i < 16; ++i) { o[0][i] = 0.f; o[1][i] = 0.f; }
    float mrun = 0.f, mmax = -1e30f, lrun = 0.f;
    f32x16 negm, zero16;
#pragma unroll
    for (int i = 0; i < 16; ++i) { negm[i] = 0.f; zero16[i] = 0.f; }
    bool shifted = false;
    gload(0, rkA, rvA);
    swrite(0, rkA, rvA);
    if (ntiles > 1) gload(1, rkB, rvB);
    __syncthreads();
    const int kro = r31 * 128, ksw = (r31 >> 1) & 7;
    const int vq = 4 * hh + ((lane & 15) >> 2);
    const int vsw = ((vq >> 1) & 1) << 2;
    const int vcl = ((lane >> 4) & 1) * 2 + ((lane & 3) >> 1);
    const int vro0 = vq * 128 + (((0 * 4 + vcl) ^ vsw) * 16) + (lane & 1) * 8;
    const int vro1 = vq * 128 + (((1 * 4 + vcl) ^ vsw) * 16) + (lane & 1) * 8;
    auto step = [&](int j, u32x4* lk, u32x4* lv, const u32x4* wk, const u32x4* wv) {
        const unsigned char* kb = smem + (j & 1) * 16384;
        const unsigned char* vb = kb + 8192;
        bf16x8 kf[2][4];
#pragma unroll
        for (int sb = 0; sb < 2; ++sb)
#pragma unroll
            for (int ks = 0; ks < 4; ++ks) kf[sb][ks] = *(const bf16x8*)(kb + sb * 4096 + kro + (((ks * 2 + hh) ^ ksw) * 16));
        if (VAR != 1 && j + 2 < ntiles) gload(j + 2, lk, lv);
        __builtin_amdgcn_sched_barrier(0);
        f32x16 s[2];
#pragma unroll
        for (int ks = 0; ks < 4; ++ks)
#pragma unroll
            for (int sb = 0; sb < 2; ++sb) {
                if (ks == 0) {
                    if (shifted) s[sb] = __builtin_amdgcn_mfma_f32_32x32x16_bf16(kf[sb][ks], qf[ks], negm, 0, 0, 0);
                    else s[sb] = __builtin_amdgcn_mfma_f32_32x32x16_bf16(kf[sb][ks], qf[ks], zero16, 0, 0, 0);
                } else s[sb] = __builtin_amdgcn_mfma_f32_32x32x16_bf16(kf[sb][ks], qf[ks], s[sb], 0, 0, 0);
            }
        __builtin_amdgcn_sched_barrier(0);
        bf16x8 vf[2][2][2];
#pragma unroll
        for (int sb = 0; sb < 2; ++sb)
#pragma unroll
            for (int s2 = 0; s2 < 2; ++s2)
#pragma unroll
                for (int dt = 0; dt < 2; ++dt) {
                    const LAS unsigned char* va = (const LAS unsigned char*)(vb) + (sb * 32 + s2 * 16) * 128 + (dt ? vro1 : vro0);
                    const s16x4 a0 = __builtin_amdgcn_ds_read_tr16_b64_v4i16((LAS s16x4*)(va));
                    const s16x4 a1 = __builtin_amdgcn_ds_read_tr16_b64_v4i16((LAS s16x4*)(va + 8 * 128));
                    vf[sb][s2][dt] = (bf16x8){a0[0], a0[1], a0[2], a0[3], a1[0], a1[1], a1[2], a1[3]};
                }
        __builtin_amdgcn_sched_barrier(0);
        float mloc = max3_f(s[0][0], s[1][0], s[0][1]);
        mloc = max3_f(mloc, s[1][1], s[0][2]);
#pragma unroll
        for (int i = 2; i < 16; ++i) mloc = max3_f(mloc, s[1][i], s[0][(i + 1) & 15]);
        float lsum = 0.f;
#pragma unroll
        for (int sb = 0; sb < 2; ++sb)
#pragma unroll
            for (int i = 0; i < 16; ++i) { if (VAR != 2) { s[sb][i] = __builtin_amdgcn_exp2f(s[sb][i]); lsum += s[sb][i]; } }
        lrun += lsum;
        bf16x8 pf[2][2];
#pragma unroll
        for (int sb = 0; sb < 2; ++sb)
#pragma unroll
            for (int s2 = 0; s2 < 2; ++s2) {
                u32x4 pw;
                pw.x = pk_bf16(s[sb][s2 * 8 + 0], s[sb][s2 * 8 + 1]);
                pw.y = pk_bf16(s[sb][s2 * 8 + 2], s[sb][s2 * 8 + 3]);
                pw.z = pk_bf16(s[sb][s2 * 8 + 4], s[sb][s2 * 8 + 5]);
                pw.w = pk_bf16(s[sb][s2 * 8 + 6], s[sb][s2 * 8 + 7]);
                pf[sb][s2] = __builtin_bit_cast(bf16x8, pw);
            }
        __builtin_amdgcn_sched_barrier(0);
#pragma unroll
        for (int sb = 0; sb < 2; ++sb)
#pragma unroll
            for (int s2 = 0; s2 < 2; ++s2)
#pragma unroll
                for (int dt = 0; dt < 2; ++dt) o[dt] = __builtin_amdgcn_mfma_f32_32x32x16_bf16(vf[sb][s2][dt], pf[sb][s2], o[dt], 0, 0, 0);
        __builtin_amdgcn_sched_barrier(0);
        mloc = fmaxf(mloc, __shfl_xor(mloc, 32));
        mmax = fmaxf(mmax, mrun + mloc);
        if (__builtin_expect(__any(fabsf(mmax - mrun) > 40.0f), 0)) {
            asm volatile("" ::: "memory");
            const float alpha = __builtin_amdgcn_exp2f(mrun - mmax);
            mrun = mmax;
            lrun *= alpha;
            shifted = true;
#pragma unroll
            for (int i = 0; i < 16; ++i) { o[0][i] *= alpha; o[1][i] *= alpha; negm[i] = -mrun; }
        }
        if (VAR != 1 && j + 1 < ntiles) swrite((j + 1) & 1, wk, wv);
        __syncthreads();
    };
    for (int j = 0; j < ntiles; j += 2) {
        step(j, rkA, rvA, rkB, rvB);
        step(j + 1, rkB, rvB, rkA, rvA);
    }
    const float ltot = lrun + __shfl_xor(lrun, 32);
    const float inv = 1.0f / ltot;
    const bf16_t* zp = p.proj + (size_t)qtok * INW + 768 + head * 64;
    bf16_t* mp = (VAR == 0 ? p.mix : p.xn) + (size_t)qtok * DM + head * 64;
#pragma unroll
    for (int dt = 0; dt < 2; ++dt)
#pragma unroll
        for (int rq = 0; rq < 4; ++rq) {
            const int d0 = dt * 32 + 8 * rq + 4 * hh;
            const u32x2 zz = *(const u32x2*)(zp + d0);
            const float z0 = bf_lo(zz.x), z1 = bf_hi(zz.x), z2 = bf_lo(zz.y), z3 = bf_hi(zz.y);
            u32x2 w;
            w.x = pk_bf16(o[dt][rq * 4 + 0] * inv * silu_f(z0), o[dt][rq * 4 + 1] * inv * silu_f(z1));
            w.y = pk_bf16(o[dt][rq * 4 + 2] * inv * silu_f(z2), o[dt][rq * 4 + 3] * inv * silu_f(z3));
            *(u32x2*)(mp + d0) = w;
        }
}

__device__ __forceinline__ void unpack8(const u32x4 u, float* f) {
    f[0] = bf_lo(u.x); f[1] = bf_hi(u.x); f[2] = bf_lo(u.y); f[3] = bf_hi(u.y);
    f[4] = bf_lo(u.z); f[5] = bf_hi(u.z); f[6] = bf_lo(u.w); f[7] = bf_hi(u.w);
}

template <int WIN>
__device__ __forceinline__ void pool_group(const Params& p, int layer, int T0, int toff, int seqlen, int gi, int fr, int fq, const bf16x8 (&wf)[4][2],
                                           const f32x4 (&ps)[4], const unsigned char* smem) {
    constexpr int HALF = WIN / 2;
    u32x2 zz[2][4];
#pragma unroll
    for (int mi = 0; mi < 2; ++mi)
#pragma unroll
        for (int ni = 0; ni < 4; ++ni) zz[mi][ni] = *(const u32x2*)(p.proj + (size_t)(T0 + mi * 16 + fr) * INW + 2560 + gi * 64 + ni * 16 + fq * 4);
#pragma unroll
    for (int mi = 0; mi < 2; ++mi) {
        const int tt = mi * 16 + fr, ts = toff + tt, tok = T0 + tt;
        int lo = ts - HALF, hi = ts - HALF + WIN - 1;
        lo = lo < 0 ? 0 : lo;
        hi = hi > seqlen - 1 ? seqlen - 1 : hi;
        const float rc = 1.0f / (float)(hi - lo + 1);
        f32x4 acc[4];
#pragma unroll
        for (int j = 0; j < 4; ++j) acc[j] = (f32x4){0.f, 0.f, 0.f, 0.f};
#pragma unroll
        for (int kk = 0; kk < 2; ++kk) {
            const int co = (gi * 64 + kk * 32 + fq * 8) * 2;
            u32x4 rw[WIN];
#pragma unroll
            for (int j = 0; j < WIN; ++j) rw[j] = *(const u32x4*)(smem + (tt + 8 - HALF + j) * 528 + co);
            const u32x4 self = *(const u32x4*)(smem + (tt + 8) * 528 + co);
            float sum[8];
#pragma unroll
            for (int e = 0; e < 8; ++e) sum[e] = 0.f;
#pragma unroll
            for (int j = 0; j < WIN; ++j) {
                const int sq = ts - HALF + j;
                const float m = (sq >= 0 && sq < seqlen) ? 1.0f : 0.0f;
                float f[8];
                unpack8(rw[j], f);
#pragma unroll
                for (int e = 0; e < 8; ++e) sum[e] = fmaf(f[e], m, sum[e]);
            }
            float us[8];
            unpack8(self, us);
            u32x4 dw;
            dw.x = pk_bf16(sum[0] * rc - us[0], sum[1] * rc - us[1]);
            dw.y = pk_bf16(sum[2] * rc - us[2], sum[3] * rc - us[3]);
            dw.z = pk_bf16(sum[4] * rc - us[4], sum[5] * rc - us[5]);
            dw.w = pk_bf16(sum[6] * rc - us[6], sum[7] * rc - us[7]);
            const bf16x8 df = __builtin_bit_cast(bf16x8, dw);
#pragma unroll
            for (int ni = 0; ni < 4; ++ni) acc[ni] = __builtin_amdgcn_mfma_f32_16x16x32_bf16(wf[ni][kk], df, acc[ni], 0, 0, 0);
        }
#pragma unroll
        for (int ni = 0; ni < 4; ++ni) {
            const int ch = gi * 64 + ni * 16 + fq * 4;
            u32x2 w;
            w.x = pk_bf16(acc[ni][0] * ps[ni][0] * silu_f(bf_lo(zz[mi][ni].x)), acc[ni][1] * ps[ni][1] * silu_f(bf_hi(zz[mi][ni].x)));
            w.y = pk_bf16(acc[ni][2] * ps[ni][2] * silu_f(bf_lo(zz[mi][ni].y)), acc[ni][3] * ps[ni][3] * silu_f(bf_hi(zz[mi][ni].y)));
            *(u32x2*)(p.mix + (size_t)tok * DM + 768 + ch) = w;
        }
    }
}

__device__ __forceinline__ void pool_item(const Params& p, int layer, int pi, unsigned char* smem) {
    const int tid = otid(), lane = tid & 63, gi = tid >> 6;
    const int fr = lane & 15, fq = lane >> 4;
    const int T0 = pi * 32;
    int seqstart, seqlen;
    if (T0 < NCTX) { seqstart = T0 & ~255; seqlen = 256; } else { seqstart = NCTX + ((T0 - NCTX) & ~2047); seqlen = 2048; }
    const int toff = T0 - seqstart;
    u32x4 st[6];
#pragma unroll
    for (int i = 0; i < 6; ++i) {
        const int e = tid + 256 * i, r = e >> 5, c = e & 31;
        int sq = toff - 8 + r;
        sq = sq < 0 ? 0 : (sq > seqlen - 1 ? seqlen - 1 : sq);
        if (e < 47 * 32) st[i] = *(const u32x4*)(p.proj + (size_t)(seqstart + sq) * INW + 2304 + c * 8);
    }
    bf16x8 wf[4][2];
    f32x4 ps[4];
    {
        const bf16_t* wp = p.PoolT + (size_t)((layer * 4 + gi) * 64) * 64;
#pragma unroll
        for (int ni = 0; ni < 4; ++ni) {
#pragma unroll
            for (int kk = 0; kk < 2; ++kk) wf[ni][kk] = *(const bf16x8*)(wp + (ni * 16 + fr) * 64 + kk * 32 + fq * 8);
            ps[ni] = *(const f32x4*)(p.pool_scale + layer * 256 + gi * 64 + ni * 16 + fq * 4);
        }
    }
#pragma unroll
    for (int i = 0; i < 6; ++i) {
        const int e = tid + 256 * i, r = e >> 5, c = e & 31;
        if (e < 47 * 32) *(u32x4*)(smem + r * 528 + c * 16) = st[i];
    }
    __syncthreads();
    if (gi == 0) pool_group<2>(p, layer, T0, toff, seqlen, gi, fr, fq, wf, ps, smem);
    else if (gi == 1) pool_group<4>(p, layer, T0, toff, seqlen, gi, fr, fq, wf, ps, smem);
    else if (gi == 2) pool_group<8>(p, layer, T0, toff, seqlen, gi, fr, fq, wf, ps, smem);
    else pool_group<16>(p, layer, T0, toff, seqlen, gi, fr, fq, wf, ps, smem);
    __syncthreads();
}

__device__ __forceinline__ void conv_item(const Params& p, int layer, int ci) {
    const int tid = otid();
    const int ch = (tid & 31) * 8, tg = tid >> 5;
    const int T0 = ci * 32 + tg * 4;
    int seqstart, seqlen;
    if (T0 < NCTX) { seqstart = T0 & ~255; seqlen = 256; } else { seqstart = NCTX + ((T0 - NCTX) & ~2047); seqlen = 2048; }
    const int seqend = seqstart + seqlen;
    u32x4 rh[6], rc[6], rb[4], rz[4];
#pragma unroll
    for (int i = 0; i < 6; ++i) {
        int tok = T0 - 1 + i;
        tok = tok < seqstart ? seqstart : (tok > seqend - 1 ? seqend - 1 : tok);
        rh[i] = *(const u32x4*)(p.proj + (size_t)tok * INW + 1280 + ch);
        rc[i] = *(const u32x4*)(p.proj + (size_t)tok * INW + 1792 + ch);
    }
#pragma unroll
    for (int i = 0; i < 4; ++i) {
        rb[i] = *(const u32x4*)(p.proj + (size_t)(T0 + i) * INW + 1536 + ch);
        rz[i] = *(const u32x4*)(p.proj + (size_t)(T0 + i) * INW + 2048 + ch);
    }
    f32x4 wv[8];
    {
        const float* cw = p.conv_w + (size_t)layer * 768 + ch;
#pragma unroll
        for (int r = 0; r < 3; ++r) { wv[r * 2] = *(const f32x4*)(cw + r * 256); wv[r * 2 + 1] = *(const f32x4*)(cw + r * 256 + 4); }
        wv[6] = *(const f32x4*)(p.conv_b + layer * 256 + ch);
        wv[7] = *(const f32x4*)(p.conv_b + layer * 256 + ch + 4);
    }
    float x[6][8];
#pragma unroll
    for (int i = 0; i < 6; ++i) {
        const int tok = T0 - 1 + i;
        const float valid = (tok >= seqstart && tok < seqend) ? 1.0f : 0.0f;
        float hc[8], cc[8];
        unpack8(rh[i], hc);
        unpack8(rc[i], cc);
#pragma unroll
        for (int e = 0; e < 8; ++e) x[i][e] = hc[e] * cc[e] * valid;
    }
#pragma unroll
    for (int t = 0; t < 4; ++t) {
        float bc[8], zc[8], o[8];
        unpack8(rb[t], bc);
        unpack8(rz[t], zc);
#pragma unroll
        for (int e = 0; e < 8; ++e) {
            const float y = x[t][e] * wv[e >> 2][e & 3] + x[t + 1][e] * wv[2 + (e >> 2)][e & 3] + x[t + 2][e] * wv[4 + (e >> 2)][e & 3] + wv[6 + (e >> 2)][e & 3];
            o[e] = bc[e] * y * silu_f(zc[e]);
        }
        u32x4 w;
        w.x = pk_bf16(o[0], o[1]); w.y = pk_bf16(o[2], o[3]); w.z = pk_bf16(o[4], o[5]); w.w = pk_bf16(o[6], o[7]);
        *(u32x4*)(p.mix + (size_t)(T0 + t) * DM + 512 + ch) = w;
    }
}

__device__ __forceinline__ void phase_mixer(const Params& p, int layer, unsigned char* smem) {
    if (gridDim.x == 512) {
        const int b = blockIdx.x;
        attn_unit<0>(p, layer, b, smem);
        if (b < 256) {
            attn_unit<0>(p, layer, 512 + b, smem);
        } else {
#pragma unroll 1
            for (int k = 0; k < 3; ++k) {
                const int idx = (b - 256) + 256 * k;
                if (idx < 384) pool_item(p, layer, idx, smem);
                else conv_item(p, layer, idx - 384);
            }
        }
    } else {
        for (int it = blockIdx.x; it < 768 + 384 + 384; it += gridDim.x) {
            if (it < 768) attn_unit<0>(p, layer, it, smem);
            else if (it < 1152) pool_item(p, layer, it - 768, smem);
            else conv_item(p, layer, it - 1152);
        }
    }
}

__global__ void __launch_bounds__(256, 2) mega(Params p, int lo, int hi) {
    __shared__ __attribute__((aligned(16))) unsigned char smem[73728];
    __shared__ uint4 xbw;
    if (p.use_cg) cg::this_grid().sync();
    if (threadIdx.x == 0) xbw = make_uint4(0u, 0u, 0u, 0u);
    __syncthreads();
    XcdBarrier xb = xcd_barrier_post(p.bar, (volatile LAS unsigned*)&xbw);
    for (int ph = lo; ph < hi; ++ph) {
        if (ph > lo) xcd_barrier(xb);
        if (ph == 0) phase_prep(p, smem);
        else if (ph == 9) phase_final(p);
        else {
            const int layer = (ph - 1) >> 2, ty = (ph - 1) & 3;
            if (ty == 0) phase_xn(p, layer);
            else if (ty == 1) phase_gemm<0>(p, layer, smem);
            else if (ty == 2) phase_mixer(p, layer, smem);
            else phase_gemm<1>(p, layer, smem);
        }
    }
}

#ifndef MK_MULTI
#define MK_MULTI 0
#endif

extern "C" void kernel_launch(void* const* d_in, const int* in_sizes, int n_in, void* d_out, int out_size, void* d_ws, size_t ws_size,
                              hipStream_t stream) {
    static int grid_blocks = 0;
    if (!grid_blocks) {
        int dev = 0, cus = 0, per_cu = 0;
        hipGetDevice(&dev);
        hipDeviceGetAttribute(&cus, hipDeviceAttributeMultiprocessorCount, dev);
        hipOccupancyMaxActiveBlocksPerMultiprocessor(&per_cu, mega, 256, 0);
        if (per_cu > 2) per_cu = 2;
        if (per_cu < 1) per_cu = 1;
        grid_blocks = cus * per_cu;
    }
    Params p{};
    const float* const* in = (const float* const*)d_in;
    p.x_prompt = in[0]; p.x_sample = in[1]; p.cache_k = in[2]; p.cache_v = in[3]; p.c = in[4]; p.c_ctx = in[5]; p.norm_g = in[6];
    p.w_ada = in[7]; p.b_ada = in[8]; p.w_in = in[9]; p.q_g = in[10]; p.k_g = in[11]; p.conv_w = in[12]; p.conv_b = in[13];
    p.pool_w = in[14]; p.pool_scale = in[15]; p.w_out = in[16]; p.final_g = in[17];
    p.out = (float*)d_out;
    unsigned char* ws = (unsigned char*)d_ws;
    size_t off = 0;
    auto take = [&](size_t bytes) { unsigned char* r = ws + off; off += (bytes + 255) & ~(size_t)255; return r; };
    p.bar = (unsigned*)take(XCD_BAR_WORDS * 4);
    p.modv = (float*)take(2 * 5 * 3072 * 4);
    p.rope = (float*)take(2048 * 4);
    p.WinT = (bf16_t*)take((size_t)2 * INW * 1024 * 2);
    p.WoutT = (bf16_t*)take((size_t)2 * 1024 * 1024 * 2);
    p.PoolT = (bf16_t*)take(2 * 4 * 64 * 64 * 2);
    p.kc = (bf16_t*)take(262144 * 2);
    p.vc = (bf16_t*)take(262144 * 2);
    p.h = (float*)take((size_t)NTOK * DM * 4);
    p.xn = (bf16_t*)take((size_t)NTOK * DM * 2);
    p.proj = (bf16_t*)take((size_t)NTOK * INW * 2);
    p.mix = (bf16_t*)take((size_t)NTOK * DM * 2);
    p.use_cg = 0;
    p.pad = 0;
    hipMemsetAsync(p.bar, 0, XCD_BAR_WORDS * 4, stream);
#if MK_MULTI
    for (int ph = 0; ph < 10; ++ph) {
        int lo = ph, hi = ph + 1;
        void* args[] = {&p, &lo, &hi};
        hipError_t e = hipLaunchCooperativeKernel((void*)mega, dim3(grid_blocks), dim3(256), args, 0, stream);
        if (e != hipSuccess) fprintf(stderr, "launch failed: %s\n", hipGetErrorString(e));
    }
#else
    int lo = 0, hi = 10;
    void* args[] = {&p, &lo, &hi};
    hipError_t e = hipLaunchCooperativeKernel((void*)mega, dim3(grid_blocks), dim3(256), args, 0, stream);
    if (e != hipSuccess) fprintf(stderr, "cooperative launch failed: %s (grid %d)\n", hipGetErrorString(e), grid_blocks);
#endif
}
```

```cpp
#include <hip/hip_runtime.h>
#include <hip/hip_cooperative_groups.h>
#include <cstdint>
#include <cstdio>
namespace cg = cooperative_groups;

#define LAS __attribute__((address_space(3)))
typedef unsigned short bf16_t;
typedef short bf16x8 __attribute__((ext_vector_type(8)));
typedef short s16x4 __attribute__((ext_vector_type(4)));
typedef float f32x4 __attribute__((ext_vector_type(4)));
typedef float f32x16 __attribute__((ext_vector_type(16)));
typedef unsigned u32x4 __attribute__((ext_vector_type(4)));
typedef unsigned u32x2 __attribute__((ext_vector_type(2)));

constexpr int NTOK = 12288, NCTX = 4096, DM = 1024, INW = 2816;
constexpr size_t OUT_NK = 12582912, OUT_NV = 13631488;
constexpr float EPSF = 1e-6f;
constexpr float QSCALE = 0.125f * 1.4426950408889634f;

struct Params {
    const float *x_prompt, *x_sample, *cache_k, *cache_v, *c, *c_ctx, *norm_g, *w_ada, *b_ada, *w_in, *q_g, *k_g, *conv_w, *conv_b,
        *pool_w, *pool_scale, *w_out, *final_g;
    float* out;
    unsigned* bar;
    float* modv;
    float* rope;
    bf16_t* WinT;
    bf16_t* WoutT;
    bf16_t* PoolT;
    bf16_t* kc;
    bf16_t* vc;
    bf16_t* h;
    bf16_t* xn;
    bf16_t* proj;
    bf16_t* mix;
    int use_cg;
    int pad;
};

__device__ __forceinline__ unsigned pk_bf16(float lo, float hi) {
    unsigned r;
    asm("v_cvt_pk_bf16_f32 %0, %1, %2" : "=v"(r) : "v"(lo), "v"(hi));
    return r;
}
__device__ __forceinline__ float bf_lo(unsigned u) { return __uint_as_float(u << 16); }
__device__ __forceinline__ float bf_hi(unsigned u) { return __uint_as_float(u & 0xffff0000u); }
__device__ __forceinline__ float silu_f(float z) { return z / (1.0f + __expf(-z)); }
__device__ __forceinline__ f32x4 bf4_to_f32(const u32x2 u) { return (f32x4){bf_lo(u.x), bf_hi(u.x), bf_lo(u.y), bf_hi(u.y)}; }
__device__ __forceinline__ float max3_f(float a, float b, float c) { float r; asm("v_max3_f32 %0, %1, %2, %3" : "=v"(r) : "v"(a), "v"(b), "v"(c)); return r; }
__device__ __forceinline__ int otid() { int t = threadIdx.x; asm volatile("" : "+v"(t)); return t; }

#define XB_TMO 128
#define XB_XCNT(j) (256 + 64 * (j))
#define XB_XSUB(j) (1280 + 64 * (j))
#define XB_XGEN(j) (2304 + 64 * (j))
#define XB_TOP 3328
#define XB_TOPGEN 3392
#define XCD_BAR_WORDS 3456
#define XB_SPIN_CAP (1u << 20)

__device__ __forceinline__ unsigned xb_ld(unsigned* p) { return __hip_atomic_load(p, __ATOMIC_RELAXED, __HIP_MEMORY_SCOPE_AGENT); }
__device__ __forceinline__ unsigned xb_add(unsigned* p, unsigned v) { return __hip_atomic_fetch_add(p, v, __ATOMIC_RELAXED, __HIP_MEMORY_SCOPE_AGENT); }
__device__ __forceinline__ unsigned xb_xcc_id() { return (unsigned)__builtin_amdgcn_s_getreg((3 << 11) | 20) & 0xFu; }
#define XB_SPIN(cond, bar)                                                   \
    do {                                                                     \
        unsigned _sp = 0;                                                    \
        while (cond) {                                                       \
            __builtin_amdgcn_s_sleep(1);                                     \
            if ((++_sp & 255u) == 0u) {                                      \
                if (xb_ld(&(bar)[XB_TMO])) break;                            \
                if (_sp > XB_SPIN_CAP) { atomicAdd(&(bar)[XB_TMO], 1u); break; } \
            }                                                                \
        }                                                                    \
    } while (0)

struct XcdBarrier {
    unsigned* bar;
    unsigned x;
    volatile LAS unsigned* st;
};

__device__ __forceinline__ XcdBarrier xcd_barrier_post(unsigned* bar, volatile LAS unsigned* st) {
    XcdBarrier b;
    b.bar = bar;
    b.x = xb_xcc_id();
    b.st = st;
    if (threadIdx.x == 0) (void)xb_add(&bar[XB_XCNT(b.x)], 1u);
    return b;
}
__device__ __forceinline__ void xcd_barrier_complete(unsigned* bar, unsigned x, unsigned& nloc, unsigned& nx) {
    const unsigned G = gridDim.x * gridDim.y * gridDim.z;
    unsigned sum, cnt, mine, sp = 0u;
    for (;;) {
        sum = 0u; cnt = 0u; mine = 0u;
#pragma unroll
        for (unsigned j = 0; j < 16; ++j) {
            const unsigned c = xb_ld(&bar[XB_XCNT(j)]);
            sum += c; cnt += (c > 0u) ? 1u : 0u; mine = (j == x) ? c : mine;
        }
        if (sum == G) break;
        __builtin_amdgcn_s_sleep(1);
        if ((++sp & 255u) == 0u) {
            if (xb_ld(&bar[XB_TMO])) break;
            if (sp > XB_SPIN_CAP) { atomicAdd(&bar[XB_TMO], 1u); break; }
        }
    }
    nloc = mine > 0u ? mine : 1u;
    nx = cnt > 0u ? cnt : 1u;
}
__device__ __forceinline__ void xcd_barrier(const XcdBarrier& b) {
    asm volatile("s_waitcnt vmcnt(0)" ::: "memory");
    __syncthreads();
    if (threadIdx.x == 0) {
        unsigned* bar = b.bar;
        __builtin_amdgcn_s_waitcnt(0);
        unsigned nloc = b.st[0], nx = b.st[1];
        if (nloc == 0u) { xcd_barrier_complete(bar, b.x, nloc, nx); b.st[0] = nloc; b.st[1] = nx; }
        const unsigned old = xb_add(&bar[XB_XSUB(b.x)], 1u);
        const unsigned gen = old / nloc;
        if (old + 1u == (gen + 1u) * nloc) {
            __builtin_amdgcn_fence(__ATOMIC_RELEASE, "agent");
            asm volatile("s_waitcnt vmcnt(0)" ::: "memory");
            const unsigned og = xb_add(&bar[XB_TOP], 1u);
            const unsigned tg = og / nx;
            if (og + 1u == (tg + 1u) * nx) xb_add(&bar[XB_TOPGEN], 1u);
            else XB_SPIN(xb_ld(&bar[XB_TOPGEN]) == tg, bar);
            __builtin_amdgcn_fence(__ATOMIC_ACQUIRE, "agent");
            xb_add(&bar[XB_XGEN(b.x)], 1u);
            asm volatile("s_waitcnt vmcnt(0)" ::: "memory");
        } else {
            XB_SPIN(xb_ld(&bar[XB_XGEN(b.x)]) == gen, bar);
            __builtin_amdgcn_fence(__ATOMIC_ACQUIRE, "agent");
            asm volatile("s_waitcnt vmcnt(0)" ::: "memory");
        }
    }
    __syncthreads();
}

__device__ __forceinline__ void prep_mod_item(const Params& p, int item, unsigned char* smem) {
    const int tid = otid();
    float* sc = (float*)smem;
    float* red = (float*)(smem + 20480);
    const int l = item / 96, j0 = (item % 96) * 32;
    for (int idx = tid; idx < 5120; idx += 256) {
        const int v = idx >> 10, k = idx & 1023;
        const float cv = (v == 0) ? p.c_ctx[k] : p.c[(v - 1) * 1024 + k];
        sc[idx] = cv / (1.0f + expf(-cv));
    }
    __syncthreads();
    const int cgp = tid & 7, kg = tid >> 3;
    float acc[5][4];
#pragma unroll
    for (int v = 0; v < 5; ++v)
#pragma unroll
        for (int e = 0; e < 4; ++e) acc[v][e] = 0.f;
    const float* wp = p.w_ada + (size_t)l * 1024 * 3072 + j0 + cgp * 4;
    f32x4 wreg[32];
#pragma unroll
    for (int kk = 0; kk < 32; ++kk) wreg[kk] = *(const f32x4*)(wp + (size_t)(kk * 32 + kg) * 3072);
#pragma unroll
    for (int kk = 0; kk < 32; ++kk) {
        const int k = kk * 32 + kg;
        const f32x4 w = wreg[kk];
#pragma unroll
        for (int v = 0; v < 5; ++v) {
            const float s = sc[v * 1024 + k];
#pragma unroll
            for (int e = 0; e < 4; ++e) acc[v][e] += s * w[e];
        }
    }
#pragma unroll
    for (int v = 0; v < 5; ++v)
#pragma unroll
        for (int e = 0; e < 4; ++e) red[kg * 160 + v * 32 + cgp * 4 + e] = acc[v][e];
    __syncthreads();
    if (tid < 160) {
        float s = 0.f;
        for (int g = 0; g < 32; ++g) s += red[g * 160 + tid];
        const int v = tid >> 5, cc = tid & 31;
        p.modv[(size_t)(l * 5 + v) * 3072 + j0 + cc] = s + p.b_ada[l * 3072 + j0 + cc];
    }
    __syncthreads();
}

__device__ __forceinline__ void prep_transpose_item(const float* src, bf16_t* dst, int N, int k0, int n0) {
    const int n = n0 + otid();
    const float* sp = src + (size_t)k0 * N + n;
    float v[64];
#pragma unroll
    for (int i = 0; i < 64; ++i) v[i] = sp[(size_t)i * N];
    bf16_t* d = dst + (size_t)n * 1024 + k0;
#pragma unroll
    for (int c = 0; c < 8; ++c) {
        u32x4 w;
        w.x = pk_bf16(v[c * 8 + 0], v[c * 8 + 1]);
        w.y = pk_bf16(v[c * 8 + 2], v[c * 8 + 3]);
        w.z = pk_bf16(v[c * 8 + 4], v[c * 8 + 5]);
        w.w = pk_bf16(v[c * 8 + 6], v[c * 8 + 7]);
        *(u32x4*)(d + c * 8) = w;
    }
}

__device__ __forceinline__ void phase_prep(const Params& p, unsigned char* smem) {
    for (int it = (int)gridDim.x - 1 - (int)blockIdx.x; it < 192; it += gridDim.x) prep_mod_item(p, it, smem);
    const int NTI = 2 * 11 * 16, NTO = 2 * 4 * 16;
    for (int it = blockIdx.x; it < NTI + NTO; it += gridDim.x) {
        if (it < NTI) {
            const int l = it / 176, r = it % 176, kt = r / 11, nt = r % 11;
            prep_transpose_item(p.w_in + (size_t)l * 1024 * INW, p.WinT + (size_t)l * INW * 1024, INW, kt * 64, nt * 256);
        } else {
            const int t = it - NTI, l = t / 64, r = t % 64, kt = r / 4, nt = r % 4;
            prep_transpose_item(p.w_out + (size_t)l * 1024 * 1024, p.WoutT + (size_t)l * 1024 * 1024, 1024, kt * 64, nt * 256);
        }
    }
    const int gsz = gridDim.x * 256;
    for (int i = blockIdx.x * 256 + otid(); i < 131072; i += gsz) {
        const int which = i >> 16, j4 = (i & 65535) * 4;
        const int d = j4 & 63, t = (j4 >> 6) & 255, kvh = (j4 >> 14) & 1, bl = j4 >> 15;
        const size_t si = ((size_t)(bl * 256 + t) * 2 + kvh) * 64 + d;
        const f32x4 v = *(const f32x4*)((which ? p.cache_v : p.cache_k) + si);
        u32x2 w;
        w.x = pk_bf16(v[0], v[1]);
        w.y = pk_bf16(v[2], v[3]);
        *(u32x2*)((which ? p.vc : p.kc) + j4) = w;
    }
    for (int j = blockIdx.x * 256 + otid(); j < 32768; j += gsz) {
        const int cc = j & 63, d = (j >> 6) & 63, lg = j >> 12;
        const float v = p.pool_w[((size_t)lg * 64 + cc) * 64 + d];
        p.PoolT[j] = (bf16_t)(pk_bf16(v, 0.f) & 0xffffu);
    }
    for (int j = blockIdx.x * 256 + otid(); j < 1024; j += gsz) {
        const int a = j & 15, r = j >> 4;
        const float inv = 1.0f / powf(10000.0f, (float)(2 * a) / 32.0f);
        const float ang = (float)r * inv;
        const float kf = rintf(ang * 0.15915494309189535f);
        float rr = fmaf(-kf, 6.2831854820251465f, ang);
        rr = fmaf(-kf, -1.7484555e-7f, rr);
        p.rope[j] = cosf(rr);
        p.rope[1024 + j] = sinf(rr);
    }
}

__device__ __forceinline__ float wave_sum(float v) {
#pragma unroll
    for (int o = 32; o >= 1; o >>= 1) v += __shfl_xor(v, o);
    return v;
}

__device__ __forceinline__ void phase_xn(const Params& p, int layer) {
    const int tid = otid(), lane = tid & 63, wave = tid >> 6;
    const int nw = gridDim.x * 4, w = blockIdx.x * 4 + wave;
    for (int t0 = w * 6; t0 < NTOK; t0 += nw * 6) {
        f32x4 x[6][4];
        if (layer == 0) {
#pragma unroll
            for (int u = 0; u < 6; ++u) {
                const int tok = t0 + u;
                const float* src = tok < NCTX ? p.x_prompt + (size_t)tok * DM : p.x_sample + (size_t)(tok - NCTX) * DM;
#pragma unroll
                for (int i = 0; i < 4; ++i) x[u][i] = *(const f32x4*)(src + i * 256 + lane * 4);
            }
        } else {
            u32x2 r[6][4];
#pragma unroll
            for (int u = 0; u < 6; ++u)
#pragma unroll
                for (int i = 0; i < 4; ++i) r[u][i] = *(const u32x2*)(p.h + (size_t)(t0 + u) * DM + i * 256 + lane * 4);
#pragma unroll
            for (int u = 0; u < 6; ++u)
#pragma unroll
                for (int i = 0; i < 4; ++i) x[u][i] = bf4_to_f32(r[u][i]);
        }
#pragma unroll
        for (int u = 0; u < 6; ++u) {
            const int tok = t0 + u;
            const int v = tok < NCTX ? 0 : 1 + ((tok - NCTX) >> 11);
            const float* mv = p.modv + (size_t)(layer * 5 + v) * 3072;
            float ss = 0.f;
#pragma unroll
            for (int i = 0; i < 4; ++i) ss += x[u][i][0] * x[u][i][0] + x[u][i][1] * x[u][i][1] + x[u][i][2] * x[u][i][2] + x[u][i][3] * x[u][i][3];
            ss = wave_sum(ss);
            const float rstd = rsqrtf(ss * (1.0f / 1024.0f) + EPSF);
#pragma unroll
            for (int i = 0; i < 4; ++i) {
                const int k = i * 256 + lane * 4;
                const f32x4 g = *(const f32x4*)(p.norm_g + layer * 1024 + k);
                const f32x4 sh = *(const f32x4*)(mv + k);
                const f32x4 sc = *(const f32x4*)(mv + 1024 + k);
                float o[4];
#pragma unroll
                for (int e = 0; e < 4; ++e) o[e] = x[u][i][e] * rstd * g[e] * (1.0f + sc[e]) + sh[e];
                u32x2 wv;
                wv.x = pk_bf16(o[0], o[1]);
                wv.y = pk_bf16(o[2], o[3]);
                *(u32x2*)(p.xn + (size_t)tok * DM + k) = wv;
            }
        }
    }
}

__device__ __forceinline__ void phase_final(const Params& p) {
    const int tid = otid(), lane = tid & 63, wave = tid >> 6;
    const int nw = gridDim.x * 4, w = blockIdx.x * 4 + wave;
    f32x4 g[4];
#pragma unroll
    for (int i = 0; i < 4; ++i) g[i] = *(const f32x4*)(p.final_g + i * 256 + lane * 4);
    for (int t0 = w * 6; t0 < NTOK; t0 += nw * 6) {
        f32x4 x[6][4];
#pragma unroll
        for (int u = 0; u < 6; ++u)
#pragma unroll
            for (int i = 0; i < 4; ++i) x[u][i] = *(const f32x4*)(p.out + (size_t)(t0 + u) * DM + i * 256 + lane * 4);
#pragma unroll
        for (int u = 0; u < 6; ++u) {
            float* row = p.out + (size_t)(t0 + u) * DM;
            float ss = 0.f;
#pragma unroll
            for (int i = 0; i < 4; ++i) ss += x[u][i][0] * x[u][i][0] + x[u][i][1] * x[u][i][1] + x[u][i][2] * x[u][i][2] + x[u][i][3] * x[u][i][3];
            ss = wave_sum(ss);
            const float rstd = rsqrtf(ss * (1.0f / 1024.0f) + EPSF);
#pragma unroll
            for (int i = 0; i < 4; ++i) *(f32x4*)(row + i * 256 + lane * 4) = x[u][i] * rstd * g[i];
        }
    }
}

template <int MODE, int MI, int STG = 0>
__device__ __forceinline__ void gemm_epilogue(const Params& p, int layer, int mw, int nw, f32x4 (&acc)[MI][4], int fr, int fq,
                                              unsigned char* ct = nullptr, int m0t = 0, int n0t = 0) {
    if (MODE == 0) {
        const bool ctx = mw < NCTX;
        if (nw < 640) {
            const bool isq = nw < 512;
            const float* gp = (isq ? p.q_g : p.k_g) + layer * 64;
            f32x4 gv[4];
#pragma unroll
            for (int ni = 0; ni < 4; ++ni) gv[ni] = *(const f32x4*)(gp + ni * 16 + fq * 4);
#pragma unroll
            for (int mi = 0; mi < MI; ++mi) {
                const int tok = mw + mi * 16 + fr;
                float ss = 0.f;
#pragma unroll
                for (int ni = 0; ni < 4; ++ni)
#pragma unroll
                    for (int e = 0; e < 4; ++e) ss += acc[mi][ni][e] * acc[mi][ni][e];
                ss += __shfl_xor(ss, 16);
                ss += __shfl_xor(ss, 32);
                const float rstd = rsqrtf(ss * (1.0f / 64.0f) + EPSF);
                f32x4 val[4];
#pragma unroll
                for (int ni = 0; ni < 4; ++ni) val[ni] = acc[mi][ni] * rstd * gv[ni];
                if (!isq && ctx) {
                    float* nk = p.out + OUT_NK + ((size_t)((tok >> 8) * 2 + layer) * 256 + (tok & 255)) * 128 + (nw - 512) + fq * 4;
#pragma unroll
                    for (int ni = 0; ni < 4; ++ni) *(f32x4*)(nk + ni * 16) = val[ni];
                }
                if (!ctx) {
                    const int pos = (tok - NCTX) & 2047, prow = pos >> 6, pcol = pos & 63;
                    const f32x4 cr = *(const f32x4*)(p.rope + prow * 16 + fq * 4), sr = *(const f32x4*)(p.rope + 1024 + prow * 16 + fq * 4);
                    const f32x4 cc = *(const f32x4*)(p.rope + pcol * 16 + fq * 4), sn = *(const f32x4*)(p.rope + 1024 + pcol * 16 + fq * 4);
                    const f32x4 a0 = val[0], a1 = val[1], a2 = val[2], a3 = val[3];
                    val[0] = a0 * cr - a1 * sr;
                    val[1] = a1 * cr + a0 * sr;
                    val[2] = a2 * cc - a3 * sn;
                    val[3] = a3 * cc + a2 * sn;
                }
                if (isq) {
#pragma unroll
                    for (int ni = 0; ni < 4; ++ni) val[ni] = val[ni] * QSCALE;
                }
                bf16_t* pr = p.proj + (size_t)tok * INW + nw + fq * 4;
#pragma unroll
                for (int ni = 0; ni < 4; ++ni) {
                    u32x2 w;
                    w.x = pk_bf16(val[ni][0], val[ni][1]);
                    w.y = pk_bf16(val[ni][2], val[ni][3]);
                    if (STG) *(u32x2*)(ct + (tok - m0t) * 272 + (nw - n0t + fq * 4 + ni * 16) * 2) = w;
                    else *(u32x2*)(pr + ni * 16) = w;
                }
            }
        } else {
            const bool isv = nw < 768;
#pragma unroll
            for (int mi = 0; mi < MI; ++mi) {
                const int tok = mw + mi * 16 + fr;
                bf16_t* pr = p.proj + (size_t)tok * INW + nw + fq * 4;
#pragma unroll
                for (int ni = 0; ni < 4; ++ni) {
                    u32x2 w;
                    w.x = pk_bf16(acc[mi][ni][0], acc[mi][ni][1]);
                    w.y = pk_bf16(acc[mi][ni][2], acc[mi][ni][3]);
                    if (STG) *(u32x2*)(ct + (tok - m0t) * 272 + (nw - n0t + fq * 4 + ni * 16) * 2) = w;
                    else *(u32x2*)(pr + ni * 16) = w;
                }
                if (isv && ctx) {
                    float* nv = p.out + OUT_NV + ((size_t)((tok >> 8) * 2 + layer) * 256 + (tok & 255)) * 128 + (nw - 640) + fq * 4;
#pragma unroll
                    for (int ni = 0; ni < 4; ++ni) *(f32x4*)(nv + ni * 16) = acc[mi][ni];
                }
            }
        }
    } else {
        const int v = mw < NCTX ? 0 : 1 + ((mw - NCTX) >> 11);
        const float* gate = p.modv + (size_t)(layer * 5 + v) * 3072 + 2048 + nw + fq * 4;
        f32x4 gt[4];
#pragma unroll
        for (int ni = 0; ni < 4; ++ni) gt[ni] = *(const f32x4*)(gate + ni * 16);
#pragma unroll
        for (int mi = 0; mi < MI; ++mi) {
            const int tok = mw + mi * 16 + fr;
            const size_t eo = (size_t)tok * DM + nw + fq * 4;
            const float* xin = (tok < NCTX ? p.x_prompt + (size_t)tok * DM : p.x_sample + (size_t)(tok - NCTX) * DM) + nw + fq * 4;
#pragma unroll
            for (int ni = 0; ni < 4; ++ni) {
                if (layer == 0) {
                    const f32x4 r = *(const f32x4*)(xin + ni * 16) + gt[ni] * acc[mi][ni];
                    u32x2 w;
                    w.x = pk_bf16(r[0], r[1]);
                    w.y = pk_bf16(r[2], r[3]);
                    *(u32x2*)(p.h + eo + ni * 16) = w;
                } else {
                    const f32x4 o = bf4_to_f32(*(const u32x2*)(p.h + eo + ni * 16));
                    *(f32x4*)(p.out + eo + ni * 16) = o + gt[ni] * acc[mi][ni];
                }
            }
        }
    }
}

template <int MODE>
__device__ __forceinline__ void gemm_tile(const Params& p, int layer, int mt, int nt, unsigned char* smem) {
    const int tid = otid(), lane = tid & 63, wave = tid >> 6, wm = wave >> 1, wn = wave & 1;
    const int fr = lane & 15, fq = lane >> 4;
    const int m0 = mt * 128, n0 = nt * 128;
    const bf16_t* A = (MODE == 0 ? p.xn : p.mix) + (size_t)m0 * 1024;
    const bf16_t* B = (MODE == 0 ? p.WinT + (size_t)layer * INW * 1024 : p.WoutT + (size_t)layer * 1024 * 1024) + (size_t)n0 * 1024;
    f32x4 acc[4][4];
#pragma unroll
    for (int i = 0; i < 4; ++i)
#pragma unroll
        for (int j = 0; j < 4; ++j) acc[i][j] = (f32x4){0.f, 0.f, 0.f, 0.f};

    const int srow = tid >> 3, scc = tid & 7;
    const bf16_t* ag = A + (size_t)srow * 1024 + scc * 8;
    const bf16_t* bg = B + (size_t)srow * 1024 + scc * 8;
    const int wofs = srow * 128 + ((scc ^ (srow & 7)) * 16);
    u32x4 raA[4], rbA[4], raB[4], rbB[4];
    auto gload = [&](int kt, u32x4* ra, u32x4* rb) {
#pragma unroll
        for (int i = 0; i < 4; ++i) {
            ra[i] = *(const u32x4*)(ag + (size_t)i * 32 * 1024 + kt * 64);
            rb[i] = *(const u32x4*)(bg + (size_t)i * 32 * 1024 + kt * 64);
        }
    };
    auto swrite = [&](int buf, const u32x4* ra, const u32x4* rb) {
        unsigned char* Aw = smem + buf * 32768;
#pragma unroll
        for (int i = 0; i < 4; ++i) {
            *(u32x4*)(Aw + wofs + i * 4096) = ra[i];
            *(u32x4*)(Aw + 16384 + wofs + i * 4096) = rb[i];
        }
    };
    gload(0, raA, rbA);
    gload(1, raB, rbB);
    swrite(0, raA, rbA);
    __syncthreads();
    const int aro = (wm * 64 + fr) * 128, bro = (wn * 64 + fr) * 128, sw = fr & 7;
    auto step = [&](int kt, u32x4* la, u32x4* lb, const u32x4* wa, const u32x4* wb) {
        const unsigned char* As = smem + (kt & 1) * 32768;
        const unsigned char* Bs = As + 16384;
        bf16x8 af[2][4], bf[2][4];
#pragma unroll
        for (int kk = 0; kk < 2; ++kk) {
            const int co = ((kk * 4 + fq) ^ sw) * 16;
#pragma unroll
            for (int i = 0; i < 4; ++i) {
                af[kk][i] = *(const bf16x8*)(As + aro + i * 2048 + co);
                bf[kk][i] = *(const bf16x8*)(Bs + bro + i * 2048 + co);
            }
        }
        if (kt + 2 < 16) gload(kt + 2, la, lb);
        __builtin_amdgcn_sched_barrier(0);
#pragma unroll
        for (int mi = 0; mi < 4; ++mi)
#pragma unroll
            for (int ni = 0; ni < 4; ++ni) acc[mi][ni] = __builtin_amdgcn_mfma_f32_16x16x32_bf16(bf[0][ni], af[0][mi], acc[mi][ni], 0, 0, 0);
        __builtin_amdgcn_sched_barrier(0);
        if (kt + 1 < 16) swrite((kt + 1) & 1, wa, wb);
        __builtin_amdgcn_sched_barrier(0);
#pragma unroll
        for (int mi = 0; mi < 4; ++mi)
#pragma unroll
            for (int ni = 0; ni < 4; ++ni) acc[mi][ni] = __builtin_amdgcn_mfma_f32_16x16x32_bf16(bf[1][ni], af[1][mi], acc[mi][ni], 0, 0, 0);
        __syncthreads();
    };
    for (int kt = 0; kt < 16; kt += 2) {
        step(kt, raA, rbA, raB, rbB);
        step(kt + 1, raB, rbB, raA, rbA);
    }

    gemm_epilogue<MODE, 4>(p, layer, m0 + wm * 64, n0 + wn * 64, acc, fr, fq);
}

template <int MODE>
__device__ __forceinline__ void gemm_tile256(const Params& p, int layer, int mt, int nt, unsigned char* smem) {
    const int tid = otid(), lane = tid & 63, wave = tid >> 6, wm = wave >> 1, wn = wave & 1;
    const int fr = lane & 15, fq = lane >> 4;
    const int m0 = mt * 256, n0 = nt * 128;
    const bf16_t* A = (MODE == 0 ? p.xn : p.mix) + (size_t)m0 * 1024;
    const bf16_t* B = (MODE == 0 ? p.WinT + (size_t)layer * INW * 1024 : p.WoutT + (size_t)layer * 1024 * 1024) + (size_t)n0 * 1024;
    f32x4 acc[8][4];
#pragma unroll
    for (int i = 0; i < 8; ++i)
#pragma unroll
        for (int j = 0; j < 4; ++j) acc[i][j] = (f32x4){0.f, 0.f, 0.f, 0.f};
    const int srow = tid >> 2, scc = tid & 3;
    const bf16_t* ag = A + (size_t)srow * 1024 + scc * 8;
    const bf16_t* bg = B + (size_t)srow * 1024 + scc * 8;
    const int wofs = srow * 64 + ((scc ^ ((4 - ((srow >> 2) & 3)) & 3)) * 16);
    u32x4 raA[4], rbA[2], raB[4], rbB[2];
    auto gload = [&](int kt, u32x4* ra, u32x4* rb) {
#pragma unroll
        for (int i = 0; i < 4; ++i) ra[i] = *(const u32x4*)(ag + (size_t)i * 64 * 1024 + kt * 32);
#pragma unroll
        for (int i = 0; i < 2; ++i) rb[i] = *(const u32x4*)(bg + (size_t)i * 64 * 1024 + kt * 32);
    };
    auto swrite = [&](int buf, const u32x4* ra, const u32x4* rb) {
        unsigned char* Aw = smem + buf * 24576;
#pragma unroll
        for (int i = 0; i < 4; ++i) *(u32x4*)(Aw + wofs + i * 4096) = ra[i];
#pragma unroll
        for (int i = 0; i < 2; ++i) *(u32x4*)(Aw + 16384 + wofs + i * 4096) = rb[i];
    };
    gload(0, raA, rbA);
    gload(1, raB, rbB);
    swrite(0, raA, rbA);
    __syncthreads();
    const int co = (fq ^ ((4 - ((fr >> 2) & 3)) & 3)) * 16;
    const int aro = (wm * 128 + fr) * 64 + co, bro = (wn * 64 + fr) * 64 + co;
    auto step = [&](int kt, u32x4* la, u32x4* lb, const u32x4* wa, const u32x4* wb) {
        const unsigned char* As = smem + (kt & 1) * 24576;
        const unsigned char* Bs = As + 16384;
        bf16x8 af[8], bf[4];
#pragma unroll
        for (int i = 0; i < 4; ++i) bf[i] = *(const bf16x8*)(Bs + bro + i * 1024);
#pragma unroll
        for (int i = 0; i < 8; ++i) af[i] = *(const bf16x8*)(As + aro + i * 1024);
        if (kt + 2 < 32) gload(kt + 2, la, lb);
        __builtin_amdgcn_sched_barrier(0);
#pragma unroll
        for (int mi = 0; mi < 4; ++mi)
#pragma unroll
            for (int ni = 0; ni < 4; ++ni) acc[mi][ni] = __builtin_amdgcn_mfma_f32_16x16x32_bf16(bf[ni], af[mi], acc[mi][ni], 0, 0, 0);
        __builtin_amdgcn_sched_barrier(0);
        if (kt + 1 < 32) swrite((kt + 1) & 1, wa, wb);
        __builtin_amdgcn_sched_barrier(0);
#pragma unroll
        for (int mi = 4; mi < 8; ++mi)
#pragma unroll
            for (int ni = 0; ni < 4; ++ni) acc[mi][ni] = __builtin_amdgcn_mfma_f32_16x16x32_bf16(bf[ni], af[mi], acc[mi][ni], 0, 0, 0);
        __syncthreads();
    };
    for (int kt = 0; kt < 32; kt += 2) {
        step(kt, raA, rbA, raB, rbB);
        step(kt + 1, raB, rbB, raA, rbA);
    }
    gemm_epilogue<MODE, 8>(p, layer, m0 + wm * 128, n0 + wn * 64, acc, fr, fq);
}

template <int MODE>
__device__ __forceinline__ void gemm_tile256_dma(const Params& p, int layer, int mt, int nt, unsigned char* smem) {
    const int tid = otid(), lane = tid & 63, wave = tid >> 6, wm = wave >> 1, wn = wave & 1;
    const int fr = lane & 15, fq = lane >> 4;
    const int m0 = mt * 256, n0 = nt * 128;
    const bf16_t* A = (MODE == 0 ? p.xn : p.mix) + (size_t)m0 * 1024;
    const bf16_t* B = (MODE == 0 ? p.WinT + (size_t)layer * INW * 1024 : p.WoutT + (size_t)layer * 1024 * 1024) + (size_t)n0 * 1024;
    f32x4 acc[8][4];
#pragma unroll
    for (int i = 0; i < 8; ++i)
#pragma unroll
        for (int j = 0; j < 4; ++j) acc[i][j] = (f32x4){0.f, 0.f, 0.f, 0.f};
    const int lrow = lane >> 2, lc = (lane & 3) ^ ((4 - ((lane >> 4) & 3)) & 3);
    const bf16_t* agp = A + (size_t)(wave * 64 + lrow) * 1024 + lc * 8;
    const bf16_t* bgp = B + (size_t)(wave * 32 + lrow) * 1024 + lc * 8;
    LAS unsigned char* lbase = (LAS unsigned char*)smem;
    const int la_off = wave * 4096 + lane * 16, lb_off = 16384 + wave * 2048 + lane * 16;
    auto dma = [&](int kt, int stage) {
        LAS unsigned char* sb = lbase + stage * 24576;
#pragma unroll
        for (int i = 0; i < 4; ++i)
            __builtin_amdgcn_global_load_lds((const void*)(agp + (size_t)i * 16 * 1024 + kt * 32), (LAS void*)(sb + la_off + i * 1024), 16, 0, 0);
#pragma unroll
        for (int i = 0; i < 2; ++i)
            __builtin_amdgcn_global_load_lds((const void*)(bgp + (size_t)i * 16 * 1024 + kt * 32), (LAS void*)(sb + lb_off + i * 1024), 16, 0, 0);
    };
    dma(0, 0);
    dma(1, 1);
    asm volatile("s_waitcnt vmcnt(6)" ::: "memory");
    __builtin_amdgcn_s_barrier();
    const int co = (fq ^ ((4 - ((fr >> 2) & 3)) & 3)) * 16;
    const int aro = (wm * 128 + fr) * 64 + co, bro = 16384 + (wn * 64 + fr) * 64 + co;
    int st = 0, st2 = 2;
    const unsigned lds0 = (unsigned)(uintptr_t)lbase;
#pragma unroll 1
    for (int kt = 0; kt < 32; ++kt) {
        const unsigned sa = lds0 + st * 24576 + aro, sbb = lds0 + st * 24576 + bro;
        bf16x8 af[8], bf[4];
#define FRAG_RD(dst, addr, OFF) asm volatile("ds_read_b128 %0, %1 offset:" #OFF : "=&v"(dst) : "v"(addr))
        FRAG_RD(bf[0], sbb, 0); FRAG_RD(bf[1], sbb, 1024); FRAG_RD(bf[2], sbb, 2048); FRAG_RD(bf[3], sbb, 3072);
        FRAG_RD(af[0], sa, 0); FRAG_RD(af[1], sa, 1024); FRAG_RD(af[2], sa, 2048); FRAG_RD(af[3], sa, 3072);
        FRAG_RD(af[4], sa, 4096); FRAG_RD(af[5], sa, 5120); FRAG_RD(af[6], sa, 6144); FRAG_RD(af[7], sa, 7168);
#undef FRAG_RD
        __builtin_amdgcn_sched_barrier(0);
        if (kt + 2 < 32) dma(kt + 2, st2);
        __builtin_amdgcn_sched_barrier(0);
        asm volatile("s_waitcnt lgkmcnt(4)" ::: "memory");
        __builtin_amdgcn_sched_barrier(0);
#pragma unroll
        for (int mi = 0; mi < 4; ++mi)
#pragma unroll
            for (int ni = 0; ni < 4; ++ni) acc[mi][ni] = __builtin_amdgcn_mfma_f32_16x16x32_bf16(bf[ni], af[mi], acc[mi][ni], 0, 0, 0);
        __builtin_amdgcn_sched_barrier(0);
        asm volatile("s_waitcnt lgkmcnt(0)" ::: "memory");
        __builtin_amdgcn_sched_barrier(0);
#pragma unroll
        for (int mi = 4; mi < 8; ++mi)
#pragma unroll
            for (int ni = 0; ni < 4; ++ni) acc[mi][ni] = __builtin_amdgcn_mfma_f32_16x16x32_bf16(bf[ni], af[mi], acc[mi][ni], 0, 0, 0);
        __builtin_amdgcn_sched_barrier(0);
        if (kt + 2 < 32) asm volatile("s_waitcnt vmcnt(6)" ::: "memory");
        else asm volatile("s_waitcnt vmcnt(0)" ::: "memory");
        __builtin_amdgcn_s_barrier();
        st = st == 2 ? 0 : st + 1;
        st2 = st2 == 2 ? 0 : st2 + 1;
    }
    if (MODE == 0) {
        gemm_epilogue<0, 8, 1>(p, layer, m0 + wm * 128, n0 + wn * 64, acc, fr, fq, smem, m0, n0);
        __syncthreads();
        u32x4 cv[16];
#pragma unroll
        for (int i = 0; i < 16; ++i) { const int e = tid + 256 * i; cv[i] = *(const u32x4*)(smem + (e >> 4) * 272 + (e & 15) * 16); }
#pragma unroll
        for (int i = 0; i < 16; ++i) { const int e = tid + 256 * i; *(u32x4*)(p.proj + (size_t)(m0 + (e >> 4)) * INW + n0 + (e & 15) * 8) = cv[i]; }
        __syncthreads();
    } else {
#pragma unroll 1
        for (int pass = 0; pass < 2; ++pass) {
            if (wm == pass) {
#pragma unroll
                for (int mi = 0; mi < 8; ++mi)
#pragma unroll
                    for (int ni = 0; ni < 4; ++ni) *(f32x4*)(smem + (mi * 16 + fr) * 528 + (wn * 64 + ni * 16 + fq * 4) * 4) = acc[mi][ni];
            }
            __syncthreads();
            const int rbase = m0 + pass * 128;
            const int c4 = (tid & 31) * 4;
            f32x4 ho[16];
#pragma unroll
            for (int i = 0; i < 16; ++i) {
                const int tok = rbase + (tid >> 5) + 8 * i;
                if (layer == 0) ho[i] = *(const f32x4*)((tok < NCTX ? p.x_prompt + (size_t)tok * DM : p.x_sample + (size_t)(tok - NCTX) * DM) + n0 + c4);
                else ho[i] = bf4_to_f32(*(const u32x2*)(p.h + (size_t)tok * DM + n0 + c4));
            }
            const int v = rbase < NCTX ? 0 : 1 + ((rbase - NCTX) >> 11);
            const f32x4 gt = *(const f32x4*)(p.modv + (size_t)(layer * 5 + v) * 3072 + 2048 + n0 + c4);
#pragma unroll
            for (int i = 0; i < 16; ++i) {
                const int row = (tid >> 5) + 8 * i, tok = rbase + row;
                const f32x4 a = *(const f32x4*)(smem + row * 528 + c4 * 4);
                const f32x4 r = ho[i] + gt * a;
                if (layer == 0) {
                    u32x2 w;
                    w.x = pk_bf16(r[0], r[1]);
                    w.y = pk_bf16(r[2], r[3]);
                    *(u32x2*)(p.h + (size_t)tok * DM + n0 + c4) = w;
                } else {
                    *(f32x4*)(p.out + (size_t)tok * DM + n0 + c4) = r;
                }
            }
            __syncthreads();
        }
    }
}

__device__ __forceinline__ void gemm_piece64_dma(const Params& p, int layer, int m0, int n0, unsigned char* smem) {
    const int tid = otid(), lane = tid & 63, wave = tid >> 6, wm = wave >> 1, wn = wave & 1;
    const int fr = lane & 15, fq = lane >> 4;
    const bf16_t* A = p.xn + (size_t)m0 * 1024;
    const bf16_t* B = p.WinT + (size_t)layer * INW * 1024 + (size_t)n0 * 1024;
    f32x4 acc[2][4];
#pragma unroll
    for (int i = 0; i < 2; ++i)
#pragma unroll
        for (int j = 0; j < 4; ++j) acc[i][j] = (f32x4){0.f, 0.f, 0.f, 0.f};
    const int lrow = lane >> 2, lc = (lane & 3) ^ ((4 - ((lane >> 4) & 3)) & 3);
    const bf16_t* agp = A + (size_t)(wave * 16 + lrow) * 1024 + lc * 8;
    const bf16_t* bgp = B + (size_t)(wave * 32 + lrow) * 1024 + lc * 8;
    LAS unsigned char* lbase = (LAS unsigned char*)smem;
    const int la_off = wave * 1024 + lane * 16, lb_off = 4096 + wave * 2048 + lane * 16;
    auto dma = [&](int kt, int stage) {
        LAS unsigned char* sb = lbase + stage * 12288;
        __builtin_amdgcn_global_load_lds((const void*)(agp + kt * 32), (LAS void*)(sb + la_off), 16, 0, 0);
#pragma unroll
        for (int i = 0; i < 2; ++i)
            __builtin_amdgcn_global_load_lds((const void*)(bgp + (size_t)i * 16 * 1024 + kt * 32), (LAS void*)(sb + lb_off + i * 1024), 16, 0, 0);
    };
    dma(0, 0);
    dma(1, 1);
    asm volatile("s_waitcnt vmcnt(3)" ::: "memory");
    __builtin_amdgcn_s_barrier();
    const int co = (fq ^ ((4 - ((fr >> 2) & 3)) & 3)) * 16;
    const int aro = (wm * 32 + fr) * 64 + co, bro = 4096 + (wn * 64 + fr) * 64 + co;
    int st = 0, st2 = 2;
    const unsigned lds0 = (unsigned)(uintptr_t)lbase;
#pragma unroll 1
    for (int kt = 0; kt < 32; ++kt) {
        const unsigned sa = lds0 + st * 12288 + aro, sbb = lds0 + st * 12288 + bro;
        bf16x8 af[2], bf[4];
#define FRAG_RD(dst, addr, OFF) asm volatile("ds_read_b128 %0, %1 offset:" #OFF : "=&v"(dst) : "v"(addr))
        FRAG_RD(bf[0], sbb, 0); FRAG_RD(bf[1], sbb, 1024); FRAG_RD(bf[2], sbb, 2048); FRAG_RD(bf[3], sbb, 3072);
        FRAG_RD(af[0], sa, 0); FRAG_RD(af[1], sa, 1024);
#undef FRAG_RD
        __builtin_amdgcn_sched_barrier(0);
        if (kt + 2 < 32) dma(kt + 2, st2);
        __builtin_amdgcn_sched_barrier(0);
        asm volatile("s_waitcnt lgkmcnt(0)" ::: "memory");
        __builtin_amdgcn_sched_barrier(0);
#pragma unroll
        for (int mi = 0; mi < 2; ++mi)
#pragma unroll
            for (int ni = 0; ni < 4; ++ni) acc[mi][ni] = __builtin_amdgcn_mfma_f32_16x16x32_bf16(bf[ni], af[mi], acc[mi][ni], 0, 0, 0);
        __builtin_amdgcn_sched_barrier(0);
        if (kt + 2 < 32) asm volatile("s_waitcnt vmcnt(3)" ::: "memory");
        else asm volatile("s_waitcnt vmcnt(0)" ::: "memory");
        __builtin_amdgcn_s_barrier();
        st = st == 2 ? 0 : st + 1;
        st2 = st2 == 2 ? 0 : st2 + 1;
    }
    gemm_epilogue<0, 2, 1>(p, layer, m0 + wm * 32, n0 + wn * 64, acc, fr, fq, smem, m0, n0);
    __syncthreads();
    u32x4 cv[4];
#pragma unroll
    for (int i = 0; i < 4; ++i) { const int e = tid + 256 * i; cv[i] = *(const u32x4*)(smem + (e >> 4) * 272 + (e & 15) * 16); }
#pragma unroll
    for (int i = 0; i < 4; ++i) { const int e = tid + 256 * i; *(u32x4*)(p.proj + (size_t)(m0 + (e >> 4)) * INW + n0 + (e & 15) * 8) = cv[i]; }
    __syncthreads();
}

template <int MODE>
__device__ __forceinline__ void phase_gemm(const Params& p, int layer, unsigned char* smem) {
    const int NT = MODE == 0 ? 22 : 8;
    const int total = 96 * NT;
    if (gridDim.x == 512) {
        const int xcd = blockIdx.x & 7, slot = blockIdx.x >> 3;
        if (MODE == 0) {
            for (int idx = slot; idx < 128; idx += 64) gemm_tile256_dma<MODE>(p, layer, xcd * 6 + idx % 6, idx / 6, smem);
            if (slot < 16) gemm_piece64_dma(p, layer, (xcd * 6 + 2 + (slot >> 2)) * 256 + (slot & 3) * 64, 21 * 128, smem);
        } else {
            if (slot < 32) gemm_tile256_dma<MODE>(p, layer, xcd * 6 + slot % 6, slot / 6, smem);
            else {
                const int d = 32 + ((slot - 32) >> 1);
                gemm_tile<MODE>(p, layer, (xcd * 6 + d % 6) * 2 + (slot & 1), d / 6, smem);
            }
        }
    } else {
        for (int t = blockIdx.x; t < total; t += gridDim.x) gemm_tile<MODE>(p, layer, t / NT, t % NT, smem);
    }
}

template <int VAR>
__device__ __forceinline__ void attn_unit(const Params& p, int layer, int unit, unsigned char* smem) {
    const int tid = otid(), lane = tid & 63, wave = tid >> 6;
    const int r31 = lane & 31, hh = lane >> 5;
    int b, head, qblk, tokbase, nself, ntiles;
    if (unit < 512) { b = unit >> 7; head = (unit >> 4) & 7; qblk = unit & 15; tokbase = NCTX + b * 2048; nself = 2048; ntiles = 36; }
    else { const int u = unit - 512; b = u >> 4; head = (u >> 1) & 7; qblk = u & 1; tokbase = b * 256; nself = 256; ntiles = 4; }
    const int kvh = head >> 2;
    const int qtok = tokbase + qblk * 128 + wave * 32 + r31;
    bf16x8 qf[4];
    {
        const bf16_t* qp = p.proj + (size_t)qtok * INW + head * 64 + hh * 8;
#pragma unroll
        for (int ks = 0; ks < 4; ++ks) qf[ks] = *(const bf16x8*)(qp + ks * 16);
    }
    const bf16_t* kself = p.proj + (size_t)tokbase * INW + 512 + kvh * 64;
    const bf16_t* vself = p.proj + (size_t)tokbase * INW + 640 + kvh * 64;
    const bf16_t* kcache = p.kc + (size_t)((b * 2 + layer) * 2 + kvh) * 256 * 64;
    const bf16_t* vcache = p.vc + (size_t)((b * 2 + layer) * 2 + kvh) * 256 * 64;
    const int srow = tid >> 3, scc = tid & 7;
    const int kwo = srow * 128 + ((scc ^ ((srow >> 1) & 7)) * 16);
    const int vwo = srow * 128 + ((scc ^ (((srow >> 1) & 1) << 2)) * 16);
    u32x4 rkA[2], rvA[2], rkB[2], rvB[2];
    auto gload = [&](int j, u32x4* rk, u32x4* rv) {
        const int key0 = j * 64;
#pragma unroll
        for (int i = 0; i < 2; ++i) {
            const int row = srow + 32 * i;
            if (key0 < nself) {
                rk[i] = *(const u32x4*)(kself + (size_t)(key0 + row) * INW + scc * 8);
                rv[i] = *(const u32x4*)(vself + (size_t)(key0 + row) * INW + scc * 8);
            } else {
                rk[i] = *(const u32x4*)(kcache + (size_t)(key0 - nself + row) * 64 + scc * 8);
                rv[i] = *(const u32x4*)(vcache + (size_t)(key0 - nself + row) * 64 + scc * 8);
            }
        }
    };
    auto swrite = [&](int buf, const u32x4* rk, const u32x4* rv) {
        unsigned char* kb = smem + buf * 16384;
        unsigned char* vb = kb + 8192;
#pragma unroll
        for (int i = 0; i < 2; ++i) {
            *(u32x4*)(kb + kwo + i * 32 * 128) = rk[i];
            *(u32x4*)(vb + vwo + i * 32 * 128) = rv[i];
        }
    };
    f32x16 o[2];
#pragma unroll
    for (int i = 0; i < 16; ++i) { o[0][i] = 0.f; o[1][i] = 0.f; }
    float mrun = 0.f, mmax = -1e30f, lrun = 0.f;
    f32x16 negm, zero16;
#pragma unroll
    for (int i = 0; i < 16; ++i) { negm[i] = 0.f; zero16[i] = 0.f; }
    bool shifted = false;
    gload(0, rkA, rvA);
    swrite(0, rkA, rvA);
    if (ntiles > 1) gload(1, rkB, rvB);
    __syncthreads();
    const int kro = r31 * 128, ksw = (r31 >> 1) & 7;
    const int vq = 4 * hh + ((lane & 15) >> 2);
    const int vsw = ((vq >> 1) & 1) << 2;
    const int vcl = ((lane >> 4) & 1) * 2 + ((lane & 3) >> 1);
    const int vro0 = vq * 128 + (((0 * 4 + vcl) ^ vsw) * 16) + (lane & 1) * 8;
    const int vro1 = vq * 128 + (((1 * 4 + vcl) ^ vsw) * 16) + (lane & 1) * 8;
    auto step = [&](int j, u32x4* lk, u32x4* lv, const u32x4* wk, const u32x4* wv) {
        const unsigned char* kb = smem + (j & 1) * 16384;
        const unsigned char* vb = kb + 8192;
        bf16x8 kf[2][4];
#pragma unroll
        for (int sb = 0; sb < 2; ++sb)
#pragma unroll
            for (int ks = 0; ks < 4; ++ks) kf[sb][ks] = *(const bf16x8*)(kb + sb * 4096 + kro + (((ks * 2 + hh) ^ ksw) * 16));
        bf16x8 vf[2][2][2];
#pragma unroll
        for (int sb = 0; sb < 2; ++sb)
#pragma unroll
            for (int s2 = 0; s2 < 2; ++s2)
#pragma unroll
                for (int dt = 0; dt < 2; ++dt) {
                    const LAS unsigned char* va = (const LAS unsigned char*)(vb) + (sb * 32 + s2 * 16) * 128 + (dt ? vro1 : vro0);
                    const s16x4 a0 = __builtin_amdgcn_ds_read_tr16_b64_v4i16((LAS s16x4*)(va));
                    const s16x4 a1 = __builtin_amdgcn_ds_read_tr16_b64_v4i16((LAS s16x4*)(va + 8 * 128));
                    vf[sb][s2][dt] = (bf16x8){a0[0], a0[1], a0[2], a0[3], a1[0], a1[1], a1[2], a1[3]};
                }
        if (VAR != 1 && j + 2 < ntiles) gload(j + 2, lk, lv);
        __builtin_amdgcn_sched_barrier(0);
        f32x16 s[2];
        float mloc, lsum = 0.f;
        bf16x8 pf[2][2];
#pragma unroll
        for (int sb = 0; sb < 2; ++sb)
#pragma unroll
            for (int ks = 0; ks < 4; ++ks) {
                if (ks == 0) {
                    if (shifted) s[sb] = __builtin_amdgcn_mfma_f32_32x32x16_bf16(kf[sb][ks], qf[ks], negm, 0, 0, 0);
                    else s[sb] = __builtin_amdgcn_mfma_f32_32x32x16_bf16(kf[sb][ks], qf[ks], zero16, 0, 0, 0);
                } else s[sb] = __builtin_amdgcn_mfma_f32_32x32x16_bf16(kf[sb][ks], qf[ks], s[sb], 0, 0, 0);
            }
#pragma unroll
        for (int sb = 0; sb < 2; ++sb) {
            float m0 = max3_f(s[sb][0], s[sb][1], s[sb][2]);
#pragma unroll
            for (int i = 3; i < 15; i += 2) m0 = max3_f(m0, s[sb][i], s[sb][i + 1]);
            m0 = fmaxf(m0, s[sb][15]);
            mloc = sb == 0 ? m0 : fmaxf(mloc, m0);
#pragma unroll
            for (int i = 0; i < 16; ++i) { if (VAR != 2) { s[sb][i] = __builtin_amdgcn_exp2f(s[sb][i]); lsum += s[sb][i]; } }
#pragma unroll
            for (int s2 = 0; s2 < 2; ++s2) {
                u32x4 pw;
                pw.x = pk_bf16(s[sb][s2 * 8 + 0], s[sb][s2 * 8 + 1]);
                pw.y = pk_bf16(s[sb][s2 * 8 + 2], s[sb][s2 * 8 + 3]);
                pw.z = pk_bf16(s[sb][s2 * 8 + 4], s[sb][s2 * 8 + 5]);
                pw.w = pk_bf16(s[sb][s2 * 8 + 6], s[sb][s2 * 8 + 7]);
                pf[sb][s2] = __builtin_bit_cast(bf16x8, pw);
            }
#pragma unroll
            for (int s2 = 0; s2 < 2; ++s2)
#pragma unroll
                for (int dt = 0; dt < 2; ++dt) o[dt] = __builtin_amdgcn_mfma_f32_32x32x16_bf16(vf[sb][s2][dt], pf[sb][s2], o[dt], 0, 0, 0);
        }
        lrun += lsum;
        __builtin_amdgcn_sched_barrier(0);
        mloc = fmaxf(mloc, __shfl_xor(mloc, 32));
        mmax = fmaxf(mmax, mrun + mloc);
        if (__builtin_expect(__any(fabsf(mmax - mrun) > 40.0f), 0)) {
            asm volatile("" ::: "memory");
            const float alpha = __builtin_amdgcn_exp2f(mrun - mmax);
            mrun = mmax;
            lrun *= alpha;
            shifted = true;
#pragma unroll
            for (int i = 0; i < 16; ++i) { o[0][i] *= alpha; o[1][i] *= alpha; negm[i] = -mrun; }
        }
        if (VAR != 1 && j + 1 < ntiles) swrite((j + 1) & 1, wk, wv);
        __syncthreads();
    };
    for (int j = 0; j < ntiles; j += 2) {
        step(j, rkA, rvA, rkB, rvB);
        step(j + 1, rkB, rvB, rkA, rvA);
    }
    const float ltot = lrun + __shfl_xor(lrun, 32);
    const float inv = 1.0f / ltot;
    const bf16_t* zp = p.proj + (size_t)qtok * INW + 768 + head * 64;
    bf16_t* mp = (VAR == 0 ? p.mix : p.xn) + (size_t)qtok * DM + head * 64;
#pragma unroll
    for (int dt = 0; dt < 2; ++dt)
#pragma unroll
        for (int rq = 0; rq < 4; ++rq) {
            const int d0 = dt * 32 + 8 * rq + 4 * hh;
            const u32x2 zz = *(const u32x2*)(zp + d0);
            const float z0 = bf_lo(zz.x), z1 = bf_hi(zz.x), z2 = bf_lo(zz.y), z3 = bf_hi(zz.y);
            u32x2 w;
            w.x = pk_bf16(o[dt][rq * 4 + 0] * inv * silu_f(z0), o[dt][rq * 4 + 1] * inv * silu_f(z1));
            w.y = pk_bf16(o[dt][rq * 4 + 2] * inv * silu_f(z2), o[dt][rq * 4 + 3] * inv * silu_f(z3));
            *(u32x2*)(mp + d0) = w;
        }
}

__device__ __forceinline__ void unpack8(const u32x4 u, float* f) {
    f[0] = bf_lo(u.x); f[1] = bf_hi(u.x); f[2] = bf_lo(u.y); f[3] = bf_hi(u.y);
    f[4] = bf_lo(u.z); f[5] = bf_hi(u.z); f[6] = bf_lo(u.w); f[7] = bf_hi(u.w);
}

template <int WIN>
__device__ __forceinline__ void pool_group(const Params& p, int layer, int T0, int toff, int seqlen, int gi, int fr, int fq, const bf16x8 (&wf)[4][2],
                                           const f32x4 (&ps)[4], const unsigned char* smem) {
    constexpr int HALF = WIN / 2;
    u32x2 zz[2][4];
#pragma unroll
    for (int mi = 0; mi < 2; ++mi)
#pragma unroll
        for (int ni = 0; ni < 4; ++ni) zz[mi][ni] = *(const u32x2*)(p.proj + (size_t)(T0 + mi * 16 + fr) * INW + 2560 + gi * 64 + ni * 16 + fq * 4);
#pragma unroll
    for (int mi = 0; mi < 2; ++mi) {
        const int tt = mi * 16 + fr, ts = toff + tt, tok = T0 + tt;
        int lo = ts - HALF, hi = ts - HALF + WIN - 1;
        lo = lo < 0 ? 0 : lo;
        hi = hi > seqlen - 1 ? seqlen - 1 : hi;
        const float rc = 1.0f / (float)(hi - lo + 1);
        f32x4 acc[4];
#pragma unroll
        for (int j = 0; j < 4; ++j) acc[j] = (f32x4){0.f, 0.f, 0.f, 0.f};
#pragma unroll
        for (int kk = 0; kk < 2; ++kk) {
            const int co = (gi * 64 + kk * 32 + fq * 8) * 2;
            u32x4 rw[WIN];
#pragma unroll
            for (int j = 0; j < WIN; ++j) rw[j] = *(const u32x4*)(smem + (tt + 8 - HALF + j) * 528 + co);
            const u32x4 self = *(const u32x4*)(smem + (tt + 8) * 528 + co);
            float sum[8];
#pragma unroll
            for (int e = 0; e < 8; ++e) sum[e] = 0.f;
#pragma unroll
            for (int j = 0; j < WIN; ++j) {
                const int sq = ts - HALF + j;
                const float m = (sq >= 0 && sq < seqlen) ? 1.0f : 0.0f;
                float f[8];
                unpack8(rw[j], f);
#pragma unroll
                for (int e = 0; e < 8; ++e) sum[e] = fmaf(f[e], m, sum[e]);
            }
            float us[8];
            unpack8(self, us);
            u32x4 dw;
            dw.x = pk_bf16(sum[0] * rc - us[0], sum[1] * rc - us[1]);
            dw.y = pk_bf16(sum[2] * rc - us[2], sum[3] * rc - us[3]);
            dw.z = pk_bf16(sum[4] * rc - us[4], sum[5] * rc - us[5]);
            dw.w = pk_bf16(sum[6] * rc - us[6], sum[7] * rc - us[7]);
            const bf16x8 df = __builtin_bit_cast(bf16x8, dw);
#pragma unroll
            for (int ni = 0; ni < 4; ++ni) acc[ni] = __builtin_amdgcn_mfma_f32_16x16x32_bf16(wf[ni][kk], df, acc[ni], 0, 0, 0);
        }
#pragma unroll
        for (int ni = 0; ni < 4; ++ni) {
            const int ch = gi * 64 + ni * 16 + fq * 4;
            u32x2 w;
            w.x = pk_bf16(acc[ni][0] * ps[ni][0] * silu_f(bf_lo(zz[mi][ni].x)), acc[ni][1] * ps[ni][1] * silu_f(bf_hi(zz[mi][ni].x)));
            w.y = pk_bf16(acc[ni][2] * ps[ni][2] * silu_f(bf_lo(zz[mi][ni].y)), acc[ni][3] * ps[ni][3] * silu_f(bf_hi(zz[mi][ni].y)));
            *(u32x2*)(p.mix + (size_t)tok * DM + 768 + ch) = w;
        }
    }
}

__device__ __forceinline__ void pool_item(const Params& p, int layer, int pi, unsigned char* smem) {
    const int tid = otid(), lane = tid & 63, gi = tid >> 6;
    const int fr = lane & 15, fq = lane >> 4;
    const int T0 = pi * 32;
    int seqstart, seqlen;
    if (T0 < NCTX) { seqstart = T0 & ~255; seqlen = 256; } else { seqstart = NCTX + ((T0 - NCTX) & ~2047); seqlen = 2048; }
    const int toff = T0 - seqstart;
    u32x4 st[6];
#pragma unroll
    for (int i = 0; i < 6; ++i) {
        const int e = tid + 256 * i, r = e >> 5, c = e & 31;
        int sq = toff - 8 + r;
        sq = sq < 0 ? 0 : (sq > seqlen - 1 ? seqlen - 1 : sq);
        if (e < 47 * 32) st[i] = *(const u32x4*)(p.proj + (size_t)(seqstart + sq) * INW + 2304 + c * 8);
    }
    bf16x8 wf[4][2];
    f32x4 ps[4];
    {
        const bf16_t* wp = p.PoolT + (size_t)((layer * 4 + gi) * 64) * 64;
#pragma unroll
        for (int ni = 0; ni < 4; ++ni) {
#pragma unroll
            for (int kk = 0; kk < 2; ++kk) wf[ni][kk] = *(const bf16x8*)(wp + (ni * 16 + fr) * 64 + kk * 32 + fq * 8);
            ps[ni] = *(const f32x4*)(p.pool_scale + layer * 256 + gi * 64 + ni * 16 + fq * 4);
        }
    }
#pragma unroll
    for (int i = 0; i < 6; ++i) {
        const int e = tid + 256 * i, r = e >> 5, c = e & 31;
        if (e < 47 * 32) *(u32x4*)(smem + r * 528 + c * 16) = st[i];
    }
    __syncthreads();
    if (gi == 0) pool_group<2>(p, layer, T0, toff, seqlen, gi, fr, fq, wf, ps, smem);
    else if (gi == 1) pool_group<4>(p, layer, T0, toff, seqlen, gi, fr, fq, wf, ps, smem);
    else if (gi == 2) pool_group<8>(p, layer, T0, toff, seqlen, gi, fr, fq, wf, ps, smem);
    else pool_group<16>(p, layer, T0, toff, seqlen, gi, fr, fq, wf, ps, smem);
    __syncthreads();
}

__device__ __forceinline__ void conv_item(const Params& p, int layer, int ci) {
    const int tid = otid();
    const int ch = (tid & 31) * 8, tg = tid >> 5;
    const int T0 = ci * 32 + tg * 4;
    int seqstart, seqlen;
    if (T0 < NCTX) { seqstart = T0 & ~255; seqlen = 256; } else { seqstart = NCTX + ((T0 - NCTX) & ~2047); seqlen = 2048; }
    const int seqend = seqstart + seqlen;
    u32x4 rh[6], rc[6], rb[4], rz[4];
#pragma unroll
    for (int i = 0; i < 6; ++i) {
        int tok = T0 - 1 + i;
        tok = tok < seqstart ? seqstart : (tok > seqend - 1 ? seqend - 1 : tok);
        rh[i] = *(const u32x4*)(p.proj + (size_t)tok * INW + 1280 + ch);
        rc[i] = *(const u32x4*)(p.proj + (size_t)tok * INW + 1792 + ch);
    }
#pragma unroll
    for (int i = 0; i < 4; ++i) {
        rb[i] = *(const u32x4*)(p.proj + (size_t)(T0 + i) * INW + 1536 + ch);
        rz[i] = *(const u32x4*)(p.proj + (size_t)(T0 + i) * INW + 2048 + ch);
    }
    f32x4 wv[8];
    {
        const float* cw = p.conv_w + (size_t)layer * 768 + ch;
#pragma unroll
        for (int r = 0; r < 3; ++r) { wv[r * 2] = *(const f32x4*)(cw + r * 256); wv[r * 2 + 1] = *(const f32x4*)(cw + r * 256 + 4); }
        wv[6] = *(const f32x4*)(p.conv_b + layer * 256 + ch);
        wv[7] = *(const f32x4*)(p.conv_b + layer * 256 + ch + 4);
    }
    float x[6][8];
#pragma unroll
    for (int i = 0; i < 6; ++i) {
        const int tok = T0 - 1 + i;
        const float valid = (tok >= seqstart && tok < seqend) ? 1.0f : 0.0f;
        float hc[8], cc[8];
        unpack8(rh[i], hc);
        unpack8(rc[i], cc);
#pragma unroll
        for (int e = 0; e < 8; ++e) x[i][e] = hc[e] * cc[e] * valid;
    }
#pragma unroll
    for (int t = 0; t < 4; ++t) {
        float bc[8], zc[8], o[8];
        unpack8(rb[t], bc);
        unpack8(rz[t], zc);
#pragma unroll
        for (int e = 0; e < 8; ++e) {
            const float y = x[t][e] * wv[e >> 2][e & 3] + x[t + 1][e] * wv[2 + (e >> 2)][e & 3] + x[t + 2][e] * wv[4 + (e >> 2)][e & 3] + wv[6 + (e >> 2)][e & 3];
            o[e] = bc[e] * y * silu_f(zc[e]);
        }
        u32x4 w;
        w.x = pk_bf16(o[0], o[1]); w.y = pk_bf16(o[2], o[3]); w.z = pk_bf16(o[4], o[5]); w.w = pk_bf16(o[6], o[7]);
        *(u32x4*)(p.mix + (size_t)(T0 + t) * DM + 512 + ch) = w;
    }
}

__device__ __forceinline__ void phase_mixer(const Params& p, int layer, unsigned char* smem) {
    if (gridDim.x == 512) {
        const int b = blockIdx.x;
        attn_unit<0>(p, layer, b, smem);
        if (b < 256) {
            attn_unit<0>(p, layer, 512 + b, smem);
        } else {
#pragma unroll 1
            for (int k = 0; k < 3; ++k) {
                const int idx = (b - 256) + 256 * k;
                if (idx < 384) pool_item(p, layer, idx, smem);
                else conv_item(p, layer, idx - 384);
            }
        }
    } else {
        for (int it = blockIdx.x; it < 768 + 384 + 384; it += gridDim.x) {
            if (it < 768) attn_unit<0>(p, layer, it, smem);
            else if (it < 1152) pool_item(p, layer, it - 768, smem);
            else conv_item(p, layer, it - 1152);
        }
    }
}

__global__ void __launch_bounds__(256, 2) mega(Params p, int lo, int hi) {
    __shared__ __attribute__((aligned(16))) unsigned char smem[73728];
    __shared__ uint4 xbw;
    if (p.use_cg) cg::this_grid().sync();
    if (threadIdx.x == 0) xbw = make_uint4(0u, 0u, 0u, 0u);
    __syncthreads();
    XcdBarrier xb = xcd_barrier_post(p.bar, (volatile LAS unsigned*)&xbw);
    for (int ph = lo; ph < hi; ++ph) {
        if (ph > lo) xcd_barrier(xb);
        if (ph == 0) phase_prep(p, smem);
        else if (ph == 9) phase_final(p);
        else {
            const int layer = (ph - 1) >> 2, ty = (ph - 1) & 3;
            if (ty == 0) phase_xn(p, layer);
            else if (ty == 1) phase_gemm<0>(p, layer, smem);
            else if (ty == 2) phase_mixer(p, layer, smem);
            else phase_gemm<1>(p, layer, smem);
        }
    }
}

#ifndef MK_MULTI
#define MK_MULTI 0
#endif

extern "C" void kernel_launch(void* const* d_in, const int* in_sizes, int n_in, void* d_out, int out_size, void* d_ws, size_t ws_size,
                              hipStream_t stream) {
    static int grid_blocks = 0;
    if (!grid_blocks) {
        int dev = 0, cus = 0, per_cu = 0;
        hipGetDevice(&dev);
        hipDeviceGetAttribute(&cus, hipDeviceAttributeMultiprocessorCount, dev);
        hipOccupancyMaxActiveBlocksPerMultiprocessor(&per_cu, mega, 256, 0);
        if (per_cu > 2) per_cu = 2;
        if (per_cu < 1) per_cu = 1;
        grid_blocks = cus * per_cu;
    }
    Params p{};
    const float* const* in = (const float* const*)d_in;
    p.x_prompt = in[0]; p.x_sample = in[1]; p.cache_k = in[2]; p.cache_v = in[3]; p.c = in[4]; p.c_ctx = in[5]; p.norm_g = in[6];
    p.w_ada = in[7]; p.b_ada = in[8]; p.w_in = in[9]; p.q_g = in[10]; p.k_g = in[11]; p.conv_w = in[12]; p.conv_b = in[13];
    p.pool_w = in[14]; p.pool_scale = in[15]; p.w_out = in[16]; p.final_g = in[17];
    p.out = (float*)d_out;
    unsigned char* ws = (unsigned char*)d_ws;
    size_t off = 0;
    auto take = [&](size_t bytes) { unsigned char* r = ws + off; off += (bytes + 255) & ~(size_t)255; return r; };
    p.bar = (unsigned*)take(XCD_BAR_WORDS * 4);
    p.modv = (float*)take(2 * 5 * 3072 * 4);
    p.rope = (float*)take(2048 * 4);
    p.WinT = (bf16_t*)take((size_t)2 * INW * 1024 * 2);
    p.WoutT = (bf16_t*)take((size_t)2 * 1024 * 1024 * 2);
    p.PoolT = (bf16_t*)take(2 * 4 * 64 * 64 * 2);
    p.kc = (bf16_t*)take(262144 * 2);
    p.vc = (bf16_t*)take(262144 * 2);
    p.h = (bf16_t*)take((size_t)NTOK * DM * 2);
    p.xn = (bf16_t*)take((size_t)NTOK * DM * 2);
    p.proj = (bf16_t*)take((size_t)NTOK * INW * 2);
    p.mix = (bf16_t*)take((size_t)NTOK * DM * 2);
    p.use_cg = 0;
    p.pad = 0;
    hipMemsetAsync(p.bar, 0, XCD_BAR_WORDS * 4, stream);
#if MK_MULTI
    for (int ph = 0; ph < 10; ++ph) {
        int lo = ph, hi = ph + 1;
        void* args[] = {&p, &lo, &hi};
        hipError_t e = hipLaunchCooperativeKernel((void*)mega, dim3(grid_blocks), dim3(256), args, 0, stream);
        if (e != hipSuccess) fprintf(stderr, "launch failed: %s\n", hipGetErrorString(e));
    }
#else
    int lo = 0, hi = 10;
    void* args[] = {&p, &lo, &hi};
    hipError_t e = hipLaunchCooperativeKernel((void*)mega, dim3(grid_blocks), dim3(256), args, 0, stream);
    if (e != hipSuccess) fprintf(stderr, "cooperative launch failed: %s (grid %d)\n", hipGetErrorString(e), grid_blocks);
#endif
}
```

```cpp
#include <hip/hip_runtime.h>
#include <hip/hip_cooperative_groups.h>
#include <cstdint>
#include <cstdio>
namespace cg = cooperative_groups;

#define LAS __attribute__((address_space(3)))
typedef unsigned short bf16_t;
typedef short bf16x8 __attribute__((ext_vector_type(8)));
typedef short s16x4 __attribute__((ext_vector_type(4)));
typedef float f32x4 __attribute__((ext_vector_type(4)));
typedef float f32x16 __attribute__((ext_vector_type(16)));
typedef unsigned u32x4 __attribute__((ext_vector_type(4)));
typedef unsigned u32x2 __attribute__((ext_vector_type(2)));

constexpr int NTOK = 12288, NCTX = 4096, DM = 1024, INW = 2816;
constexpr size_t OUT_NK = 12582912, OUT_NV = 13631488;
constexpr float EPSF = 1e-6f;
constexpr float QSCALE = 0.125f * 1.4426950408889634f;

struct Params {
    const float *x_prompt, *x_sample, *cache_k, *cache_v, *c, *c_ctx, *norm_g, *w_ada, *b_ada, *w_in, *q_g, *k_g, *conv_w, *conv_b,
        *pool_w, *pool_scale, *w_out, *final_g;
    float* out;
    unsigned* bar;
    float* modv;
    float* rope;
    bf16_t* WinT;
    bf16_t* WoutT;
    bf16_t* PoolT;
    bf16_t* kc;
    bf16_t* vc;
    bf16_t* h;
    bf16_t* xn;
    bf16_t* proj;
    bf16_t* mix;
    int use_cg;
    int pad;
};

__device__ __forceinline__ unsigned pk_bf16(float lo, float hi) {
    unsigned r;
    asm("v_cvt_pk_bf16_f32 %0, %1, %2" : "=v"(r) : "v"(lo), "v"(hi));
    return r;
}
__device__ __forceinline__ float bf_lo(unsigned u) { return __uint_as_float(u << 16); }
__device__ __forceinline__ float bf_hi(unsigned u) { return __uint_as_float(u & 0xffff0000u); }
__device__ __forceinline__ float silu_f(float z) { return z / (1.0f + __expf(-z)); }
__device__ __forceinline__ f32x4 bf4_to_f32(const u32x2 u) { return (f32x4){bf_lo(u.x), bf_hi(u.x), bf_lo(u.y), bf_hi(u.y)}; }
__device__ __forceinline__ float max3_f(float a, float b, float c) { float r; asm("v_max3_f32 %0, %1, %2, %3" : "=v"(r) : "v"(a), "v"(b), "v"(c)); return r; }
__device__ __forceinline__ int otid() { int t = threadIdx.x; asm volatile("" : "+v"(t)); return t; }

#define XB_TMO 128
#define XB_XCNT(j) (256 + 64 * (j))
#define XB_XSUB(j) (1280 + 64 * (j))
#define XB_XGEN(j) (2304 + 64 * (j))
#define XB_TOP 3328
#define XB_TOPGEN 3392
#define XCD_BAR_WORDS 3456
#define XB_SPIN_CAP (1u << 20)

__device__ __forceinline__ unsigned xb_ld(unsigned* p) { return __hip_atomic_load(p, __ATOMIC_RELAXED, __HIP_MEMORY_SCOPE_AGENT); }
__device__ __forceinline__ unsigned xb_add(unsigned* p, unsigned v) { return __hip_atomic_fetch_add(p, v, __ATOMIC_RELAXED, __HIP_MEMORY_SCOPE_AGENT); }
__device__ __forceinline__ unsigned xb_xcc_id() { return (unsigned)__builtin_amdgcn_s_getreg((3 << 11) | 20) & 0xFu; }
#define XB_SPIN(cond, bar)                                                   \
    do {                                                                     \
        unsigned _sp = 0;                                                    \
        while (cond) {                                                       \
            __builtin_amdgcn_s_sleep(1);                                     \
            if ((++_sp & 255u) == 0u) {                                      \
                if (xb_ld(&(bar)[XB_TMO])) break;                            \
                if (_sp > XB_SPIN_CAP) { atomicAdd(&(bar)[XB_TMO], 1u); break; } \
            }                                                                \
        }                                                                    \
    } while (0)

struct XcdBarrier {
    unsigned* bar;
    unsigned x;
    volatile LAS unsigned* st;
};

__device__ __forceinline__ XcdBarrier xcd_barrier_post(unsigned* bar, volatile LAS unsigned* st) {
    XcdBarrier b;
    b.bar = bar;
    b.x = xb_xcc_id();
    b.st = st;
    if (threadIdx.x == 0) (void)xb_add(&bar[XB_XCNT(b.x)], 1u);
    return b;
}
__device__ __forceinline__ void xcd_barrier_complete(unsigned* bar, unsigned x, unsigned& nloc, unsigned& nx) {
    const unsigned G = gridDim.x * gridDim.y * gridDim.z;
    unsigned sum, cnt, mine, sp = 0u;
    for (;;) {
        sum = 0u; cnt = 0u; mine = 0u;
#pragma unroll
        for (unsigned j = 0; j < 16; ++j) {
            const unsigned c = xb_ld(&bar[XB_XCNT(j)]);
            sum += c; cnt += (c > 0u) ? 1u : 0u; mine = (j == x) ? c : mine;
        }
        if (sum == G) break;
        __builtin_amdgcn_s_sleep(1);
        if ((++sp & 255u) == 0u) {
            if (xb_ld(&bar[XB_TMO])) break;
            if (sp > XB_SPIN_CAP) { atomicAdd(&bar[XB_TMO], 1u); break; }
        }
    }
    nloc = mine > 0u ? mine : 1u;
    nx = cnt > 0u ? cnt : 1u;
}
__device__ __forceinline__ void xcd_barrier(const XcdBarrier& b) {
    asm volatile("s_waitcnt vmcnt(0)" ::: "memory");
    __syncthreads();
    if (threadIdx.x == 0) {
        unsigned* bar = b.bar;
        __builtin_amdgcn_s_waitcnt(0);
        unsigned nloc = b.st[0], nx = b.st[1];
        if (nloc == 0u) { xcd_barrier_complete(bar, b.x, nloc, nx); b.st[0] = nloc; b.st[1] = nx; }
        const unsigned old = xb_add(&bar[XB_XSUB(b.x)], 1u);
        const unsigned gen = old / nloc;
        if (old + 1u == (gen + 1u) * nloc) {
            __builtin_amdgcn_fence(__ATOMIC_RELEASE, "agent");
            asm volatile("s_waitcnt vmcnt(0)" ::: "memory");
            const unsigned og = xb_add(&bar[XB_TOP], 1u);
            const unsigned tg = og / nx;
            if (og + 1u == (tg + 1u) * nx) xb_add(&bar[XB_TOPGEN], 1u);
            else XB_SPIN(xb_ld(&bar[XB_TOPGEN]) == tg, bar);
            __builtin_amdgcn_fence(__ATOMIC_ACQUIRE, "agent");
            xb_add(&bar[XB_XGEN(b.x)], 1u);
            asm volatile("s_waitcnt vmcnt(0)" ::: "memory");
        } else {
            XB_SPIN(xb_ld(&bar[XB_XGEN(b.x)]) == gen, bar);
            __builtin_amdgcn_fence(__ATOMIC_ACQUIRE, "agent");
            asm volatile("s_waitcnt vmcnt(0)" ::: "memory");
        }
    }
    __syncthreads();
}

__device__ __forceinline__ void prep_mod_item(const Params& p, int item, unsigned char* smem) {
    const int tid = otid();
    float* sc = (float*)smem;
    float* red = (float*)(smem + 20480);
    const int l = item / 96, j0 = (item % 96) * 32;
    for (int idx = tid; idx < 5120; idx += 256) {
        const int v = idx >> 10, k = idx & 1023;
        const float cv = (v == 0) ? p.c_ctx[k] : p.c[(v - 1) * 1024 + k];
        sc[idx] = cv / (1.0f + expf(-cv));
    }
    __syncthreads();
    const int cgp = tid & 7, kg = tid >> 3;
    float acc[5][4];
#pragma unroll
    for (int v = 0; v < 5; ++v)
#pragma unroll
        for (int e = 0; e < 4; ++e) acc[v][e] = 0.f;
    const float* wp = p.w_ada + (size_t)l * 1024 * 3072 + j0 + cgp * 4;
    f32x4 wreg[32];
#pragma unroll
    for (int kk = 0; kk < 32; ++kk) wreg[kk] = *(const f32x4*)(wp + (size_t)(kk * 32 + kg) * 3072);
#pragma unroll
    for (int kk = 0; kk < 32; ++kk) {
        const int k = kk * 32 + kg;
        const f32x4 w = wreg[kk];
#pragma unroll
        for (int v = 0; v < 5; ++v) {
            const float s = sc[v * 1024 + k];
#pragma unroll
            for (int e = 0; e < 4; ++e) acc[v][e] += s * w[e];
        }
    }
#pragma unroll
    for (int v = 0; v < 5; ++v)
#pragma unroll
        for (int e = 0; e < 4; ++e) red[kg * 160 + v * 32 + cgp * 4 + e] = acc[v][e];
    __syncthreads();
    if (tid < 160) {
        float s = 0.f;
        for (int g = 0; g < 32; ++g) s += red[g * 160 + tid];
        const int v = tid >> 5, cc = tid & 31;
        p.modv[(size_t)(l * 5 + v) * 3072 + j0 + cc] = s + p.b_ada[l * 3072 + j0 + cc];
    }
    __syncthreads();
}

__device__ __forceinline__ void prep_transpose_item(const float* src, bf16_t* dst, int N, int k0, int n0) {
    const int n = n0 + otid();
    const float* sp = src + (size_t)k0 * N + n;
    float v[32];
#pragma unroll
    for (int i = 0; i < 32; ++i) v[i] = sp[(size_t)i * N];
    bf16_t* d = dst + (size_t)n * 1024 + k0;
#pragma unroll
    for (int c = 0; c < 4; ++c) {
        u32x4 w;
        w.x = pk_bf16(v[c * 8 + 0], v[c * 8 + 1]);
        w.y = pk_bf16(v[c * 8 + 2], v[c * 8 + 3]);
        w.z = pk_bf16(v[c * 8 + 4], v[c * 8 + 5]);
        w.w = pk_bf16(v[c * 8 + 6], v[c * 8 + 7]);
        *(u32x4*)(d + c * 8) = w;
    }
}

__device__ __forceinline__ void phase_prep(const Params& p, unsigned char* smem) {
    const int ntb = (int)gridDim.x * 5 / 8, nmb = (int)gridDim.x - ntb;
    const int NTI = 2 * 11 * 32, NTO = 2 * 4 * 32;
    if ((int)blockIdx.x < ntb) {
        for (int it = blockIdx.x; it < NTI + NTO; it += ntb) {
            if (it < NTI) {
                const int l = it / 352, r = it % 352, kt = r / 11, nt = r % 11;
                prep_transpose_item(p.w_in + (size_t)l * 1024 * INW, p.WinT + (size_t)l * INW * 1024, INW, kt * 32, nt * 256);
            } else {
                const int t = it - NTI, l = t / 128, r = t % 128, kt = r / 4, nt = r % 4;
                prep_transpose_item(p.w_out + (size_t)l * 1024 * 1024, p.WoutT + (size_t)l * 1024 * 1024, 1024, kt * 32, nt * 256);
            }
        }
    } else {
        for (int it = (int)blockIdx.x - ntb; it < 192; it += nmb) prep_mod_item(p, it, smem);
    }
    const int gsz = gridDim.x * 256;
    for (int i = blockIdx.x * 256 + otid(); i < 131072; i += gsz) {
        const int which = i >> 16, j4 = (i & 65535) * 4;
        const int d = j4 & 63, t = (j4 >> 6) & 255, kvh = (j4 >> 14) & 1, bl = j4 >> 15;
        const size_t si = ((size_t)(bl * 256 + t) * 2 + kvh) * 64 + d;
        const f32x4 v = *(const f32x4*)((which ? p.cache_v : p.cache_k) + si);
        u32x2 w;
        w.x = pk_bf16(v[0], v[1]);
        w.y = pk_bf16(v[2], v[3]);
        *(u32x2*)((which ? p.vc : p.kc) + j4) = w;
    }
    for (int j = blockIdx.x * 256 + otid(); j < 32768; j += gsz) {
        const int cc = j & 63, d = (j >> 6) & 63, lg = j >> 12;
        const float v = p.pool_w[((size_t)lg * 64 + cc) * 64 + d];
        p.PoolT[j] = (bf16_t)(pk_bf16(v, 0.f) & 0xffffu);
    }
    for (int j = blockIdx.x * 256 + otid(); j < 1024; j += gsz) {
        const int a = j & 15, r = j >> 4;
        const float inv = 1.0f / powf(10000.0f, (float)(2 * a) / 32.0f);
        const float ang = (float)r * inv;
        const float kf = rintf(ang * 0.15915494309189535f);
        float rr = fmaf(-kf, 6.2831854820251465f, ang);
        rr = fmaf(-kf, -1.7484555e-7f, rr);
        p.rope[j] = cosf(rr);
        p.rope[1024 + j] = sinf(rr);
    }
}

__device__ __forceinline__ float wave_sum(float v) {
#pragma unroll
    for (int o = 32; o >= 1; o >>= 1) v += __shfl_xor(v, o);
    return v;
}

__device__ __forceinline__ void phase_xn(const Params& p, int layer) {
    const int tid = otid(), lane = tid & 63, wave = tid >> 6;
    const int nw = gridDim.x * 4, w = blockIdx.x * 4 + wave;
    for (int t0 = w * 6; t0 < NTOK; t0 += nw * 6) {
        f32x4 x[6][4];
        if (layer == 0) {
#pragma unroll
            for (int u = 0; u < 6; ++u) {
                const int tok = t0 + u;
                const float* src = tok < NCTX ? p.x_prompt + (size_t)tok * DM : p.x_sample + (size_t)(tok - NCTX) * DM;
#pragma unroll
                for (int i = 0; i < 4; ++i) x[u][i] = *(const f32x4*)(src + i * 256 + lane * 4);
            }
        } else {
            u32x2 r[6][4];
#pragma unroll
            for (int u = 0; u < 6; ++u)
#pragma unroll
                for (int i = 0; i < 4; ++i) r[u][i] = *(const u32x2*)(p.h + (size_t)(t0 + u) * DM + i * 256 + lane * 4);
#pragma unroll
            for (int u = 0; u < 6; ++u)
#pragma unroll
                for (int i = 0; i < 4; ++i) x[u][i] = bf4_to_f32(r[u][i]);
        }
#pragma unroll
        for (int u = 0; u < 6; ++u) {
            const int tok = t0 + u;
            const int v = tok < NCTX ? 0 : 1 + ((tok - NCTX) >> 11);
            const float* mv = p.modv + (size_t)(layer * 5 + v) * 3072;
            float ss = 0.f;
#pragma unroll
            for (int i = 0; i < 4; ++i) ss += x[u][i][0] * x[u][i][0] + x[u][i][1] * x[u][i][1] + x[u][i][2] * x[u][i][2] + x[u][i][3] * x[u][i][3];
            ss = wave_sum(ss);
            const float rstd = rsqrtf(ss * (1.0f / 1024.0f) + EPSF);
#pragma unroll
            for (int i = 0; i < 4; ++i) {
                const int k = i * 256 + lane * 4;
                const f32x4 g = *(const f32x4*)(p.norm_g + layer * 1024 + k);
                const f32x4 sh = *(const f32x4*)(mv + k);
                const f32x4 sc = *(const f32x4*)(mv + 1024 + k);
                float o[4];
#pragma unroll
                for (int e = 0; e < 4; ++e) o[e] = x[u][i][e] * rstd * g[e] * (1.0f + sc[e]) + sh[e];
                u32x2 wv;
                wv.x = pk_bf16(o[0], o[1]);
                wv.y = pk_bf16(o[2], o[3]);
                *(u32x2*)(p.xn + (size_t)tok * DM + k) = wv;
            }
        }
    }
}

__device__ __forceinline__ void phase_final(const Params& p) {
    const int tid = otid(), lane = tid & 63, wave = tid >> 6;
    const int nw = gridDim.x * 4, w = blockIdx.x * 4 + wave;
    f32x4 g[4];
#pragma unroll
    for (int i = 0; i < 4; ++i) g[i] = *(const f32x4*)(p.final_g + i * 256 + lane * 4);
    for (int t0 = w * 6; t0 < NTOK; t0 += nw * 6) {
        u32x2 r[6][4];
#pragma unroll
        for (int u = 0; u < 6; ++u)
#pragma unroll
            for (int i = 0; i < 4; ++i) r[u][i] = *(const u32x2*)(p.xn + (size_t)(t0 + u) * DM + i * 256 + lane * 4);
#pragma unroll
        for (int u = 0; u < 6; ++u) {
            float* row = p.out + (size_t)(t0 + u) * DM;
            f32x4 x[4];
            float ss = 0.f;
#pragma unroll
            for (int i = 0; i < 4; ++i) {
                x[i] = bf4_to_f32(r[u][i]);
                ss += x[i][0] * x[i][0] + x[i][1] * x[i][1] + x[i][2] * x[i][2] + x[i][3] * x[i][3];
            }
            ss = wave_sum(ss);
            const float rstd = rsqrtf(ss * (1.0f / 1024.0f) + EPSF);
#pragma unroll
            for (int i = 0; i < 4; ++i) *(f32x4*)(row + i * 256 + lane * 4) = x[i] * rstd * g[i];
        }
    }
}

template <int MODE, int MI, int STG = 0>
__device__ __forceinline__ void gemm_epilogue(const Params& p, int layer, int mw, int nw, f32x4 (&acc)[MI][4], int fr, int fq,
                                              unsigned char* ct = nullptr, int m0t = 0, int n0t = 0) {
    if (MODE == 0) {
        const bool ctx = mw < NCTX;
        if (nw < 640) {
            const bool isq = nw < 512;
            const float* gp = (isq ? p.q_g : p.k_g) + layer * 64;
            f32x4 gv[4];
#pragma unroll
            for (int ni = 0; ni < 4; ++ni) gv[ni] = *(const f32x4*)(gp + ni * 16 + fq * 4);
#pragma unroll
            for (int mi = 0; mi < MI; ++mi) {
                const int tok = mw + mi * 16 + fr;
                float ss = 0.f;
#pragma unroll
                for (int ni = 0; ni < 4; ++ni)
#pragma unroll
                    for (int e = 0; e < 4; ++e) ss += acc[mi][ni][e] * acc[mi][ni][e];
                ss += __shfl_xor(ss, 16);
                ss += __shfl_xor(ss, 32);
                const float rstd = rsqrtf(ss * (1.0f / 64.0f) + EPSF);
                f32x4 val[4];
#pragma unroll
                for (int ni = 0; ni < 4; ++ni) val[ni] = acc[mi][ni] * rstd * gv[ni];
                if (!isq && ctx) {
                    float* nk = p.out + OUT_NK + ((size_t)((tok >> 8) * 2 + layer) * 256 + (tok & 255)) * 128 + (nw - 512) + fq * 4;
#pragma unroll
                    for (int ni = 0; ni < 4; ++ni) *(f32x4*)(nk + ni * 16) = val[ni];
                }
                if (!ctx) {
                    const int pos = (tok - NCTX) & 2047, prow = pos >> 6, pcol = pos & 63;
                    const f32x4 cr = *(const f32x4*)(p.rope + prow * 16 + fq * 4), sr = *(const f32x4*)(p.rope + 1024 + prow * 16 + fq * 4);
                    const f32x4 cc = *(const f32x4*)(p.rope + pcol * 16 + fq * 4), sn = *(const f32x4*)(p.rope + 1024 + pcol * 16 + fq * 4);
                    const f32x4 a0 = val[0], a1 = val[1], a2 = val[2], a3 = val[3];
                    val[0] = a0 * cr - a1 * sr;
                    val[1] = a1 * cr + a0 * sr;
                    val[2] = a2 * cc - a3 * sn;
                    val[3] = a3 * cc + a2 * sn;
                }
                if (isq) {
#pragma unroll
                    for (int ni = 0; ni < 4; ++ni) val[ni] = val[ni] * QSCALE;
                }
                bf16_t* pr = p.proj + (size_t)tok * INW + nw + fq * 4;
#pragma unroll
                for (int ni = 0; ni < 4; ++ni) {
                    u32x2 w;
                    w.x = pk_bf16(val[ni][0], val[ni][1]);
                    w.y = pk_bf16(val[ni][2], val[ni][3]);
                    if (STG) *(u32x2*)(ct + (tok - m0t) * 272 + (nw - n0t + fq * 4 + ni * 16) * 2) = w;
                    else *(u32x2*)(pr + ni * 16) = w;
                }
            }
        } else {
            const bool isv = nw < 768;
#pragma unroll
            for (int mi = 0; mi < MI; ++mi) {
                const int tok = mw + mi * 16 + fr;
                bf16_t* pr = p.proj + (size_t)tok * INW + nw + fq * 4;
#pragma unroll
                for (int ni = 0; ni < 4; ++ni) {
                    u32x2 w;
                    w.x = pk_bf16(acc[mi][ni][0], acc[mi][ni][1]);
                    w.y = pk_bf16(acc[mi][ni][2], acc[mi][ni][3]);
                    if (STG) *(u32x2*)(ct + (tok - m0t) * 272 + (nw - n0t + fq * 4 + ni * 16) * 2) = w;
                    else *(u32x2*)(pr + ni * 16) = w;
                }
                if (isv && ctx) {
                    float* nv = p.out + OUT_NV + ((size_t)((tok >> 8) * 2 + layer) * 256 + (tok & 255)) * 128 + (nw - 640) + fq * 4;
#pragma unroll
                    for (int ni = 0; ni < 4; ++ni) *(f32x4*)(nv + ni * 16) = acc[mi][ni];
                }
            }
        }
    } else {
        const int v = mw < NCTX ? 0 : 1 + ((mw - NCTX) >> 11);
        const float* gate = p.modv + (size_t)(layer * 5 + v) * 3072 + 2048 + nw + fq * 4;
        f32x4 gt[4];
#pragma unroll
        for (int ni = 0; ni < 4; ++ni) gt[ni] = *(const f32x4*)(gate + ni * 16);
#pragma unroll
        for (int mi = 0; mi < MI; ++mi) {
            const int tok = mw + mi * 16 + fr;
            const size_t eo = (size_t)tok * DM + nw + fq * 4;
            const float* xin = (tok < NCTX ? p.x_prompt + (size_t)tok * DM : p.x_sample + (size_t)(tok - NCTX) * DM) + nw + fq * 4;
#pragma unroll
            for (int ni = 0; ni < 4; ++ni) {
                if (layer == 0) {
                    const f32x4 r = *(const f32x4*)(xin + ni * 16) + gt[ni] * acc[mi][ni];
                    u32x2 w;
                    w.x = pk_bf16(r[0], r[1]);
                    w.y = pk_bf16(r[2], r[3]);
                    *(u32x2*)(p.h + eo + ni * 16) = w;
                } else {
                    const f32x4 r = bf4_to_f32(*(const u32x2*)(p.h + eo + ni * 16)) + gt[ni] * acc[mi][ni];
                    u32x2 w;
                    w.x = pk_bf16(r[0], r[1]);
                    w.y = pk_bf16(r[2], r[3]);
                    *(u32x2*)(p.xn + eo + ni * 16) = w;
                }
            }
        }
    }
}

template <int MODE>
__device__ __forceinline__ void gemm_tile(const Params& p, int layer, int mt, int nt, unsigned char* smem) {
    const int tid = otid(), lane = tid & 63, wave = tid >> 6, wm = wave >> 1, wn = wave & 1;
    const int fr = lane & 15, fq = lane >> 4;
    const int m0 = mt * 128, n0 = nt * 128;
    const bf16_t* A = (MODE == 0 ? p.xn : p.mix) + (size_t)m0 * 1024;
    const bf16_t* B = (MODE == 0 ? p.WinT + (size_t)layer * INW * 1024 : p.WoutT + (size_t)layer * 1024 * 1024) + (size_t)n0 * 1024;
    f32x4 acc[4][4];
#pragma unroll
    for (int i = 0; i < 4; ++i)
#pragma unroll
        for (int j = 0; j < 4; ++j) acc[i][j] = (f32x4){0.f, 0.f, 0.f, 0.f};

    const int srow = tid >> 3, scc = tid & 7;
    const bf16_t* ag = A + (size_t)srow * 1024 + scc * 8;
    const bf16_t* bg = B + (size_t)srow * 1024 + scc * 8;
    const int wofs = srow * 128 + ((scc ^ (srow & 7)) * 16);
    u32x4 raA[4], rbA[4], raB[4], rbB[4];
    auto gload = [&](int kt, u32x4* ra, u32x4* rb) {
#pragma unroll
        for (int i = 0; i < 4; ++i) {
            ra[i] = *(const u32x4*)(ag + (size_t)i * 32 * 1024 + kt * 64);
            rb[i] = *(const u32x4*)(bg + (size_t)i * 32 * 1024 + kt * 64);
        }
    };
    auto swrite = [&](int buf, const u32x4* ra, const u32x4* rb) {
        unsigned char* Aw = smem + buf * 32768;
#pragma unroll
        for (int i = 0; i < 4; ++i) {
            *(u32x4*)(Aw + wofs + i * 4096) = ra[i];
            *(u32x4*)(Aw + 16384 + wofs + i * 4096) = rb[i];
        }
    };
    gload(0, raA, rbA);
    gload(1, raB, rbB);
    swrite(0, raA, rbA);
    __syncthreads();
    const int aro = (wm * 64 + fr) * 128, bro = (wn * 64 + fr) * 128, sw = fr & 7;
    auto step = [&](int kt, u32x4* la, u32x4* lb, const u32x4* wa, const u32x4* wb) {
        const unsigned char* As = smem + (kt & 1) * 32768;
        const unsigned char* Bs = As + 16384;
        bf16x8 af[2][4], bf[2][4];
#pragma unroll
        for (int kk = 0; kk < 2; ++kk) {
            const int co = ((kk * 4 + fq) ^ sw) * 16;
#pragma unroll
            for (int i = 0; i < 4; ++i) {
                af[kk][i] = *(const bf16x8*)(As + aro + i * 2048 + co);
                bf[kk][i] = *(const bf16x8*)(Bs + bro + i * 2048 + co);
            }
        }
        if (kt + 2 < 16) gload(kt + 2, la, lb);
        __builtin_amdgcn_sched_barrier(0);
#pragma unroll
        for (int mi = 0; mi < 4; ++mi)
#pragma unroll
            for (int ni = 0; ni < 4; ++ni) acc[mi][ni] = __builtin_amdgcn_mfma_f32_16x16x32_bf16(bf[0][ni], af[0][mi], acc[mi][ni], 0, 0, 0);
        __builtin_amdgcn_sched_barrier(0);
        if (kt + 1 < 16) swrite((kt + 1) & 1, wa, wb);
        __builtin_amdgcn_sched_barrier(0);
#pragma unroll
        for (int mi = 0; mi < 4; ++mi)
#pragma unroll
            for (int ni = 0; ni < 4; ++ni) acc[mi][ni] = __builtin_amdgcn_mfma_f32_16x16x32_bf16(bf[1][ni], af[1][mi], acc[mi][ni], 0, 0, 0);
        __syncthreads();
    };
    for (int kt = 0; kt < 16; kt += 2) {
        step(kt, raA, rbA, raB, rbB);
        step(kt + 1, raB, rbB, raA, rbA);
    }

    gemm_epilogue<MODE, 4>(p, layer, m0 + wm * 64, n0 + wn * 64, acc, fr, fq);
}

template <int MODE>
__device__ __forceinline__ void gemm_tile256(const Params& p, int layer, int mt, int nt, unsigned char* smem) {
    const int tid = otid(), lane = tid & 63, wave = tid >> 6, wm = wave >> 1, wn = wave & 1;
    const int fr = lane & 15, fq = lane >> 4;
    const int m0 = mt * 256, n0 = nt * 128;
    const bf16_t* A = (MODE == 0 ? p.xn : p.mix) + (size_t)m0 * 1024;
    const bf16_t* B = (MODE == 0 ? p.WinT + (size_t)layer * INW * 1024 : p.WoutT + (size_t)layer * 1024 * 1024) + (size_t)n0 * 1024;
    f32x4 acc[8][4];
#pragma unroll
    for (int i = 0; i < 8; ++i)
#pragma unroll
        for (int j = 0; j < 4; ++j) acc[i][j] = (f32x4){0.f, 0.f, 0.f, 0.f};
    const int srow = tid >> 2, scc = tid & 3;
    const bf16_t* ag = A + (size_t)srow * 1024 + scc * 8;
    const bf16_t* bg = B + (size_t)srow * 1024 + scc * 8;
    const int wofs = srow * 64 + ((scc ^ ((4 - ((srow >> 2) & 3)) & 3)) * 16);
    u32x4 raA[4], rbA[2], raB[4], rbB[2];
    auto gload = [&](int kt, u32x4* ra, u32x4* rb) {
#pragma unroll
        for (int i = 0; i < 4; ++i) ra[i] = *(const u32x4*)(ag + (size_t)i * 64 * 1024 + kt * 32);
#pragma unroll
        for (int i = 0; i < 2; ++i) rb[i] = *(const u32x4*)(bg + (size_t)i * 64 * 1024 + kt * 32);
    };
    auto swrite = [&](int buf, const u32x4* ra, const u32x4* rb) {
        unsigned char* Aw = smem + buf * 24576;
#pragma unroll
        for (int i = 0; i < 4; ++i) *(u32x4*)(Aw + wofs + i * 4096) = ra[i];
#pragma unroll
        for (int i = 0; i < 2; ++i) *(u32x4*)(Aw + 16384 + wofs + i * 4096) = rb[i];
    };
    gload(0, raA, rbA);
    gload(1, raB, rbB);
    swrite(0, raA, rbA);
    __syncthreads();
    const int co = (fq ^ ((4 - ((fr >> 2) & 3)) & 3)) * 16;
    const int aro = (wm * 128 + fr) * 64 + co, bro = (wn * 64 + fr) * 64 + co;
    auto step = [&](int kt, u32x4* la, u32x4* lb, const u32x4* wa, const u32x4* wb) {
        const unsigned char* As = smem + (kt & 1) * 24576;
        const unsigned char* Bs = As + 16384;
        bf16x8 af[8], bf[4];
#pragma unroll
        for (int i = 0; i < 4; ++i) bf[i] = *(const bf16x8*)(Bs + bro + i * 1024);
#pragma unroll
        for (int i = 0; i < 8; ++i) af[i] = *(const bf16x8*)(As + aro + i * 1024);
        if (kt + 2 < 32) gload(kt + 2, la, lb);
        __builtin_amdgcn_sched_barrier(0);
#pragma unroll
        for (int mi = 0; mi < 4; ++mi)
#pragma unroll
            for (int ni = 0; ni < 4; ++ni) acc[mi][ni] = __builtin_amdgcn_mfma_f32_16x16x32_bf16(bf[ni], af[mi], acc[mi][ni], 0, 0, 0);
        __builtin_amdgcn_sched_barrier(0);
        if (kt + 1 < 32) swrite((kt + 1) & 1, wa, wb);
        __builtin_amdgcn_sched_barrier(0);
#pragma unroll
        for (int mi = 4; mi < 8; ++mi)
#pragma unroll
            for (int ni = 0; ni < 4; ++ni) acc[mi][ni] = __builtin_amdgcn_mfma_f32_16x16x32_bf16(bf[ni], af[mi], acc[mi][ni], 0, 0, 0);
        __syncthreads();
    };
    for (int kt = 0; kt < 32; kt += 2) {
        step(kt, raA, rbA, raB, rbB);
        step(kt + 1, raB, rbB, raA, rbA);
    }
    gemm_epilogue<MODE, 8>(p, layer, m0 + wm * 128, n0 + wn * 64, acc, fr, fq);
}

template <int MODE>
__device__ __forceinline__ void gemm_tile256_dma(const Params& p, int layer, int mt, int nt, unsigned char* smem) {
    const int tid = otid(), lane = tid & 63, wave = tid >> 6, wm = wave >> 1, wn = wave & 1;
    const int fr = lane & 15, fq = lane >> 4;
    const int m0 = mt * 256, n0 = nt * 128;
    const bf16_t* A = (MODE == 0 ? p.xn : p.mix) + (size_t)m0 * 1024;
    const bf16_t* B = (MODE == 0 ? p.WinT + (size_t)layer * INW * 1024 : p.WoutT + (size_t)layer * 1024 * 1024) + (size_t)n0 * 1024;
    f32x4 acc[8][4];
#pragma unroll
    for (int i = 0; i < 8; ++i)
#pragma unroll
        for (int j = 0; j < 4; ++j) acc[i][j] = (f32x4){0.f, 0.f, 0.f, 0.f};
    const int lrow = lane >> 2, lc = (lane & 3) ^ ((4 - ((lane >> 4) & 3)) & 3);
    const bf16_t* agp = A + (size_t)(wave * 64 + lrow) * 1024 + lc * 8;
    const bf16_t* bgp = B + (size_t)(wave * 32 + lrow) * 1024 + lc * 8;
    LAS unsigned char* lbase = (LAS unsigned char*)smem;
    const int la_off = wave * 4096 + lane * 16, lb_off = 16384 + wave * 2048 + lane * 16;
    auto dma = [&](int kt, int stage) {
        LAS unsigned char* sb = lbase + stage * 24576;
#pragma unroll
        for (int i = 0; i < 4; ++i)
            __builtin_amdgcn_global_load_lds((const void*)(agp + (size_t)i * 16 * 1024 + kt * 32), (LAS void*)(sb + la_off + i * 1024), 16, 0, 0);
#pragma unroll
        for (int i = 0; i < 2; ++i)
            __builtin_amdgcn_global_load_lds((const void*)(bgp + (size_t)i * 16 * 1024 + kt * 32), (LAS void*)(sb + lb_off + i * 1024), 16, 0, 0);
    };
    dma(0, 0);
    dma(1, 1);
    asm volatile("s_waitcnt vmcnt(6)" ::: "memory");
    __builtin_amdgcn_s_barrier();
    const int co = (fq ^ ((4 - ((fr >> 2) & 3)) & 3)) * 16;
    const int aro = (wm * 128 + fr) * 64 + co, bro = 16384 + (wn * 64 + fr) * 64 + co;
    int st = 0, st2 = 2;
    const unsigned lds0 = (unsigned)(uintptr_t)lbase;
#pragma unroll 1
    for (int kt = 0; kt < 32; ++kt) {
        const unsigned sa = lds0 + st * 24576 + aro, sbb = lds0 + st * 24576 + bro;
        bf16x8 af[8], bf[4];
#define FRAG_RD(dst, addr, OFF) asm volatile("ds_read_b128 %0, %1 offset:" #OFF : "=&v"(dst) : "v"(addr))
        FRAG_RD(bf[0], sbb, 0); FRAG_RD(bf[1], sbb, 1024); FRAG_RD(bf[2], sbb, 2048); FRAG_RD(bf[3], sbb, 3072);
        FRAG_RD(af[0], sa, 0); FRAG_RD(af[1], sa, 1024); FRAG_RD(af[2], sa, 2048); FRAG_RD(af[3], sa, 3072);
        FRAG_RD(af[4], sa, 4096); FRAG_RD(af[5], sa, 5120); FRAG_RD(af[6], sa, 6144); FRAG_RD(af[7], sa, 7168);
#undef FRAG_RD
        __builtin_amdgcn_sched_barrier(0);
        if (kt + 2 < 32) dma(kt + 2, st2);
        __builtin_amdgcn_sched_barrier(0);
        asm volatile("s_waitcnt lgkmcnt(4)" ::: "memory");
        __builtin_amdgcn_sched_barrier(0);
#pragma unroll
        for (int mi = 0; mi < 4; ++mi)
#pragma unroll
            for (int ni = 0; ni < 4; ++ni) acc[mi][ni] = __builtin_amdgcn_mfma_f32_16x16x32_bf16(bf[ni], af[mi], acc[mi][ni], 0, 0, 0);
        __builtin_amdgcn_sched_barrier(0);
        asm volatile("s_waitcnt lgkmcnt(0)" ::: "memory");
        __builtin_amdgcn_sched_barrier(0);
#pragma unroll
        for (int mi = 4; mi < 8; ++mi)
#pragma unroll
            for (int ni = 0; ni < 4; ++ni) acc[mi][ni] = __builtin_amdgcn_mfma_f32_16x16x32_bf16(bf[ni], af[mi], acc[mi][ni], 0, 0, 0);
        __builtin_amdgcn_sched_barrier(0);
        if (kt + 2 < 32) asm volatile("s_waitcnt vmcnt(6)" ::: "memory");
        else asm volatile("s_waitcnt vmcnt(0)" ::: "memory");
        __builtin_amdgcn_s_barrier();
        st = st == 2 ? 0 : st + 1;
        st2 = st2 == 2 ? 0 : st2 + 1;
    }
    if (MODE == 0) {
        gemm_epilogue<0, 8, 1>(p, layer, m0 + wm * 128, n0 + wn * 64, acc, fr, fq, smem, m0, n0);
        __syncthreads();
        u32x4 cv[16];
#pragma unroll
        for (int i = 0; i < 16; ++i) { const int e = tid + 256 * i; cv[i] = *(const u32x4*)(smem + (e >> 4) * 272 + (e & 15) * 16); }
#pragma unroll
        for (int i = 0; i < 16; ++i) { const int e = tid + 256 * i; *(u32x4*)(p.proj + (size_t)(m0 + (e >> 4)) * INW + n0 + (e & 15) * 8) = cv[i]; }
        __syncthreads();
    } else {
#pragma unroll 1
        for (int pass = 0; pass < 2; ++pass) {
            if (wm == pass) {
#pragma unroll
                for (int mi = 0; mi < 8; ++mi)
#pragma unroll
                    for (int ni = 0; ni < 4; ++ni) *(f32x4*)(smem + (mi * 16 + fr) * 528 + (wn * 64 + ni * 16 + fq * 4) * 4) = acc[mi][ni];
            }
            __syncthreads();
            const int rbase = m0 + pass * 128;
            const int c4 = (tid & 31) * 4;
            f32x4 ho[16];
#pragma unroll
            for (int i = 0; i < 16; ++i) {
                const int tok = rbase + (tid >> 5) + 8 * i;
                if (layer == 0) ho[i] = *(const f32x4*)((tok < NCTX ? p.x_prompt + (size_t)tok * DM : p.x_sample + (size_t)(tok - NCTX) * DM) + n0 + c4);
                else ho[i] = bf4_to_f32(*(const u32x2*)(p.h + (size_t)tok * DM + n0 + c4));
            }
            const int v = rbase < NCTX ? 0 : 1 + ((rbase - NCTX) >> 11);
            const f32x4 gt = *(const f32x4*)(p.modv + (size_t)(layer * 5 + v) * 3072 + 2048 + n0 + c4);
#pragma unroll
            for (int i = 0; i < 16; ++i) {
                const int row = (tid >> 5) + 8 * i, tok = rbase + row;
                const f32x4 a = *(const f32x4*)(smem + row * 528 + c4 * 4);
                const f32x4 r = ho[i] + gt * a;
                if (layer == 0) {
                    u32x2 w;
                    w.x = pk_bf16(r[0], r[1]);
                    w.y = pk_bf16(r[2], r[3]);
                    *(u32x2*)(p.h + (size_t)tok * DM + n0 + c4) = w;
                } else {
                    u32x2 w;
                    w.x = pk_bf16(r[0], r[1]);
                    w.y = pk_bf16(r[2], r[3]);
                    *(u32x2*)(p.xn + (size_t)tok * DM + n0 + c4) = w;
                }
            }
            __syncthreads();
        }
    }
}

__device__ __forceinline__ void gemm_piece64_dma(const Params& p, int layer, int m0, int n0, unsigned char* smem) {
    const int tid = otid(), lane = tid & 63, wave = tid >> 6, wm = wave >> 1, wn = wave & 1;
    const int fr = lane & 15, fq = lane >> 4;
    const bf16_t* A = p.xn + (size_t)m0 * 1024;
    const bf16_t* B = p.WinT + (size_t)layer * INW * 1024 + (size_t)n0 * 1024;
    f32x4 acc[2][4];
#pragma unroll
    for (int i = 0; i < 2; ++i)
#pragma unroll
        for (int j = 0; j < 4; ++j) acc[i][j] = (f32x4){0.f, 0.f, 0.f, 0.f};
    const int lrow = lane >> 2, lc = (lane & 3) ^ ((4 - ((lane >> 4) & 3)) & 3);
    const bf16_t* agp = A + (size_t)(wave * 16 + lrow) * 1024 + lc * 8;
    const bf16_t* bgp = B + (size_t)(wave * 32 + lrow) * 1024 + lc * 8;
    LAS unsigned char* lbase = (LAS unsigned char*)smem;
    const int la_off = wave * 1024 + lane * 16, lb_off = 4096 + wave * 2048 + lane * 16;
    auto dma = [&](int kt, int stage) {
        LAS unsigned char* sb = lbase + stage * 12288;
        __builtin_amdgcn_global_load_lds((const void*)(agp + kt * 32), (LAS void*)(sb + la_off), 16, 0, 0);
#pragma unroll
        for (int i = 0; i < 2; ++i)
            __builtin_amdgcn_global_load_lds((const void*)(bgp + (size_t)i * 16 * 1024 + kt * 32), (LAS void*)(sb + lb_off + i * 1024), 16, 0, 0);
    };
    dma(0, 0);
    dma(1, 1);
    asm volatile("s_waitcnt vmcnt(3)" ::: "memory");
    __builtin_amdgcn_s_barrier();
    const int co = (fq ^ ((4 - ((fr >> 2) & 3)) & 3)) * 16;
    const int aro = (wm * 32 + fr) * 64 + co, bro = 4096 + (wn * 64 + fr) * 64 + co;
    int st = 0, st2 = 2;
    const unsigned lds0 = (unsigned)(uintptr_t)lbase;
#pragma unroll 1
    for (int kt = 0; kt < 32; ++kt) {
        const unsigned sa = lds0 + st * 12288 + aro, sbb = lds0 + st * 12288 + bro;
        bf16x8 af[2], bf[4];
#define FRAG_RD(dst, addr, OFF) asm volatile("ds_read_b128 %0, %1 offset:" #OFF : "=&v"(dst) : "v"(addr))
        FRAG_RD(bf[0], sbb, 0); FRAG_RD(bf[1], sbb, 1024); FRAG_RD(bf[2], sbb, 2048); FRAG_RD(bf[3], sbb, 3072);
        FRAG_RD(af[0], sa, 0); FRAG_RD(af[1], sa, 1024);
#undef FRAG_RD
        __builtin_amdgcn_sched_barrier(0);
        if (kt + 2 < 32) dma(kt + 2, st2);
        __builtin_amdgcn_sched_barrier(0);
        asm volatile("s_waitcnt lgkmcnt(0)" ::: "memory");
        __builtin_amdgcn_sched_barrier(0);
#pragma unroll
        for (int mi = 0; mi < 2; ++mi)
#pragma unroll
            for (int ni = 0; ni < 4; ++ni) acc[mi][ni] = __builtin_amdgcn_mfma_f32_16x16x32_bf16(bf[ni], af[mi], acc[mi][ni], 0, 0, 0);
        __builtin_amdgcn_sched_barrier(0);
        if (kt + 2 < 32) asm volatile("s_waitcnt vmcnt(3)" ::: "memory");
        else asm volatile("s_waitcnt vmcnt(0)" ::: "memory");
        __builtin_amdgcn_s_barrier();
        st = st == 2 ? 0 : st + 1;
        st2 = st2 == 2 ? 0 : st2 + 1;
    }
    gemm_epilogue<0, 2, 1>(p, layer, m0 + wm * 32, n0 + wn * 64, acc, fr, fq, smem, m0, n0);
    __syncthreads();
    u32x4 cv[4];
#pragma unroll
    for (int i = 0; i < 4; ++i) { const int e = tid + 256 * i; cv[i] = *(const u32x4*)(smem + (e >> 4) * 272 + (e & 15) * 16); }
#pragma unroll
    for (int i = 0; i < 4; ++i) { const int e = tid + 256 * i; *(u32x4*)(p.proj + (size_t)(m0 + (e >> 4)) * INW + n0 + (e & 15) * 8) = cv[i]; }
    __syncthreads();
}

template <int MODE>
__device__ __forceinline__ void phase_gemm(const Params& p, int layer, unsigned char* smem) {
    const int NT = MODE == 0 ? 22 : 8;
    const int total = 96 * NT;
    if (gridDim.x == 512) {
        const int xcd = blockIdx.x & 7, slot = blockIdx.x >> 3;
        if (MODE == 0) {
            if (slot < 16) gemm_piece64_dma(p, layer, (xcd * 6 + 2 + (slot >> 2)) * 256 + (slot & 3) * 64, 21 * 128, smem);
            for (int idx = slot; idx < 128; idx += 64) gemm_tile256_dma<MODE>(p, layer, xcd * 6 + idx % 6, idx / 6, smem);
        } else {
            if (slot < 32) gemm_tile256_dma<MODE>(p, layer, xcd * 6 + slot % 6, slot / 6, smem);
            else {
                const int d = 32 + ((slot - 32) >> 1);
                gemm_tile<MODE>(p, layer, (xcd * 6 + d % 6) * 2 + (slot & 1), d / 6, smem);
            }
        }
    } else {
        for (int t = blockIdx.x; t < total; t += gridDim.x) gemm_tile<MODE>(p, layer, t / NT, t % NT, smem);
    }
}

template <int VAR>
__device__ __forceinline__ void attn_unit(const Params& p, int layer, int unit, unsigned char* smem) {
    const int tid = otid(), lane = tid & 63, wave = tid >> 6;
    const int r31 = lane & 31, hh = lane >> 5;
    int b, head, qblk, tokbase, nself, ntiles;
    if (unit < 512) { b = unit >> 7; head = (unit >> 4) & 7; qblk = unit & 15; tokbase = NCTX + b * 2048; nself = 2048; ntiles = 36; }
    else { const int u = unit - 512; b = u >> 4; head = (u >> 1) & 7; qblk = u & 1; tokbase = b * 256; nself = 256; ntiles = 4; }
    const int kvh = head >> 2;
    const int qtok = tokbase + qblk * 128 + wave * 32 + r31;
    bf16x8 qf[4];
    {
        const bf16_t* qp = p.proj + (size_t)qtok * INW + head * 64 + hh * 8;
#pragma unroll
        for (int ks = 0; ks < 4; ++ks) qf[ks] = *(const bf16x8*)(qp + ks * 16);
    }
    const bf16_t* kself = p.proj + (size_t)tokbase * INW + 512 + kvh * 64;
    const bf16_t* vself = p.proj + (size_t)tokbase * INW + 640 + kvh * 64;
    const bf16_t* kcache = p.kc + (size_t)((b * 2 + layer) * 2 + kvh) * 256 * 64;
    const bf16_t* vcache = p.vc + (size_t)((b * 2 + layer) * 2 + kvh) * 256 * 64;
    const int srow = tid >> 3, scc = tid & 7;
    const int kwo = srow * 128 + ((scc ^ ((srow >> 1) & 7)) * 16);
    const int vwo = srow * 128 + ((scc ^ (((srow >> 1) & 1) << 2)) * 16);
    u32x4 rkA[2], rvA[2], rkB[2], rvB[2];
    auto gload = [&](int j, u32x4* rk, u32x4* rv) {
        const int key0 = j * 64;
#pragma unroll
        for (int i = 0; i < 2; ++i) {
            const int row = srow + 32 * i;
            if (key0 < nself) {
                rk[i] = *(const u32x4*)(kself + (size_t)(key0 + row) * INW + scc * 8);
                rv[i] = *(const u32x4*)(vself + (size_t)(key0 + row) * INW + scc * 8);
            } else {
                rk[i] = *(const u32x4*)(kcache + (size_t)(key0 - nself + row) * 64 + scc * 8);
                rv[i] = *(const u32x4*)(vcache + (size_t)(key0 - nself + row) * 64 + scc * 8);
            }
        }
    };
    auto swrite = [&](int buf, const u32x4* rk, const u32x4* rv) {
        unsigned char* kb = smem + buf * 16384;
        unsigned char* vb = kb + 8192;
#pragma unroll
        for (int i = 0; i < 2; ++i) {
            *(u32x4*)(kb + kwo + i * 32 * 128) = rk[i];
            *(u32x4*)(vb + vwo + i * 32 * 128) = rv[i];
        }
    };
    f32x16 o[2];
#pragma unroll
    for (int i = 0; i < 16; ++i) { o[0][i] = 0.f; o[1][i] = 0.f; }
    float mrun = 0.f, mmax = -1e30f, lrun = 0.f;
    f32x16 negm, zero16;
#pragma unroll
    for (int i = 0; i < 16; ++i) { negm[i] = 0.f; zero16[i] = 0.f; }
    bool shifted = false;
    gload(0, rkA, rvA);
    swrite(0, rkA, rvA);
    if (ntiles > 1) gload(1, rkB, rvB);
    __syncthreads();
    const int kro = r31 * 128, ksw = (r31 >> 1) & 7;
    const int vq = 4 * hh + ((lane & 15) >> 2);
    const int vsw = ((vq >> 1) & 1) << 2;
    const int vcl = ((lane >> 4) & 1) * 2 + ((lane & 3) >> 1);
    const int vro0 = vq * 128 + (((0 * 4 + vcl) ^ vsw) * 16) + (lane & 1) * 8;
    const int vro1 = vq * 128 + (((1 * 4 + vcl) ^ vsw) * 16) + (lane & 1) * 8;
    auto step = [&](int j, u32x4* lk, u32x4* lv, const u32x4* wk, const u32x4* wv) {
        const unsigned char* kb = smem + (j & 1) * 16384;
        const unsigned char* vb = kb + 8192;
        bf16x8 kf[2][4];
#pragma unroll
        for (int sb = 0; sb < 2; ++sb)
#pragma unroll
            for (int ks = 0; ks < 4; ++ks) kf[sb][ks] = *(const bf16x8*)(kb + sb * 4096 + kro + (((ks * 2 + hh) ^ ksw) * 16));
        bf16x8 vf[2][2][2];
#pragma unroll
        for (int sb = 0; sb < 2; ++sb)
#pragma unroll
            for (int s2 = 0; s2 < 2; ++s2)
#pragma unroll
                for (int dt = 0; dt < 2; ++dt) {
                    const LAS unsigned char* va = (const LAS unsigned char*)(vb) + (sb * 32 + s2 * 16) * 128 + (dt ? vro1 : vro0);
                    const s16x4 a0 = __builtin_amdgcn_ds_read_tr16_b64_v4i16((LAS s16x4*)(va));
                    const s16x4 a1 = __builtin_amdgcn_ds_read_tr16_b64_v4i16((LAS s16x4*)(va + 8 * 128));
                    vf[sb][s2][dt] = (bf16x8){a0[0], a0[1], a0[2], a0[3], a1[0], a1[1], a1[2], a1[3]};
                }
        if (VAR != 1 && j + 2 < ntiles) gload(j + 2, lk, lv);
        __builtin_amdgcn_sched_barrier(0);
        f32x16 s[2];
        float mloc, lsum = 0.f;
        bf16x8 pf[2][2];
#pragma unroll
        for (int sb = 0; sb < 2; ++sb)
#pragma unroll
            for (int ks = 0; ks < 4; ++ks) {
                if (ks == 0) {
                    if (shifted) s[sb] = __builtin_amdgcn_mfma_f32_32x32x16_bf16(kf[sb][ks], qf[ks], negm, 0, 0, 0);
                    else s[sb] = __builtin_amdgcn_mfma_f32_32x32x16_bf16(kf[sb][ks], qf[ks], zero16, 0, 0, 0);
                } else s[sb] = __builtin_amdgcn_mfma_f32_32x32x16_bf16(kf[sb][ks], qf[ks], s[sb], 0, 0, 0);
            }
#pragma unroll
        for (int sb = 0; sb < 2; ++sb) {
            float m0 = max3_f(s[sb][0], s[sb][1], s[sb][2]);
#pragma unroll
            for (int i = 3; i < 15; i += 2) m0 = max3_f(m0, s[sb][i], s[sb][i + 1]);
            m0 = fmaxf(m0, s[sb][15]);
            mloc = sb == 0 ? m0 : fmaxf(mloc, m0);
#pragma unroll
            for (int i = 0; i < 16; ++i) { if (VAR != 2) { s[sb][i] = __builtin_amdgcn_exp2f(s[sb][i]); lsum += s[sb][i]; } }
#pragma unroll
            for (int s2 = 0; s2 < 2; ++s2) {
                u32x4 pw;
                pw.x = pk_bf16(s[sb][s2 * 8 + 0], s[sb][s2 * 8 + 1]);
                pw.y = pk_bf16(s[sb][s2 * 8 + 2], s[sb][s2 * 8 + 3]);
                pw.z = pk_bf16(s[sb][s2 * 8 + 4], s[sb][s2 * 8 + 5]);
                pw.w = pk_bf16(s[sb][s2 * 8 + 6], s[sb][s2 * 8 + 7]);
                pf[sb][s2] = __builtin_bit_cast(bf16x8, pw);
            }
#pragma unroll
            for (int s2 = 0; s2 < 2; ++s2)
#pragma unroll
                for (int dt = 0; dt < 2; ++dt) o[dt] = __builtin_amdgcn_mfma_f32_32x32x16_bf16(vf[sb][s2][dt], pf[sb][s2], o[dt], 0, 0, 0);
        }
        lrun += lsum;
        __builtin_amdgcn_sched_barrier(0);
        mloc = fmaxf(mloc, __shfl_xor(mloc, 32));
        mmax = fmaxf(mmax, mrun + mloc);
        if (__builtin_expect(__any(fabsf(mmax - mrun) > 40.0f), 0)) {
            asm volatile("" ::: "memory");
            const float alpha = __builtin_amdgcn_exp2f(mrun - mmax);
            mrun = mmax;
            lrun *= alpha;
            shifted = true;
#pragma unroll
            for (int i = 0; i < 16; ++i) { o[0][i] *= alpha; o[1][i] *= alpha; negm[i] = -mrun; }
        }
        if (VAR != 1 && j + 1 < ntiles) swrite((j + 1) & 1, wk, wv);
        __syncthreads();
    };
    for (int j = 0; j < ntiles; j += 2) {
        step(j, rkA, rvA, rkB, rvB);
        step(j + 1, rkB, rvB, rkA, rvA);
    }
    const float ltot = lrun + __shfl_xor(lrun, 32);
    const float inv = 1.0f / ltot;
    const bf16_t* zp = p.proj + (size_t)qtok * INW + 768 + head * 64;
    bf16_t* mp = (VAR == 0 ? p.mix : p.xn) + (size_t)qtok * DM + head * 64;
#pragma unroll
    for (int dt = 0; dt < 2; ++dt)
#pragma unroll
        for (int rq = 0; rq < 4; ++rq) {
            const int d0 = dt * 32 + 8 * rq + 4 * hh;
            const u32x2 zz = *(const u32x2*)(zp + d0);
            const float z0 = bf_lo(zz.x), z1 = bf_hi(zz.x), z2 = bf_lo(zz.y), z3 = bf_hi(zz.y);
            u32x2 w;
            w.x = pk_bf16(o[dt][rq * 4 + 0] * inv * silu_f(z0), o[dt][rq * 4 + 1] * inv * silu_f(z1));
            w.y = pk_bf16(o[dt][rq * 4 + 2] * inv * silu_f(z2), o[dt][rq * 4 + 3] * inv * silu_f(z3));
            *(u32x2*)(mp + d0) = w;
        }
}

__device__ __forceinline__ void unpack8(const u32x4 u, float* f) {
    f[0] = bf_lo(u.x); f[1] = bf_hi(u.x); f[2] = bf_lo(u.y); f[3] = bf_hi(u.y);
    f[4] = bf_lo(u.z); f[5] = bf_hi(u.z); f[6] = bf_lo(u.w); f[7] = bf_hi(u.w);
}

template <int WIN>
__device__ __forceinline__ void pool_group(const Params& p, int layer, int T0, int toff, int seqlen, int gi, int fr, int fq, const bf16x8 (&wf)[4][2],
                                           const f32x4 (&ps)[4], const unsigned char* smem) {
    constexpr int HALF = WIN / 2;
    u32x2 zz[2][4];
#pragma unroll
    for (int mi = 0; mi < 2; ++mi)
#pragma unroll
        for (int ni = 0; ni < 4; ++ni) zz[mi][ni] = *(const u32x2*)(p.proj + (size_t)(T0 + mi * 16 + fr) * INW + 2560 + gi * 64 + ni * 16 + fq * 4);
#pragma unroll
    for (int mi = 0; mi < 2; ++mi) {
        const int tt = mi * 16 + fr, ts = toff + tt, tok = T0 + tt;
        int lo = ts - HALF, hi = ts - HALF + WIN - 1;
        lo = lo < 0 ? 0 : lo;
        hi = hi > seqlen - 1 ? seqlen - 1 : hi;
        const float rc = 1.0f / (float)(hi - lo + 1);
        f32x4 acc[4];
#pragma unroll
        for (int j = 0; j < 4; ++j) acc[j] = (f32x4){0.f, 0.f, 0.f, 0.f};
#pragma unroll
        for (int kk = 0; kk < 2; ++kk) {
            const int co = (gi * 64 + kk * 32 + fq * 8) * 2;
            u32x4 rw[WIN];
#pragma unroll
            for (int j = 0; j < WIN; ++j) rw[j] = *(const u32x4*)(smem + (tt + 8 - HALF + j) * 528 + co);
            const u32x4 self = *(const u32x4*)(smem + (tt + 8) * 528 + co);
            float sum[8];
#pragma unroll
            for (int e = 0; e < 8; ++e) sum[e] = 0.f;
#pragma unroll
            for (int j = 0; j < WIN; ++j) {
                const int sq = ts - HALF + j;
                const float m = (sq >= 0 && sq < seqlen) ? 1.0f : 0.0f;
                float f[8];
                unpack8(rw[j], f);
#pragma unroll
                for (int e = 0; e < 8; ++e) sum[e] = fmaf(f[e], m, sum[e]);
            }
            float us[8];
            unpack8(self, us);
            u32x4 dw;
            dw.x = pk_bf16(sum[0] * rc - us[0], sum[1] * rc - us[1]);
            dw.y = pk_bf16(sum[2] * rc - us[2], sum[3] * rc - us[3]);
            dw.z = pk_bf16(sum[4] * rc - us[4], sum[5] * rc - us[5]);
            dw.w = pk_bf16(sum[6] * rc - us[6], sum[7] * rc - us[7]);
            const bf16x8 df = __builtin_bit_cast(bf16x8, dw);
#pragma unroll
            for (int ni = 0; ni < 4; ++ni) acc[ni] = __builtin_amdgcn_mfma_f32_16x16x32_bf16(wf[ni][kk], df, acc[ni], 0, 0, 0);
        }
#pragma unroll
        for (int ni = 0; ni < 4; ++ni) {
            const int ch = gi * 64 + ni * 16 + fq * 4;
            u32x2 w;
            w.x = pk_bf16(acc[ni][0] * ps[ni][0] * silu_f(bf_lo(zz[mi][ni].x)), acc[ni][1] * ps[ni][1] * silu_f(bf_hi(zz[mi][ni].x)));
            w.y = pk_bf16(acc[ni][2] * ps[ni][2] * silu_f(bf_lo(zz[mi][ni].y)), acc[ni][3] * ps[ni][3] * silu_f(bf_hi(zz[mi][ni].y)));
            *(u32x2*)(p.mix + (size_t)tok * DM + 768 + ch) = w;
        }
    }
}

__device__ __forceinline__ void pool_item(const Params& p, int layer, int pi, unsigned char* smem) {
    const int tid = otid(), lane = tid & 63, gi = tid >> 6;
    const int fr = lane & 15, fq = lane >> 4;
    const int T0 = pi * 32;
    int seqstart, seqlen;
    if (T0 < NCTX) { seqstart = T0 & ~255; seqlen = 256; } else { seqstart = NCTX + ((T0 - NCTX) & ~2047); seqlen = 2048; }
    const int toff = T0 - seqstart;
    u32x4 st[6];
#pragma unroll
    for (int i = 0; i < 6; ++i) {
        const int e = tid + 256 * i, r = e >> 5, c = e & 31;
        int sq = toff - 8 + r;
        sq = sq < 0 ? 0 : (sq > seqlen - 1 ? seqlen - 1 : sq);
        if (e < 47 * 32) st[i] = *(const u32x4*)(p.proj + (size_t)(seqstart + sq) * INW + 2304 + c * 8);
    }
    bf16x8 wf[4][2];
    f32x4 ps[4];
    {
        const bf16_t* wp = p.PoolT + (size_t)((layer * 4 + gi) * 64) * 64;
#pragma unroll
        for (int ni = 0; ni < 4; ++ni) {
#pragma unroll
            for (int kk = 0; kk < 2; ++kk) wf[ni][kk] = *(const bf16x8*)(wp + (ni * 16 + fr) * 64 + kk * 32 + fq * 8);
            ps[ni] = *(const f32x4*)(p.pool_scale + layer * 256 + gi * 64 + ni * 16 + fq * 4);
        }
    }
#pragma unroll
    for (int i = 0; i < 6; ++i) {
        const int e = tid + 256 * i, r = e >> 5, c = e & 31;
        if (e < 47 * 32) *(u32x4*)(smem + r * 528 + c * 16) = st[i];
    }
    __syncthreads();
    if (gi == 0) pool_group<2>(p, layer, T0, toff, seqlen, gi, fr, fq, wf, ps, smem);
    else if (gi == 1) pool_group<4>(p, layer, T0, toff, seqlen, gi, fr, fq, wf, ps, smem);
    else if (gi == 2) pool_group<8>(p, layer, T0, toff, seqlen, gi, fr, fq, wf, ps, smem);
    else pool_group<16>(p, layer, T0, toff, seqlen, gi, fr, fq, wf, ps, smem);
    __syncthreads();
}

__device__ __forceinline__ void conv_item(const Params& p, int layer, int ci) {
    const int tid = otid();
    const int ch = (tid & 31) * 8, tg = tid >> 5;
    const int T0 = ci * 32 + tg * 4;
    int seqstart, seqlen;
    if (T0 < NCTX) { seqstart = T0 & ~255; seqlen = 256; } else { seqstart = NCTX + ((T0 - NCTX) & ~2047); seqlen = 2048; }
    const int seqend = seqstart + seqlen;
    u32x4 rh[6], rc[6], rb[4], rz[4];
#pragma unroll
    for (int i = 0; i < 6; ++i) {
        int tok = T0 - 1 + i;
        tok = tok < seqstart ? seqstart : (tok > seqend - 1 ? seqend - 1 : tok);
        rh[i] = *(const u32x4*)(p.proj + (size_t)tok * INW + 1280 + ch);
        rc[i] = *(const u32x4*)(p.proj + (size_t)tok * INW + 1792 + ch);
    }
#pragma unroll
    for (int i = 0; i < 4; ++i) {
        rb[i] = *(const u32x4*)(p.proj + (size_t)(T0 + i) * INW + 1536 + ch);
        rz[i] = *(const u32x4*)(p.proj + (size_t)(T0 + i) * INW + 2048 + ch);
    }
    f32x4 wv[8];
    {
        const float* cw = p.conv_w + (size_t)layer * 768 + ch;
#pragma unroll
        for (int r = 0; r < 3; ++r) { wv[r * 2] = *(const f32x4*)(cw + r * 256); wv[r * 2 + 1] = *(const f32x4*)(cw + r * 256 + 4); }
        wv[6] = *(const f32x4*)(p.conv_b + layer * 256 + ch);
        wv[7] = *(const f32x4*)(p.conv_b + layer * 256 + ch + 4);
    }
    float x[6][8];
#pragma unroll
    for (int i = 0; i < 6; ++i) {
        const int tok = T0 - 1 + i;
        const float valid = (tok >= seqstart && tok < seqend) ? 1.0f : 0.0f;
        float hc[8], cc[8];
        unpack8(rh[i], hc);
        unpack8(rc[i], cc);
#pragma unroll
        for (int e = 0; e < 8; ++e) x[i][e] = hc[e] * cc[e] * valid;
    }
#pragma unroll
    for (int t = 0; t < 4; ++t) {
        float bc[8], zc[8], o[8];
        unpack8(rb[t], bc);
        unpack8(rz[t], zc);
#pragma unroll
        for (int e = 0; e < 8; ++e) {
            const float y = x[t][e] * wv[e >> 2][e & 3] + x[t + 1][e] * wv[2 + (e >> 2)][e & 3] + x[t + 2][e] * wv[4 + (e >> 2)][e & 3] + wv[6 + (e >> 2)][e & 3];
            o[e] = bc[e] * y * silu_f(zc[e]);
        }
        u32x4 w;
        w.x = pk_bf16(o[0], o[1]); w.y = pk_bf16(o[2], o[3]); w.z = pk_bf16(o[4], o[5]); w.w = pk_bf16(o[6], o[7]);
        *(u32x4*)(p.mix + (size_t)(T0 + t) * DM + 512 + ch) = w;
    }
}

__device__ __forceinline__ void phase_mixer(const Params& p, int layer, unsigned char* smem) {
    if (gridDim.x == 512) {
        const int b = blockIdx.x;
        attn_unit<0>(p, layer, b, smem);
        if (b < 256) {
            attn_unit<0>(p, layer, 512 + b, smem);
        } else {
#pragma unroll 1
            for (int k = 0; k < 3; ++k) {
                const int idx = (b - 256) + 256 * k;
                if (idx < 384) pool_item(p, layer, idx, smem);
                else conv_item(p, layer, idx - 384);
            }
        }
    } else {
        for (int it = blockIdx.x; it < 768 + 384 + 384; it += gridDim.x) {
            if (it < 768) attn_unit<0>(p, layer, it, smem);
            else if (it < 1152) pool_item(p, layer, it - 768, smem);
            else conv_item(p, layer, it - 1152);
        }
    }
}

__global__ void __launch_bounds__(256, 2) mega(Params p, int lo, int hi) {
    __shared__ __attribute__((aligned(16))) unsigned char smem[73728];
    __shared__ uint4 xbw;
    if (p.use_cg) cg::this_grid().sync();
    if (threadIdx.x == 0) xbw = make_uint4(0u, 0u, 0u, 0u);
    __syncthreads();
    XcdBarrier xb = xcd_barrier_post(p.bar, (volatile LAS unsigned*)&xbw);
    for (int ph = lo; ph < hi; ++ph) {
        if (ph > lo) xcd_barrier(xb);
        if (ph == 0) phase_prep(p, smem);
        else if (ph == 9) phase_final(p);
        else {
            const int layer = (ph - 1) >> 2, ty = (ph - 1) & 3;
            if (ty == 0) phase_xn(p, layer);
            else if (ty == 1) phase_gemm<0>(p, layer, smem);
            else if (ty == 2) phase_mixer(p, layer, smem);
            else phase_gemm<1>(p, layer, smem);
        }
    }
}

#ifndef MK_MULTI
#define MK_MULTI 0
#endif

extern "C" void kernel_launch(void* const* d_in, const int* in_sizes, int n_in, void* d_out, int out_size, void* d_ws, size_t ws_size,
                              hipStream_t stream) {
    static int grid_blocks = 0;
    if (!grid_blocks) {
        int dev = 0, cus = 0, per_cu = 0;
        hipGetDevice(&dev);
        hipDeviceGetAttribute(&cus, hipDeviceAttributeMultiprocessorCount, dev);
        hipOccupancyMaxActiveBlocksPerMultiprocessor(&per_cu, mega, 256, 0);
        if (per_cu > 2) per_cu = 2;
        if (per_cu < 1) per_cu = 1;
        grid_blocks = cus * per_cu;
    }
    Params p{};
    const float* const* in = (const float* const*)d_in;
    p.x_prompt = in[0]; p.x_sample = in[1]; p.cache_k = in[2]; p.cache_v = in[3]; p.c = in[4]; p.c_ctx = in[5]; p.norm_g = in[6];
    p.w_ada = in[7]; p.b_ada = in[8]; p.w_in = in[9]; p.q_g = in[10]; p.k_g = in[11]; p.conv_w = in[12]; p.conv_b = in[13];
    p.pool_w = in[14]; p.pool_scale = in[15]; p.w_out = in[16]; p.final_g = in[17];
    p.out = (float*)d_out;
    unsigned char* ws = (unsigned char*)d_ws;
    size_t off = 0;
    auto take = [&](size_t bytes) { unsigned char* r = ws + off; off += (bytes + 255) & ~(size_t)255; return r; };
    p.bar = (unsigned*)take(XCD_BAR_WORDS * 4);
    p.modv = (float*)take(2 * 5 * 3072 * 4);
    p.rope = (float*)take(2048 * 4);
    p.WinT = (bf16_t*)take((size_t)2 * INW * 1024 * 2);
    p.WoutT = (bf16_t*)take((size_t)2 * 1024 * 1024 * 2);
    p.PoolT = (bf16_t*)take(2 * 4 * 64 * 64 * 2);
    p.kc = (bf16_t*)take(262144 * 2);
    p.vc = (bf16_t*)take(262144 * 2);
    p.h = (bf16_t*)take((size_t)NTOK * DM * 2);
    p.xn = (bf16_t*)take((size_t)NTOK * DM * 2);
    p.proj = (bf16_t*)take((size_t)NTOK * INW * 2);
    p.mix = (bf16_t*)take((size_t)NTOK * DM * 2);
    p.use_cg = 0;
    p.pad = 0;
    hipMemsetAsync(p.bar, 0, XCD_BAR_WORDS * 4, stream);
#if MK_MULTI
    for (int ph = 0; ph < 10; ++ph) {
        int lo = ph, hi = ph + 1;
        void* args[] = {&p, &lo, &hi};
        hipError_t e = hipLaunchCooperativeKernel((void*)mega, dim3(grid_blocks), dim3(256), args, 0, stream);
        if (e != hipSuccess) fprintf(stderr, "launch failed: %s\n", hipGetErrorString(e));
    }
#else
    int lo = 0, hi = 10;
    void* args[] = {&p, &lo, &hi};
    hipError_t e = hipLaunchCooperativeKernel((void*)mega, dim3(grid_blocks), dim3(256), args, 0, stream);
    if (e != hipSuccess) fprintf(stderr, "cooperative launch failed: %s (grid %d)\n", hipGetErrorString(e), grid_blocks);
#endif
}
```

```cpp
#include <hip/hip_runtime.h>
#include <hip/hip_cooperative_groups.h>
#include <cstdint>
#include <cstdio>
namespace cg = cooperative_groups;

#define LAS __attribute__((address_space(3)))
typedef unsigned short bf16_t;
typedef short bf16x8 __attribute__((ext_vector_type(8)));
typedef short s16x4 __attribute__((ext_vector_type(4)));
typedef float f32x4 __attribute__((ext_vector_type(4)));
typedef float f32x16 __attribute__((ext_vector_type(16)));
typedef unsigned u32x4 __attribute__((ext_vector_type(4)));
typedef unsigned u32x2 __attribute__((ext_vector_type(2)));

constexpr int NTOK = 12288, NCTX = 4096, DM = 1024, INW = 2816;
constexpr size_t OUT_NK = 12582912, OUT_NV = 13631488;
constexpr float EPSF = 1e-6f;
constexpr float QSCALE = 0.125f * 1.4426950408889634f;

struct Params {
    const float *x_prompt, *x_sample, *cache_k, *cache_v, *c, *c_ctx, *norm_g, *w_ada, *b_ada, *w_in, *q_g, *k_g, *conv_w, *conv_b,
        *pool_w, *pool_scale, *w_out, *final_g;
    float* out;
    unsigned* bar;
    float* modv;
    float* rope;
    bf16_t* WinT;
    bf16_t* WoutT;
    bf16_t* PoolT;
    bf16_t* kc;
    bf16_t* vc;
    bf16_t* h;
    bf16_t* xn;
    bf16_t* proj;
    bf16_t* mix;
    int use_cg;
    int pad;
};

__device__ __forceinline__ unsigned pk_bf16(float lo, float hi) {
    unsigned r;
    asm("v_cvt_pk_bf16_f32 %0, %1, %2" : "=v"(r) : "v"(lo), "v"(hi));
    return r;
}
__device__ __forceinline__ float bf_lo(unsigned u) { return __uint_as_float(u << 16); }
__device__ __forceinline__ float bf_hi(unsigned u) { return __uint_as_float(u & 0xffff0000u); }
__device__ __forceinline__ float silu_f(float z) { return z / (1.0f + __expf(-z)); }
__device__ __forceinline__ f32x4 bf4_to_f32(const u32x2 u) { return (f32x4){bf_lo(u.x), bf_hi(u.x), bf_lo(u.y), bf_hi(u.y)}; }
__device__ __forceinline__ float max3_f(float a, float b, float c) { float r; asm("v_max3_f32 %0, %1, %2, %3" : "=v"(r) : "v"(a), "v"(b), "v"(c)); return r; }
__device__ __forceinline__ int otid() { int t = threadIdx.x; asm volatile("" : "+v"(t)); return t; }

#define XB_TMO 128
#define XB_XCNT(j) (256 + 64 * (j))
#define XB_XSUB(j) (1280 + 64 * (j))
#define XB_XGEN(j) (2304 + 64 * (j))
#define XB_TOP 3328
#define XB_TOPGEN 3392
#define XCD_BAR_WORDS 3456
#define XB_SPIN_CAP (1u << 20)

__device__ __forceinline__ unsigned xb_ld(unsigned* p) { return __hip_atomic_load(p, __ATOMIC_RELAXED, __HIP_MEMORY_SCOPE_AGENT); }
__device__ __forceinline__ unsigned xb_add(unsigned* p, unsigned v) { return __hip_atomic_fetch_add(p, v, __ATOMIC_RELAXED, __HIP_MEMORY_SCOPE_AGENT); }
__device__ __forceinline__ unsigned xb_xcc_id() { return (unsigned)__builtin_amdgcn_s_getreg((3 << 11) | 20) & 0xFu; }
#define XB_SPIN(cond, bar)                                                   \
    do {                                                                     \
        unsigned _sp = 0;                                                    \
        while (cond) {                                                       \
            __builtin_amdgcn_s_sleep(1);                                     \
            if ((++_sp & 255u) == 0u) {                                      \
                if (xb_ld(&(bar)[XB_TMO])) break;                            \
                if (_sp > XB_SPIN_CAP) { atomicAdd(&(bar)[XB_TMO], 1u); break; } \
            }                                                                \
        }                                                                    \
    } while (0)

struct XcdBarrier {
    unsigned* bar;
    unsigned x;
    volatile LAS unsigned* st;
};

__device__ __forceinline__ XcdBarrier xcd_barrier_post(unsigned* bar, volatile LAS unsigned* st) {
    XcdBarrier b;
    b.bar = bar;
    b.x = xb_xcc_id();
    b.st = st;
    if (threadIdx.x == 0) (void)xb_add(&bar[XB_XCNT(b.x)], 1u);
    return b;
}
__device__ __forceinline__ void xcd_barrier_complete(unsigned* bar, unsigned x, unsigned& nloc, unsigned& nx) {
    const unsigned G = gridDim.x * gridDim.y * gridDim.z;
    unsigned sum, cnt, mine, sp = 0u;
    for (;;) {
        sum = 0u; cnt = 0u; mine = 0u;
#pragma unroll
        for (unsigned j = 0; j < 16; ++j) {
            const unsigned c = xb_ld(&bar[XB_XCNT(j)]);
            sum += c; cnt += (c > 0u) ? 1u : 0u; mine = (j == x) ? c : mine;
        }
        if (sum == G) break;
        __builtin_amdgcn_s_sleep(1);
        if ((++sp & 255u) == 0u) {
            if (xb_ld(&bar[XB_TMO])) break;
            if (sp > XB_SPIN_CAP) { atomicAdd(&bar[XB_TMO], 1u); break; }
        }
    }
    nloc = mine > 0u ? mine : 1u;
    nx = cnt > 0u ? cnt : 1u;
}
__device__ __forceinline__ void xcd_barrier(const XcdBarrier& b) {
    asm volatile("s_waitcnt vmcnt(0)" ::: "memory");
    __syncthreads();
    if (threadIdx.x == 0) {
        unsigned* bar = b.bar;
        __builtin_amdgcn_s_waitcnt(0);
        unsigned nloc = b.st[0], nx = b.st[1];
        if (nloc == 0u) { xcd_barrier_complete(bar, b.x, nloc, nx); b.st[0] = nloc; b.st[1] = nx; }
        const unsigned old = xb_add(&bar[XB_XSUB(b.x)], 1u);
        const unsigned gen = old / nloc;
        if (old + 1u == (gen + 1u) * nloc) {
            __builtin_amdgcn_fence(__ATOMIC_RELEASE, "agent");
            asm volatile("s_waitcnt vmcnt(0)" ::: "memory");
            const unsigned og = xb_add(&bar[XB_TOP], 1u);
            const unsigned tg = og / nx;
            if (og + 1u == (tg + 1u) * nx) xb_add(&bar[XB_TOPGEN], 1u);
            else XB_SPIN(xb_ld(&bar[XB_TOPGEN]) == tg, bar);
            __builtin_amdgcn_fence(__ATOMIC_ACQUIRE, "agent");
            xb_add(&bar[XB_XGEN(b.x)], 1u);
            asm volatile("s_waitcnt vmcnt(0)" ::: "memory");
        } else {
            XB_SPIN(xb_ld(&bar[XB_XGEN(b.x)]) == gen, bar);
            __builtin_amdgcn_fence(__ATOMIC_ACQUIRE, "agent");
            asm volatile("s_waitcnt vmcnt(0)" ::: "memory");
        }
    }
    __syncthreads();
}

__device__ __forceinline__ void prep_mod_item(const Params& p, int item, unsigned char* smem) {
    const int tid = otid();
    float* sc = (float*)smem;
    float* red = (float*)(smem + 20480);
    const int l = item / 96, j0 = (item % 96) * 32;
    for (int idx = tid; idx < 5120; idx += 256) {
        const int v = idx >> 10, k = idx & 1023;
        const float cv = (v == 0) ? p.c_ctx[k] : p.c[(v - 1) * 1024 + k];
        sc[idx] = cv / (1.0f + expf(-cv));
    }
    __syncthreads();
    const int cgp = tid & 7, kg = tid >> 3;
    float acc[5][4];
#pragma unroll
    for (int v = 0; v < 5; ++v)
#pragma unroll
        for (int e = 0; e < 4; ++e) acc[v][e] = 0.f;
    const float* wp = p.w_ada + (size_t)l * 1024 * 3072 + j0 + cgp * 4;
    f32x4 wreg[32];
#pragma unroll
    for (int kk = 0; kk < 32; ++kk) wreg[kk] = *(const f32x4*)(wp + (size_t)(kk * 32 + kg) * 3072);
#pragma unroll
    for (int kk = 0; kk < 32; ++kk) {
        const int k = kk * 32 + kg;
        const f32x4 w = wreg[kk];
#pragma unroll
        for (int v = 0; v < 5; ++v) {
            const float s = sc[v * 1024 + k];
#pragma unroll
            for (int e = 0; e < 4; ++e) acc[v][e] += s * w[e];
        }
    }
#pragma unroll
    for (int v = 0; v < 5; ++v)
#pragma unroll
        for (int e = 0; e < 4; ++e) red[kg * 160 + v * 32 + cgp * 4 + e] = acc[v][e];
    __syncthreads();
    if (tid < 160) {
        float s = 0.f;
        for (int g = 0; g < 32; ++g) s += red[g * 160 + tid];
        const int v = tid >> 5, cc = tid & 31;
        p.modv[(size_t)(l * 5 + v) * 3072 + j0 + cc] = s + p.b_ada[l * 3072 + j0 + cc];
    }
    __syncthreads();
}

__device__ __forceinline__ void prep_transpose_item(const float* src, bf16_t* dst, int N, int k0, int n0) {
    const int n = n0 + otid();
    const float* sp = src + (size_t)k0 * N + n;
    float v[32];
#pragma unroll
    for (int i = 0; i < 32; ++i) v[i] = sp[(size_t)i * N];
    bf16_t* d = dst + (size_t)n * 1024 + k0;
#pragma unroll
    for (int c = 0; c < 4; ++c) {
        u32x4 w;
        w.x = pk_bf16(v[c * 8 + 0], v[c * 8 + 1]);
        w.y = pk_bf16(v[c * 8 + 2], v[c * 8 + 3]);
        w.z = pk_bf16(v[c * 8 + 4], v[c * 8 + 5]);
        w.w = pk_bf16(v[c * 8 + 6], v[c * 8 + 7]);
        *(u32x4*)(d + c * 8) = w;
    }
}

__device__ __forceinline__ void phase_prep(const Params& p, unsigned char* smem) {
    const int ntb = (int)gridDim.x * 5 / 8, nmb = (int)gridDim.x - ntb;
    const int NTI = 2 * 11 * 32, NTO = 2 * 4 * 32;
    if ((int)blockIdx.x < ntb) {
        for (int it = blockIdx.x; it < NTI + NTO; it += ntb) {
            if (it < NTI) {
                const int l = it / 352, r = it % 352, kt = r / 11, nt = r % 11;
                prep_transpose_item(p.w_in + (size_t)l * 1024 * INW, p.WinT + (size_t)l * INW * 1024, INW, kt * 32, nt * 256);
            } else {
                const int t = it - NTI, l = t / 128, r = t % 128, kt = r / 4, nt = r % 4;
                prep_transpose_item(p.w_out + (size_t)l * 1024 * 1024, p.WoutT + (size_t)l * 1024 * 1024, 1024, kt * 32, nt * 256);
            }
        }
    } else {
        for (int it = (int)blockIdx.x - ntb; it < 192; it += nmb) prep_mod_item(p, it, smem);
    }
    const int gsz = gridDim.x * 256;
    for (int i = blockIdx.x * 256 + otid(); i < 131072; i += gsz) {
        const int which = i >> 16, j4 = (i & 65535) * 4;
        const int d = j4 & 63, t = (j4 >> 6) & 255, kvh = (j4 >> 14) & 1, bl = j4 >> 15;
        const size_t si = ((size_t)(bl * 256 + t) * 2 + kvh) * 64 + d;
        const f32x4 v = *(const f32x4*)((which ? p.cache_v : p.cache_k) + si);
        u32x2 w;
        w.x = pk_bf16(v[0], v[1]);
        w.y = pk_bf16(v[2], v[3]);
        *(u32x2*)((which ? p.vc : p.kc) + j4) = w;
    }
    for (int j = blockIdx.x * 256 + otid(); j < 32768; j += gsz) {
        const int cc = j & 63, d = (j >> 6) & 63, lg = j >> 12;
        const float v = p.pool_w[((size_t)lg * 64 + cc) * 64 + d];
        p.PoolT[j] = (bf16_t)(pk_bf16(v, 0.f) & 0xffffu);
    }
    for (int j = blockIdx.x * 256 + otid(); j < 1024; j += gsz) {
        const int a = j & 15, r = j >> 4;
        const float inv = 1.0f / powf(10000.0f, (float)(2 * a) / 32.0f);
        const float ang = (float)r * inv;
        const float kf = rintf(ang * 0.15915494309189535f);
        float rr = fmaf(-kf, 6.2831854820251465f, ang);
        rr = fmaf(-kf, -1.7484555e-7f, rr);
        p.rope[j] = cosf(rr);
        p.rope[1024 + j] = sinf(rr);
    }
}

__device__ __forceinline__ float wave_sum(float v) {
#pragma unroll
    for (int o = 32; o >= 1; o >>= 1) v += __shfl_xor(v, o);
    return v;
}

__device__ __forceinline__ void phase_xn(const Params& p, int layer) {
    const int tid = otid(), lane = tid & 63, wave = tid >> 6;
    const int nw = gridDim.x * 4, w = blockIdx.x * 4 + wave;
    for (int t0 = w * 6; t0 < NTOK; t0 += nw * 6) {
        f32x4 x[6][4];
        if (layer == 0) {
#pragma unroll
            for (int u = 0; u < 6; ++u) {
                const int tok = t0 + u;
                const float* src = tok < NCTX ? p.x_prompt + (size_t)tok * DM : p.x_sample + (size_t)(tok - NCTX) * DM;
#pragma unroll
                for (int i = 0; i < 4; ++i) x[u][i] = *(const f32x4*)(src + i * 256 + lane * 4);
            }
        } else {
            u32x2 r[6][4];
#pragma unroll
            for (int u = 0; u < 6; ++u)
#pragma unroll
                for (int i = 0; i < 4; ++i) r[u][i] = *(const u32x2*)(p.h + (size_t)(t0 + u) * DM + i * 256 + lane * 4);
#pragma unroll
            for (int u = 0; u < 6; ++u)
#pragma unroll
                for (int i = 0; i < 4; ++i) x[u][i] = bf4_to_f32(r[u][i]);
        }
#pragma unroll
        for (int u = 0; u < 6; ++u) {
            const int tok = t0 + u;
            const int v = tok < NCTX ? 0 : 1 + ((tok - NCTX) >> 11);
            const float* mv = p.modv + (size_t)(layer * 5 + v) * 3072;
            float ss = 0.f;
#pragma unroll
            for (int i = 0; i < 4; ++i) ss += x[u][i][0] * x[u][i][0] + x[u][i][1] * x[u][i][1] + x[u][i][2] * x[u][i][2] + x[u][i][3] * x[u][i][3];
            ss = wave_sum(ss);
            const float rstd = rsqrtf(ss * (1.0f / 1024.0f) + EPSF);
#pragma unroll
            for (int i = 0; i < 4; ++i) {
                const int k = i * 256 + lane * 4;
                const f32x4 g = *(const f32x4*)(p.norm_g + layer * 1024 + k);
                const f32x4 sh = *(const f32x4*)(mv + k);
                const f32x4 sc = *(const f32x4*)(mv + 1024 + k);
                float o[4];
#pragma unroll
                for (int e = 0; e < 4; ++e) o[e] = x[u][i][e] * rstd * g[e] * (1.0f + sc[e]) + sh[e];
                u32x2 wv;
                wv.x = pk_bf16(o[0], o[1]);
                wv.y = pk_bf16(o[2], o[3]);
                *(u32x2*)(p.xn + (size_t)tok * DM + k) = wv;
            }
        }
    }
}

__device__ __forceinline__ void phase_final(const Params& p) {
    const int tid = otid(), lane = tid & 63, wave = tid >> 6;
    const int nw = gridDim.x * 4, w = blockIdx.x * 4 + wave;
    f32x4 g[4];
#pragma unroll
    for (int i = 0; i < 4; ++i) g[i] = *(const f32x4*)(p.final_g + i * 256 + lane * 4);
    for (int t0 = w * 6; t0 < NTOK; t0 += nw * 6) {
        u32x2 r[6][4];
#pragma unroll
        for (int u = 0; u < 6; ++u)
#pragma unroll
            for (int i = 0; i < 4; ++i) r[u][i] = *(const u32x2*)(p.xn + (size_t)(t0 + u) * DM + i * 256 + lane * 4);
#pragma unroll
        for (int u = 0; u < 6; ++u) {
            float* row = p.out + (size_t)(t0 + u) * DM;
            f32x4 x[4];
            float ss = 0.f;
#pragma unroll
            for (int i = 0; i < 4; ++i) {
                x[i] = bf4_to_f32(r[u][i]);
                ss += x[i][0] * x[i][0] + x[i][1] * x[i][1] + x[i][2] * x[i][2] + x[i][3] * x[i][3];
            }
            ss = wave_sum(ss);
            const float rstd = rsqrtf(ss * (1.0f / 1024.0f) + EPSF);
#pragma unroll
            for (int i = 0; i < 4; ++i) *(f32x4*)(row + i * 256 + lane * 4) = x[i] * rstd * g[i];
        }
    }
}

template <int MODE, int MI, int STG = 0>
__device__ __forceinline__ void gemm_epilogue(const Params& p, int layer, int mw, int nw, f32x4 (&acc)[MI][4], int fr, int fq,
                                              unsigned char* ct = nullptr, int m0t = 0, int n0t = 0) {
    if (MODE == 0) {
        const bool ctx = mw < NCTX;
        if (nw < 640) {
            const bool isq = nw < 512;
            const float* gp = (isq ? p.q_g : p.k_g) + layer * 64;
            f32x4 gv[4];
#pragma unroll
            for (int ni = 0; ni < 4; ++ni) gv[ni] = *(const f32x4*)(gp + ni * 16 + fq * 4);
#pragma unroll
            for (int mi = 0; mi < MI; ++mi) {
                const int tok = mw + mi * 16 + fr;
                float ss = 0.f;
#pragma unroll
                for (int ni = 0; ni < 4; ++ni)
#pragma unroll
                    for (int e = 0; e < 4; ++e) ss += acc[mi][ni][e] * acc[mi][ni][e];
                ss += __shfl_xor(ss, 16);
                ss += __shfl_xor(ss, 32);
                const float rstd = rsqrtf(ss * (1.0f / 64.0f) + EPSF);
                f32x4 val[4];
#pragma unroll
                for (int ni = 0; ni < 4; ++ni) val[ni] = acc[mi][ni] * rstd * gv[ni];
                if (!isq && ctx) {
                    float* nk = p.out + OUT_NK + ((size_t)((tok >> 8) * 2 + layer) * 256 + (tok & 255)) * 128 + (nw - 512) + fq * 4;
#pragma unroll
                    for (int ni = 0; ni < 4; ++ni) *(f32x4*)(nk + ni * 16) = val[ni];
                }
                if (!ctx) {
                    const int pos = (tok - NCTX) & 2047, prow = pos >> 6, pcol = pos & 63;
                    const f32x4 cr = *(const f32x4*)(p.rope + prow * 16 + fq * 4), sr = *(const f32x4*)(p.rope + 1024 + prow * 16 + fq * 4);
                    const f32x4 cc = *(const f32x4*)(p.rope + pcol * 16 + fq * 4), sn = *(const f32x4*)(p.rope + 1024 + pcol * 16 + fq * 4);
                    const f32x4 a0 = val[0], a1 = val[1], a2 = val[2], a3 = val[3];
                    val[0] = a0 * cr - a1 * sr;
                    val[1] = a1 * cr + a0 * sr;
                    val[2] = a2 * cc - a3 * sn;
                    val[3] = a3 * cc + a2 * sn;
                }
                if (isq) {
#pragma unroll
                    for (int ni = 0; ni < 4; ++ni) val[ni] = val[ni] * QSCALE;
                }
                bf16_t* pr = p.proj + (size_t)tok * INW + nw + fq * 4;
#pragma unroll
                for (int ni = 0; ni < 4; ++ni) {
                    u32x2 w;
                    w.x = pk_bf16(val[ni][0], val[ni][1]);
                    w.y = pk_bf16(val[ni][2], val[ni][3]);
                    if (STG) *(u32x2*)(ct + (tok - m0t) * 272 + (nw - n0t + fq * 4 + ni * 16) * 2) = w;
                    else *(u32x2*)(pr + ni * 16) = w;
                }
            }
        } else {
            const bool isv = nw < 768;
#pragma unroll
            for (int mi = 0; mi < MI; ++mi) {
                const int tok = mw + mi * 16 + fr;
                bf16_t* pr = p.proj + (size_t)tok * INW + nw + fq * 4;
#pragma unroll
                for (int ni = 0; ni < 4; ++ni) {
                    u32x2 w;
                    w.x = pk_bf16(acc[mi][ni][0], acc[mi][ni][1]);
                    w.y = pk_bf16(acc[mi][ni][2], acc[mi][ni][3]);
                    if (STG) *(u32x2*)(ct + (tok - m0t) * 272 + (nw - n0t + fq * 4 + ni * 16) * 2) = w;
                    else *(u32x2*)(pr + ni * 16) = w;
                }
                if (isv && ctx) {
                    float* nv = p.out + OUT_NV + ((size_t)((tok >> 8) * 2 + layer) * 256 + (tok & 255)) * 128 + (nw - 640) + fq * 4;
#pragma unroll
                    for (int ni = 0; ni < 4; ++ni) *(f32x4*)(nv + ni * 16) = acc[mi][ni];
                }
            }
        }
    } else {
        const int v = mw < NCTX ? 0 : 1 + ((mw - NCTX) >> 11);
        const float* gate = p.modv + (size_t)(layer * 5 + v) * 3072 + 2048 + nw + fq * 4;
        f32x4 gt[4];
#pragma unroll
        for (int ni = 0; ni < 4; ++ni) gt[ni] = *(const f32x4*)(gate + ni * 16);
#pragma unroll
        for (int mi = 0; mi < MI; ++mi) {
            const int tok = mw + mi * 16 + fr;
            const size_t eo = (size_t)tok * DM + nw + fq * 4;
            const float* xin = (tok < NCTX ? p.x_prompt + (size_t)tok * DM : p.x_sample + (size_t)(tok - NCTX) * DM) + nw + fq * 4;
#pragma unroll
            for (int ni = 0; ni < 4; ++ni) {
                if (layer == 0) {
                    const f32x4 r = *(const f32x4*)(xin + ni * 16) + gt[ni] * acc[mi][ni];
                    u32x2 w;
                    w.x = pk_bf16(r[0], r[1]);
                    w.y = pk_bf16(r[2], r[3]);
                    *(u32x2*)(p.h + eo + ni * 16) = w;
                } else {
                    const f32x4 r = bf4_to_f32(*(const u32x2*)(p.h + eo + ni * 16)) + gt[ni] * acc[mi][ni];
                    u32x2 w;
                    w.x = pk_bf16(r[0], r[1]);
                    w.y = pk_bf16(r[2], r[3]);
                    *(u32x2*)(p.xn + eo + ni * 16) = w;
                }
            }
        }
    }
}

template <int MODE>
__device__ __forceinline__ void gemm_tile(const Params& p, int layer, int mt, int nt, unsigned char* smem) {
    const int tid = otid(), lane = tid & 63, wave = tid >> 6, wm = wave >> 1, wn = wave & 1;
    const int fr = lane & 15, fq = lane >> 4;
    const int m0 = mt * 128, n0 = nt * 128;
    const bf16_t* A = (MODE == 0 ? p.xn : p.mix) + (size_t)m0 * 1024;
    const bf16_t* B = (MODE == 0 ? p.WinT + (size_t)layer * INW * 1024 : p.WoutT + (size_t)layer * 1024 * 1024) + (size_t)n0 * 1024;
    f32x4 acc[4][4];
#pragma unroll
    for (int i = 0; i < 4; ++i)
#pragma unroll
        for (int j = 0; j < 4; ++j) acc[i][j] = (f32x4){0.f, 0.f, 0.f, 0.f};

    const int srow = tid >> 3, scc = tid & 7;
    const bf16_t* ag = A + (size_t)srow * 1024 + scc * 8;
    const bf16_t* bg = B + (size_t)srow * 1024 + scc * 8;
    const int wofs = srow * 128 + ((scc ^ (srow & 7)) * 16);
    u32x4 raA[4], rbA[4], raB[4], rbB[4];
    auto gload = [&](int kt, u32x4* ra, u32x4* rb) {
#pragma unroll
        for (int i = 0; i < 4; ++i) {
            ra[i] = *(const u32x4*)(ag + (size_t)i * 32 * 1024 + kt * 64);
            rb[i] = *(const u32x4*)(bg + (size_t)i * 32 * 1024 + kt * 64);
        }
    };
    auto swrite = [&](int buf, const u32x4* ra, const u32x4* rb) {
        unsigned char* Aw = smem + buf * 32768;
#pragma unroll
        for (int i = 0; i < 4; ++i) {
            *(u32x4*)(Aw + wofs + i * 4096) = ra[i];
            *(u32x4*)(Aw + 16384 + wofs + i * 4096) = rb[i];
        }
    };
    gload(0, raA, rbA);
    gload(1, raB, rbB);
    swrite(0, raA, rbA);
    __syncthreads();
    const int aro = (wm * 64 + fr) * 128, bro = (wn * 64 + fr) * 128, sw = fr & 7;
    auto step = [&](int kt, u32x4* la, u32x4* lb, const u32x4* wa, const u32x4* wb) {
        const unsigned char* As = smem + (kt & 1) * 32768;
        const unsigned char* Bs = As + 16384;
        bf16x8 af[2][4], bf[2][4];
#pragma unroll
        for (int kk = 0; kk < 2; ++kk) {
            const int co = ((kk * 4 + fq) ^ sw) * 16;
#pragma unroll
            for (int i = 0; i < 4; ++i) {
                af[kk][i] = *(const bf16x8*)(As + aro + i * 2048 + co);
                bf[kk][i] = *(const bf16x8*)(Bs + bro + i * 2048 + co);
            }
        }
        if (kt + 2 < 16) gload(kt + 2, la, lb);
        __builtin_amdgcn_sched_barrier(0);
#pragma unroll
        for (int mi = 0; mi < 4; ++mi)
#pragma unroll
            for (int ni = 0; ni < 4; ++ni) acc[mi][ni] = __builtin_amdgcn_mfma_f32_16x16x32_bf16(bf[0][ni], af[0][mi], acc[mi][ni], 0, 0, 0);
        __builtin_amdgcn_sched_barrier(0);
        if (kt + 1 < 16) swrite((kt + 1) & 1, wa, wb);
        __builtin_amdgcn_sched_barrier(0);
#pragma unroll
        for (int mi = 0; mi < 4; ++mi)
#pragma unroll
            for (int ni = 0; ni < 4; ++ni) acc[mi][ni] = __builtin_amdgcn_mfma_f32_16x16x32_bf16(bf[1][ni], af[1][mi], acc[mi][ni], 0, 0, 0);
        __syncthreads();
    };
    for (int kt = 0; kt < 16; kt += 2) {
        step(kt, raA, rbA, raB, rbB);
        step(kt + 1, raB, rbB, raA, rbA);
    }

    gemm_epilogue<MODE, 4>(p, layer, m0 + wm * 64, n0 + wn * 64, acc, fr, fq);
}

template <int MODE>
__device__ __forceinline__ void gemm_tile256(const Params& p, int layer, int mt, int nt, unsigned char* smem) {
    const int tid = otid(), lane = tid & 63, wave = tid >> 6, wm = wave >> 1, wn = wave & 1;
    const int fr = lane & 15, fq = lane >> 4;
    const int m0 = mt * 256, n0 = nt * 128;
    const bf16_t* A = (MODE == 0 ? p.xn : p.mix) + (size_t)m0 * 1024;
    const bf16_t* B = (MODE == 0 ? p.WinT + (size_t)layer * INW * 1024 : p.WoutT + (size_t)layer * 1024 * 1024) + (size_t)n0 * 1024;
    f32x4 acc[8][4];
#pragma unroll
    for (int i = 0; i < 8; ++i)
#pragma unroll
        for (int j = 0; j < 4; ++j) acc[i][j] = (f32x4){0.f, 0.f, 0.f, 0.f};
    const int srow = tid >> 2, scc = tid & 3;
    const bf16_t* ag = A + (size_t)srow * 1024 + scc * 8;
    const bf16_t* bg = B + (size_t)srow * 1024 + scc * 8;
    const int wofs = srow * 64 + ((scc ^ ((4 - ((srow >> 2) & 3)) & 3)) * 16);
    u32x4 raA[4], rbA[2], raB[4], rbB[2];
    auto gload = [&](int kt, u32x4* ra, u32x4* rb) {
#pragma unroll
        for (int i = 0; i < 4; ++i) ra[i] = *(const u32x4*)(ag + (size_t)i * 64 * 1024 + kt * 32);
#pragma unroll
        for (int i = 0; i < 2; ++i) rb[i] = *(const u32x4*)(bg + (size_t)i * 64 * 1024 + kt * 32);
    };
    auto swrite = [&](int buf, const u32x4* ra, const u32x4* rb) {
        unsigned char* Aw = smem + buf * 24576;
#pragma unroll
        for (int i = 0; i < 4; ++i) *(u32x4*)(Aw + wofs + i * 4096) = ra[i];
#pragma unroll
        for (int i = 0; i < 2; ++i) *(u32x4*)(Aw + 16384 + wofs + i * 4096) = rb[i];
    };
    gload(0, raA, rbA);
    gload(1, raB, rbB);
    swrite(0, raA, rbA);
    __syncthreads();
    const int co = (fq ^ ((4 - ((fr >> 2) & 3)) & 3)) * 16;
    const int aro = (wm * 128 + fr) * 64 + co, bro = (wn * 64 + fr) * 64 + co;
    auto step = [&](int kt, u32x4* la, u32x4* lb, const u32x4* wa, const u32x4* wb) {
        const unsigned char* As = smem + (kt & 1) * 24576;
        const unsigned char* Bs = As + 16384;
        bf16x8 af[8], bf[4];
#pragma unroll
        for (int i = 0; i < 4; ++i) bf[i] = *(const bf16x8*)(Bs + bro + i * 1024);
#pragma unroll
        for (int i = 0; i < 8; ++i) af[i] = *(const bf16x8*)(As + aro + i * 1024);
        if (kt + 2 < 32) gload(kt + 2, la, lb);
        __builtin_amdgcn_sched_barrier(0);
#pragma unroll
        for (int mi = 0; mi < 4; ++mi)
#pragma unroll
            for (int ni = 0; ni < 4; ++ni) acc[mi][ni] = __builtin_amdgcn_mfma_f32_16x16x32_bf16(bf[ni], af[mi], acc[mi][ni], 0, 0, 0);
        __builtin_amdgcn_sched_barrier(0);
        if (kt + 1 < 32) swrite((kt + 1) & 1, wa, wb);
        __builtin_amdgcn_sched_barrier(0);
#pragma unroll
        for (int mi = 4; mi < 8; ++mi)
#pragma unroll
            for (int ni = 0; ni < 4; ++ni) acc[mi][ni] = __builtin_amdgcn_mfma_f32_16x16x32_bf16(bf[ni], af[mi], acc[mi][ni], 0, 0, 0);
        __syncthreads();
    };
    for (int kt = 0; kt < 32; kt += 2) {
        step(kt, raA, rbA, raB, rbB);
        step(kt + 1, raB, rbB, raA, rbA);
    }
    gemm_epilogue<MODE, 8>(p, layer, m0 + wm * 128, n0 + wn * 64, acc, fr, fq);
}

template <int MODE>
__device__ __forceinline__ void gemm_tile256_dma(const Params& p, int layer, int mt, int nt, unsigned char* smem) {
    const int tid = otid(), lane = tid & 63, wave = tid >> 6, wm = wave >> 1, wn = wave & 1;
    const int fr = lane & 15, fq = lane >> 4;
    const int m0 = mt * 256, n0 = nt * 128;
    const bf16_t* A = (MODE == 0 ? p.xn : p.mix) + (size_t)m0 * 1024;
    const bf16_t* B = (MODE == 0 ? p.WinT + (size_t)layer * INW * 1024 : p.WoutT + (size_t)layer * 1024 * 1024) + (size_t)n0 * 1024;
    f32x4 acc[8][4];
#pragma unroll
    for (int i = 0; i < 8; ++i)
#pragma unroll
        for (int j = 0; j < 4; ++j) acc[i][j] = (f32x4){0.f, 0.f, 0.f, 0.f};
    const int lrow = lane >> 2, lc = (lane & 3) ^ ((4 - ((lane >> 4) & 3)) & 3);
    const bf16_t* agp = A + (size_t)(wave * 64 + lrow) * 1024 + lc * 8;
    const bf16_t* bgp = B + (size_t)(wave * 32 + lrow) * 1024 + lc * 8;
    LAS unsigned char* lbase = (LAS unsigned char*)smem;
    const int la_off = wave * 4096 + lane * 16, lb_off = 16384 + wave * 2048 + lane * 16;
    auto dma = [&](int kt, int stage) {
        LAS unsigned char* sb = lbase + stage * 24576;
#pragma unroll
        for (int i = 0; i < 4; ++i)
            __builtin_amdgcn_global_load_lds((const void*)(agp + (size_t)i * 16 * 1024 + kt * 32), (LAS void*)(sb + la_off + i * 1024), 16, 0, 0);
#pragma unroll
        for (int i = 0; i < 2; ++i)
            __builtin_amdgcn_global_load_lds((const void*)(bgp + (size_t)i * 16 * 1024 + kt * 32), (LAS void*)(sb + lb_off + i * 1024), 16, 0, 0);
    };
    dma(0, 0);
    dma(1, 1);
    asm volatile("s_waitcnt vmcnt(6)" ::: "memory");
    __builtin_amdgcn_s_barrier();
    const int co = (fq ^ ((4 - ((fr >> 2) & 3)) & 3)) * 16;
    const int aro = (wm * 128 + fr) * 64 + co, bro = 16384 + (wn * 64 + fr) * 64 + co;
    int st = 0, st2 = 2;
    const unsigned lds0 = (unsigned)(uintptr_t)lbase;
#pragma unroll 1
    for (int kt = 0; kt < 32; ++kt) {
        const unsigned sa = lds0 + st * 24576 + aro, sbb = lds0 + st * 24576 + bro;
        bf16x8 af[8], bf[4];
#define FRAG_RD(dst, addr, OFF) asm volatile("ds_read_b128 %0, %1 offset:" #OFF : "=&v"(dst) : "v"(addr))
        FRAG_RD(bf[0], sbb, 0); FRAG_RD(bf[1], sbb, 1024); FRAG_RD(bf[2], sbb, 2048); FRAG_RD(bf[3], sbb, 3072);
        FRAG_RD(af[0], sa, 0); FRAG_RD(af[1], sa, 1024); FRAG_RD(af[2], sa, 2048); FRAG_RD(af[3], sa, 3072);
        FRAG_RD(af[4], sa, 4096); FRAG_RD(af[5], sa, 5120); FRAG_RD(af[6], sa, 6144); FRAG_RD(af[7], sa, 7168);
#undef FRAG_RD
        __builtin_amdgcn_sched_barrier(0);
        if (kt + 2 < 32) dma(kt + 2, st2);
        __builtin_amdgcn_sched_barrier(0);
        asm volatile("s_waitcnt lgkmcnt(4)" ::: "memory");
        __builtin_amdgcn_sched_barrier(0);
#pragma unroll
        for (int mi = 0; mi < 4; ++mi)
#pragma unroll
            for (int ni = 0; ni < 4; ++ni) acc[mi][ni] = __builtin_amdgcn_mfma_f32_16x16x32_bf16(bf[ni], af[mi], acc[mi][ni], 0, 0, 0);
        __builtin_amdgcn_sched_barrier(0);
        asm volatile("s_waitcnt lgkmcnt(0)" ::: "memory");
        __builtin_amdgcn_sched_barrier(0);
#pragma unroll
        for (int mi = 4; mi < 8; ++mi)
#pragma unroll
            for (int ni = 0; ni < 4; ++ni) acc[mi][ni] = __builtin_amdgcn_mfma_f32_16x16x32_bf16(bf[ni], af[mi], acc[mi][ni], 0, 0, 0);
        __builtin_amdgcn_sched_barrier(0);
        if (kt + 2 < 32) asm volatile("s_waitcnt vmcnt(6)" ::: "memory");
        else asm volatile("s_waitcnt vmcnt(0)" ::: "memory");
        __builtin_amdgcn_s_barrier();
        st = st == 2 ? 0 : st + 1;
        st2 = st2 == 2 ? 0 : st2 + 1;
    }
    if (MODE == 0) {
        gemm_epilogue<0, 8, 1>(p, layer, m0 + wm * 128, n0 + wn * 64, acc, fr, fq, smem, m0, n0);
        __syncthreads();
        u32x4 cv[16];
#pragma unroll
        for (int i = 0; i < 16; ++i) { const int e = tid + 256 * i; cv[i] = *(const u32x4*)(smem + (e >> 4) * 272 + (e & 15) * 16); }
#pragma unroll
        for (int i = 0; i < 16; ++i) { const int e = tid + 256 * i; *(u32x4*)(p.proj + (size_t)(m0 + (e >> 4)) * INW + n0 + (e & 15) * 8) = cv[i]; }
        __syncthreads();
    } else {
#pragma unroll 1
        for (int pass = 0; pass < 2; ++pass) {
            if (wm == pass) {
#pragma unroll
                for (int mi = 0; mi < 8; ++mi)
#pragma unroll
                    for (int ni = 0; ni < 4; ++ni) *(f32x4*)(smem + (mi * 16 + fr) * 528 + (wn * 64 + ni * 16 + fq * 4) * 4) = acc[mi][ni];
            }
            __syncthreads();
            const int rbase = m0 + pass * 128;
            const int c4 = (tid & 31) * 4;
            f32x4 ho[16];
#pragma unroll
            for (int i = 0; i < 16; ++i) {
                const int tok = rbase + (tid >> 5) + 8 * i;
                if (layer == 0) ho[i] = *(const f32x4*)((tok < NCTX ? p.x_prompt + (size_t)tok * DM : p.x_sample + (size_t)(tok - NCTX) * DM) + n0 + c4);
                else ho[i] = bf4_to_f32(*(const u32x2*)(p.h + (size_t)tok * DM + n0 + c4));
            }
            const int v = rbase < NCTX ? 0 : 1 + ((rbase - NCTX) >> 11);
            const f32x4 gt = *(const f32x4*)(p.modv + (size_t)(layer * 5 + v) * 3072 + 2048 + n0 + c4);
#pragma unroll
            for (int i = 0; i < 16; ++i) {
                const int row = (tid >> 5) + 8 * i, tok = rbase + row;
                const f32x4 a = *(const f32x4*)(smem + row * 528 + c4 * 4);
                const f32x4 r = ho[i] + gt * a;
                if (layer == 0) {
                    u32x2 w;
                    w.x = pk_bf16(r[0], r[1]);
                    w.y = pk_bf16(r[2], r[3]);
                    *(u32x2*)(p.h + (size_t)tok * DM + n0 + c4) = w;
                } else {
                    u32x2 w;
                    w.x = pk_bf16(r[0], r[1]);
                    w.y = pk_bf16(r[2], r[3]);
                    *(u32x2*)(p.xn + (size_t)tok * DM + n0 + c4) = w;
                }
            }
            __syncthreads();
        }
    }
}

__device__ __forceinline__ void gemm_piece64_dma(const Params& p, int layer, int m0, int n0, unsigned char* smem) {
    const int tid = otid(), lane = tid & 63, wave = tid >> 6, wm = wave >> 1, wn = wave & 1;
    const int fr = lane & 15, fq = lane >> 4;
    const bf16_t* A = p.xn + (size_t)m0 * 1024;
    const bf16_t* B = p.WinT + (size_t)layer * INW * 1024 + (size_t)n0 * 1024;
    f32x4 acc[2][4];
#pragma unroll
    for (int i = 0; i < 2; ++i)
#pragma unroll
        for (int j = 0; j < 4; ++j) acc[i][j] = (f32x4){0.f, 0.f, 0.f, 0.f};
    const int lrow = lane >> 2, lc = (lane & 3) ^ ((4 - ((lane >> 4) & 3)) & 3);
    const bf16_t* agp = A + (size_t)(wave * 16 + lrow) * 1024 + lc * 8;
    const bf16_t* bgp = B + (size_t)(wave * 32 + lrow) * 1024 + lc * 8;
    LAS unsigned char* lbase = (LAS unsigned char*)smem;
    const int la_off = wave * 1024 + lane * 16, lb_off = 4096 + wave * 2048 + lane * 16;
    auto dma = [&](int kt, int stage) {
        LAS unsigned char* sb = lbase + stage * 12288;
        __builtin_amdgcn_global_load_lds((const void*)(agp + kt * 32), (LAS void*)(sb + la_off), 16, 0, 0);
#pragma unroll
        for (int i = 0; i < 2; ++i)
            __builtin_amdgcn_global_load_lds((const void*)(bgp + (size_t)i * 16 * 1024 + kt * 32), (LAS void*)(sb + lb_off + i * 1024), 16, 0, 0);
    };
    dma(0, 0);
    dma(1, 1);
    asm volatile("s_waitcnt vmcnt(3)" ::: "memory");
    __builtin_amdgcn_s_barrier();
    const int co = (fq ^ ((4 - ((fr >> 2) & 3)) & 3)) * 16;
    const int aro = (wm * 32 + fr) * 64 + co, bro = 4096 + (wn * 64 + fr) * 64 + co;
    int st = 0, st2 = 2;
    const unsigned lds0 = (unsigned)(uintptr_t)lbase;
#pragma unroll 1
    for (int kt = 0; kt < 32; ++kt) {
        const unsigned sa = lds0 + st * 12288 + aro, sbb = lds0 + st * 12288 + bro;
        bf16x8 af[2], bf[4];
#define FRAG_RD(dst, addr, OFF) asm volatile("ds_read_b128 %0, %1 offset:" #OFF : "=&v"(dst) : "v"(addr))
        FRAG_RD(bf[0], sbb, 0); FRAG_RD(bf[1], sbb, 1024); FRAG_RD(bf[2], sbb, 2048); FRAG_RD(bf[3], sbb, 3072);
        FRAG_RD(af[0], sa, 0); FRAG_RD(af[1], sa, 1024);
#undef FRAG_RD
        __builtin_amdgcn_sched_barrier(0);
        if (kt + 2 < 32) dma(kt + 2, st2);
        __builtin_amdgcn_sched_barrier(0);
        asm volatile("s_waitcnt lgkmcnt(0)" ::: "memory");
        __builtin_amdgcn_sched_barrier(0);
#pragma unroll
        for (int mi = 0; mi < 2; ++mi)
#pragma unroll
            for (int ni = 0; ni < 4; ++ni) acc[mi][ni] = __builtin_amdgcn_mfma_f32_16x16x32_bf16(bf[ni], af[mi], acc[mi][ni], 0, 0, 0);
        __builtin_amdgcn_sched_barrier(0);
        if (kt + 2 < 32) asm volatile("s_waitcnt vmcnt(3)" ::: "memory");
        else asm volatile("s_waitcnt vmcnt(0)" ::: "memory");
        __builtin_amdgcn_s_barrier();
        st = st == 2 ? 0 : st + 1;
        st2 = st2 == 2 ? 0 : st2 + 1;
    }
    gemm_epilogue<0, 2, 1>(p, layer, m0 + wm * 32, n0 + wn * 64, acc, fr, fq, smem, m0, n0);
    __syncthreads();
    u32x4 cv[4];
#pragma unroll
    for (int i = 0; i < 4; ++i) { const int e = tid + 256 * i; cv[i] = *(const u32x4*)(smem + (e >> 4) * 272 + (e & 15) * 16); }
#pragma unroll
    for (int i = 0; i < 4; ++i) { const int e = tid + 256 * i; *(u32x4*)(p.proj + (size_t)(m0 + (e >> 4)) * INW + n0 + (e & 15) * 8) = cv[i]; }
    __syncthreads();
}

template <int MODE>
__device__ __forceinline__ void phase_gemm(const Params& p, int layer, unsigned char* smem) {
    const int NT = MODE == 0 ? 22 : 8;
    const int total = 96 * NT;
    if (gridDim.x == 512) {
        const int xcd = blockIdx.x & 7, slot = blockIdx.x >> 3;
        if (MODE == 0) {
            if (slot < 16) gemm_piece64_dma(p, layer, (xcd * 6 + 2 + (slot >> 2)) * 256 + (slot & 3) * 64, 21 * 128, smem);
            for (int idx = slot; idx < 128; idx += 64) gemm_tile256_dma<MODE>(p, layer, xcd * 6 + idx % 6, idx / 6, smem);
        } else {
            if (slot < 32) gemm_tile256_dma<MODE>(p, layer, xcd * 6 + slot % 6, slot / 6, smem);
            else {
                const int d = 32 + ((slot - 32) >> 1);
                gemm_tile<MODE>(p, layer, (xcd * 6 + d % 6) * 2 + (slot & 1), d / 6, smem);
            }
        }
    } else {
        for (int t = blockIdx.x; t < total; t += gridDim.x) gemm_tile<MODE>(p, layer, t / NT, t % NT, smem);
    }
}

template <int VAR>
__device__ __forceinline__ void attn_unit(const Params& p, int layer, int unit, unsigned char* smem) {
    const int tid = otid(), lane = tid & 63, wave = tid >> 6;
    const int r31 = lane & 31, hh = lane >> 5;
    int b, head, qblk, tokbase, nself, ntiles;
    if (unit < 512) { b = unit >> 7; head = (unit >> 4) & 7; qblk = unit & 15; tokbase = NCTX + b * 2048; nself = 2048; ntiles = 36; }
    else { const int u = unit - 512; b = u >> 4; head = (u >> 1) & 7; qblk = u & 1; tokbase = b * 256; nself = 256; ntiles = 4; }
    const int kvh = head >> 2;
    const int qtok = tokbase + qblk * 128 + wave * 32 + r31;
    bf16x8 qf[4];
    {
        const bf16_t* qp = p.proj + (size_t)qtok * INW + head * 64 + hh * 8;
#pragma unroll
        for (int ks = 0; ks < 4; ++ks) qf[ks] = *(const bf16x8*)(qp + ks * 16);
    }
    const bf16_t* kself = p.proj + (size_t)tokbase * INW + 512 + kvh * 64;
    const bf16_t* vself = p.proj + (size_t)tokbase * INW + 640 + kvh * 64;
    const bf16_t* kcache = p.kc + (size_t)((b * 2 + layer) * 2 + kvh) * 256 * 64;
    const bf16_t* vcache = p.vc + (size_t)((b * 2 + layer) * 2 + kvh) * 256 * 64;
    const int srow = tid >> 3, scc = tid & 7;
    const int kwo = srow * 128 + ((scc ^ ((srow >> 1) & 7)) * 16);
    const int vwo = srow * 128 + ((scc ^ (((srow >> 1) & 1) << 2)) * 16);
    u32x4 rkA[2], rvA[2], rkB[2], rvB[2];
    auto gload = [&](int j, u32x4* rk, u32x4* rv) {
        const int key0 = j * 64;
#pragma unroll
        for (int i = 0; i < 2; ++i) {
            const int row = srow + 32 * i;
            if (key0 < nself) {
                rk[i] = *(const u32x4*)(kself + (size_t)(key0 + row) * INW + scc * 8);
                rv[i] = *(const u32x4*)(vself + (size_t)(key0 + row) * INW + scc * 8);
            } else {
                rk[i] = *(const u32x4*)(kcache + (size_t)(key0 - nself + row) * 64 + scc * 8);
                rv[i] = *(const u32x4*)(vcache + (size_t)(key0 - nself + row) * 64 + scc * 8);
            }
        }
    };
    auto swrite = [&](int buf, const u32x4* rk, const u32x4* rv) {
        unsigned char* kb = smem + buf * 16384;
        unsigned char* vb = kb + 8192;
#pragma unroll
        for (int i = 0; i < 2; ++i) {
            *(u32x4*)(kb + kwo + i * 32 * 128) = rk[i];
            *(u32x4*)(vb + vwo + i * 32 * 128) = rv[i];
        }
    };
    f32x16 o[2];
#pragma unroll
    for (int i = 0; i < 16; ++i) { o[0][i] = 0.f; o[1][i] = 0.f; }
    float mrun = 0.f, mmax = -1e30f, lrun = 0.f;
    f32x16 negm, zero16;
#pragma unroll
    for (int i = 0; i < 16; ++i) { negm[i] = 0.f; zero16[i] = 0.f; }
    bool shifted = false;
    gload(0, rkA, rvA);
    swrite(0, rkA, rvA);
    if (ntiles > 1) gload(1, rkB, rvB);
    __syncthreads();
    const int kro = r31 * 128, ksw = (r31 >> 1) & 7;
    const int vq = 4 * hh + ((lane & 15) >> 2);
    const int vsw = ((vq >> 1) & 1) << 2;
    const int vcl = ((lane >> 4) & 1) * 2 + ((lane & 3) >> 1);
    const int vro0 = vq * 128 + (((0 * 4 + vcl) ^ vsw) * 16) + (lane & 1) * 8;
    const int vro1 = vq * 128 + (((1 * 4 + vcl) ^ vsw) * 16) + (lane & 1) * 8;
    auto step = [&](int j, u32x4* lk, u32x4* lv, const u32x4* wk, const u32x4* wv) {
        const unsigned char* kb = smem + (j & 1) * 16384;
        const unsigned char* vb = kb + 8192;
        bf16x8 kf[2][4];
#pragma unroll
        for (int sb = 0; sb < 2; ++sb)
#pragma unroll
            for (int ks = 0; ks < 4; ++ks) kf[sb][ks] = *(const bf16x8*)(kb + sb * 4096 + kro + (((ks * 2 + hh) ^ ksw) * 16));
        bf16x8 vf[2][2][2];
#pragma unroll
        for (int sb = 0; sb < 2; ++sb)
#pragma unroll
            for (int s2 = 0; s2 < 2; ++s2)
#pragma unroll
                for (int dt = 0; dt < 2; ++dt) {
                    const LAS unsigned char* va = (const LAS unsigned char*)(vb) + (sb * 32 + s2 * 16) * 128 + (dt ? vro1 : vro0);
                    const s16x4 a0 = __builtin_amdgcn_ds_read_tr16_b64_v4i16((LAS s16x4*)(va));
                    const s16x4 a1 = __builtin_amdgcn_ds_read_tr16_b64_v4i16((LAS s16x4*)(va + 8 * 128));
                    vf[sb][s2][dt] = (bf16x8){a0[0], a0[1], a0[2], a0[3], a1[0], a1[1], a1[2], a1[3]};
                }
        if (VAR != 1 && j + 2 < ntiles) gload(j + 2, lk, lv);
        __builtin_amdgcn_sched_barrier(0);
        f32x16 s[2];
        float mloc, lsum = 0.f;
        bf16x8 pf[2][2];
#pragma unroll
        for (int sb = 0; sb < 2; ++sb)
#pragma unroll
            for (int ks = 0; ks < 4; ++ks) {
                if (ks == 0) {
                    if (shifted) s[sb] = __builtin_amdgcn_mfma_f32_32x32x16_bf16(kf[sb][ks], qf[ks], negm, 0, 0, 0);
                    else s[sb] = __builtin_amdgcn_mfma_f32_32x32x16_bf16(kf[sb][ks], qf[ks], zero16, 0, 0, 0);
                } else s[sb] = __builtin_amdgcn_mfma_f32_32x32x16_bf16(kf[sb][ks], qf[ks], s[sb], 0, 0, 0);
            }
#pragma unroll
        for (int sb = 0; sb < 2; ++sb) {
            float m0 = max3_f(s[sb][0], s[sb][1], s[sb][2]);
#pragma unroll
            for (int i = 3; i < 15; i += 2) m0 = max3_f(m0, s[sb][i], s[sb][i + 1]);
            m0 = fmaxf(m0, s[sb][15]);
            mloc = sb == 0 ? m0 : fmaxf(mloc, m0);
#pragma unroll
            for (int i = 0; i < 16; ++i) { if (VAR != 2) { s[sb][i] = __builtin_amdgcn_exp2f(s[sb][i]); lsum += s[sb][i]; } }
#pragma unroll
            for (int s2 = 0; s2 < 2; ++s2) {
                u32x4 pw;
                pw.x = pk_bf16(s[sb][s2 * 8 + 0], s[sb][s2 * 8 + 1]);
                pw.y = pk_bf16(s[sb][s2 * 8 + 2], s[sb][s2 * 8 + 3]);
                pw.z = pk_bf16(s[sb][s2 * 8 + 4], s[sb][s2 * 8 + 5]);
                pw.w = pk_bf16(s[sb][s2 * 8 + 6], s[sb][s2 * 8 + 7]);
                pf[sb][s2] = __builtin_bit_cast(bf16x8, pw);
            }
#pragma unroll
            for (int s2 = 0; s2 < 2; ++s2)
#pragma unroll
                for (int dt = 0; dt < 2; ++dt) o[dt] = __builtin_amdgcn_mfma_f32_32x32x16_bf16(vf[sb][s2][dt], pf[sb][s2], o[dt], 0, 0, 0);
        }
        lrun += lsum;
        __builtin_amdgcn_sched_barrier(0);
        mloc = fmaxf(mloc, __shfl_xor(mloc, 32));
        mmax = fmaxf(mmax, mrun + mloc);
        if (__builtin_expect(__any(fabsf(mmax - mrun) > 40.0f), 0)) {
            asm volatile("" ::: "memory");
            const float alpha = __builtin_amdgcn_exp2f(mrun - mmax);
            mrun = mmax;
            lrun *= alpha;
            shifted = true;
#pragma unroll
            for (int i = 0; i < 16; ++i) { o[0][i] *= alpha; o[1][i] *= alpha; negm[i] = -mrun; }
        }
        if (VAR != 1 && j + 1 < ntiles) swrite((j + 1) & 1, wk, wv);
        __syncthreads();
    };
    for (int j = 0; j < ntiles; j += 2) {
        step(j, rkA, rvA, rkB, rvB);
        step(j + 1, rkB, rvB, rkA, rvA);
    }
    const float ltot = lrun + __shfl_xor(lrun, 32);
    const float inv = 1.0f / ltot;
    const bf16_t* zp = p.proj + (size_t)qtok * INW + 768 + head * 64;
    bf16_t* mp = (VAR == 0 ? p.mix : p.xn) + (size_t)qtok * DM + head * 64;
#pragma unroll
    for (int dt = 0; dt < 2; ++dt)
#pragma unroll
        for (int rq = 0; rq < 4; ++rq) {
            const int d0 = dt * 32 + 8 * rq + 4 * hh;
            const u32x2 zz = *(const u32x2*)(zp + d0);
            const float z0 = bf_lo(zz.x), z1 = bf_hi(zz.x), z2 = bf_lo(zz.y), z3 = bf_hi(zz.y);
            u32x2 w;
            w.x = pk_bf16(o[dt][rq * 4 + 0] * inv * silu_f(z0), o[dt][rq * 4 + 1] * inv * silu_f(z1));
            w.y = pk_bf16(o[dt][rq * 4 + 2] * inv * silu_f(z2), o[dt][rq * 4 + 3] * inv * silu_f(z3));
            *(u32x2*)(mp + d0) = w;
        }
}

__device__ __forceinline__ void unpack8(const u32x4 u, float* f) {
    f[0] = bf_lo(u.x); f[1] = bf_hi(u.x); f[2] = bf_lo(u.y); f[3] = bf_hi(u.y);
    f[4] = bf_lo(u.z); f[5] = bf_hi(u.z); f[6] = bf_lo(u.w); f[7] = bf_hi(u.w);
}

template <int WIN>
__device__ __forceinline__ void pool_group(const Params& p, int layer, int T0, int toff, int seqlen, int gi, int fr, int fq, const bf16x8 (&wf)[4][2],
                                           const f32x4 (&ps)[4], const unsigned char* smem) {
    constexpr int HALF = WIN / 2;
    u32x2 zz[2][4];
#pragma unroll
    for (int mi = 0; mi < 2; ++mi)
#pragma unroll
        for (int ni = 0; ni < 4; ++ni) zz[mi][ni] = *(const u32x2*)(p.proj + (size_t)(T0 + mi * 16 + fr) * INW + 2560 + gi * 64 + ni * 16 + fq * 4);
#pragma unroll
    for (int mi = 0; mi < 2; ++mi) {
        const int tt = mi * 16 + fr, ts = toff + tt, tok = T0 + tt;
        int lo = ts - HALF, hi = ts - HALF + WIN - 1;
        lo = lo < 0 ? 0 : lo;
        hi = hi > seqlen - 1 ? seqlen - 1 : hi;
        const float rc = 1.0f / (float)(hi - lo + 1);
        f32x4 acc[4];
#pragma unroll
        for (int j = 0; j < 4; ++j) acc[j] = (f32x4){0.f, 0.f, 0.f, 0.f};
#pragma unroll
        for (int kk = 0; kk < 2; ++kk) {
            const int co = (gi * 64 + kk * 32 + fq * 8) * 2;
            u32x4 rw[WIN];
#pragma unroll
            for (int j = 0; j < WIN; ++j) rw[j] = *(const u32x4*)(smem + (tt + 8 - HALF + j) * 528 + co);
            const u32x4 self = *(const u32x4*)(smem + (tt + 8) * 528 + co);
            float sum[8];
#pragma unroll
            for (int e = 0; e < 8; ++e) sum[e] = 0.f;
#pragma unroll
            for (int j = 0; j < WIN; ++j) {
                const int sq = ts - HALF + j;
                const float m = (sq >= 0 && sq < seqlen) ? 1.0f : 0.0f;
                float f[8];
                unpack8(rw[j], f);
#pragma unroll
                for (int e = 0; e < 8; ++e) sum[e] = fmaf(f[e], m, sum[e]);
            }
            float us[8];
            unpack8(self, us);
            u32x4 dw;
            dw.x = pk_bf16(sum[0] * rc - us[0], sum[1] * rc - us[1]);
            dw.y = pk_bf16(sum[2] * rc - us[2], sum[3] * rc - us[3]);
            dw.z = pk_bf16(sum[4] * rc - us[4], sum[5] * rc - us[5]);
            dw.w = pk_bf16(sum[6] * rc - us[6], sum[7] * rc - us[7]);
            const bf16x8 df = __builtin_bit_cast(bf16x8, dw);
#pragma unroll
            for (int ni = 0; ni < 4; ++ni) acc[ni] = __builtin_amdgcn_mfma_f32_16x16x32_bf16(wf[ni][kk], df, acc[ni], 0, 0, 0);
        }
#pragma unroll
        for (int ni = 0; ni < 4; ++ni) {
            const int ch = gi * 64 + ni * 16 + fq * 4;
            u32x2 w;
            w.x = pk_bf16(acc[ni][0] * ps[ni][0] * silu_f(bf_lo(zz[mi][ni].x)), acc[ni][1] * ps[ni][1] * silu_f(bf_hi(zz[mi][ni].x)));
            w.y = pk_bf16(acc[ni][2] * ps[ni][2] * silu_f(bf_lo(zz[mi][ni].y)), acc[ni][3] * ps[ni][3] * silu_f(bf_hi(zz[mi][ni].y)));
            *(u32x2*)(p.mix + (size_t)tok * DM + 768 + ch) = w;
        }
    }
}

__device__ __forceinline__ void pool_item(const Params& p, int layer, int pi, unsigned char* smem) {
    const int tid = otid(), lane = tid & 63, gi = tid >> 6;
    const int fr = lane & 15, fq = lane >> 4;
    const int T0 = pi * 32;
    int seqstart, seqlen;
    if (T0 < NCTX) { seqstart = T0 & ~255; seqlen = 256; } else { seqstart = NCTX + ((T0 - NCTX) & ~2047); seqlen = 2048; }
    const int toff = T0 - seqstart;
    u32x4 st[6];
#pragma unroll
    for (int i = 0; i < 6; ++i) {
        const int e = tid + 256 * i, r = e >> 5, c = e & 31;
        int sq = toff - 8 + r;
        sq = sq < 0 ? 0 : (sq > seqlen - 1 ? seqlen - 1 : sq);
        if (e < 47 * 32) st[i] = *(const u32x4*)(p.proj + (size_t)(seqstart + sq) * INW + 2304 + c * 8);
    }
    bf16x8 wf[4][2];
    f32x4 ps[4];
    {
        const bf16_t* wp = p.PoolT + (size_t)((layer * 4 + gi) * 64) * 64;
#pragma unroll
        for (int ni = 0; ni < 4; ++ni) {
#pragma unroll
            for (int kk = 0; kk < 2; ++kk) wf[ni][kk] = *(const bf16x8*)(wp + (ni * 16 + fr) * 64 + kk * 32 + fq * 8);
            ps[ni] = *(const f32x4*)(p.pool_scale + layer * 256 + gi * 64 + ni * 16 + fq * 4);
        }
    }
#pragma unroll
    for (int i = 0; i < 6; ++i) {
        const int e = tid + 256 * i, r = e >> 5, c = e & 31;
        if (e < 47 * 32) *(u32x4*)(smem + r * 528 + c * 16) = st[i];
    }
    __syncthreads();
    if (gi == 0) pool_group<2>(p, layer, T0, toff, seqlen, gi, fr, fq, wf, ps, smem);
    else if (gi == 1) pool_group<4>(p, layer, T0, toff, seqlen, gi, fr, fq, wf, ps, smem);
    else if (gi == 2) pool_group<8>(p, layer, T0, toff, seqlen, gi, fr, fq, wf, ps, smem);
    else pool_group<16>(p, layer, T0, toff, seqlen, gi, fr, fq, wf, ps, smem);
    __syncthreads();
}

__device__ __forceinline__ void conv_item(const Params& p, int layer, int ci) {
    const int tid = otid();
    const int ch = (tid & 31) * 8, tg = tid >> 5;
    const int T0 = ci * 32 + tg * 4;
    int seqstart, seqlen;
    if (T0 < NCTX) { seqstart = T0 & ~255; seqlen = 256; } else { seqstart = NCTX + ((T0 - NCTX) & ~2047); seqlen = 2048; }
    const int seqend = seqstart + seqlen;
    u32x4 rh[6], rc[6], rb[4], rz[4];
#pragma unroll
    for (int i = 0; i < 6; ++i) {
        int tok = T0 - 1 + i;
        tok = tok < seqstart ? seqstart : (tok > seqend - 1 ? seqend - 1 : tok);
        rh[i] = *(const u32x4*)(p.proj + (size_t)tok * INW + 1280 + ch);
        rc[i] = *(const u32x4*)(p.proj + (size_t)tok * INW + 1792 + ch);
    }
#pragma unroll
    for (int i = 0; i < 4; ++i) {
        rb[i] = *(const u32x4*)(p.proj + (size_t)(T0 + i) * INW + 1536 + ch);
        rz[i] = *(const u32x4*)(p.proj + (size_t)(T0 + i) * INW + 2048 + ch);
    }
    f32x4 wv[8];
    {
        const float* cw = p.conv_w + (size_t)layer * 768 + ch;
#pragma unroll
        for (int r = 0; r < 3; ++r) { wv[r * 2] = *(const f32x4*)(cw + r * 256); wv[r * 2 + 1] = *(const f32x4*)(cw + r * 256 + 4); }
        wv[6] = *(const f32x4*)(p.conv_b + layer * 256 + ch);
        wv[7] = *(const f32x4*)(p.conv_b + layer * 256 + ch + 4);
    }
    float x[6][8];
#pragma unroll
    for (int i = 0; i < 6; ++i) {
        const int tok = T0 - 1 + i;
        const float valid = (tok >= seqstart && tok < seqend) ? 1.0f : 0.0f;
        float hc[8], cc[8];
        unpack8(rh[i], hc);
        unpack8(rc[i], cc);
#pragma unroll
        for (int e = 0; e < 8; ++e) x[i][e] = hc[e] * cc[e] * valid;
    }
#pragma unroll
    for (int t = 0; t < 4; ++t) {
        float bc[8], zc[8], o[8];
        unpack8(rb[t], bc);
        unpack8(rz[t], zc);
#pragma unroll
        for (int e = 0; e < 8; ++e) {
            const float y = x[t][e] * wv[e >> 2][e & 3] + x[t + 1][e] * wv[2 + (e >> 2)][e & 3] + x[t + 2][e] * wv[4 + (e >> 2)][e & 3] + wv[6 + (e >> 2)][e & 3];
            o[e] = bc[e] * y * silu_f(zc[e]);
        }
        u32x4 w;
        w.x = pk_bf16(o[0], o[1]); w.y = pk_bf16(o[2], o[3]); w.z = pk_bf16(o[4], o[5]); w.w = pk_bf16(o[6], o[7]);
        *(u32x4*)(p.mix + (size_t)(T0 + t) * DM + 512 + ch) = w;
    }
}

__device__ __forceinline__ void phase_mixer(const Params& p, int layer, unsigned char* smem) {
    if (gridDim.x == 512) {
        const int b = blockIdx.x;
        {
            const int xcd = b & 7, slot = b >> 3;
            attn_unit<0>(p, layer, ((xcd >> 1) << 7) | ((((xcd & 1) << 2) | (slot >> 4)) << 4) | (slot & 15), smem);
        }
        if (b < 256) {
            const int xcd = b & 7, slot = b >> 3;
            attn_unit<0>(p, layer, 512 + ((((xcd << 1) | (slot >> 4)) << 4) | (slot & 15)), smem);
        } else {
#pragma unroll 1
            for (int k = 0; k < 3; ++k) {
                const int idx = (b - 256) + 256 * k;
                if (idx < 384) pool_item(p, layer, idx, smem);
                else conv_item(p, layer, idx - 384);
            }
        }
    } else {
        for (int it = blockIdx.x; it < 768 + 384 + 384; it += gridDim.x) {
            if (it < 768) attn_unit<0>(p, layer, it, smem);
            else if (it < 1152) pool_item(p, layer, it - 768, smem);
            else conv_item(p, layer, it - 1152);
        }
    }
}

__global__ void __launch_bounds__(256, 2) mega(Params p, int lo, int hi) {
    __shared__ __attribute__((aligned(16))) unsigned char smem[73728];
    __shared__ uint4 xbw;
    if (p.use_cg) cg::this_grid().sync();
    if (threadIdx.x == 0) xbw = make_uint4(0u, 0u, 0u, 0u);
    __syncthreads();
    XcdBarrier xb = xcd_barrier_post(p.bar, (volatile LAS unsigned*)&xbw);
    for (int ph = lo; ph < hi; ++ph) {
        if (ph > lo) xcd_barrier(xb);
        if (ph == 0) phase_prep(p, smem);
        else if (ph == 9) phase_final(p);
        else {
            const int layer = (ph - 1) >> 2, ty = (ph - 1) & 3;
            if (ty == 0) phase_xn(p, layer);
            else if (ty == 1) phase_gemm<0>(p, layer, smem);
            else if (ty == 2) phase_mixer(p, layer, smem);
            else phase_gemm<1>(p, layer, smem);
        }
    }
}

#ifndef MK_MULTI
#define MK_MULTI 0
#endif

extern "C" void kernel_launch(void* const* d_in, const int* in_sizes, int n_in, void* d_out, int out_size, void* d_ws, size_t ws_size,
                              hipStream_t stream) {
    static int grid_blocks = 0;
    if (!grid_blocks) {
        int dev = 0, cus = 0, per_cu = 0;
        hipGetDevice(&dev);
        hipDeviceGetAttribute(&cus, hipDeviceAttributeMultiprocessorCount, dev);
        hipOccupancyMaxActiveBlocksPerMultiprocessor(&per_cu, mega, 256, 0);
        if (per_cu > 2) per_cu = 2;
        if (per_cu < 1) per_cu = 1;
        grid_blocks = cus * per_cu;
    }
    Params p{};
    const float* const* in = (const float* const*)d_in;
    p.x_prompt = in[0]; p.x_sample = in[1]; p.cache_k = in[2]; p.cache_v = in[3]; p.c = in[4]; p.c_ctx = in[5]; p.norm_g = in[6];
    p.w_ada = in[7]; p.b_ada = in[8]; p.w_in = in[9]; p.q_g = in[10]; p.k_g = in[11]; p.conv_w = in[12]; p.conv_b = in[13];
    p.pool_w = in[14]; p.pool_scale = in[15]; p.w_out = in[16]; p.final_g = in[17];
    p.out = (float*)d_out;
    unsigned char* ws = (unsigned char*)d_ws;
    size_t off = 0;
    auto take = [&](size_t bytes) { unsigned char* r = ws + off; off += (bytes + 255) & ~(size_t)255; return r; };
    p.bar = (unsigned*)take(XCD_BAR_WORDS * 4);
    p.modv = (float*)take(2 * 5 * 3072 * 4);
    p.rope = (float*)take(2048 * 4);
    p.WinT = (bf16_t*)take((size_t)2 * INW * 1024 * 2);
    p.WoutT = (bf16_t*)take((size_t)2 * 1024 * 1024 * 2);
    p.PoolT = (bf16_t*)take(2 * 4 * 64 * 64 * 2);
    p.kc = (bf16_t*)take(262144 * 2);
    p.vc = (bf16_t*)take(262144 * 2);
    p.h = (bf16_t*)take((size_t)NTOK * DM * 2);
    p.xn = (bf16_t*)take((size_t)NTOK * DM * 2);
    p.proj = (bf16_t*)take((size_t)NTOK * INW * 2);
    p.mix = (bf16_t*)take((size_t)NTOK * DM * 2);
    p.use_cg = 0;
    p.pad = 0;
    hipMemsetAsync(p.bar, 0, XCD_BAR_WORDS * 4, stream);
#if MK_MULTI
    for (int ph = 0; ph < 10; ++ph) {
        int lo = ph, hi = ph + 1;
        void* args[] = {&p, &lo, &hi};
        hipError_t e = hipLaunchCooperativeKernel((void*)mega, dim3(grid_blocks), dim3(256), args, 0, stream);
        if (e != hipSuccess) fprintf(stderr, "launch failed: %s\n", hipGetErrorString(e));
    }
#else
    int lo = 0, hi = 10;
    void* args[] = {&p, &lo, &hi};
    hipError_t e = hipLaunchCooperativeKernel((void*)mega, dim3(grid_blocks), dim3(256), args, 0, stream);
    if (e != hipSuccess) fprintf(stderr, "cooperative launch failed: %s (grid %d)\n", hipGetErrorString(e), grid_blocks);
#endif
}
```

```cpp
#include <hip/hip_runtime.h>
#include <hip/hip_cooperative_groups.h>
#include <cstdint>
#include <cstdio>
namespace cg = cooperative_groups;

#define LAS __attribute__((address_space(3)))
typedef unsigned short bf16_t;
typedef short bf16x8 __attribute__((ext_vector_type(8)));
typedef short s16x4 __attribute__((ext_vector_type(4)));
typedef float f32x4 __attribute__((ext_vector_type(4)));
typedef float f32x16 __attribute__((ext_vector_type(16)));
typedef unsigned u32x4 __attribute__((ext_vector_type(4)));
typedef unsigned u32x2 __attribute__((ext_vector_type(2)));

constexpr int NTOK = 12288, NCTX = 4096, DM = 1024, INW = 2816;
constexpr size_t OUT_NK = 12582912, OUT_NV = 13631488;
constexpr float EPSF = 1e-6f;
constexpr float QSCALE = 0.125f * 1.4426950408889634f;

struct Params {
    const float *x_prompt, *x_sample, *cache_k, *cache_v, *c, *c_ctx, *norm_g, *w_ada, *b_ada, *w_in, *q_g, *k_g, *conv_w, *conv_b,
        *pool_w, *pool_scale, *w_out, *final_g;
    float* out;
    unsigned* bar;
    float* modv;
    float* rope;
    bf16_t* WinT;
    bf16_t* WoutT;
    bf16_t* PoolT;
    bf16_t* kc;
    bf16_t* vc;
    bf16_t* h;
    bf16_t* xn;
    bf16_t* proj;
    bf16_t* mix;
    int use_cg;
    int pad;
};

__device__ __forceinline__ unsigned pk_bf16(float lo, float hi) {
    unsigned r;
    asm("v_cvt_pk_bf16_f32 %0, %1, %2" : "=v"(r) : "v"(lo), "v"(hi));
    return r;
}
__device__ __forceinline__ float bf_lo(unsigned u) { return __uint_as_float(u << 16); }
__device__ __forceinline__ float bf_hi(unsigned u) { return __uint_as_float(u & 0xffff0000u); }
__device__ __forceinline__ float silu_f(float z) { return z / (1.0f + __expf(-z)); }
__device__ __forceinline__ f32x4 bf4_to_f32(const u32x2 u) { return (f32x4){bf_lo(u.x), bf_hi(u.x), bf_lo(u.y), bf_hi(u.y)}; }
__device__ __forceinline__ float max3_f(float a, float b, float c) { float r; asm("v_max3_f32 %0, %1, %2, %3" : "=v"(r) : "v"(a), "v"(b), "v"(c)); return r; }
__device__ __forceinline__ int otid() { int t = threadIdx.x; asm volatile("" : "+v"(t)); return t; }

#define XB_TMO 128
#define XB_XCNT(j) (256 + 64 * (j))
#define XB_XSUB(j) (1280 + 64 * (j))
#define XB_XGEN(j) (2304 + 64 * (j))
#define XB_TOP 3328
#define XB_TOPGEN 3392
#define XCD_BAR_WORDS 3456
#define XB_SPIN_CAP (1u << 20)

__device__ __forceinline__ unsigned xb_ld(unsigned* p) { return __hip_atomic_load(p, __ATOMIC_RELAXED, __HIP_MEMORY_SCOPE_AGENT); }
__device__ __forceinline__ unsigned xb_add(unsigned* p, unsigned v) { return __hip_atomic_fetch_add(p, v, __ATOMIC_RELAXED, __HIP_MEMORY_SCOPE_AGENT); }
__device__ __forceinline__ unsigned xb_xcc_id() { return (unsigned)__builtin_amdgcn_s_getreg((3 << 11) | 20) & 0xFu; }
#define XB_SPIN(cond, bar)                                                   \
    do {                                                                     \
        unsigned _sp = 0;                                                    \
        while (cond) {                                                       \
            __builtin_amdgcn_s_sleep(1);                                     \
            if ((++_sp & 255u) == 0u) {                                      \
                if (xb_ld(&(bar)[XB_TMO])) break;                            \
                if (_sp > XB_SPIN_CAP) { atomicAdd(&(bar)[XB_TMO], 1u); break; } \
            }                                                                \
        }                                                                    \
    } while (0)

struct XcdBarrier {
    unsigned* bar;
    unsigned x;
    volatile LAS unsigned* st;
};

__device__ __forceinline__ XcdBarrier xcd_barrier_post(unsigned* bar, volatile LAS unsigned* st) {
    XcdBarrier b;
    b.bar = bar;
    b.x = xb_xcc_id();
    b.st = st;
    if (threadIdx.x == 0) (void)xb_add(&bar[XB_XCNT(b.x)], 1u);
    return b;
}
__device__ __forceinline__ void xcd_barrier_complete(unsigned* bar, unsigned x, unsigned& nloc, unsigned& nx) {
    const unsigned G = gridDim.x * gridDim.y * gridDim.z;
    unsigned sum, cnt, mine, sp = 0u;
    for (;;) {
        sum = 0u; cnt = 0u; mine = 0u;
#pragma unroll
        for (unsigned j = 0; j < 16; ++j) {
            const unsigned c = xb_ld(&bar[XB_XCNT(j)]);
            sum += c; cnt += (c > 0u) ? 1u : 0u; mine = (j == x) ? c : mine;
        }
        if (sum == G) break;
        __builtin_amdgcn_s_sleep(1);
        if ((++sp & 255u) == 0u) {
            if (xb_ld(&bar[XB_TMO])) break;
            if (sp > XB_SPIN_CAP) { atomicAdd(&bar[XB_TMO], 1u); break; }
        }
    }
    nloc = mine > 0u ? mine : 1u;
    nx = cnt > 0u ? cnt : 1u;
}
__device__ __forceinline__ void xcd_barrier(const XcdBarrier& b) {
    asm volatile("s_waitcnt vmcnt(0)" ::: "memory");
    __syncthreads();
    if (threadIdx.x == 0) {
        unsigned* bar = b.bar;
        __builtin_amdgcn_s_waitcnt(0);
        unsigned nloc = b.st[0], nx = b.st[1];
        if (nloc == 0u) { xcd_barrier_complete(bar, b.x, nloc, nx); b.st[0] = nloc; b.st[1] = nx; }
        const unsigned old = xb_add(&bar[XB_XSUB(b.x)], 1u);
        const unsigned gen = old / nloc;
        if (old + 1u == (gen + 1u) * nloc) {
            __builtin_amdgcn_fence(__ATOMIC_RELEASE, "agent");
            asm volatile("s_waitcnt vmcnt(0)" ::: "memory");
            const unsigned og = xb_add(&bar[XB_TOP], 1u);
            const unsigned tg = og / nx;
            if (og + 1u == (tg + 1u) * nx) xb_add(&bar[XB_TOPGEN], 1u);
            else XB_SPIN(xb_ld(&bar[XB_TOPGEN]) == tg, bar);
            __builtin_amdgcn_fence(__ATOMIC_ACQUIRE, "agent");
            xb_add(&bar[XB_XGEN(b.x)], 1u);
            asm volatile("s_waitcnt vmcnt(0)" ::: "memory");
        } else {
            XB_SPIN(xb_ld(&bar[XB_XGEN(b.x)]) == gen, bar);
            __builtin_amdgcn_fence(__ATOMIC_ACQUIRE, "agent");
            asm volatile("s_waitcnt vmcnt(0)" ::: "memory");
        }
    }
    __syncthreads();
}

__device__ __forceinline__ void prep_mod_item(const Params& p, int item, unsigned char* smem) {
    const int tid = otid();
    float* sc = (float*)smem;
    float* red = (float*)(smem + 20480);
    const int l = item / 96, j0 = (item % 96) * 32;
    for (int idx = tid; idx < 5120; idx += 256) {
        const int v = idx >> 10, k = idx & 1023;
        const float cv = (v == 0) ? p.c_ctx[k] : p.c[(v - 1) * 1024 + k];
        sc[idx] = cv / (1.0f + expf(-cv));
    }
    __syncthreads();
    const int cgp = tid & 7, kg = tid >> 3;
    float acc[5][4];
#pragma unroll
    for (int v = 0; v < 5; ++v)
#pragma unroll
        for (int e = 0; e < 4; ++e) acc[v][e] = 0.f;
    const float* wp = p.w_ada + (size_t)l * 1024 * 3072 + j0 + cgp * 4;
    f32x4 wreg[32];
#pragma unroll
    for (int kk = 0; kk < 32; ++kk) wreg[kk] = *(const f32x4*)(wp + (size_t)(kk * 32 + kg) * 3072);
#pragma unroll
    for (int kk = 0; kk < 32; ++kk) {
        const int k = kk * 32 + kg;
        const f32x4 w = wreg[kk];
#pragma unroll
        for (int v = 0; v < 5; ++v) {
            const float s = sc[v * 1024 + k];
#pragma unroll
            for (int e = 0; e < 4; ++e) acc[v][e] += s * w[e];
        }
    }
#pragma unroll
    for (int v = 0; v < 5; ++v)
#pragma unroll
        for (int e = 0; e < 4; ++e) red[kg * 160 + v * 32 + cgp * 4 + e] = acc[v][e];
    __syncthreads();
    if (tid < 160) {
        float s = 0.f;
        for (int g = 0; g < 32; ++g) s += red[g * 160 + tid];
        const int v = tid >> 5, cc = tid & 31;
        p.modv[(size_t)(l * 5 + v) * 3072 + j0 + cc] = s + p.b_ada[l * 3072 + j0 + cc];
    }
    __syncthreads();
}

__device__ __forceinline__ void prep_transpose_item(const float* src, bf16_t* dst, int N, int k0, int n0) {
    const int n = n0 + otid();
    const float* sp = src + (size_t)k0 * N + n;
    float v[32];
#pragma unroll
    for (int i = 0; i < 32; ++i) v[i] = sp[(size_t)i * N];
    bf16_t* d = dst + (size_t)n * 1024 + k0;
#pragma unroll
    for (int c = 0; c < 4; ++c) {
        u32x4 w;
        w.x = pk_bf16(v[c * 8 + 0], v[c * 8 + 1]);
        w.y = pk_bf16(v[c * 8 + 2], v[c * 8 + 3]);
        w.z = pk_bf16(v[c * 8 + 4], v[c * 8 + 5]);
        w.w = pk_bf16(v[c * 8 + 6], v[c * 8 + 7]);
        *(u32x4*)(d + c * 8) = w;
    }
}

__device__ __forceinline__ void phase_prep(const Params& p, unsigned char* smem) {
    const int ntb = (int)gridDim.x * 5 / 8, nmb = (int)gridDim.x - ntb;
    const int NTI = 2 * 11 * 32, NTO = 2 * 4 * 32;
    if ((int)blockIdx.x < ntb) {
        for (int it = blockIdx.x; it < NTI + NTO; it += ntb) {
            if (it < NTI) {
                const int l = it / 352, r = it % 352, kt = r / 11, nt = r % 11;
                prep_transpose_item(p.w_in + (size_t)l * 1024 * INW, p.WinT + (size_t)l * INW * 1024, INW, kt * 32, nt * 256);
            } else {
                const int t = it - NTI, l = t / 128, r = t % 128, kt = r / 4, nt = r % 4;
                prep_transpose_item(p.w_out + (size_t)l * 1024 * 1024, p.WoutT + (size_t)l * 1024 * 1024, 1024, kt * 32, nt * 256);
            }
        }
    } else {
        for (int it = (int)blockIdx.x - ntb; it < 192; it += nmb) prep_mod_item(p, it, smem);
    }
    const int gsz = gridDim.x * 256;
    for (int i = blockIdx.x * 256 + otid(); i < 131072; i += gsz) {
        const int which = i >> 16, j4 = (i & 65535) * 4;
        const int d = j4 & 63, t = (j4 >> 6) & 255, kvh = (j4 >> 14) & 1, bl = j4 >> 15;
        const size_t si = ((size_t)(bl * 256 + t) * 2 + kvh) * 64 + d;
        const f32x4 v = *(const f32x4*)((which ? p.cache_v : p.cache_k) + si);
        u32x2 w;
        w.x = pk_bf16(v[0], v[1]);
        w.y = pk_bf16(v[2], v[3]);
        *(u32x2*)((which ? p.vc : p.kc) + j4) = w;
    }
    for (int j = blockIdx.x * 256 + otid(); j < 32768; j += gsz) {
        const int cc = j & 63, d = (j >> 6) & 63, lg = j >> 12;
        const float v = p.pool_w[((size_t)lg * 64 + cc) * 64 + d];
        p.PoolT[j] = (bf16_t)(pk_bf16(v, 0.f) & 0xffffu);
    }
    for (int j = blockIdx.x * 256 + otid(); j < 1024; j += gsz) {
        const int a = j & 15, r = j >> 4;
        const float inv = 1.0f / powf(10000.0f, (float)(2 * a) / 32.0f);
        const float ang = (float)r * inv;
        const float kf = rintf(ang * 0.15915494309189535f);
        float rr = fmaf(-kf, 6.2831854820251465f, ang);
        rr = fmaf(-kf, -1.7484555e-7f, rr);
        p.rope[j] = cosf(rr);
        p.rope[1024 + j] = sinf(rr);
    }
}

__device__ __forceinline__ float wave_sum(float v) {
#pragma unroll
    for (int o = 32; o >= 1; o >>= 1) v += __shfl_xor(v, o);
    return v;
}

__device__ __forceinline__ void phase_xn(const Params& p, int layer) {
    const int tid = otid(), lane = tid & 63, wave = tid >> 6;
    const int nw = gridDim.x * 4, w = blockIdx.x * 4 + wave;
    for (int t0 = w * 6; t0 < NTOK; t0 += nw * 6) {
        f32x4 x[6][4];
        if (layer == 0) {
#pragma unroll
            for (int u = 0; u < 6; ++u) {
                const int tok = t0 + u;
                const float* src = tok < NCTX ? p.x_prompt + (size_t)tok * DM : p.x_sample + (size_t)(tok - NCTX) * DM;
#pragma unroll
                for (int i = 0; i < 4; ++i) x[u][i] = *(const f32x4*)(src + i * 256 + lane * 4);
            }
        } else {
            u32x2 r[6][4];
#pragma unroll
            for (int u = 0; u < 6; ++u)
#pragma unroll
                for (int i = 0; i < 4; ++i) r[u][i] = *(const u32x2*)(p.h + (size_t)(t0 + u) * DM + i * 256 + lane * 4);
#pragma unroll
            for (int u = 0; u < 6; ++u)
#pragma unroll
                for (int i = 0; i < 4; ++i) x[u][i] = bf4_to_f32(r[u][i]);
        }
#pragma unroll
        for (int u = 0; u < 6; ++u) {
            const int tok = t0 + u;
            const int v = tok < NCTX ? 0 : 1 + ((tok - NCTX) >> 11);
            const float* mv = p.modv + (size_t)(layer * 5 + v) * 3072;
            float ss = 0.f;
#pragma unroll
            for (int i = 0; i < 4; ++i) ss += x[u][i][0] * x[u][i][0] + x[u][i][1] * x[u][i][1] + x[u][i][2] * x[u][i][2] + x[u][i][3] * x[u][i][3];
            ss = wave_sum(ss);
            const float rstd = rsqrtf(ss * (1.0f / 1024.0f) + EPSF);
#pragma unroll
            for (int i = 0; i < 4; ++i) {
                const int k = i * 256 + lane * 4;
                const f32x4 g = *(const f32x4*)(p.norm_g + layer * 1024 + k);
                const f32x4 sh = *(const f32x4*)(mv + k);
                const f32x4 sc = *(const f32x4*)(mv + 1024 + k);
                float o[4];
#pragma unroll
                for (int e = 0; e < 4; ++e) o[e] = x[u][i][e] * rstd * g[e] * (1.0f + sc[e]) + sh[e];
                u32x2 wv;
                wv.x = pk_bf16(o[0], o[1]);
                wv.y = pk_bf16(o[2], o[3]);
                *(u32x2*)(p.xn + (size_t)tok * DM + k) = wv;
            }
        }
    }
}

__device__ __forceinline__ void phase_final(const Params& p) {
    const int tid = otid(), lane = tid & 63, wave = tid >> 6;
    const int nw = gridDim.x * 4, w = blockIdx.x * 4 + wave;
    f32x4 g[4];
#pragma unroll
    for (int i = 0; i < 4; ++i) g[i] = *(const f32x4*)(p.final_g + i * 256 + lane * 4);
    for (int t0 = w * 6; t0 < NTOK; t0 += nw * 6) {
        u32x2 r[6][4];
#pragma unroll
        for (int u = 0; u < 6; ++u)
#pragma unroll
            for (int i = 0; i < 4; ++i) r[u][i] = *(const u32x2*)(p.xn + (size_t)(t0 + u) * DM + i * 256 + lane * 4);
#pragma unroll
        for (int u = 0; u < 6; ++u) {
            float* row = p.out + (size_t)(t0 + u) * DM;
            f32x4 x[4];
            float ss = 0.f;
#pragma unroll
            for (int i = 0; i < 4; ++i) {
                x[i] = bf4_to_f32(r[u][i]);
                ss += x[i][0] * x[i][0] + x[i][1] * x[i][1] + x[i][2] * x[i][2] + x[i][3] * x[i][3];
            }
            ss = wave_sum(ss);
            const float rstd = rsqrtf(ss * (1.0f / 1024.0f) + EPSF);
#pragma unroll
            for (int i = 0; i < 4; ++i) *(f32x4*)(row + i * 256 + lane * 4) = x[i] * rstd * g[i];
        }
    }
}

template <int MODE, int MI, int STG = 0>
__device__ __forceinline__ void gemm_epilogue(const Params& p, int layer, int mw, int nw, f32x4 (&acc)[MI][4], int fr, int fq,
                                              unsigned char* ct = nullptr, int m0t = 0, int n0t = 0) {
    if (MODE == 0) {
        const bool ctx = mw < NCTX;
        if (nw < 640) {
            const bool isq = nw < 512;
            const float* gp = (isq ? p.q_g : p.k_g) + layer * 64;
            f32x4 gv[4];
#pragma unroll
            for (int ni = 0; ni < 4; ++ni) gv[ni] = *(const f32x4*)(gp + ni * 16 + fq * 4);
#pragma unroll
            for (int mi = 0; mi < MI; ++mi) {
                const int tok = mw + mi * 16 + fr;
                float ss = 0.f;
#pragma unroll
                for (int ni = 0; ni < 4; ++ni)
#pragma unroll
                    for (int e = 0; e < 4; ++e) ss += acc[mi][ni][e] * acc[mi][ni][e];
                ss += __shfl_xor(ss, 16);
                ss += __shfl_xor(ss, 32);
                const float rstd = rsqrtf(ss * (1.0f / 64.0f) + EPSF);
                f32x4 val[4];
#pragma unroll
                for (int ni = 0; ni < 4; ++ni) val[ni] = acc[mi][ni] * rstd * gv[ni];
                if (!isq && ctx) {
                    float* nk = p.out + OUT_NK + ((size_t)((tok >> 8) * 2 + layer) * 256 + (tok & 255)) * 128 + (nw - 512) + fq * 4;
#pragma unroll
                    for (int ni = 0; ni < 4; ++ni) *(f32x4*)(nk + ni * 16) = val[ni];
                }
                if (!ctx) {
                    const int pos = (tok - NCTX) & 2047, prow = pos >> 6, pcol = pos & 63;
                    const f32x4 cr = *(const f32x4*)(p.rope + prow * 16 + fq * 4), sr = *(const f32x4*)(p.rope + 1024 + prow * 16 + fq * 4);
                    const f32x4 cc = *(const f32x4*)(p.rope + pcol * 16 + fq * 4), sn = *(const f32x4*)(p.rope + 1024 + pcol * 16 + fq * 4);
                    const f32x4 a0 = val[0], a1 = val[1], a2 = val[2], a3 = val[3];
                    val[0] = a0 * cr - a1 * sr;
                    val[1] = a1 * cr + a0 * sr;
                    val[2] = a2 * cc - a3 * sn;
                    val[3] = a3 * cc + a2 * sn;
                }
                if (isq) {
#pragma unroll
                    for (int ni = 0; ni < 4; ++ni) val[ni] = val[ni] * QSCALE;
                }
                bf16_t* pr = p.proj + (size_t)tok * INW + nw + fq * 4;
#pragma unroll
                for (int ni = 0; ni < 4; ++ni) {
                    u32x2 w;
                    w.x = pk_bf16(val[ni][0], val[ni][1]);
                    w.y = pk_bf16(val[ni][2], val[ni][3]);
                    if (STG) *(u32x2*)(ct + (tok - m0t) * 272 + (nw - n0t + fq * 4 + ni * 16) * 2) = w;
                    else *(u32x2*)(pr + ni * 16) = w;
                }
            }
        } else {
            const bool isv = nw < 768;
#pragma unroll
            for (int mi = 0; mi < MI; ++mi) {
                const int tok = mw + mi * 16 + fr;
                bf16_t* pr = p.proj + (size_t)tok * INW + nw + fq * 4;
#pragma unroll
                for (int ni = 0; ni < 4; ++ni) {
                    u32x2 w;
                    w.x = pk_bf16(acc[mi][ni][0], acc[mi][ni][1]);
                    w.y = pk_bf16(acc[mi][ni][2], acc[mi][ni][3]);
                    if (STG) *(u32x2*)(ct + (tok - m0t) * 272 + (nw - n0t + fq * 4 + ni * 16) * 2) = w;
                    else *(u32x2*)(pr + ni * 16) = w;
                }
                if (isv && ctx) {
                    float* nv = p.out + OUT_NV + ((size_t)((tok >> 8) * 2 + layer) * 256 + (tok & 255)) * 128 + (nw - 640) + fq * 4;
#pragma unroll
                    for (int ni = 0; ni < 4; ++ni) *(f32x4*)(nv + ni * 16) = acc[mi][ni];
                }
            }
        }
    } else {
        const int v = mw < NCTX ? 0 : 1 + ((mw - NCTX) >> 11);
        const float* gate = p.modv + (size_t)(layer * 5 + v) * 3072 + 2048 + nw + fq * 4;
        f32x4 gt[4];
#pragma unroll
        for (int ni = 0; ni < 4; ++ni) gt[ni] = *(const f32x4*)(gate + ni * 16);
#pragma unroll
        for (int mi = 0; mi < MI; ++mi) {
            const int tok = mw + mi * 16 + fr;
            const size_t eo = (size_t)tok * DM + nw + fq * 4;
            const float* xin = (tok < NCTX ? p.x_prompt + (size_t)tok * DM : p.x_sample + (size_t)(tok - NCTX) * DM) + nw + fq * 4;
#pragma unroll
            for (int ni = 0; ni < 4; ++ni) {
                if (layer == 0) {
                    const f32x4 r = *(const f32x4*)(xin + ni * 16) + gt[ni] * acc[mi][ni];
                    u32x2 w;
                    w.x = pk_bf16(r[0], r[1]);
                    w.y = pk_bf16(r[2], r[3]);
                    *(u32x2*)(p.h + eo + ni * 16) = w;
                } else {
                    const f32x4 r = bf4_to_f32(*(const u32x2*)(p.h + eo + ni * 16)) + gt[ni] * acc[mi][ni];
                    u32x2 w;
                    w.x = pk_bf16(r[0], r[1]);
                    w.y = pk_bf16(r[2], r[3]);
                    *(u32x2*)(p.xn + eo + ni * 16) = w;
                }
            }
        }
    }
}

template <int MODE>
__device__ __forceinline__ void gemm_tile(const Params& p, int layer, int mt, int nt, unsigned char* smem) {
    const int tid = otid(), lane = tid & 63, wave = tid >> 6, wm = wave >> 1, wn = wave & 1;
    const int fr = lane & 15, fq = lane >> 4;
    const int m0 = mt * 128, n0 = nt * 128;
    const bf16_t* A = (MODE == 0 ? p.xn : p.mix) + (size_t)m0 * 1024;
    const bf16_t* B = (MODE == 0 ? p.WinT + (size_t)layer * INW * 1024 : p.WoutT + (size_t)layer * 1024 * 1024) + (size_t)n0 * 1024;
    f32x4 acc[4][4];
#pragma unroll
    for (int i = 0; i < 4; ++i)
#pragma unroll
        for (int j = 0; j < 4; ++j) acc[i][j] = (f32x4){0.f, 0.f, 0.f, 0.f};

    const int srow = tid >> 3, scc = tid & 7;
    const bf16_t* ag = A + (size_t)srow * 1024 + scc * 8;
    const bf16_t* bg = B + (size_t)srow * 1024 + scc * 8;
    const int wofs = srow * 128 + ((scc ^ (srow & 7)) * 16);
    u32x4 raA[4], rbA[4], raB[4], rbB[4];
    auto gload = [&](int kt, u32x4* ra, u32x4* rb) {
#pragma unroll
        for (int i = 0; i < 4; ++i) {
            ra[i] = *(const u32x4*)(ag + (size_t)i * 32 * 1024 + kt * 64);
            rb[i] = *(const u32x4*)(bg + (size_t)i * 32 * 1024 + kt * 64);
        }
    };
    auto swrite = [&](int buf, const u32x4* ra, const u32x4* rb) {
        unsigned char* Aw = smem + buf * 32768;
#pragma unroll
        for (int i = 0; i < 4; ++i) {
            *(u32x4*)(Aw + wofs + i * 4096) = ra[i];
            *(u32x4*)(Aw + 16384 + wofs + i * 4096) = rb[i];
        }
    };
    gload(0, raA, rbA);
    gload(1, raB, rbB);
    swrite(0, raA, rbA);
    __syncthreads();
    const int aro = (wm * 64 + fr) * 128, bro = (wn * 64 + fr) * 128, sw = fr & 7;
    auto step = [&](int kt, u32x4* la, u32x4* lb, const u32x4* wa, const u32x4* wb) {
        const unsigned char* As = smem + (kt & 1) * 32768;
        const unsigned char* Bs = As + 16384;
        bf16x8 af[2][4], bf[2][4];
#pragma unroll
        for (int kk = 0; kk < 2; ++kk) {
            const int co = ((kk * 4 + fq) ^ sw) * 16;
#pragma unroll
            for (int i = 0; i < 4; ++i) {
                af[kk][i] = *(const bf16x8*)(As + aro + i * 2048 + co);
                bf[kk][i] = *(const bf16x8*)(Bs + bro + i * 2048 + co);
            }
        }
        if (kt + 2 < 16) gload(kt + 2, la, lb);
        __builtin_amdgcn_sched_barrier(0);
#pragma unroll
        for (int mi = 0; mi < 4; ++mi)
#pragma unroll
            for (int ni = 0; ni < 4; ++ni) acc[mi][ni] = __builtin_amdgcn_mfma_f32_16x16x32_bf16(bf[0][ni], af[0][mi], acc[mi][ni], 0, 0, 0);
        __builtin_amdgcn_sched_barrier(0);
        if (kt + 1 < 16) swrite((kt + 1) & 1, wa, wb);
        __builtin_amdgcn_sched_barrier(0);
#pragma unroll
        for (int mi = 0; mi < 4; ++mi)
#pragma unroll
            for (int ni = 0; ni < 4; ++ni) acc[mi][ni] = __builtin_amdgcn_mfma_f32_16x16x32_bf16(bf[1][ni], af[1][mi], acc[mi][ni], 0, 0, 0);
        __syncthreads();
    };
    for (int kt = 0; kt < 16; kt += 2) {
        step(kt, raA, rbA, raB, rbB);
        step(kt + 1, raB, rbB, raA, rbA);
    }

    gemm_epilogue<MODE, 4>(p, layer, m0 + wm * 64, n0 + wn * 64, acc, fr, fq);
}

template <int MODE>
__device__ __forceinline__ void gemm_tile256(const Params& p, int layer, int mt, int nt, unsigned char* smem) {
    const int tid = otid(), lane = tid & 63, wave = tid >> 6, wm = wave >> 1, wn = wave & 1;
    const int fr = lane & 15, fq = lane >> 4;
    const int m0 = mt * 256, n0 = nt * 128;
    const bf16_t* A = (MODE == 0 ? p.xn : p.mix) + (size_t)m0 * 1024;
    const bf16_t* B = (MODE == 0 ? p.WinT + (size_t)layer * INW * 1024 : p.WoutT + (size_t)layer * 1024 * 1024) + (size_t)n0 * 1024;
    f32x4 acc[8][4];
#pragma unroll
    for (int i = 0; i < 8; ++i)
#pragma unroll
        for (int j = 0; j < 4; ++j) acc[i][j] = (f32x4){0.f, 0.f, 0.f, 0.f};
    const int srow = tid >> 2, scc = tid & 3;
    const bf16_t* ag = A + (size_t)srow * 1024 + scc * 8;
    const bf16_t* bg = B + (size_t)srow * 1024 + scc * 8;
    const int wofs = srow * 64 + ((scc ^ ((4 - ((srow >> 2) & 3)) & 3)) * 16);
    u32x4 raA[4], rbA[2], raB[4], rbB[2];
    auto gload = [&](int kt, u32x4* ra, u32x4* rb) {
#pragma unroll
        for (int i = 0; i < 4; ++i) ra[i] = *(const u32x4*)(ag + (size_t)i * 64 * 1024 + kt * 32);
#pragma unroll
        for (int i = 0; i < 2; ++i) rb[i] = *(const u32x4*)(bg + (size_t)i * 64 * 1024 + kt * 32);
    };
    auto swrite = [&](int buf, const u32x4* ra, const u32x4* rb) {
        unsigned char* Aw = smem + buf * 24576;
#pragma unroll
        for (int i = 0; i < 4; ++i) *(u32x4*)(Aw + wofs + i * 4096) = ra[i];
#pragma unroll
        for (int i = 0; i < 2; ++i) *(u32x4*)(Aw + 16384 + wofs + i * 4096) = rb[i];
    };
    gload(0, raA, rbA);
    gload(1, raB, rbB);
    swrite(0, raA, rbA);
    __syncthreads();
    const int co = (fq ^ ((4 - ((fr >> 2) & 3)) & 3)) * 16;
    const int aro = (wm * 128 + fr) * 64 + co, bro = (wn * 64 + fr) * 64 + co;
    auto step = [&](int kt, u32x4* la, u32x4* lb, const u32x4* wa, const u32x4* wb) {
        const unsigned char* As = smem + (kt & 1) * 24576;
        const unsigned char* Bs = As + 16384;
        bf16x8 af[8], bf[4];
#pragma unroll
        for (int i = 0; i < 4; ++i) bf[i] = *(const bf16x8*)(Bs + bro + i * 1024);
#pragma unroll
        for (int i = 0; i < 8; ++i) af[i] = *(const bf16x8*)(As + aro + i * 1024);
        if (kt + 2 < 32) gload(kt + 2, la, lb);
        __builtin_amdgcn_sched_barrier(0);
#pragma unroll
        for (int mi = 0; mi < 4; ++mi)
#pragma unroll
            for (int ni = 0; ni < 4; ++ni) acc[mi][ni] = __builtin_amdgcn_mfma_f32_16x16x32_bf16(bf[ni], af[mi], acc[mi][ni], 0, 0, 0);
        __builtin_amdgcn_sched_barrier(0);
        if (kt + 1 < 32) swrite((kt + 1) & 1, wa, wb);
        __builtin_amdgcn_sched_barrier(0);
#pragma unroll
        for (int mi = 4; mi < 8; ++mi)
#pragma unroll
            for (int ni = 0; ni < 4; ++ni) acc[mi][ni] = __builtin_amdgcn_mfma_f32_16x16x32_bf16(bf[ni], af[mi], acc[mi][ni], 0, 0, 0);
        __syncthreads();
    };
    for (int kt = 0; kt < 32; kt += 2) {
        step(kt, raA, rbA, raB, rbB);
        step(kt + 1, raB, rbB, raA, rbA);
    }
    gemm_epilogue<MODE, 8>(p, layer, m0 + wm * 128, n0 + wn * 64, acc, fr, fq);
}

template <int MODE>
__device__ __forceinline__ void gemm_tile256_dma(const Params& p, int layer, int mt, int nt, unsigned char* smem) {
    const int tid = otid(), lane = tid & 63, wave = tid >> 6, wm = wave >> 1, wn = wave & 1;
    const int fr = lane & 15, fq = lane >> 4;
    const int m0 = mt * 256, n0 = nt * 128;
    const bf16_t* A = (MODE == 0 ? p.xn : p.mix) + (size_t)m0 * 1024;
    const bf16_t* B = (MODE == 0 ? p.WinT + (size_t)layer * INW * 1024 : p.WoutT + (size_t)layer * 1024 * 1024) + (size_t)n0 * 1024;
    f32x4 acc[8][4];
#pragma unroll
    for (int i = 0; i < 8; ++i)
#pragma unroll
        for (int j = 0; j < 4; ++j) acc[i][j] = (f32x4){0.f, 0.f, 0.f, 0.f};
    const int lrow = lane >> 2, lc = (lane & 3) ^ ((4 - ((lane >> 4) & 3)) & 3);
    const bf16_t* agp = A + (size_t)(wave * 64 + lrow) * 1024 + lc * 8;
    const bf16_t* bgp = B + (size_t)(wave * 32 + lrow) * 1024 + lc * 8;
    LAS unsigned char* lbase = (LAS unsigned char*)smem;
    const int la_off = wave * 4096 + lane * 16, lb_off = 16384 + wave * 2048 + lane * 16;
    auto dma = [&](int kt, int stage) {
        LAS unsigned char* sb = lbase + stage * 24576;
#pragma unroll
        for (int i = 0; i < 4; ++i)
            __builtin_amdgcn_global_load_lds((const void*)(agp + (size_t)i * 16 * 1024 + kt * 32), (LAS void*)(sb + la_off + i * 1024), 16, 0, 0);
#pragma unroll
        for (int i = 0; i < 2; ++i)
            __builtin_amdgcn_global_load_lds((const void*)(bgp + (size_t)i * 16 * 1024 + kt * 32), (LAS void*)(sb + lb_off + i * 1024), 16, 0, 0);
    };
    dma(0, 0);
    dma(1, 1);
    asm volatile("s_waitcnt vmcnt(6)" ::: "memory");
    __builtin_amdgcn_s_barrier();
    const int co = (fq ^ ((4 - ((fr >> 2) & 3)) & 3)) * 16;
    const int aro = (wm * 128 + fr) * 64 + co, bro = 16384 + (wn * 64 + fr) * 64 + co;
    int st = 0, st2 = 2;
    const unsigned lds0 = (unsigned)(uintptr_t)lbase;
#pragma unroll 1
    for (int kt = 0; kt < 32; ++kt) {
        const unsigned sa = lds0 + st * 24576 + aro, sbb = lds0 + st * 24576 + bro;
        bf16x8 af[8], bf[4];
#define FRAG_RD(dst, addr, OFF) asm volatile("ds_read_b128 %0, %1 offset:" #OFF : "=&v"(dst) : "v"(addr))
        FRAG_RD(bf[0], sbb, 0); FRAG_RD(bf[1], sbb, 1024); FRAG_RD(bf[2], sbb, 2048); FRAG_RD(bf[3], sbb, 3072);
        FRAG_RD(af[0], sa, 0); FRAG_RD(af[1], sa, 1024); FRAG_RD(af[2], sa, 2048); FRAG_RD(af[3], sa, 3072);
        FRAG_RD(af[4], sa, 4096); FRAG_RD(af[5], sa, 5120); FRAG_RD(af[6], sa, 6144); FRAG_RD(af[7], sa, 7168);
#undef FRAG_RD
        __builtin_amdgcn_sched_barrier(0);
        if (kt + 2 < 32) dma(kt + 2, st2);
        __builtin_amdgcn_sched_barrier(0);
        asm volatile("s_waitcnt lgkmcnt(4)" ::: "memory");
        __builtin_amdgcn_sched_barrier(0);
#pragma unroll
        for (int mi = 0; mi < 4; ++mi)
#pragma unroll
            for (int ni = 0; ni < 4; ++ni) acc[mi][ni] = __builtin_amdgcn_mfma_f32_16x16x32_bf16(bf[ni], af[mi], acc[mi][ni], 0, 0, 0);
        __builtin_amdgcn_sched_barrier(0);
        asm volatile("s_waitcnt lgkmcnt(0)" ::: "memory");
        __builtin_amdgcn_sched_barrier(0);
#pragma unroll
        for (int mi = 4; mi < 8; ++mi)
#pragma unroll
            for (int ni = 0; ni < 4; ++ni) acc[mi][ni] = __builtin_amdgcn_mfma_f32_16x16x32_bf16(bf[ni], af[mi], acc[mi][ni], 0, 0, 0);
        __builtin_amdgcn_sched_barrier(0);
        if (kt + 2 < 32) asm volatile("s_waitcnt vmcnt(6)" ::: "memory");
        else asm volatile("s_waitcnt vmcnt(0)" ::: "memory");
        __builtin_amdgcn_s_barrier();
        st = st == 2 ? 0 : st + 1;
        st2 = st2 == 2 ? 0 : st2 + 1;
    }
    if (MODE == 0) {
        gemm_epilogue<0, 8, 1>(p, layer, m0 + wm * 128, n0 + wn * 64, acc, fr, fq, smem, m0, n0);
        __syncthreads();
        u32x4 cv[16];
#pragma unroll
        for (int i = 0; i < 16; ++i) { const int e = tid + 256 * i; cv[i] = *(const u32x4*)(smem + (e >> 4) * 272 + (e & 15) * 16); }
#pragma unroll
        for (int i = 0; i < 16; ++i) { const int e = tid + 256 * i; *(u32x4*)(p.proj + (size_t)(m0 + (e >> 4)) * INW + n0 + (e & 15) * 8) = cv[i]; }
        __syncthreads();
    } else {
#pragma unroll 1
        for (int pass = 0; pass < 2; ++pass) {
            if (wm == pass) {
#pragma unroll
                for (int mi = 0; mi < 8; ++mi)
#pragma unroll
                    for (int ni = 0; ni < 4; ++ni) *(f32x4*)(smem + (mi * 16 + fr) * 528 + (wn * 64 + ni * 16 + fq * 4) * 4) = acc[mi][ni];
            }
            __syncthreads();
            const int rbase = m0 + pass * 128;
            const int c4 = (tid & 31) * 4;
            f32x4 ho[16];
#pragma unroll
            for (int i = 0; i < 16; ++i) {
                const int tok = rbase + (tid >> 5) + 8 * i;
                if (layer == 0) ho[i] = *(const f32x4*)((tok < NCTX ? p.x_prompt + (size_t)tok * DM : p.x_sample + (size_t)(tok - NCTX) * DM) + n0 + c4);
                else ho[i] = bf4_to_f32(*(const u32x2*)(p.h + (size_t)tok * DM + n0 + c4));
            }
            const int v = rbase < NCTX ? 0 : 1 + ((rbase - NCTX) >> 11);
            const f32x4 gt = *(const f32x4*)(p.modv + (size_t)(layer * 5 + v) * 3072 + 2048 + n0 + c4);
#pragma unroll
            for (int i = 0; i < 16; ++i) {
                const int row = (tid >> 5) + 8 * i, tok = rbase + row;
                const f32x4 a = *(const f32x4*)(smem + row * 528 + c4 * 4);
                const f32x4 r = ho[i] + gt * a;
                if (layer == 0) {
                    u32x2 w;
                    w.x = pk_bf16(r[0], r[1]);
                    w.y = pk_bf16(r[2], r[3]);
                    *(u32x2*)(p.h + (size_t)tok * DM + n0 + c4) = w;
                } else {
                    u32x2 w;
                    w.x = pk_bf16(r[0], r[1]);
                    w.y = pk_bf16(r[2], r[3]);
                    *(u32x2*)(p.xn + (size_t)tok * DM + n0 + c4) = w;
                }
            }
            __syncthreads();
        }
    }
}

__device__ __forceinline__ void gemm_piece64_dma(const Params& p, int layer, int m0, int n0, unsigned char* smem) {
    const int tid = otid(), lane = tid & 63, wave = tid >> 6, wm = wave >> 1, wn = wave & 1;
    const int fr = lane & 15, fq = lane >> 4;
    const bf16_t* A = p.xn + (size_t)m0 * 1024;
    const bf16_t* B = p.WinT + (size_t)layer * INW * 1024 + (size_t)n0 * 1024;
    f32x4 acc[2][4];
#pragma unroll
    for (int i = 0; i < 2; ++i)
#pragma unroll
        for (int j = 0; j < 4; ++j) acc[i][j] = (f32x4){0.f, 0.f, 0.f, 0.f};
    const int lrow = lane >> 2, lc = (lane & 3) ^ ((4 - ((lane >> 4) & 3)) & 3);
    const bf16_t* agp = A + (size_t)(wave * 16 + lrow) * 1024 + lc * 8;
    const bf16_t* bgp = B + (size_t)(wave * 32 + lrow) * 1024 + lc * 8;
    LAS unsigned char* lbase = (LAS unsigned char*)smem;
    const int la_off = wave * 1024 + lane * 16, lb_off = 4096 + wave * 2048 + lane * 16;
    auto dma = [&](int kt, int stage) {
        LAS unsigned char* sb = lbase + stage * 12288;
        __builtin_amdgcn_global_load_lds((const void*)(agp + kt * 32), (LAS void*)(sb + la_off), 16, 0, 0);
#pragma unroll
        for (int i = 0; i < 2; ++i)
            __builtin_amdgcn_global_load_lds((const void*)(bgp + (size_t)i * 16 * 1024 + kt * 32), (LAS void*)(sb + lb_off + i * 1024), 16, 0, 0);
    };
    dma(0, 0);
    dma(1, 1);
    asm volatile("s_waitcnt vmcnt(3)" ::: "memory");
    __builtin_amdgcn_s_barrier();
    const int co = (fq ^ ((4 - ((fr >> 2) & 3)) & 3)) * 16;
    const int aro = (wm * 32 + fr) * 64 + co, bro = 4096 + (wn * 64 + fr) * 64 + co;
    int st = 0, st2 = 2;
    const unsigned lds0 = (unsigned)(uintptr_t)lbase;
#pragma unroll 1
    for (int kt = 0; kt < 32; ++kt) {
        const unsigned sa = lds0 + st * 12288 + aro, sbb = lds0 + st * 12288 + bro;
        bf16x8 af[2], bf[4];
#define FRAG_RD(dst, addr, OFF) asm volatile("ds_read_b128 %0, %1 offset:" #OFF : "=&v"(dst) : "v"(addr))
        FRAG_RD(bf[0], sbb, 0); FRAG_RD(bf[1], sbb, 1024); FRAG_RD(bf[2], sbb, 2048); FRAG_RD(bf[3], sbb, 3072);
        FRAG_RD(af[0], sa, 0); FRAG_RD(af[1], sa, 1024);
#undef FRAG_RD
        __builtin_amdgcn_sched_barrier(0);
        if (kt + 2 < 32) dma(kt + 2, st2);
        __builtin_amdgcn_sched_barrier(0);
        asm volatile("s_waitcnt lgkmcnt(0)" ::: "memory");
        __builtin_amdgcn_sched_barrier(0);
#pragma unroll
        for (int mi = 0; mi < 2; ++mi)
#pragma unroll
            for (int ni = 0; ni < 4; ++ni) acc[mi][ni] = __builtin_amdgcn_mfma_f32_16x16x32_bf16(bf[ni], af[mi], acc[mi][ni], 0, 0, 0);
        __builtin_amdgcn_sched_barrier(0);
        if (kt + 2 < 32) asm volatile("s_waitcnt vmcnt(3)" ::: "memory");
        else asm volatile("s_waitcnt vmcnt(0)" ::: "memory");
        __builtin_amdgcn_s_barrier();
        st = st == 2 ? 0 : st + 1;
        st2 = st2 == 2 ? 0 : st2 + 1;
    }
    gemm_epilogue<0, 2, 1>(p, layer, m0 + wm * 32, n0 + wn * 64, acc, fr, fq, smem, m0, n0);
    __syncthreads();
    u32x4 cv[4];
#pragma unroll
    for (int i = 0; i < 4; ++i) { const int e = tid + 256 * i; cv[i] = *(const u32x4*)(smem + (e >> 4) * 272 + (e & 15) * 16); }
#pragma unroll
    for (int i = 0; i < 4; ++i) { const int e = tid + 256 * i; *(u32x4*)(p.proj + (size_t)(m0 + (e >> 4)) * INW + n0 + (e & 15) * 8) = cv[i]; }
    __syncthreads();
}

template <int MODE>
__device__ __forceinline__ void phase_gemm(const Params& p, int layer, unsigned char* smem) {
    const int NT = MODE == 0 ? 22 : 8;
    const int total = 96 * NT;
    if (gridDim.x == 512) {
        const int xcd = blockIdx.x & 7, slot = blockIdx.x >> 3;
        if (MODE == 0) {
            if (slot < 16) gemm_piece64_dma(p, layer, (xcd * 6 + 2 + (slot >> 2)) * 256 + (slot & 3) * 64, 21 * 128, smem);
            for (int idx = slot; idx < 128; idx += 64) gemm_tile256_dma<MODE>(p, layer, xcd * 6 + idx % 6, idx / 6, smem);
        } else {
            if (slot < 32) gemm_tile256_dma<MODE>(p, layer, xcd * 6 + slot % 6, slot / 6, smem);
            else {
                const int d = 32 + ((slot - 32) >> 1);
                gemm_tile<MODE>(p, layer, (xcd * 6 + d % 6) * 2 + (slot & 1), d / 6, smem);
            }
        }
    } else {
        for (int t = blockIdx.x; t < total; t += gridDim.x) gemm_tile<MODE>(p, layer, t / NT, t % NT, smem);
    }
}

template <int VAR>
__device__ __forceinline__ void attn_unit(const Params& p, int layer, int unit, unsigned char* smem) {
    const int tid = otid(), lane = tid & 63, wave = tid >> 6;
    const int r31 = lane & 31, hh = lane >> 5;
    int b, head, qblk, tokbase, nself, ntiles;
    if (unit < 512) { b = unit >> 7; head = (unit >> 4) & 7; qblk = unit & 15; tokbase = NCTX + b * 2048; nself = 2048; ntiles = 36; }
    else { const int u = unit - 512; b = u >> 4; head = (u >> 1) & 7; qblk = u & 1; tokbase = b * 256; nself = 256; ntiles = 4; }
    const int kvh = head >> 2;
    const int qtok = tokbase + qblk * 128 + wave * 32 + r31;
    bf16x8 qf[4];
    {
        const bf16_t* qp = p.proj + (size_t)qtok * INW + head * 64 + hh * 8;
#pragma unroll
        for (int ks = 0; ks < 4; ++ks) qf[ks] = *(const bf16x8*)(qp + ks * 16);
    }
    const bf16_t* kself = p.proj + (size_t)tokbase * INW + 512 + kvh * 64;
    const bf16_t* vself = p.proj + (size_t)tokbase * INW + 640 + kvh * 64;
    const bf16_t* kcache = p.kc + (size_t)((b * 2 + layer) * 2 + kvh) * 256 * 64;
    const bf16_t* vcache = p.vc + (size_t)((b * 2 + layer) * 2 + kvh) * 256 * 64;
    const int srow = tid >> 3, scc = tid & 7;
    const int kwo = srow * 128 + ((scc ^ ((srow >> 1) & 7)) * 16);
    const int vwo = srow * 128 + ((scc ^ (((srow >> 1) & 1) << 2)) * 16);
    u32x4 rkA[2], rvA[2], rkB[2], rvB[2];
    auto gload = [&](int j, u32x4* rk, u32x4* rv) {
        const int key0 = j * 64;
#pragma unroll
        for (int i = 0; i < 2; ++i) {
            const int row = srow + 32 * i;
            if (key0 < nself) {
                rk[i] = *(const u32x4*)(kself + (size_t)(key0 + row) * INW + scc * 8);
                rv[i] = *(const u32x4*)(vself + (size_t)(key0 + row) * INW + scc * 8);
            } else {
                rk[i] = *(const u32x4*)(kcache + (size_t)(key0 - nself + row) * 64 + scc * 8);
                rv[i] = *(const u32x4*)(vcache + (size_t)(key0 - nself + row) * 64 + scc * 8);
            }
        }
    };
    auto swrite = [&](int buf, const u32x4* rk, const u32x4* rv) {
        unsigned char* kb = smem + buf * 16384;
        unsigned char* vb = kb + 8192;
#pragma unroll
        for (int i = 0; i < 2; ++i) {
            *(u32x4*)(kb + kwo + i * 32 * 128) = rk[i];
            *(u32x4*)(vb + vwo + i * 32 * 128) = rv[i];
        }
    };
    f32x16 o[2];
#pragma unroll
    for (int i = 0; i < 16; ++i) { o[0][i] = 0.f; o[1][i] = 0.f; }
    float mrun = 0.f, mmax = -1e30f, lrun = 0.f;
    f32x16 negm, zero16;
#pragma unroll
    for (int i = 0; i < 16; ++i) { negm[i] = 0.f; zero16[i] = 0.f; }
    bool shifted = false;
    gload(0, rkA, rvA);
    swrite(0, rkA, rvA);
    if (ntiles > 1) gload(1, rkB, rvB);
    __syncthreads();
    const int kro = r31 * 128, ksw = (r31 >> 1) & 7;
    const int vq = 4 * hh + ((lane & 15) >> 2);
    const int vsw = ((vq >> 1) & 1) << 2;
    const int vcl = ((lane >> 4) & 1) * 2 + ((lane & 3) >> 1);
    const int vro0 = vq * 128 + (((0 * 4 + vcl) ^ vsw) * 16) + (lane & 1) * 8;
    const int vro1 = vq * 128 + (((1 * 4 + vcl) ^ vsw) * 16) + (lane & 1) * 8;
    auto step = [&](int j, u32x4* lk, u32x4* lv, const u32x4* wk, const u32x4* wv) {
        const unsigned char* kb = smem + (j & 1) * 16384;
        const unsigned char* vb = kb + 8192;
        bf16x8 kf[2][4];
#pragma unroll
        for (int sb = 0; sb < 2; ++sb)
#pragma unroll
            for (int ks = 0; ks < 4; ++ks) kf[sb][ks] = *(const bf16x8*)(kb + sb * 4096 + kro + (((ks * 2 + hh) ^ ksw) * 16));
        bf16x8 vf[2][2][2];
#pragma unroll
        for (int sb = 0; sb < 2; ++sb)
#pragma unroll
            for (int s2 = 0; s2 < 2; ++s2)
#pragma unroll
                for (int dt = 0; dt < 2; ++dt) {
                    const LAS unsigned char* va = (const LAS unsigned char*)(vb) + (sb * 32 + s2 * 16) * 128 + (dt ? vro1 : vro0);
                    const s16x4 a0 = __builtin_amdgcn_ds_read_tr16_b64_v4i16((LAS s16x4*)(va));
                    const s16x4 a1 = __builtin_amdgcn_ds_read_tr16_b64_v4i16((LAS s16x4*)(va + 8 * 128));
                    vf[sb][s2][dt] = (bf16x8){a0[0], a0[1], a0[2], a0[3], a1[0], a1[1], a1[2], a1[3]};
                }
        if (VAR != 1 && j + 2 < ntiles) gload(j + 2, lk, lv);
        __builtin_amdgcn_sched_barrier(0);
        f32x16 s[2];
        float mloc, lsum = 0.f;
        bf16x8 pf[2][2];
#pragma unroll
        for (int sb = 0; sb < 2; ++sb)
#pragma unroll
            for (int ks = 0; ks < 4; ++ks) {
                if (ks == 0) {
                    if (shifted) s[sb] = __builtin_amdgcn_mfma_f32_32x32x16_bf16(kf[sb][ks], qf[ks], negm, 0, 0, 0);
                    else s[sb] = __builtin_amdgcn_mfma_f32_32x32x16_bf16(kf[sb][ks], qf[ks], zero16, 0, 0, 0);
                } else s[sb] = __builtin_amdgcn_mfma_f32_32x32x16_bf16(kf[sb][ks], qf[ks], s[sb], 0, 0, 0);
            }
#pragma unroll
        for (int sb = 0; sb < 2; ++sb) {
            float m0 = max3_f(s[sb][0], s[sb][1], s[sb][2]);
#pragma unroll
            for (int i = 3; i < 15; i += 2) m0 = max3_f(m0, s[sb][i], s[sb][i + 1]);
            m0 = fmaxf(m0, s[sb][15]);
            mloc = sb == 0 ? m0 : fmaxf(mloc, m0);
#pragma unroll
            for (int i = 0; i < 16; ++i) { if (VAR != 2) { s[sb][i] = __builtin_amdgcn_exp2f(s[sb][i]); lsum += s[sb][i]; } }
#pragma unroll
            for (int s2 = 0; s2 < 2; ++s2) {
                u32x4 pw;
                pw.x = pk_bf16(s[sb][s2 * 8 + 0], s[sb][s2 * 8 + 1]);
                pw.y = pk_bf16(s[sb][s2 * 8 + 2], s[sb][s2 * 8 + 3]);
                pw.z = pk_bf16(s[sb][s2 * 8 + 4], s[sb][s2 * 8 + 5]);
                pw.w = pk_bf16(s[sb][s2 * 8 + 6], s[sb][s2 * 8 + 7]);
                pf[sb][s2] = __builtin_bit_cast(bf16x8, pw);
            }
#pragma unroll
            for (int s2 = 0; s2 < 2; ++s2)
#pragma unroll
                for (int dt = 0; dt < 2; ++dt) o[dt] = __builtin_amdgcn_mfma_f32_32x32x16_bf16(vf[sb][s2][dt], pf[sb][s2], o[dt], 0, 0, 0);
        }
        lrun += lsum;
        __builtin_amdgcn_sched_barrier(0);
        mloc = fmaxf(mloc, __shfl_xor(mloc, 32));
        mmax = fmaxf(mmax, mrun + mloc);
        if (__builtin_expect(__any(fabsf(mmax - mrun) > 40.0f), 0)) {
            asm volatile("" ::: "memory");
            const float alpha = __builtin_amdgcn_exp2f(mrun - mmax);
            mrun = mmax;
            lrun *= alpha;
            shifted = true;
#pragma unroll
            for (int i = 0; i < 16; ++i) { o[0][i] *= alpha; o[1][i] *= alpha; negm[i] = -mrun; }
        }
        if (VAR != 1 && j + 1 < ntiles) swrite((j + 1) & 1, wk, wv);
        __syncthreads();
    };
    for (int j = 0; j < ntiles; j += 2) {
        step(j, rkA, rvA, rkB, rvB);
        step(j + 1, rkB, rvB, rkA, rvA);
    }
    const float ltot = lrun + __shfl_xor(lrun, 32);
    const float inv = 1.0f / ltot;
    const bf16_t* zp = p.proj + (size_t)qtok * INW + 768 + head * 64;
    bf16_t* mp = (VAR == 0 ? p.mix : p.xn) + (size_t)qtok * DM + head * 64;
#pragma unroll
    for (int dt = 0; dt < 2; ++dt)
#pragma unroll
        for (int rq = 0; rq < 4; ++rq) {
            const int d0 = dt * 32 + 8 * rq + 4 * hh;
            const u32x2 zz = *(const u32x2*)(zp + d0);
            const float z0 = bf_lo(zz.x), z1 = bf_hi(zz.x), z2 = bf_lo(zz.y), z3 = bf_hi(zz.y);
            u32x2 w;
            w.x = pk_bf16(o[dt][rq * 4 + 0] * inv * silu_f(z0), o[dt][rq * 4 + 1] * inv * silu_f(z1));
            w.y = pk_bf16(o[dt][rq * 4 + 2] * inv * silu_f(z2), o[dt][rq * 4 + 3] * inv * silu_f(z3));
            *(u32x2*)(mp + d0) = w;
        }
}

__device__ __forceinline__ void unpack8(const u32x4 u, float* f) {
    f[0] = bf_lo(u.x); f[1] = bf_hi(u.x); f[2] = bf_lo(u.y); f[3] = bf_hi(u.y);
    f[4] = bf_lo(u.z); f[5] = bf_hi(u.z); f[6] = bf_lo(u.w); f[7] = bf_hi(u.w);
}

template <int WIN>
__device__ __forceinline__ void pool_group(const Params& p, int layer, int T0, int toff, int seqlen, int gi, int fr, int fq, const bf16x8 (&wf)[4][2],
                                           const f32x4 (&ps)[4], const unsigned char* smem) {
    constexpr int HALF = WIN / 2;
    u32x2 zz[2][4];
#pragma unroll
    for (int mi = 0; mi < 2; ++mi)
#pragma unroll
        for (int ni = 0; ni < 4; ++ni) zz[mi][ni] = *(const u32x2*)(p.proj + (size_t)(T0 + mi * 16 + fr) * INW + 2560 + gi * 64 + ni * 16 + fq * 4);
#pragma unroll
    for (int mi = 0; mi < 2; ++mi) {
        const int tt = mi * 16 + fr, ts = toff + tt, tok = T0 + tt;
        int lo = ts - HALF, hi = ts - HALF + WIN - 1;
        lo = lo < 0 ? 0 : lo;
        hi = hi > seqlen - 1 ? seqlen - 1 : hi;
        const float rc = 1.0f / (float)(hi - lo + 1);
        f32x4 acc[4];
#pragma unroll
        for (int j = 0; j < 4; ++j) acc[j] = (f32x4){0.f, 0.f, 0.f, 0.f};
#pragma unroll
        for (int kk = 0; kk < 2; ++kk) {
            const int co = (gi * 64 + kk * 32 + fq * 8) * 2;
            u32x4 rw[WIN];
#pragma unroll
            for (int j = 0; j < WIN; ++j) rw[j] = *(const u32x4*)(smem + (tt + 8 - HALF + j) * 528 + co);
            const u32x4 self = *(const u32x4*)(smem + (tt + 8) * 528 + co);
            float sum[8];
#pragma unroll
            for (int e = 0; e < 8; ++e) sum[e] = 0.f;
#pragma unroll
            for (int j = 0; j < WIN; ++j) {
                const int sq = ts - HALF + j;
                const float m = (sq >= 0 && sq < seqlen) ? 1.0f : 0.0f;
                float f[8];
                unpack8(rw[j], f);
#pragma unroll
                for (int e = 0; e < 8; ++e) sum[e] = fmaf(f[e], m, sum[e]);
            }
            float us[8];
            unpack8(self, us);
            u32x4 dw;
            dw.x = pk_bf16(sum[0] * rc - us[0], sum[1] * rc - us[1]);
            dw.y = pk_bf16(sum[2] * rc - us[2], sum[3] * rc - us[3]);
            dw.z = pk_bf16(sum[4] * rc - us[4], sum[5] * rc - us[5]);
            dw.w = pk_bf16(sum[6] * rc - us[6], sum[7] * rc - us[7]);
            const bf16x8 df = __builtin_bit_cast(bf16x8, dw);
#pragma unroll
            for (int ni = 0; ni < 4; ++ni) acc[ni] = __builtin_amdgcn_mfma_f32_16x16x32_bf16(wf[ni][kk], df, acc[ni], 0, 0, 0);
        }
#pragma unroll
        for (int ni = 0; ni < 4; ++ni) {
            const int ch = gi * 64 + ni * 16 + fq * 4;
            u32x2 w;
            w.x = pk_bf16(acc[ni][0] * ps[ni][0] * silu_f(bf_lo(zz[mi][ni].x)), acc[ni][1] * ps[ni][1] * silu_f(bf_hi(zz[mi][ni].x)));
            w.y = pk_bf16(acc[ni][2] * ps[ni][2] * silu_f(bf_lo(zz[mi][ni].y)), acc[ni][3] * ps[ni][3] * silu_f(bf_hi(zz[mi][ni].y)));
            *(u32x2*)(p.mix + (size_t)tok * DM + 768 + ch) = w;
        }
    }
}

__device__ __forceinline__ void pool_item(const Params& p, int layer, int pi, unsigned char* smem) {
    const int tid = otid(), lane = tid & 63, gi = tid >> 6;
    const int fr = lane & 15, fq = lane >> 4;
    const int T0 = pi * 32;
    int seqstart, seqlen;
    if (T0 < NCTX) { seqstart = T0 & ~255; seqlen = 256; } else { seqstart = NCTX + ((T0 - NCTX) & ~2047); seqlen = 2048; }
    const int toff = T0 - seqstart;
    u32x4 st[6];
#pragma unroll
    for (int i = 0; i < 6; ++i) {
        const int e = tid + 256 * i, r = e >> 5, c = e & 31;
        int sq = toff - 8 + r;
        sq = sq < 0 ? 0 : (sq > seqlen - 1 ? seqlen - 1 : sq);
        if (e < 47 * 32) st[i] = *(const u32x4*)(p.proj + (size_t)(seqstart + sq) * INW + 2304 + c * 8);
    }
    bf16x8 wf[4][2];
    f32x4 ps[4];
    {
        const bf16_t* wp = p.PoolT + (size_t)((layer * 4 + gi) * 64) * 64;
#pragma unroll
        for (int ni = 0; ni < 4; ++ni) {
#pragma unroll
            for (int kk = 0; kk < 2; ++kk) wf[ni][kk] = *(const bf16x8*)(wp + (ni * 16 + fr) * 64 + kk * 32 + fq * 8);
            ps[ni] = *(const f32x4*)(p.pool_scale + layer * 256 + gi * 64 + ni * 16 + fq * 4);
        }
    }
#pragma unroll
    for (int i = 0; i < 6; ++i) {
        const int e = tid + 256 * i, r = e >> 5, c = e & 31;
        if (e < 47 * 32) *(u32x4*)(smem + r * 528 + c * 16) = st[i];
    }
    __syncthreads();
    if (gi == 0) pool_group<2>(p, layer, T0, toff, seqlen, gi, fr, fq, wf, ps, smem);
    else if (gi == 1) pool_group<4>(p, layer, T0, toff, seqlen, gi, fr, fq, wf, ps, smem);
    else if (gi == 2) pool_group<8>(p, layer, T0, toff, seqlen, gi, fr, fq, wf, ps, smem);
    else pool_group<16>(p, layer, T0, toff, seqlen, gi, fr, fq, wf, ps, smem);
    __syncthreads();
}

__device__ __forceinline__ void conv_item(const Params& p, int layer, int ci) {
    const int tid = otid();
    const int ch = (tid & 31) * 8, tg = tid >> 5;
    const int T0 = ci * 32 + tg * 4;
    int seqstart, seqlen;
    if (T0 < NCTX) { seqstart = T0 & ~255; seqlen = 256; } else { seqstart = NCTX + ((T0 - NCTX) & ~2047); seqlen = 2048; }
    const int seqend = seqstart + seqlen;
    u32x4 rh[6], rc[6], rb[4], rz[4];
#pragma unroll
    for (int i = 0; i < 6; ++i) {
        int tok = T0 - 1 + i;
        tok = tok < seqstart ? seqstart : (tok > seqend - 1 ? seqend - 1 : tok);
        rh[i] = *(const u32x4*)(p.proj + (size_t)tok * INW + 1280 + ch);
        rc[i] = *(const u32x4*)(p.proj + (size_t)tok * INW + 1792 + ch);
    }
#pragma unroll
    for (int i = 0; i < 4; ++i) {
        rb[i] = *(const u32x4*)(p.proj + (size_t)(T0 + i) * INW + 1536 + ch);
        rz[i] = *(const u32x4*)(p.proj + (size_t)(T0 + i) * INW + 2048 + ch);
    }
    f32x4 wv[8];
    {
        const float* cw = p.conv_w + (size_t)layer * 768 + ch;
#pragma unroll
        for (int r = 0; r < 3; ++r) { wv[r * 2] = *(const f32x4*)(cw + r * 256); wv[r * 2 + 1] = *(const f32x4*)(cw + r * 256 + 4); }
        wv[6] = *(const f32x4*)(p.conv_b + layer * 256 + ch);
        wv[7] = *(const f32x4*)(p.conv_b + layer * 256 + ch + 4);
    }
    float x[6][8];
#pragma unroll
    for (int i = 0; i < 6; ++i) {
        const int tok = T0 - 1 + i;
        const float valid = (tok >= seqstart && tok < seqend) ? 1.0f : 0.0f;
        float hc[8], cc[8];
        unpack8(rh[i], hc);
        unpack8(rc[i], cc);
#pragma unroll
        for (int e = 0; e < 8; ++e) x[i][e] = hc[e] * cc[e] * valid;
    }
#pragma unroll
    for (int t = 0; t < 4; ++t) {
        float bc[8], zc[8], o[8];
        unpack8(rb[t], bc);
        unpack8(rz[t], zc);
#pragma unroll
        for (int e = 0; e < 8; ++e) {
            const float y = x[t][e] * wv[e >> 2][e & 3] + x[t + 1][e] * wv[2 + (e >> 2)][e & 3] + x[t + 2][e] * wv[4 + (e >> 2)][e & 3] + wv[6 + (e >> 2)][e & 3];
            o[e] = bc[e] * y * silu_f(zc[e]);
        }
        u32x4 w;
        w.x = pk_bf16(o[0], o[1]); w.y = pk_bf16(o[2], o[3]); w.z = pk_bf16(o[4], o[5]); w.w = pk_bf16(o[6], o[7]);
        *(u32x4*)(p.mix + (size_t)(T0 + t) * DM + 512 + ch) = w;
    }
}

__device__ __forceinline__ void phase_mixer(const Params& p, int layer, unsigned char* smem) {
    if (gridDim.x == 512) {
        const int b = blockIdx.x;
        if (b < 256) {
            const int xcd = b & 7, slot = b >> 3;
            attn_unit<0>(p, layer, 512 + ((((xcd << 1) | (slot >> 4)) << 4) | (slot & 15)), smem);
        }
        {
            const int xcd = b & 7, slot = b >> 3;
            attn_unit<0>(p, layer, ((xcd >> 1) << 7) | ((((xcd & 1) << 2) | (slot >> 4)) << 4) | (slot & 15), smem);
        }
        if (b >= 256) {
#pragma unroll 1
            for (int k = 0; k < 3; ++k) {
                const int idx = (b - 256) + 256 * k;
                if (idx < 384) pool_item(p, layer, idx, smem);
                else conv_item(p, layer, idx - 384);
            }
        }
    } else {
        for (int it = blockIdx.x; it < 768 + 384 + 384; it += gridDim.x) {
            if (it < 768) attn_unit<0>(p, layer, it, smem);
            else if (it < 1152) pool_item(p, layer, it - 768, smem);
            else conv_item(p, layer, it - 1152);
        }
    }
}

__global__ void __launch_bounds__(256, 2) mega(Params p, int lo, int hi) {
    __shared__ __attribute__((aligned(16))) unsigned char smem[73728];
    __shared__ uint4 xbw;
    if (p.use_cg) cg::this_grid().sync();
    if (threadIdx.x == 0) xbw = make_uint4(0u, 0u, 0u, 0u);
    __syncthreads();
    XcdBarrier xb = xcd_barrier_post(p.bar, (volatile LAS unsigned*)&xbw);
    for (int ph = lo; ph < hi; ++ph) {
        if (ph > lo) xcd_barrier(xb);
        if (ph == 0) phase_prep(p, smem);
        else if (ph == 9) phase_final(p);
        else {
            const int layer = (ph - 1) >> 2, ty = (ph - 1) & 3;
            if (ty == 0) phase_xn(p, layer);
            else if (ty == 1) phase_gemm<0>(p, layer, smem);
            else if (ty == 2) phase_mixer(p, layer, smem);
            else phase_gemm<1>(p, layer, smem);
        }
    }
}

#ifndef MK_MULTI
#define MK_MULTI 0
#endif

extern "C" void kernel_launch(void* const* d_in, const int* in_sizes, int n_in, void* d_out, int out_size, void* d_ws, size_t ws_size,
                              hipStream_t stream) {
    static int grid_blocks = 0;
    if (!grid_blocks) {
        int dev = 0, cus = 0, per_cu = 0;
        hipGetDevice(&dev);
        hipDeviceGetAttribute(&cus, hipDeviceAttributeMultiprocessorCount, dev);
        hipOccupancyMaxActiveBlocksPerMultiprocessor(&per_cu, mega, 256, 0);
        if (per_cu > 2) per_cu = 2;
        if (per_cu < 1) per_cu = 1;
        grid_blocks = cus * per_cu;
    }
    Params p{};
    const float* const* in = (const float* const*)d_in;
    p.x_prompt = in[0]; p.x_sample = in[1]; p.cache_k = in[2]; p.cache_v = in[3]; p.c = in[4]; p.c_ctx = in[5]; p.norm_g = in[6];
    p.w_ada = in[7]; p.b_ada = in[8]; p.w_in = in[9]; p.q_g = in[10]; p.k_g = in[11]; p.conv_w = in[12]; p.conv_b = in[13];
    p.pool_w = in[14]; p.pool_scale = in[15]; p.w_out = in[16]; p.final_g = in[17];
    p.out = (float*)d_out;
    unsigned char* ws = (unsigned char*)d_ws;
    size_t off = 0;
    auto take = [&](size_t bytes) { unsigned char* r = ws + off; off += (bytes + 255) & ~(size_t)255; return r; };
    p.bar = (unsigned*)take(XCD_BAR_WORDS * 4);
    p.modv = (float*)take(2 * 5 * 3072 * 4);
    p.rope = (float*)take(2048 * 4);
    p.WinT = (bf16_t*)take((size_t)2 * INW * 1024 * 2);
    p.WoutT = (bf16_t*)take((size_t)2 * 1024 * 1024 * 2);
    p.PoolT = (bf16_t*)take(2 * 4 * 64 * 64 * 2);
    p.kc = (bf16_t*)take(262144 * 2);
    p.vc = (bf16_t*)take(262144 * 2);
    p.h = (bf16_t*)take((size_t)NTOK * DM * 2);
    p.xn = (bf16_t*)take((size_t)NTOK * DM * 2);
    p.proj = (bf16_t*)take((size_t)NTOK * INW * 2);
    p.mix = (bf16_t*)take((size_t)NTOK * DM * 2);
    p.use_cg = 0;
    p.pad = 0;
    hipMemsetAsync(p.bar, 0, XCD_BAR_WORDS * 4, stream);
#if MK_MULTI
    for (int ph = 0; ph < 10; ++ph) {
        int lo = ph, hi = ph + 1;
        void* args[] = {&p, &lo, &hi};
        hipError_t e = hipLaunchCooperativeKernel((void*)mega, dim3(grid_blocks), dim3(256), args, 0, stream);
        if (e != hipSuccess) fprintf(stderr, "launch failed: %s\n", hipGetErrorString(e));
    }
#else
    int lo = 0, hi = 10;
    void* args[] = {&p, &lo, &hi};
    hipError_t e = hipLaunchCooperativeKernel((void*)mega, dim3(grid_blocks), dim3(256), args, 0, stream);
    if (e != hipSuccess) fprintf(stderr, "cooperative launch failed: %s (grid %d)\n", hipGetErrorString(e), grid_blocks);
#endif
}
```

```cpp
#include <hip/hip_runtime.h>
#include <hip/hip_cooperative_groups.h>
#include <cstdint>
#include <cstdio>
namespace cg = cooperative_groups;

#define LAS __attribute__((address_space(3)))
typedef unsigned short bf16_t;
typedef short bf16x8 __attribute__((ext_vector_type(8)));
typedef short s16x4 __attribute__((ext_vector_type(4)));
typedef float f32x4 __attribute__((ext_vector_type(4)));
typedef float f32x16 __attribute__((ext_vector_type(16)));
typedef unsigned u32x4 __attribute__((ext_vector_type(4)));
typedef unsigned u32x2 __attribute__((ext_vector_type(2)));

constexpr int NTOK = 12288, NCTX = 4096, DM = 1024, INW = 2816;
constexpr size_t OUT_NK = 12582912, OUT_NV = 13631488;
constexpr float EPSF = 1e-6f;
constexpr float QSCALE = 0.125f * 1.4426950408889634f;

struct Params {
    const float *x_prompt, *x_sample, *cache_k, *cache_v, *c, *c_ctx, *norm_g, *w_ada, *b_ada, *w_in, *q_g, *k_g, *conv_w, *conv_b,
        *pool_w, *pool_scale, *w_out, *final_g;
    float* out;
    unsigned* bar;
    float* modv;
    float* rope;
    bf16_t* WinT;
    bf16_t* WoutT;
    bf16_t* PoolT;
    bf16_t* kc;
    bf16_t* vc;
    bf16_t* h;
    bf16_t* xn;
    bf16_t* proj;
    bf16_t* mix;
    int use_cg;
    int pad;
};

__device__ __forceinline__ unsigned pk_bf16(float lo, float hi) {
    unsigned r;
    asm("v_cvt_pk_bf16_f32 %0, %1, %2" : "=v"(r) : "v"(lo), "v"(hi));
    return r;
}
__device__ __forceinline__ float bf_lo(unsigned u) { return __uint_as_float(u << 16); }
__device__ __forceinline__ float bf_hi(unsigned u) { return __uint_as_float(u & 0xffff0000u); }
__device__ __forceinline__ float silu_f(float z) { return z / (1.0f + __expf(-z)); }
__device__ __forceinline__ f32x4 bf4_to_f32(const u32x2 u) { return (f32x4){bf_lo(u.x), bf_hi(u.x), bf_lo(u.y), bf_hi(u.y)}; }
__device__ __forceinline__ void unpack8(const u32x4 u, float* f) {
    f[0] = bf_lo(u.x); f[1] = bf_hi(u.x); f[2] = bf_lo(u.y); f[3] = bf_hi(u.y);
    f[4] = bf_lo(u.z); f[5] = bf_hi(u.z); f[6] = bf_lo(u.w); f[7] = bf_hi(u.w);
}
__device__ __forceinline__ float max3_f(float a, float b, float c) { float r; asm("v_max3_f32 %0, %1, %2, %3" : "=v"(r) : "v"(a), "v"(b), "v"(c)); return r; }
__device__ __forceinline__ int otid() { int t = threadIdx.x; asm volatile("" : "+v"(t)); return t; }

#define XB_TMO 128
#define XB_XCNT(j) (256 + 64 * (j))
#define XB_XSUB(j) (1280 + 64 * (j))
#define XB_XGEN(j) (2304 + 64 * (j))
#define XB_TOP 3328
#define XB_TOPGEN 3392
#define XCD_BAR_WORDS 3456
#define XB_SPIN_CAP (1u << 20)

__device__ __forceinline__ unsigned xb_ld(unsigned* p) { return __hip_atomic_load(p, __ATOMIC_RELAXED, __HIP_MEMORY_SCOPE_AGENT); }
__device__ __forceinline__ unsigned xb_add(unsigned* p, unsigned v) { return __hip_atomic_fetch_add(p, v, __ATOMIC_RELAXED, __HIP_MEMORY_SCOPE_AGENT); }
__device__ __forceinline__ unsigned xb_xcc_id() { return (unsigned)__builtin_amdgcn_s_getreg((3 << 11) | 20) & 0xFu; }
#define XB_SPIN(cond, bar)                                                   \
    do {                                                                     \
        unsigned _sp = 0;                                                    \
        while (cond) {                                                       \
            __builtin_amdgcn_s_sleep(1);                                     \
            if ((++_sp & 255u) == 0u) {                                      \
                if (xb_ld(&(bar)[XB_TMO])) break;                            \
                if (_sp > XB_SPIN_CAP) { atomicAdd(&(bar)[XB_TMO], 1u); break; } \
            }                                                                \
        }                                                                    \
    } while (0)

struct XcdBarrier {
    unsigned* bar;
    unsigned x;
    volatile LAS unsigned* st;
};

__device__ __forceinline__ XcdBarrier xcd_barrier_post(unsigned* bar, volatile LAS unsigned* st) {
    XcdBarrier b;
    b.bar = bar;
    b.x = xb_xcc_id();
    b.st = st;
    if (threadIdx.x == 0) (void)xb_add(&bar[XB_XCNT(b.x)], 1u);
    return b;
}
__device__ __forceinline__ void xcd_barrier_complete(unsigned* bar, unsigned x, unsigned& nloc, unsigned& nx) {
    const unsigned G = gridDim.x * gridDim.y * gridDim.z;
    unsigned sum, cnt, mine, sp = 0u;
    for (;;) {
        sum = 0u; cnt = 0u; mine = 0u;
#pragma unroll
        for (unsigned j = 0; j < 16; ++j) {
            const unsigned c = xb_ld(&bar[XB_XCNT(j)]);
            sum += c; cnt += (c > 0u) ? 1u : 0u; mine = (j == x) ? c : mine;
        }
        if (sum == G) break;
        __builtin_amdgcn_s_sleep(1);
        if ((++sp & 255u) == 0u) {
            if (xb_ld(&bar[XB_TMO])) break;
            if (sp > XB_SPIN_CAP) { atomicAdd(&bar[XB_TMO], 1u); break; }
        }
    }
    nloc = mine > 0u ? mine : 1u;
    nx = cnt > 0u ? cnt : 1u;
}
__device__ __forceinline__ void xcd_barrier(const XcdBarrier& b) {
    asm volatile("s_waitcnt vmcnt(0)" ::: "memory");
    __syncthreads();
    if (threadIdx.x == 0) {
        unsigned* bar = b.bar;
        __builtin_amdgcn_s_waitcnt(0);
        unsigned nloc = b.st[0], nx = b.st[1];
        if (nloc == 0u) { xcd_barrier_complete(bar, b.x, nloc, nx); b.st[0] = nloc; b.st[1] = nx; }
        const unsigned old = xb_add(&bar[XB_XSUB(b.x)], 1u);
        const unsigned gen = old / nloc;
        if (old + 1u == (gen + 1u) * nloc) {
            __builtin_amdgcn_fence(__ATOMIC_RELEASE, "agent");
            asm volatile("s_waitcnt vmcnt(0)" ::: "memory");
            const unsigned og = xb_add(&bar[XB_TOP], 1u);
            const unsigned tg = og / nx;
            if (og + 1u == (tg + 1u) * nx) xb_add(&bar[XB_TOPGEN], 1u);
            else XB_SPIN(xb_ld(&bar[XB_TOPGEN]) == tg, bar);
            __builtin_amdgcn_fence(__ATOMIC_ACQUIRE, "agent");
            xb_add(&bar[XB_XGEN(b.x)], 1u);
            asm volatile("s_waitcnt vmcnt(0)" ::: "memory");
        } else {
            XB_SPIN(xb_ld(&bar[XB_XGEN(b.x)]) == gen, bar);
            __builtin_amdgcn_fence(__ATOMIC_ACQUIRE, "agent");
            asm volatile("s_waitcnt vmcnt(0)" ::: "memory");
        }
    }
    __syncthreads();
}

__device__ __forceinline__ void prep_mod_item(const Params& p, int item, unsigned char* smem) {
    const int tid = otid();
    float* sc = (float*)smem;
    float* red = (float*)(smem + 20480);
    const int l = item / 96, j0 = (item % 96) * 32;
    for (int idx = tid; idx < 5120; idx += 256) {
        const int v = idx >> 10, k = idx & 1023;
        const float cv = (v == 0) ? p.c_ctx[k] : p.c[(v - 1) * 1024 + k];
        sc[idx] = cv / (1.0f + expf(-cv));
    }
    __syncthreads();
    const int cgp = tid & 7, kg = tid >> 3;
    float acc[5][4];
#pragma unroll
    for (int v = 0; v < 5; ++v)
#pragma unroll
        for (int e = 0; e < 4; ++e) acc[v][e] = 0.f;
    const float* wp = p.w_ada + (size_t)l * 1024 * 3072 + j0 + cgp * 4;
    f32x4 wreg[32];
#pragma unroll
    for (int kk = 0; kk < 32; ++kk) wreg[kk] = *(const f32x4*)(wp + (size_t)(kk * 32 + kg) * 3072);
#pragma unroll
    for (int kk = 0; kk < 32; ++kk) {
        const int k = kk * 32 + kg;
        const f32x4 w = wreg[kk];
#pragma unroll
        for (int v = 0; v < 5; ++v) {
            const float s = sc[v * 1024 + k];
#pragma unroll
            for (int e = 0; e < 4; ++e) acc[v][e] += s * w[e];
        }
    }
#pragma unroll
    for (int v = 0; v < 5; ++v)
#pragma unroll
        for (int e = 0; e < 4; ++e) red[kg * 160 + v * 32 + cgp * 4 + e] = acc[v][e];
    __syncthreads();
    if (tid < 160) {
        float s = 0.f;
        for (int g = 0; g < 32; ++g) s += red[g * 160 + tid];
        const int v = tid >> 5, cc = tid & 31;
        p.modv[(size_t)(l * 5 + v) * 3072 + j0 + cc] = s + p.b_ada[l * 3072 + j0 + cc];
    }
    __syncthreads();
}

__device__ __forceinline__ void prep_transpose_item(const float* src, bf16_t* dst, int N, int k0, int n0) {
    const int n = n0 + otid();
    const float* sp = src + (size_t)k0 * N + n;
    float v[32];
#pragma unroll
    for (int i = 0; i < 32; ++i) v[i] = sp[(size_t)i * N];
    bf16_t* d = dst + (size_t)n * 1024 + k0;
#pragma unroll
    for (int c = 0; c < 4; ++c) {
        u32x4 w;
        w.x = pk_bf16(v[c * 8 + 0], v[c * 8 + 1]);
        w.y = pk_bf16(v[c * 8 + 2], v[c * 8 + 3]);
        w.z = pk_bf16(v[c * 8 + 4], v[c * 8 + 5]);
        w.w = pk_bf16(v[c * 8 + 6], v[c * 8 + 7]);
        *(u32x4*)(d + c * 8) = w;
    }
}

__device__ __forceinline__ void phase_prep(const Params& p, unsigned char* smem) {
    const int ntb = (int)gridDim.x * 5 / 8, nmb = (int)gridDim.x - ntb;
    const int NTI = 2 * 11 * 32, NTO = 2 * 4 * 32;
    if ((int)blockIdx.x < ntb) {
        for (int it = blockIdx.x; it < NTI + NTO; it += ntb) {
            if (it < NTI) {
                const int l = it / 352, r = it % 352, kt = r / 11, nt = r % 11;
                prep_transpose_item(p.w_in + (size_t)l * 1024 * INW, p.WinT + (size_t)l * INW * 1024, INW, kt * 32, nt * 256);
            } else {
                const int t = it - NTI, l = t / 128, r = t % 128, kt = r / 4, nt = r % 4;
                prep_transpose_item(p.w_out + (size_t)l * 1024 * 1024, p.WoutT + (size_t)l * 1024 * 1024, 1024, kt * 32, nt * 256);
            }
        }
    } else {
        for (int it = (int)blockIdx.x - ntb; it < 192; it += nmb) prep_mod_item(p, it, smem);
    }
    const int gsz = gridDim.x * 256;
    for (int i = blockIdx.x * 256 + otid(); i < 131072; i += gsz) {
        const int which = i >> 16, j4 = (i & 65535) * 4;
        const int d = j4 & 63, t = (j4 >> 6) & 255, kvh = (j4 >> 14) & 1, bl = j4 >> 15;
        const size_t si = ((size_t)(bl * 256 + t) * 2 + kvh) * 64 + d;
        const f32x4 v = *(const f32x4*)((which ? p.cache_v : p.cache_k) + si);
        u32x2 w;
        w.x = pk_bf16(v[0], v[1]);
        w.y = pk_bf16(v[2], v[3]);
        *(u32x2*)((which ? p.vc : p.kc) + j4) = w;
    }
    for (int j = blockIdx.x * 256 + otid(); j < 32768; j += gsz) {
        const int cc = j & 63, d = (j >> 6) & 63, lg = j >> 12;
        const float v = p.pool_w[((size_t)lg * 64 + cc) * 64 + d];
        p.PoolT[j] = (bf16_t)(pk_bf16(v, 0.f) & 0xffffu);
    }
    for (int j = blockIdx.x * 256 + otid(); j < 1024; j += gsz) {
        const int a = j & 15, r = j >> 4;
        const float inv = 1.0f / powf(10000.0f, (float)(2 * a) / 32.0f);
        const float ang = (float)r * inv;
        const float kf = rintf(ang * 0.15915494309189535f);
        float rr = fmaf(-kf, 6.2831854820251465f, ang);
        rr = fmaf(-kf, -1.7484555e-7f, rr);
        p.rope[j] = cosf(rr);
        p.rope[1024 + j] = sinf(rr);
    }
}

__device__ __forceinline__ float wave_sum(float v) {
#pragma unroll
    for (int o = 32; o >= 1; o >>= 1) v += __shfl_xor(v, o);
    return v;
}

__device__ __forceinline__ void phase_xn(const Params& p, int layer) {
    const int tid = otid(), lane = tid & 63, wave = tid >> 6;
    const int nw = gridDim.x * 4, w = blockIdx.x * 4 + wave;
    for (int t0 = w * 6; t0 < NTOK; t0 += nw * 6) {
        f32x4 x[6][4];
        if (layer == 0) {
#pragma unroll
            for (int u = 0; u < 6; ++u) {
                const int tok = t0 + u;
                const float* src = tok < NCTX ? p.x_prompt + (size_t)tok * DM : p.x_sample + (size_t)(tok - NCTX) * DM;
#pragma unroll
                for (int i = 0; i < 4; ++i) x[u][i] = *(const f32x4*)(src + i * 256 + lane * 4);
            }
        } else {
            u32x2 r[6][4];
#pragma unroll
            for (int u = 0; u < 6; ++u)
#pragma unroll
                for (int i = 0; i < 4; ++i) r[u][i] = *(const u32x2*)(p.h + (size_t)(t0 + u) * DM + i * 256 + lane * 4);
#pragma unroll
            for (int u = 0; u < 6; ++u)
#pragma unroll
                for (int i = 0; i < 4; ++i) x[u][i] = bf4_to_f32(r[u][i]);
        }
#pragma unroll
        for (int u = 0; u < 6; ++u) {
            const int tok = t0 + u;
            const int v = tok < NCTX ? 0 : 1 + ((tok - NCTX) >> 11);
            const float* mv = p.modv + (size_t)(layer * 5 + v) * 3072;
            float ss = 0.f;
#pragma unroll
            for (int i = 0; i < 4; ++i) ss += x[u][i][0] * x[u][i][0] + x[u][i][1] * x[u][i][1] + x[u][i][2] * x[u][i][2] + x[u][i][3] * x[u][i][3];
            ss = wave_sum(ss);
            const float rstd = rsqrtf(ss * (1.0f / 1024.0f) + EPSF);
#pragma unroll
            for (int i = 0; i < 4; ++i) {
                const int k = i * 256 + lane * 4;
                const f32x4 g = *(const f32x4*)(p.norm_g + layer * 1024 + k);
                const f32x4 sh = *(const f32x4*)(mv + k);
                const f32x4 sc = *(const f32x4*)(mv + 1024 + k);
                float o[4];
#pragma unroll
                for (int e = 0; e < 4; ++e) o[e] = x[u][i][e] * rstd * g[e] * (1.0f + sc[e]) + sh[e];
                u32x2 wv;
                wv.x = pk_bf16(o[0], o[1]);
                wv.y = pk_bf16(o[2], o[3]);
                *(u32x2*)(p.xn + (size_t)tok * DM + k) = wv;
            }
        }
    }
}

__device__ __forceinline__ void phase_final(const Params& p) {
    const int tid = otid(), lane = tid & 63, wave = tid >> 6;
    const int nw = gridDim.x * 4, w = blockIdx.x * 4 + wave;
    f32x4 g[4];
#pragma unroll
    for (int i = 0; i < 4; ++i) g[i] = *(const f32x4*)(p.final_g + i * 256 + lane * 4);
    for (int t0 = w * 6; t0 < NTOK; t0 += nw * 6) {
        u32x2 r[6][4];
#pragma unroll
        for (int u = 0; u < 6; ++u)
#pragma unroll
            for (int i = 0; i < 4; ++i) r[u][i] = *(const u32x2*)(p.xn + (size_t)(t0 + u) * DM + i * 256 + lane * 4);
#pragma unroll
        for (int u = 0; u < 6; ++u) {
            float* row = p.out + (size_t)(t0 + u) * DM;
            f32x4 x[4];
            float ss = 0.f;
#pragma unroll
            for (int i = 0; i < 4; ++i) {
                x[i] = bf4_to_f32(r[u][i]);
                ss += x[i][0] * x[i][0] + x[i][1] * x[i][1] + x[i][2] * x[i][2] + x[i][3] * x[i][3];
            }
            ss = wave_sum(ss);
            const float rstd = rsqrtf(ss * (1.0f / 1024.0f) + EPSF);
#pragma unroll
            for (int i = 0; i < 4; ++i) *(f32x4*)(row + i * 256 + lane * 4) = x[i] * rstd * g[i];
        }
    }
}

template <int MODE, int MI, int STG = 0>
__device__ __forceinline__ void gemm_epilogue(const Params& p, int layer, int mw, int nw, f32x4 (&acc)[MI][4], int fr, int fq,
                                              unsigned char* ct = nullptr, int m0t = 0, int n0t = 0) {
    if (MODE == 0) {
        const bool ctx = mw < NCTX;
        if (nw < 640) {
            const bool isq = nw < 512;
            const float* gp = (isq ? p.q_g : p.k_g) + layer * 64;
            f32x4 gv[4];
#pragma unroll
            for (int ni = 0; ni < 4; ++ni) gv[ni] = *(const f32x4*)(gp + ni * 16 + fq * 4);
#pragma unroll
            for (int mi = 0; mi < MI; ++mi) {
                const int tok = mw + mi * 16 + fr;
                float ss = 0.f;
#pragma unroll
                for (int ni = 0; ni < 4; ++ni)
#pragma unroll
                    for (int e = 0; e < 4; ++e) ss += acc[mi][ni][e] * acc[mi][ni][e];
                ss += __shfl_xor(ss, 16);
                ss += __shfl_xor(ss, 32);
                const float rstd = rsqrtf(ss * (1.0f / 64.0f) + EPSF);
                f32x4 val[4];
#pragma unroll
                for (int ni = 0; ni < 4; ++ni) val[ni] = acc[mi][ni] * rstd * gv[ni];
                if (!isq && ctx) {
                    float* nk = p.out + OUT_NK + ((size_t)((tok >> 8) * 2 + layer) * 256 + (tok & 255)) * 128 + (nw - 512) + fq * 4;
#pragma unroll
                    for (int ni = 0; ni < 4; ++ni) *(f32x4*)(nk + ni * 16) = val[ni];
                }
                if (!ctx) {
                    const int pos = (tok - NCTX) & 2047, prow = pos >> 6, pcol = pos & 63;
                    const f32x4 cr = *(const f32x4*)(p.rope + prow * 16 + fq * 4), sr = *(const f32x4*)(p.rope + 1024 + prow * 16 + fq * 4);
                    const f32x4 cc = *(const f32x4*)(p.rope + pcol * 16 + fq * 4), sn = *(const f32x4*)(p.rope + 1024 + pcol * 16 + fq * 4);
                    const f32x4 a0 = val[0], a1 = val[1], a2 = val[2], a3 = val[3];
                    val[0] = a0 * cr - a1 * sr;
                    val[1] = a1 * cr + a0 * sr;
                    val[2] = a2 * cc - a3 * sn;
                    val[3] = a3 * cc + a2 * sn;
                }
                if (isq) {
#pragma unroll
                    for (int ni = 0; ni < 4; ++ni) val[ni] = val[ni] * QSCALE;
                }
                bf16_t* pr = p.proj + (size_t)tok * INW + nw + fq * 4;
#pragma unroll
                for (int ni = 0; ni < 4; ++ni) {
                    u32x2 w;
                    w.x = pk_bf16(val[ni][0], val[ni][1]);
                    w.y = pk_bf16(val[ni][2], val[ni][3]);
                    if (STG) *(u32x2*)(ct + (tok - m0t) * 272 + (nw - n0t + fq * 4 + ni * 16) * 2) = w;
                    else *(u32x2*)(pr + ni * 16) = w;
                }
            }
        } else {
            const bool isv = nw < 768;
#pragma unroll
            for (int mi = 0; mi < MI; ++mi) {
                const int tok = mw + mi * 16 + fr;
                bf16_t* pr = p.proj + (size_t)tok * INW + nw + fq * 4;
#pragma unroll
                for (int ni = 0; ni < 4; ++ni) {
                    u32x2 w;
                    w.x = pk_bf16(acc[mi][ni][0], acc[mi][ni][1]);
                    w.y = pk_bf16(acc[mi][ni][2], acc[mi][ni][3]);
                    if (STG) *(u32x2*)(ct + (tok - m0t) * 272 + (nw - n0t + fq * 4 + ni * 16) * 2) = w;
                    else *(u32x2*)(pr + ni * 16) = w;
                }
                if (isv && ctx) {
                    float* nv = p.out + OUT_NV + ((size_t)((tok >> 8) * 2 + layer) * 256 + (tok & 255)) * 128 + (nw - 640) + fq * 4;
#pragma unroll
                    for (int ni = 0; ni < 4; ++ni) *(f32x4*)(nv + ni * 16) = acc[mi][ni];
                }
            }
        }
    } else {
        const int v = mw < NCTX ? 0 : 1 + ((mw - NCTX) >> 11);
        const float* gate = p.modv + (size_t)(layer * 5 + v) * 3072 + 2048 + nw + fq * 4;
        f32x4 gt[4];
#pragma unroll
        for (int ni = 0; ni < 4; ++ni) gt[ni] = *(const f32x4*)(gate + ni * 16);
#pragma unroll
        for (int mi = 0; mi < MI; ++mi) {
            const int tok = mw + mi * 16 + fr;
            const size_t eo = (size_t)tok * DM + nw + fq * 4;
            const float* xin = (tok < NCTX ? p.x_prompt + (size_t)tok * DM : p.x_sample + (size_t)(tok - NCTX) * DM) + nw + fq * 4;
#pragma unroll
            for (int ni = 0; ni < 4; ++ni) {
                if (layer == 0) {
                    const f32x4 r = *(const f32x4*)(xin + ni * 16) + gt[ni] * acc[mi][ni];
                    u32x2 w;
                    w.x = pk_bf16(r[0], r[1]);
                    w.y = pk_bf16(r[2], r[3]);
                    *(u32x2*)(p.h + eo + ni * 16) = w;
                } else {
                    const f32x4 r = bf4_to_f32(*(const u32x2*)(p.h + eo + ni * 16)) + gt[ni] * acc[mi][ni];
                    u32x2 w;
                    w.x = pk_bf16(r[0], r[1]);
                    w.y = pk_bf16(r[2], r[3]);
                    *(u32x2*)(p.xn + eo + ni * 16) = w;
                }
            }
        }
    }
}

template <int MODE>
__device__ __forceinline__ void gemm_tile(const Params& p, int layer, int mt, int nt, unsigned char* smem) {
    const int tid = otid(), lane = tid & 63, wave = tid >> 6, wm = wave >> 1, wn = wave & 1;
    const int fr = lane & 15, fq = lane >> 4;
    const int m0 = mt * 128, n0 = nt * 128;
    const bf16_t* A = (MODE == 0 ? p.xn : p.mix) + (size_t)m0 * 1024;
    const bf16_t* B = (MODE == 0 ? p.WinT + (size_t)layer * INW * 1024 : p.WoutT + (size_t)layer * 1024 * 1024) + (size_t)n0 * 1024;
    f32x4 acc[4][4];
#pragma unroll
    for (int i = 0; i < 4; ++i)
#pragma unroll
        for (int j = 0; j < 4; ++j) acc[i][j] = (f32x4){0.f, 0.f, 0.f, 0.f};

    const int srow = tid >> 3, scc = tid & 7;
    const bf16_t* ag = A + (size_t)srow * 1024 + scc * 8;
    const bf16_t* bg = B + (size_t)srow * 1024 + scc * 8;
    const int wofs = srow * 128 + ((scc ^ (srow & 7)) * 16);
    u32x4 raA[4], rbA[4], raB[4], rbB[4];
    auto gload = [&](int kt, u32x4* ra, u32x4* rb) {
#pragma unroll
        for (int i = 0; i < 4; ++i) {
            ra[i] = *(const u32x4*)(ag + (size_t)i * 32 * 1024 + kt * 64);
            rb[i] = *(const u32x4*)(bg + (size_t)i * 32 * 1024 + kt * 64);
        }
    };
    auto swrite = [&](int buf, const u32x4* ra, const u32x4* rb) {
        unsigned char* Aw = smem + buf * 32768;
#pragma unroll
        for (int i = 0; i < 4; ++i) {
            *(u32x4*)(Aw + wofs + i * 4096) = ra[i];
            *(u32x4*)(Aw + 16384 + wofs + i * 4096) = rb[i];
        }
    };
    gload(0, raA, rbA);
    gload(1, raB, rbB);
    swrite(0, raA, rbA);
    __syncthreads();
    const int aro = (wm * 64 + fr) * 128, bro = (wn * 64 + fr) * 128, sw = fr & 7;
    auto step = [&](int kt, u32x4* la, u32x4* lb, const u32x4* wa, const u32x4* wb) {
        const unsigned char* As = smem + (kt & 1) * 32768;
        const unsigned char* Bs = As + 16384;
        bf16x8 af[2][4], bf[2][4];
#pragma unroll
        for (int kk = 0; kk < 2; ++kk) {
            const int co = ((kk * 4 + fq) ^ sw) * 16;
#pragma unroll
            for (int i = 0; i < 4; ++i) {
                af[kk][i] = *(const bf16x8*)(As + aro + i * 2048 + co);
                bf[kk][i] = *(const bf16x8*)(Bs + bro + i * 2048 + co);
            }
        }
        if (kt + 2 < 16) gload(kt + 2, la, lb);
        __builtin_amdgcn_sched_barrier(0);
#pragma unroll
        for (int mi = 0; mi < 4; ++mi)
#pragma unroll
            for (int ni = 0; ni < 4; ++ni) acc[mi][ni] = __builtin_amdgcn_mfma_f32_16x16x32_bf16(bf[0][ni], af[0][mi], acc[mi][ni], 0, 0, 0);
        __builtin_amdgcn_sched_barrier(0);
        if (kt + 1 < 16) swrite((kt + 1) & 1, wa, wb);
        __builtin_amdgcn_sched_barrier(0);
#pragma unroll
        for (int mi = 0; mi < 4; ++mi)
#pragma unroll
            for (int ni = 0; ni < 4; ++ni) acc[mi][ni] = __builtin_amdgcn_mfma_f32_16x16x32_bf16(bf[1][ni], af[1][mi], acc[mi][ni], 0, 0, 0);
        __syncthreads();
    };
    for (int kt = 0; kt < 16; kt += 2) {
        step(kt, raA, rbA, raB, rbB);
        step(kt + 1, raB, rbB, raA, rbA);
    }

    gemm_epilogue<MODE, 4>(p, layer, m0 + wm * 64, n0 + wn * 64, acc, fr, fq);
}

template <int MODE>
__device__ __forceinline__ void gemm_tile256(const Params& p, int layer, int mt, int nt, unsigned char* smem) {
    const int tid = otid(), lane = tid & 63, wave = tid >> 6, wm = wave >> 1, wn = wave & 1;
    const int fr = lane & 15, fq = lane >> 4;
    const int m0 = mt * 256, n0 = nt * 128;
    const bf16_t* A = (MODE == 0 ? p.xn : p.mix) + (size_t)m0 * 1024;
    const bf16_t* B = (MODE == 0 ? p.WinT + (size_t)layer * INW * 1024 : p.WoutT + (size_t)layer * 1024 * 1024) + (size_t)n0 * 1024;
    f32x4 acc[8][4];
#pragma unroll
    for (int i = 0; i < 8; ++i)
#pragma unroll
        for (int j = 0; j < 4; ++j) acc[i][j] = (f32x4){0.f, 0.f, 0.f, 0.f};
    const int srow = tid >> 2, scc = tid & 3;
    const bf16_t* ag = A + (size_t)srow * 1024 + scc * 8;
    const bf16_t* bg = B + (size_t)srow * 1024 + scc * 8;
    const int wofs = srow * 64 + ((scc ^ ((4 - ((srow >> 2) & 3)) & 3)) * 16);
    u32x4 raA[4], rbA[2], raB[4], rbB[2];
    auto gload = [&](int kt, u32x4* ra, u32x4* rb) {
#pragma unroll
        for (int i = 0; i < 4; ++i) ra[i] = *(const u32x4*)(ag + (size_t)i * 64 * 1024 + kt * 32);
#pragma unroll
        for (int i = 0; i < 2; ++i) rb[i] = *(const u32x4*)(bg + (size_t)i * 64 * 1024 + kt * 32);
    };
    auto swrite = [&](int buf, const u32x4* ra, const u32x4* rb) {
        unsigned char* Aw = smem + buf * 24576;
#pragma unroll
        for (int i = 0; i < 4; ++i) *(u32x4*)(Aw + wofs + i * 4096) = ra[i];
#pragma unroll
        for (int i = 0; i < 2; ++i) *(u32x4*)(Aw + 16384 + wofs + i * 4096) = rb[i];
    };
    gload(0, raA, rbA);
    gload(1, raB, rbB);
    swrite(0, raA, rbA);
    __syncthreads();
    const int co = (fq ^ ((4 - ((fr >> 2) & 3)) & 3)) * 16;
    const int aro = (wm * 128 + fr) * 64 + co, bro = (wn * 64 + fr) * 64 + co;
    auto step = [&](int kt, u32x4* la, u32x4* lb, const u32x4* wa, const u32x4* wb) {
        const unsigned char* As = smem + (kt & 1) * 24576;
        const unsigned char* Bs = As + 16384;
        bf16x8 af[8], bf[4];
#pragma unroll
        for (int i = 0; i < 4; ++i) bf[i] = *(const bf16x8*)(Bs + bro + i * 1024);
#pragma unroll
        for (int i = 0; i < 8; ++i) af[i] = *(const bf16x8*)(As + aro + i * 1024);
        if (kt + 2 < 32) gload(kt + 2, la, lb);
        __builtin_amdgcn_sched_barrier(0);
#pragma unroll
        for (int mi = 0; mi < 4; ++mi)
#pragma unroll
            for (int ni = 0; ni < 4; ++ni) acc[mi][ni] = __builtin_amdgcn_mfma_f32_16x16x32_bf16(bf[ni], af[mi], acc[mi][ni], 0, 0, 0);
        __builtin_amdgcn_sched_barrier(0);
        if (kt + 1 < 32) swrite((kt + 1) & 1, wa, wb);
        __builtin_amdgcn_sched_barrier(0);
#pragma unroll
        for (int mi = 4; mi < 8; ++mi)
#pragma unroll
            for (int ni = 0; ni < 4; ++ni) acc[mi][ni] = __builtin_amdgcn_mfma_f32_16x16x32_bf16(bf[ni], af[mi], acc[mi][ni], 0, 0, 0);
        __syncthreads();
    };
    for (int kt = 0; kt < 32; kt += 2) {
        step(kt, raA, rbA, raB, rbB);
        step(kt + 1, raB, rbB, raA, rbA);
    }
    gemm_epilogue<MODE, 8>(p, layer, m0 + wm * 128, n0 + wn * 64, acc, fr, fq);
}

template <int MODE>
__device__ __forceinline__ void gemm_tile256_dma(const Params& p, int layer, int mt, int nt, unsigned char* smem) {
    const int tid = otid(), lane = tid & 63, wave = tid >> 6, wm = wave >> 1, wn = wave & 1;
    const int fr = lane & 15, fq = lane >> 4;
    const int m0 = mt * 256, n0 = nt * 128;
    const bf16_t* A = (MODE == 0 ? p.xn : p.mix) + (size_t)m0 * 1024;
    const bf16_t* B = (MODE == 0 ? p.WinT + (size_t)layer * INW * 1024 : p.WoutT + (size_t)layer * 1024 * 1024) + (size_t)n0 * 1024;
    f32x4 acc[8][4];
#pragma unroll
    for (int i = 0; i < 8; ++i)
#pragma unroll
        for (int j = 0; j < 4; ++j) acc[i][j] = (f32x4){0.f, 0.f, 0.f, 0.f};
    const int lrow = lane >> 2, lc = (lane & 3) ^ ((4 - ((lane >> 4) & 3)) & 3);
    const bf16_t* agp = A + (size_t)(wave * 64 + lrow) * 1024 + lc * 8;
    const bf16_t* bgp = B + (size_t)(wave * 32 + lrow) * 1024 + lc * 8;
    LAS unsigned char* lbase = (LAS unsigned char*)smem;
    const int la_off = wave * 4096 + lane * 16, lb_off = 16384 + wave * 2048 + lane * 16;
    auto dma = [&](int kt, int stage) {
        LAS unsigned char* sb = lbase + stage * 24576;
#pragma unroll
        for (int i = 0; i < 4; ++i)
            __builtin_amdgcn_global_load_lds((const void*)(agp + (size_t)i * 16 * 1024 + kt * 32), (LAS void*)(sb + la_off + i * 1024), 16, 0, 0);
#pragma unroll
        for (int i = 0; i < 2; ++i)
            __builtin_amdgcn_global_load_lds((const void*)(bgp + (size_t)i * 16 * 1024 + kt * 32), (LAS void*)(sb + lb_off + i * 1024), 16, 0, 0);
    };
    dma(0, 0);
    dma(1, 1);
    asm volatile("s_waitcnt vmcnt(6)" ::: "memory");
    __builtin_amdgcn_s_barrier();
    const int co = (fq ^ ((4 - ((fr >> 2) & 3)) & 3)) * 16;
    const int aro = (wm * 128 + fr) * 64 + co, bro = 16384 + (wn * 64 + fr) * 64 + co;
    int st = 0, st2 = 2;
    const unsigned lds0 = (unsigned)(uintptr_t)lbase;
#pragma unroll 1
    for (int kt = 0; kt < 32; ++kt) {
        const unsigned sa = lds0 + st * 24576 + aro, sbb = lds0 + st * 24576 + bro;
        bf16x8 af[8], bf[4];
#define FRAG_RD(dst, addr, OFF) asm volatile("ds_read_b128 %0, %1 offset:" #OFF : "=&v"(dst) : "v"(addr))
        FRAG_RD(bf[0], sbb, 0); FRAG_RD(bf[1], sbb, 1024); FRAG_RD(bf[2], sbb, 2048); FRAG_RD(bf[3], sbb, 3072);
        FRAG_RD(af[0], sa, 0); FRAG_RD(af[1], sa, 1024); FRAG_RD(af[2], sa, 2048); FRAG_RD(af[3], sa, 3072);
        FRAG_RD(af[4], sa, 4096); FRAG_RD(af[5], sa, 5120); FRAG_RD(af[6], sa, 6144); FRAG_RD(af[7], sa, 7168);
#undef FRAG_RD
        __builtin_amdgcn_sched_barrier(0);
        if (kt + 2 < 32) dma(kt + 2, st2);
        __builtin_amdgcn_sched_barrier(0);
        asm volatile("s_waitcnt lgkmcnt(4)" ::: "memory");
        __builtin_amdgcn_sched_barrier(0);
#pragma unroll
        for (int mi = 0; mi < 4; ++mi)
#pragma unroll
            for (int ni = 0; ni < 4; ++ni) acc[mi][ni] = __builtin_amdgcn_mfma_f32_16x16x32_bf16(bf[ni], af[mi], acc[mi][ni], 0, 0, 0);
        __builtin_amdgcn_sched_barrier(0);
        asm volatile("s_waitcnt lgkmcnt(0)" ::: "memory");
        __builtin_amdgcn_sched_barrier(0);
#pragma unroll
        for (int mi = 4; mi < 8; ++mi)
#pragma unroll
            for (int ni = 0; ni < 4; ++ni) acc[mi][ni] = __builtin_amdgcn_mfma_f32_16x16x32_bf16(bf[ni], af[mi], acc[mi][ni], 0, 0, 0);
        __builtin_amdgcn_sched_barrier(0);
        if (kt + 2 < 32) asm volatile("s_waitcnt vmcnt(6)" ::: "memory");
        else asm volatile("s_waitcnt vmcnt(0)" ::: "memory");
        __builtin_amdgcn_s_barrier();
        st = st == 2 ? 0 : st + 1;
        st2 = st2 == 2 ? 0 : st2 + 1;
    }
    if (MODE == 0) {
        gemm_epilogue<0, 8, 1>(p, layer, m0 + wm * 128, n0 + wn * 64, acc, fr, fq, smem, m0, n0);
        __syncthreads();
        u32x4 cv[16];
#pragma unroll
        for (int i = 0; i < 16; ++i) { const int e = tid + 256 * i; cv[i] = *(const u32x4*)(smem + (e >> 4) * 272 + (e & 15) * 16); }
#pragma unroll
        for (int i = 0; i < 16; ++i) { const int e = tid + 256 * i; *(u32x4*)(p.proj + (size_t)(m0 + (e >> 4)) * INW + n0 + (e & 15) * 8) = cv[i]; }
        __syncthreads();
    } else {
        {
            const int v = m0 < NCTX ? 0 : 1 + ((m0 - NCTX) >> 11);
            const float* gate = p.modv + (size_t)(layer * 5 + v) * 3072 + 2048 + n0 + wn * 64 + fq * 4;
            f32x4 gt[4];
#pragma unroll
            for (int ni = 0; ni < 4; ++ni) gt[ni] = *(const f32x4*)(gate + ni * 16);
#pragma unroll
            for (int mi = 0; mi < 8; ++mi)
#pragma unroll
                for (int ni = 0; ni < 4; ++ni) {
                    const f32x4 g = gt[ni] * acc[mi][ni];
                    u32x2 w;
                    w.x = pk_bf16(g[0], g[1]);
                    w.y = pk_bf16(g[2], g[3]);
                    *(u32x2*)(smem + (wm * 128 + mi * 16 + fr) * 272 + (wn * 64 + ni * 16 + fq * 4) * 2) = w;
                }
        }
        __syncthreads();
        bf16_t* dst = layer == 0 ? p.h : p.xn;
#pragma unroll 1
        for (int hf = 0; hf < 2; ++hf) {
            f32x4 ha[8], hb[8];
            u32x4 hv[8];
#pragma unroll
            for (int i = 0; i < 8; ++i) {
                const int e = tid + 256 * (hf * 8 + i), tok = m0 + (e >> 4), c8 = (e & 15) * 8;
                if (layer == 0) {
                    const float* xp = (tok < NCTX ? p.x_prompt + (size_t)tok * DM : p.x_sample + (size_t)(tok - NCTX) * DM) + n0 + c8;
                    ha[i] = *(const f32x4*)xp;
                    hb[i] = *(const f32x4*)(xp + 4);
                } else {
                    hv[i] = *(const u32x4*)(p.h + (size_t)tok * DM + n0 + c8);
                }
            }
#pragma unroll
            for (int i = 0; i < 8; ++i) {
                const int e = tid + 256 * (hf * 8 + i), tok = m0 + (e >> 4), c8 = (e & 15) * 8;
                float g[8], o[8];
                unpack8(*(const u32x4*)(smem + (e >> 4) * 272 + (e & 15) * 16), g);
                if (layer == 0) {
#pragma unroll
                    for (int q = 0; q < 4; ++q) { o[q] = ha[i][q]; o[4 + q] = hb[i][q]; }
                } else {
                    unpack8(hv[i], o);
                }
                u32x4 w;
                w.x = pk_bf16(o[0] + g[0], o[1] + g[1]);
                w.y = pk_bf16(o[2] + g[2], o[3] + g[3]);
                w.z = pk_bf16(o[4] + g[4], o[5] + g[5]);
                w.w = pk_bf16(o[6] + g[6], o[7] + g[7]);
                *(u32x4*)(dst + (size_t)tok * DM + n0 + c8) = w;
            }
        }
        __syncthreads();
    }
}

__device__ __forceinline__ void gemm_piece64_dma(const Params& p, int layer, int m0, int n0, unsigned char* smem) {
    const int tid = otid(), lane = tid & 63, wave = tid >> 6, wm = wave >> 1, wn = wave & 1;
    const int fr = lane & 15, fq = lane >> 4;
    const bf16_t* A = p.xn + (size_t)m0 * 1024;
    const bf16_t* B = p.WinT + (size_t)layer * INW * 1024 + (size_t)n0 * 1024;
    f32x4 acc[2][4];
#pragma unroll
    for (int i = 0; i < 2; ++i)
#pragma unroll
        for (int j = 0; j < 4; ++j) acc[i][j] = (f32x4){0.f, 0.f, 0.f, 0.f};
    const int lrow = lane >> 2, lc = (lane & 3) ^ ((4 - ((lane >> 4) & 3)) & 3);
    const bf16_t* agp = A + (size_t)(wave * 16 + lrow) * 1024 + lc * 8;
    const bf16_t* bgp = B + (size_t)(wave * 32 + lrow) * 1024 + lc * 8;
    LAS unsigned char* lbase = (LAS unsigned char*)smem;
    const int la_off = wave * 1024 + lane * 16, lb_off = 4096 + wave * 2048 + lane * 16;
    auto dma = [&](int kt, int stage) {
        LAS unsigned char* sb = lbase + stage * 12288;
        __builtin_amdgcn_global_load_lds((const void*)(agp + kt * 32), (LAS void*)(sb + la_off), 16, 0, 0);
#pragma unroll
        for (int i = 0; i < 2; ++i)
            __builtin_amdgcn_global_load_lds((const void*)(bgp + (size_t)i * 16 * 1024 + kt * 32), (LAS void*)(sb + lb_off + i * 1024), 16, 0, 0);
    };
    dma(0, 0);
    dma(1, 1);
    asm volatile("s_waitcnt vmcnt(3)" ::: "memory");
    __builtin_amdgcn_s_barrier();
    const int co = (fq ^ ((4 - ((fr >> 2) & 3)) & 3)) * 16;
    const int aro = (wm * 32 + fr) * 64 + co, bro = 4096 + (wn * 64 + fr) * 64 + co;
    int st = 0, st2 = 2;
    const unsigned lds0 = (unsigned)(uintptr_t)lbase;
#pragma unroll 1
    for (int kt = 0; kt < 32; ++kt) {
        const unsigned sa = lds0 + st * 12288 + aro, sbb = lds0 + st * 12288 + bro;
        bf16x8 af[2], bf[4];
#define FRAG_RD(dst, addr, OFF) asm volatile("ds_read_b128 %0, %1 offset:" #OFF : "=&v"(dst) : "v"(addr))
        FRAG_RD(bf[0], sbb, 0); FRAG_RD(bf[1], sbb, 1024); FRAG_RD(bf[2], sbb, 2048); FRAG_RD(bf[3], sbb, 3072);
        FRAG_RD(af[0], sa, 0); FRAG_RD(af[1], sa, 1024);
#undef FRAG_RD
        __builtin_amdgcn_sched_barrier(0);
        if (kt + 2 < 32) dma(kt + 2, st2);
        __builtin_amdgcn_sched_barrier(0);
        asm volatile("s_waitcnt lgkmcnt(0)" ::: "memory");
        __builtin_amdgcn_sched_barrier(0);
#pragma unroll
        for (int mi = 0; mi < 2; ++mi)
#pragma unroll
            for (int ni = 0; ni < 4; ++ni) acc[mi][ni] = __builtin_amdgcn_mfma_f32_16x16x32_bf16(bf[ni], af[mi], acc[mi][ni], 0, 0, 0);
        __builtin_amdgcn_sched_barrier(0);
        if (kt + 2 < 32) asm volatile("s_waitcnt vmcnt(3)" ::: "memory");
        else asm volatile("s_waitcnt vmcnt(0)" ::: "memory");
        __builtin_amdgcn_s_barrier();
        st = st == 2 ? 0 : st + 1;
        st2 = st2 == 2 ? 0 : st2 + 1;
    }
    gemm_epilogue<0, 2, 1>(p, layer, m0 + wm * 32, n0 + wn * 64, acc, fr, fq, smem, m0, n0);
    __syncthreads();
    u32x4 cv[4];
#pragma unroll
    for (int i = 0; i < 4; ++i) { const int e = tid + 256 * i; cv[i] = *(const u32x4*)(smem + (e >> 4) * 272 + (e & 15) * 16); }
#pragma unroll
    for (int i = 0; i < 4; ++i) { const int e = tid + 256 * i; *(u32x4*)(p.proj + (size_t)(m0 + (e >> 4)) * INW + n0 + (e & 15) * 8) = cv[i]; }
    __syncthreads();
}

template <int MODE>
__device__ __forceinline__ void phase_gemm(const Params& p, int layer, unsigned char* smem) {
    const int NT = MODE == 0 ? 22 : 8;
    const int total = 96 * NT;
    if (gridDim.x == 512) {
        const int xcd = blockIdx.x & 7, slot = blockIdx.x >> 3;
        if (MODE == 0) {
            if (slot < 16) gemm_piece64_dma(p, layer, (xcd * 6 + 2 + (slot >> 2)) * 256 + (slot & 3) * 64, 21 * 128, smem);
            for (int idx = slot; idx < 128; idx += 64) gemm_tile256_dma<MODE>(p, layer, xcd * 6 + idx % 6, idx / 6, smem);
        } else {
            if (slot < 32) gemm_tile256_dma<MODE>(p, layer, xcd * 6 + slot % 6, slot / 6, smem);
            else {
                const int d = 32 + ((slot - 32) >> 1);
                gemm_tile<MODE>(p, layer, (xcd * 6 + d % 6) * 2 + (slot & 1), d / 6, smem);
            }
        }
    } else {
        for (int t = blockIdx.x; t < total; t += gridDim.x) gemm_tile<MODE>(p, layer, t / NT, t % NT, smem);
    }
}

template <int VAR>
__device__ __forceinline__ void attn_unit(const Params& p, int layer, int unit, unsigned char* smem) {
    const int tid = otid(), lane = tid & 63, wave = tid >> 6;
    const int r31 = lane & 31, hh = lane >> 5;
    int b, head, qblk, tokbase, nself, ntiles;
    if (unit < 512) { b = unit >> 7; head = (unit >> 4) & 7; qblk = unit & 15; tokbase = NCTX + b * 2048; nself = 2048; ntiles = 36; }
    else { const int u = unit - 512; b = u >> 4; head = (u >> 1) & 7; qblk = u & 1; tokbase = b * 256; nself = 256; ntiles = 4; }
    const int kvh = head >> 2;
    const int qtok = tokbase + qblk * 128 + wave * 32 + r31;
    bf16x8 qf[4];
    {
        const bf16_t* qp = p.proj + (size_t)qtok * INW + head * 64 + hh * 8;
#pragma unroll
        for (int ks = 0; ks < 4; ++ks) qf[ks] = *(const bf16x8*)(qp + ks * 16);
    }
    const bf16_t* kself = p.proj + (size_t)tokbase * INW + 512 + kvh * 64;
    const bf16_t* vself = p.proj + (size_t)tokbase * INW + 640 + kvh * 64;
    const bf16_t* kcache = p.kc + (size_t)((b * 2 + layer) * 2 + kvh) * 256 * 64;
    const bf16_t* vcache = p.vc + (size_t)((b * 2 + layer) * 2 + kvh) * 256 * 64;
    const int srow = tid >> 3, scc = tid & 7;
    const int kwo = srow * 128 + ((scc ^ ((srow >> 1) & 7)) * 16);
    const int vwo = srow * 128 + ((scc ^ (((srow >> 1) & 1) << 2)) * 16);
    u32x4 rkA[2], rvA[2], rkB[2], rvB[2];
    auto gload = [&](int j, u32x4* rk, u32x4* rv) {
        const int key0 = j * 64;
#pragma unroll
        for (int i = 0; i < 2; ++i) {
            const int row = srow + 32 * i;
            if (key0 < nself) {
                rk[i] = *(const u32x4*)(kself + (size_t)(key0 + row) * INW + scc * 8);
                rv[i] = *(const u32x4*)(vself + (size_t)(key0 + row) * INW + scc * 8);
            } else {
                rk[i] = *(const u32x4*)(kcache + (size_t)(key0 - nself + row) * 64 + scc * 8);
                rv[i] = *(const u32x4*)(vcache + (size_t)(key0 - nself + row) * 64 + scc * 8);
            }
        }
    };
    auto swrite = [&](int buf, const u32x4* rk, const u32x4* rv) {
        unsigned char* kb = smem + buf * 16384;
        unsigned char* vb = kb + 8192;
#pragma unroll
        for (int i = 0; i < 2; ++i) {
            *(u32x4*)(kb + kwo + i * 32 * 128) = rk[i];
            *(u32x4*)(vb + vwo + i * 32 * 128) = rv[i];
        }
    };
    f32x16 o[2];
#pragma unroll
    for (int i = 0; i < 16; ++i) { o[0][i] = 0.f; o[1][i] = 0.f; }
    float mrun = 0.f, mmax = -1e30f, lrun = 0.f;
    f32x16 negm, zero16;
#pragma unroll
    for (int i = 0; i < 16; ++i) { negm[i] = 0.f; zero16[i] = 0.f; }
    bool shifted = false;
    gload(0, rkA, rvA);
    swrite(0, rkA, rvA);
    if (ntiles > 1) gload(1, rkB, rvB);
    __syncthreads();
    const int kro = r31 * 128, ksw = (r31 >> 1) & 7;
    const int vq = 4 * hh + ((lane & 15) >> 2);
    const int vsw = ((vq >> 1) & 1) << 2;
    const int vcl = ((lane >> 4) & 1) * 2 + ((lane & 3) >> 1);
    const int vro0 = vq * 128 + (((0 * 4 + vcl) ^ vsw) * 16) + (lane & 1) * 8;
    const int vro1 = vq * 128 + (((1 * 4 + vcl) ^ vsw) * 16) + (lane & 1) * 8;
    auto step = [&](int j, u32x4* lk, u32x4* lv, const u32x4* wk, const u32x4* wv) {
        const unsigned char* kb = smem + (j & 1) * 16384;
        const unsigned char* vb = kb + 8192;
        bf16x8 kf[2][4];
#pragma unroll
        for (int sb = 0; sb < 2; ++sb)
#pragma unroll
            for (int ks = 0; ks < 4; ++ks) kf[sb][ks] = *(const bf16x8*)(kb + sb * 4096 + kro + (((ks * 2 + hh) ^ ksw) * 16));
        bf16x8 vf[2][2][2];
#pragma unroll
        for (int sb = 0; sb < 2; ++sb)
#pragma unroll
            for (int s2 = 0; s2 < 2; ++s2)
#pragma unroll
                for (int dt = 0; dt < 2; ++dt) {
                    const LAS unsigned char* va = (const LAS unsigned char*)(vb) + (sb * 32 + s2 * 16) * 128 + (dt ? vro1 : vro0);
                    const s16x4 a0 = __builtin_amdgcn_ds_read_tr16_b64_v4i16((LAS s16x4*)(va));
                    const s16x4 a1 = __builtin_amdgcn_ds_read_tr16_b64_v4i16((LAS s16x4*)(va + 8 * 128));
                    vf[sb][s2][dt] = (bf16x8){a0[0], a0[1], a0[2], a0[3], a1[0], a1[1], a1[2], a1[3]};
                }
        if (VAR != 1 && j + 2 < ntiles) gload(j + 2, lk, lv);
        __builtin_amdgcn_sched_barrier(0);
        f32x16 s[2];
        float mloc, lsum = 0.f;
        bf16x8 pf[2][2];
#pragma unroll
        for (int sb = 0; sb < 2; ++sb)
#pragma unroll
            for (int ks = 0; ks < 4; ++ks) {
                if (ks == 0) {
                    if (shifted) s[sb] = __builtin_amdgcn_mfma_f32_32x32x16_bf16(kf[sb][ks], qf[ks], negm, 0, 0, 0);
                    else s[sb] = __builtin_amdgcn_mfma_f32_32x32x16_bf16(kf[sb][ks], qf[ks], zero16, 0, 0, 0);
                } else s[sb] = __builtin_amdgcn_mfma_f32_32x32x16_bf16(kf[sb][ks], qf[ks], s[sb], 0, 0, 0);
            }
#pragma unroll
        for (int sb = 0; sb < 2; ++sb) {
            float m0 = max3_f(s[sb][0], s[sb][1], s[sb][2]);
#pragma unroll
            for (int i = 3; i < 15; i += 2) m0 = max3_f(m0, s[sb][i], s[sb][i + 1]);
            m0 = fmaxf(m0, s[sb][15]);
            mloc = sb == 0 ? m0 : fmaxf(mloc, m0);
#pragma unroll
            for (int i = 0; i < 16; ++i) { if (VAR != 2) { s[sb][i] = __builtin_amdgcn_exp2f(s[sb][i]); lsum += s[sb][i]; } }
#pragma unroll
            for (int s2 = 0; s2 < 2; ++s2) {
                u32x4 pw;
                pw.x = pk_bf16(s[sb][s2 * 8 + 0], s[sb][s2 * 8 + 1]);
                pw.y = pk_bf16(s[sb][s2 * 8 + 2], s[sb][s2 * 8 + 3]);
                pw.z = pk_bf16(s[sb][s2 * 8 + 4], s[sb][s2 * 8 + 5]);
                pw.w = pk_bf16(s[sb][s2 * 8 + 6], s[sb][s2 * 8 + 7]);
                pf[sb][s2] = __builtin_bit_cast(bf16x8, pw);
            }
#pragma unroll
            for (int s2 = 0; s2 < 2; ++s2)
#pragma unroll
                for (int dt = 0; dt < 2; ++dt) o[dt] = __builtin_amdgcn_mfma_f32_32x32x16_bf16(vf[sb][s2][dt], pf[sb][s2], o[dt], 0, 0, 0);
        }
        lrun += lsum;
        __builtin_amdgcn_sched_barrier(0);
        mloc = fmaxf(mloc, __shfl_xor(mloc, 32));
        mmax = fmaxf(mmax, mrun + mloc);
        if (__builtin_expect(__any(fabsf(mmax - mrun) > 40.0f), 0)) {
            asm volatile("" ::: "memory");
            const float alpha = __builtin_amdgcn_exp2f(mrun - mmax);
            mrun = mmax;
            lrun *= alpha;
            shifted = true;
#pragma unroll
            for (int i = 0; i < 16; ++i) { o[0][i] *= alpha; o[1][i] *= alpha; negm[i] = -mrun; }
        }
        if (VAR != 1 && j + 1 < ntiles) swrite((j + 1) & 1, wk, wv);
        __syncthreads();
    };
    for (int j = 0; j < ntiles; j += 2) {
        step(j, rkA, rvA, rkB, rvB);
        step(j + 1, rkB, rvB, rkA, rvA);
    }
    const float ltot = lrun + __shfl_xor(lrun, 32);
    const float inv = 1.0f / ltot;
    const bf16_t* zp = p.proj + (size_t)qtok * INW + 768 + head * 64;
    bf16_t* mp = (VAR == 0 ? p.mix : p.xn) + (size_t)qtok * DM + head * 64;
#pragma unroll
    for (int dt = 0; dt < 2; ++dt)
#pragma unroll
        for (int rq = 0; rq < 4; ++rq) {
            const int d0 = dt * 32 + 8 * rq + 4 * hh;
            const u32x2 zz = *(const u32x2*)(zp + d0);
            const float z0 = bf_lo(zz.x), z1 = bf_hi(zz.x), z2 = bf_lo(zz.y), z3 = bf_hi(zz.y);
            u32x2 w;
            w.x = pk_bf16(o[dt][rq * 4 + 0] * inv * silu_f(z0), o[dt][rq * 4 + 1] * inv * silu_f(z1));
            w.y = pk_bf16(o[dt][rq * 4 + 2] * inv * silu_f(z2), o[dt][rq * 4 + 3] * inv * silu_f(z3));
            *(u32x2*)(mp + d0) = w;
        }
}


template <int WIN>
__device__ __forceinline__ void pool_group(const Params& p, int layer, int T0, int toff, int seqlen, int gi, int fr, int fq, const bf16x8 (&wf)[4][2],
                                           const f32x4 (&ps)[4], const unsigned char* smem) {
    constexpr int HALF = WIN / 2;
    u32x2 zz[2][4];
#pragma unroll
    for (int mi = 0; mi < 2; ++mi)
#pragma unroll
        for (int ni = 0; ni < 4; ++ni) zz[mi][ni] = *(const u32x2*)(p.proj + (size_t)(T0 + mi * 16 + fr) * INW + 2560 + gi * 64 + ni * 16 + fq * 4);
#pragma unroll
    for (int mi = 0; mi < 2; ++mi) {
        const int tt = mi * 16 + fr, ts = toff + tt, tok = T0 + tt;
        int lo = ts - HALF, hi = ts - HALF + WIN - 1;
        lo = lo < 0 ? 0 : lo;
        hi = hi > seqlen - 1 ? seqlen - 1 : hi;
        const float rc = 1.0f / (float)(hi - lo + 1);
        f32x4 acc[4];
#pragma unroll
        for (int j = 0; j < 4; ++j) acc[j] = (f32x4){0.f, 0.f, 0.f, 0.f};
#pragma unroll
        for (int kk = 0; kk < 2; ++kk) {
            const int co = (gi * 64 + kk * 32 + fq * 8) * 2;
            u32x4 rw[WIN];
#pragma unroll
            for (int j = 0; j < WIN; ++j) rw[j] = *(const u32x4*)(smem + (tt + 8 - HALF + j) * 528 + co);
            const u32x4 self = *(const u32x4*)(smem + (tt + 8) * 528 + co);
            float sum[8];
#pragma unroll
            for (int e = 0; e < 8; ++e) sum[e] = 0.f;
#pragma unroll
            for (int j = 0; j < WIN; ++j) {
                const int sq = ts - HALF + j;
                const float m = (sq >= 0 && sq < seqlen) ? 1.0f : 0.0f;
                float f[8];
                unpack8(rw[j], f);
#pragma unroll
                for (int e = 0; e < 8; ++e) sum[e] = fmaf(f[e], m, sum[e]);
            }
            float us[8];
            unpack8(self, us);
            u32x4 dw;
            dw.x = pk_bf16(sum[0] * rc - us[0], sum[1] * rc - us[1]);
            dw.y = pk_bf16(sum[2] * rc - us[2], sum[3] * rc - us[3]);
            dw.z = pk_bf16(sum[4] * rc - us[4], sum[5] * rc - us[5]);
            dw.w = pk_bf16(sum[6] * rc - us[6], sum[7] * rc - us[7]);
            const bf16x8 df = __builtin_bit_cast(bf16x8, dw);
#pragma unroll
            for (int ni = 0; ni < 4; ++ni) acc[ni] = __builtin_amdgcn_mfma_f32_16x16x32_bf16(wf[ni][kk], df, acc[ni], 0, 0, 0);
        }
#pragma unroll
        for (int ni = 0; ni < 4; ++ni) {
            const int ch = gi * 64 + ni * 16 + fq * 4;
            u32x2 w;
            w.x = pk_bf16(acc[ni][0] * ps[ni][0] * silu_f(bf_lo(zz[mi][ni].x)), acc[ni][1] * ps[ni][1] * silu_f(bf_hi(zz[mi][ni].x)));
            w.y = pk_bf16(acc[ni][2] * ps[ni][2] * silu_f(bf_lo(zz[mi][ni].y)), acc[ni][3] * ps[ni][3] * silu_f(bf_hi(zz[mi][ni].y)));
            *(u32x2*)(p.mix + (size_t)tok * DM + 768 + ch) = w;
        }
    }
}

__device__ __forceinline__ void pool_item(const Params& p, int layer, int pi, unsigned char* smem) {
    const int tid = otid(), lane = tid & 63, gi = tid >> 6;
    const int fr = lane & 15, fq = lane >> 4;
    const int T0 = pi * 32;
    int seqstart, seqlen;
    if (T0 < NCTX) { seqstart = T0 & ~255; seqlen = 256; } else { seqstart = NCTX + ((T0 - NCTX) & ~2047); seqlen = 2048; }
    const int toff = T0 - seqstart;
    u32x4 st[6];
#pragma unroll
    for (int i = 0; i < 6; ++i) {
        const int e = tid + 256 * i, r = e >> 5, c = e & 31;
        int sq = toff - 8 + r;
        sq = sq < 0 ? 0 : (sq > seqlen - 1 ? seqlen - 1 : sq);
        if (e < 47 * 32) st[i] = *(const u32x4*)(p.proj + (size_t)(seqstart + sq) * INW + 2304 + c * 8);
    }
    bf16x8 wf[4][2];
    f32x4 ps[4];
    {
        const bf16_t* wp = p.PoolT + (size_t)((layer * 4 + gi) * 64) * 64;
#pragma unroll
        for (int ni = 0; ni < 4; ++ni) {
#pragma unroll
            for (int kk = 0; kk < 2; ++kk) wf[ni][kk] = *(const bf16x8*)(wp + (ni * 16 + fr) * 64 + kk * 32 + fq * 8);
            ps[ni] = *(const f32x4*)(p.pool_scale + layer * 256 + gi * 64 + ni * 16 + fq * 4);
        }
    }
#pragma unroll
    for (int i = 0; i < 6; ++i) {
        const int e = tid + 256 * i, r = e >> 5, c = e & 31;
        if (e < 47 * 32) *(u32x4*)(smem + r * 528 + c * 16) = st[i];
    }
    __syncthreads();
    if (gi == 0) pool_group<2>(p, layer, T0, toff, seqlen, gi, fr, fq, wf, ps, smem);
    else if (gi == 1) pool_group<4>(p, layer, T0, toff, seqlen, gi, fr, fq, wf, ps, smem);
    else if (gi == 2) pool_group<8>(p, layer, T0, toff, seqlen, gi, fr, fq, wf, ps, smem);
    else pool_group<16>(p, layer, T0, toff, seqlen, gi, fr, fq, wf, ps, smem);
    __syncthreads();
}

__device__ __forceinline__ void conv_item(const Params& p, int layer, int ci) {
    const int tid = otid();
    const int ch = (tid & 31) * 8, tg = tid >> 5;
    const int T0 = ci * 32 + tg * 4;
    int seqstart, seqlen;
    if (T0 < NCTX) { seqstart = T0 & ~255; seqlen = 256; } else { seqstart = NCTX + ((T0 - NCTX) & ~2047); seqlen = 2048; }
    const int seqend = seqstart + seqlen;
    u32x4 rh[6], rc[6], rb[4], rz[4];
#pragma unroll
    for (int i = 0; i < 6; ++i) {
        int tok = T0 - 1 + i;
        tok = tok < seqstart ? seqstart : (tok > seqend - 1 ? seqend - 1 : tok);
        rh[i] = *(const u32x4*)(p.proj + (size_t)tok * INW + 1280 + ch);
        rc[i] = *(const u32x4*)(p.proj + (size_t)tok * INW + 1792 + ch);
    }
#pragma unroll
    for (int i = 0; i < 4; ++i) {
        rb[i] = *(const u32x4*)(p.proj + (size_t)(T0 + i) * INW + 1536 + ch);
        rz[i] = *(const u32x4*)(p.proj + (size_t)(T0 + i) * INW + 2048 + ch);
    }
    f32x4 wv[8];
    {
        const float* cw = p.conv_w + (size_t)layer * 768 + ch;
#pragma unroll
        for (int r = 0; r < 3; ++r) { wv[r * 2] = *(const f32x4*)(cw + r * 256); wv[r * 2 + 1] = *(const f32x4*)(cw + r * 256 + 4); }
        wv[6] = *(const f32x4*)(p.conv_b + layer * 256 + ch);
        wv[7] = *(const f32x4*)(p.conv_b + layer * 256 + ch + 4);
    }
    float x[6][8];
#pragma unroll
    for (int i = 0; i < 6; ++i) {
        const int tok = T0 - 1 + i;
        const float valid = (tok >= seqstart && tok < seqend) ? 1.0f : 0.0f;
        float hc[8], cc[8];
        unpack8(rh[i], hc);
        unpack8(rc[i], cc);
#pragma unroll
        for (int e = 0; e < 8; ++e) x[i][e] = hc[e] * cc[e] * valid;
    }
#pragma unroll
    for (int t = 0; t < 4; ++t) {
        float bc[8], zc[8], o[8];
        unpack8(rb[t], bc);
        unpack8(rz[t], zc);
#pragma unroll
        for (int e = 0; e < 8; ++e) {
            const float y = x[t][e] * wv[e >> 2][e & 3] + x[t + 1][e] * wv[2 + (e >> 2)][e & 3] + x[t + 2][e] * wv[4 + (e >> 2)][e & 3] + wv[6 + (e >> 2)][e & 3];
            o[e] = bc[e] * y * silu_f(zc[e]);
        }
        u32x4 w;
        w.x = pk_bf16(o[0], o[1]); w.y = pk_bf16(o[2], o[3]); w.z = pk_bf16(o[4], o[5]); w.w = pk_bf16(o[6], o[7]);
        *(u32x4*)(p.mix + (size_t)(T0 + t) * DM + 512 + ch) = w;
    }
}

__device__ __forceinline__ void phase_mixer(const Params& p, int layer, unsigned char* smem) {
    if (gridDim.x == 512) {
        const int b = blockIdx.x;
        if (b < 256) {
            const int xcd = b & 7, slot = b >> 3;
            attn_unit<0>(p, layer, 512 + ((((xcd << 1) | (slot >> 4)) << 4) | (slot & 15)), smem);
        }
        {
            const int xcd = b & 7, slot = b >> 3;
            attn_unit<0>(p, layer, ((xcd >> 1) << 7) | ((((xcd & 1) << 2) | (slot >> 4)) << 4) | (slot & 15), smem);
        }
        if (b >= 256) {
#pragma unroll 1
            for (int k = 0; k < 3; ++k) {
                const int idx = (b - 256) + 256 * k;
                if (idx < 384) pool_item(p, layer, idx, smem);
                else conv_item(p, layer, idx - 384);
            }
        }
    } else {
        for (int it = blockIdx.x; it < 768 + 384 + 384; it += gridDim.x) {
            if (it < 768) attn_unit<0>(p, layer, it, smem);
            else if (it < 1152) pool_item(p, layer, it - 768, smem);
            else conv_item(p, layer, it - 1152);
        }
    }
}

__global__ void __launch_bounds__(256, 2) mega(Params p, int lo, int hi) {
    __shared__ __attribute__((aligned(16))) unsigned char smem[73728];
    __shared__ uint4 xbw;
    if (p.use_cg) cg::this_grid().sync();
    if (threadIdx.x == 0) xbw = make_uint4(0u, 0u, 0u, 0u);
    __syncthreads();
    XcdBarrier xb = xcd_barrier_post(p.bar, (volatile LAS unsigned*)&xbw);
    for (int ph = lo; ph < hi; ++ph) {
        if (ph > lo) xcd_barrier(xb);
        if (ph == 0) phase_prep(p, smem);
        else if (ph == 9) phase_final(p);
        else {
            const int layer = (ph - 1) >> 2, ty = (ph - 1) & 3;
            if (ty == 0) phase_xn(p, layer);
            else if (ty == 1) phase_gemm<0>(p, layer, smem);
            else if (ty == 2) phase_mixer(p, layer, smem);
            else phase_gemm<1>(p, layer, smem);
        }
    }
}

#ifndef MK_MULTI
#define MK_MULTI 0
#endif

extern "C" void kernel_launch(void* const* d_in, const int* in_sizes, int n_in, void* d_out, int out_size, void* d_ws, size_t ws_size,
                              hipStream_t stream) {
    static int grid_blocks = 0;
    if (!grid_blocks) {
        int dev = 0, cus = 0, per_cu = 0;
        hipGetDevice(&dev);
        hipDeviceGetAttribute(&cus, hipDeviceAttributeMultiprocessorCount, dev);
        hipOccupancyMaxActiveBlocksPerMultiprocessor(&per_cu, mega, 256, 0);
        if (per_cu > 2) per_cu = 2;
        if (per_cu < 1) per_cu = 1;
        grid_blocks = cus * per_cu;
    }
    Params p{};
    const float* const* in = (const float* const*)d_in;
    p.x_prompt = in[0]; p.x_sample = in[1]; p.cache_k = in[2]; p.cache_v = in[3]; p.c = in[4]; p.c_ctx = in[5]; p.norm_g = in[6];
    p.w_ada = in[7]; p.b_ada = in[8]; p.w_in = in[9]; p.q_g = in[10]; p.k_g = in[11]; p.conv_w = in[12]; p.conv_b = in[13];
    p.pool_w = in[14]; p.pool_scale = in[15]; p.w_out = in[16]; p.final_g = in[17];
    p.out = (float*)d_out;
    unsigned char* ws = (unsigned char*)d_ws;
    size_t off = 0;
    auto take = [&](size_t bytes) { unsigned char* r = ws + off; off += (bytes + 255) & ~(size_t)255; return r; };
    p.bar = (unsigned*)take(XCD_BAR_WORDS * 4);
    p.modv = (float*)take(2 * 5 * 3072 * 4);
    p.rope = (float*)take(2048 * 4);
    p.WinT = (bf16_t*)take((size_t)2 * INW * 1024 * 2);
    p.WoutT = (bf16_t*)take((size_t)2 * 1024 * 1024 * 2);
    p.PoolT = (bf16_t*)take(2 * 4 * 64 * 64 * 2);
    p.kc = (bf16_t*)take(262144 * 2);
    p.vc = (bf16_t*)take(262144 * 2);
    p.h = (bf16_t*)take((size_t)NTOK * DM * 2);
    p.xn = (bf16_t*)take((size_t)NTOK * DM * 2);
    p.proj = (bf16_t*)take((size_t)NTOK * INW * 2);
    p.mix = (bf16_t*)take((size_t)NTOK * DM * 2);
    p.use_cg = 0;
    p.pad = 0;
    hipMemsetAsync(p.bar, 0, XCD_BAR_WORDS * 4, stream);
#if MK_MULTI
    for (int ph = 0; ph < 10; ++ph) {
        int lo = ph, hi = ph + 1;
        void* args[] = {&p, &lo, &hi};
        hipError_t e = hipLaunchCooperativeKernel((void*)mega, dim3(grid_blocks), dim3(256), args, 0, stream);
        if (e != hipSuccess) fprintf(stderr, "launch failed: %s\n", hipGetErrorString(e));
    }
#else
    int lo = 0, hi = 10;
    void* args[] = {&p, &lo, &hi};
    hipError_t e = hipLaunchCooperativeKernel((void*)mega, dim3(grid_blocks), dim3(256), args, 0, stream);
    if (e != hipSuccess) fprintf(stderr, "cooperative launch failed: %s (grid %d)\n", hipGetErrorString(e), grid_blocks);
#endif
}
```

```cpp
#include <hip/hip_runtime.h>
#include <hip/hip_cooperative_groups.h>
#include <cstdint>
#include <cstdio>
namespace cg = cooperative_groups;

#define LAS __attribute__((address_space(3)))
typedef unsigned short bf16_t;
typedef short bf16x8 __attribute__((ext_vector_type(8)));
typedef short s16x4 __attribute__((ext_vector_type(4)));
typedef float f32x4 __attribute__((ext_vector_type(4)));
typedef float f32x16 __attribute__((ext_vector_type(16)));
typedef unsigned u32x4 __attribute__((ext_vector_type(4)));
typedef unsigned u32x2 __attribute__((ext_vector_type(2)));

constexpr int NTOK = 12288, NCTX = 4096, DM = 1024, INW = 2816;
constexpr size_t OUT_NK = 12582912, OUT_NV = 13631488;
constexpr float EPSF = 1e-6f;
constexpr float QSCALE = 0.125f * 1.4426950408889634f;

struct Params {
    const float *x_prompt, *x_sample, *cache_k, *cache_v, *c, *c_ctx, *norm_g, *w_ada, *b_ada, *w_in, *q_g, *k_g, *conv_w, *conv_b,
        *pool_w, *pool_scale, *w_out, *final_g;
    float* out;
    unsigned* bar;
    float* modv;
    float* rope;
    bf16_t* WinT;
    bf16_t* WoutT;
    bf16_t* PoolT;
    bf16_t* kc;
    bf16_t* vc;
    bf16_t* h;
    bf16_t* xn;
    bf16_t* proj;
    bf16_t* mix;
    int use_cg;
    int pad;
};

__device__ __forceinline__ unsigned pk_bf16(float lo, float hi) {
    unsigned r;
    asm("v_cvt_pk_bf16_f32 %0, %1, %2" : "=v"(r) : "v"(lo), "v"(hi));
    return r;
}
__device__ __forceinline__ float bf_lo(unsigned u) { return __uint_as_float(u << 16); }
__device__ __forceinline__ float bf_hi(unsigned u) { return __uint_as_float(u & 0xffff0000u); }
__device__ __forceinline__ float silu_f(float z) { return z / (1.0f + __expf(-z)); }
__device__ __forceinline__ f32x4 bf4_to_f32(const u32x2 u) { return (f32x4){bf_lo(u.x), bf_hi(u.x), bf_lo(u.y), bf_hi(u.y)}; }
__device__ __forceinline__ void unpack8(const u32x4 u, float* f) {
    f[0] = bf_lo(u.x); f[1] = bf_hi(u.x); f[2] = bf_lo(u.y); f[3] = bf_hi(u.y);
    f[4] = bf_lo(u.z); f[5] = bf_hi(u.z); f[6] = bf_lo(u.w); f[7] = bf_hi(u.w);
}
__device__ __forceinline__ float max3_f(float a, float b, float c) { float r; asm("v_max3_f32 %0, %1, %2, %3" : "=v"(r) : "v"(a), "v"(b), "v"(c)); return r; }
__device__ __forceinline__ int otid() { int t = threadIdx.x; asm volatile("" : "+v"(t)); return t; }

#define XB_TMO 128
#define XB_XCNT(j) (256 + 64 * (j))
#define XB_XSUB(j) (1280 + 64 * (j))
#define XB_XGEN(j) (2304 + 64 * (j))
#define XB_TOP 3328
#define XB_TOPGEN 3392
#define XCD_BAR_WORDS 3456
#define XB_SPIN_CAP (1u << 20)

__device__ __forceinline__ unsigned xb_ld(unsigned* p) { return __hip_atomic_load(p, __ATOMIC_RELAXED, __HIP_MEMORY_SCOPE_AGENT); }
__device__ __forceinline__ unsigned xb_add(unsigned* p, unsigned v) { return __hip_atomic_fetch_add(p, v, __ATOMIC_RELAXED, __HIP_MEMORY_SCOPE_AGENT); }
__device__ __forceinline__ unsigned xb_xcc_id() { return (unsigned)__builtin_amdgcn_s_getreg((3 << 11) | 20) & 0xFu; }
#define XB_SPIN(cond, bar)                                                   \
    do {                                                                     \
        unsigned _sp = 0;                                                    \
        while (cond) {                                                       \
            __builtin_amdgcn_s_sleep(1);                                     \
            if ((++_sp & 255u) == 0u) {                                      \
                if (xb_ld(&(bar)[XB_TMO])) break;                            \
                if (_sp > XB_SPIN_CAP) { atomicAdd(&(bar)[XB_TMO], 1u); break; } \
            }                                                                \
        }                                                                    \
    } while (0)

struct XcdBarrier {
    unsigned* bar;
    unsigned x;
    volatile LAS unsigned* st;
};

__device__ __forceinline__ XcdBarrier xcd_barrier_post(unsigned* bar, volatile LAS unsigned* st) {
    XcdBarrier b;
    b.bar = bar;
    b.x = xb_xcc_id();
    b.st = st;
    if (threadIdx.x == 0) (void)xb_add(&bar[XB_XCNT(b.x)], 1u);
    return b;
}
__device__ __forceinline__ void xcd_barrier_complete(unsigned* bar, unsigned x, unsigned& nloc, unsigned& nx) {
    const unsigned G = gridDim.x * gridDim.y * gridDim.z;
    unsigned sum, cnt, mine, sp = 0u;
    for (;;) {
        sum = 0u; cnt = 0u; mine = 0u;
#pragma unroll
        for (unsigned j = 0; j < 16; ++j) {
            const unsigned c = xb_ld(&bar[XB_XCNT(j)]);
            sum += c; cnt += (c > 0u) ? 1u : 0u; mine = (j == x) ? c : mine;
        }
        if (sum == G) break;
        __builtin_amdgcn_s_sleep(1);
        if ((++sp & 255u) == 0u) {
            if (xb_ld(&bar[XB_TMO])) break;
            if (sp > XB_SPIN_CAP) { atomicAdd(&bar[XB_TMO], 1u); break; }
        }
    }
    nloc = mine > 0u ? mine : 1u;
    nx = cnt > 0u ? cnt : 1u;
}
__device__ __forceinline__ void xcd_barrier(const XcdBarrier& b) {
    asm volatile("s_waitcnt vmcnt(0)" ::: "memory");
    __syncthreads();
    if (threadIdx.x == 0) {
        unsigned* bar = b.bar;
        __builtin_amdgcn_s_waitcnt(0);
        unsigned nloc = b.st[0], nx = b.st[1];
        if (nloc == 0u) { xcd_barrier_complete(bar, b.x, nloc, nx); b.st[0] = nloc; b.st[1] = nx; }
        const unsigned old = xb_add(&bar[XB_XSUB(b.x)], 1u);
        const unsigned gen = old / nloc;
        if (old + 1u == (gen + 1u) * nloc) {
            __builtin_amdgcn_fence(__ATOMIC_RELEASE, "agent");
            asm volatile("s_waitcnt vmcnt(0)" ::: "memory");
            const unsigned og = xb_add(&bar[XB_TOP], 1u);
            const unsigned tg = og / nx;
            if (og + 1u == (tg + 1u) * nx) xb_add(&bar[XB_TOPGEN], 1u);
            else XB_SPIN(xb_ld(&bar[XB_TOPGEN]) == tg, bar);
            __builtin_amdgcn_fence(__ATOMIC_ACQUIRE, "agent");
            xb_add(&bar[XB_XGEN(b.x)], 1u);
            asm volatile("s_waitcnt vmcnt(0)" ::: "memory");
        } else {
            XB_SPIN(xb_ld(&bar[XB_XGEN(b.x)]) == gen, bar);
            __builtin_amdgcn_fence(__ATOMIC_ACQUIRE, "agent");
            asm volatile("s_waitcnt vmcnt(0)" ::: "memory");
        }
    }
    __syncthreads();
}

__device__ __forceinline__ void prep_mod_item(const Params& p, int item, unsigned char* smem) {
    const int tid = otid();
    float* sc = (float*)smem;
    float* red = (float*)(smem + 20480);
    const int l = item / 96, j0 = (item % 96) * 32;
    for (int idx = tid; idx < 5120; idx += 256) {
        const int v = idx >> 10, k = idx & 1023;
        const float cv = (v == 0) ? p.c_ctx[k] : p.c[(v - 1) * 1024 + k];
        sc[idx] = cv / (1.0f + expf(-cv));
    }
    __syncthreads();
    const int cgp = tid & 7, kg = tid >> 3;
    float acc[5][4];
#pragma unroll
    for (int v = 0; v < 5; ++v)
#pragma unroll
        for (int e = 0; e < 4; ++e) acc[v][e] = 0.f;
    const float* wp = p.w_ada + (size_t)l * 1024 * 3072 + j0 + cgp * 4;
    f32x4 wreg[32];
#pragma unroll
    for (int kk = 0; kk < 32; ++kk) wreg[kk] = *(const f32x4*)(wp + (size_t)(kk * 32 + kg) * 3072);
#pragma unroll
    for (int kk = 0; kk < 32; ++kk) {
        const int k = kk * 32 + kg;
        const f32x4 w = wreg[kk];
#pragma unroll
        for (int v = 0; v < 5; ++v) {
            const float s = sc[v * 1024 + k];
#pragma unroll
            for (int e = 0; e < 4; ++e) acc[v][e] += s * w[e];
        }
    }
#pragma unroll
    for (int v = 0; v < 5; ++v)
#pragma unroll
        for (int e = 0; e < 4; ++e) red[kg * 160 + v * 32 + cgp * 4 + e] = acc[v][e];
    __syncthreads();
    if (tid < 160) {
        float s = 0.f;
        for (int g = 0; g < 32; ++g) s += red[g * 160 + tid];
        const int v = tid >> 5, cc = tid & 31;
        p.modv[(size_t)(l * 5 + v) * 3072 + j0 + cc] = s + p.b_ada[l * 3072 + j0 + cc];
    }
    __syncthreads();
}

__device__ __forceinline__ void prep_transpose_item(const float* src, bf16_t* dst, int N, int k0, int n0) {
    const int n = n0 + otid();
    const float* sp = src + (size_t)k0 * N + n;
    float v[32];
#pragma unroll
    for (int i = 0; i < 32; ++i) v[i] = sp[(size_t)i * N];
    bf16_t* d = dst + (size_t)n * 1024 + k0;
#pragma unroll
    for (int c = 0; c < 4; ++c) {
        u32x4 w;
        w.x = pk_bf16(v[c * 8 + 0], v[c * 8 + 1]);
        w.y = pk_bf16(v[c * 8 + 2], v[c * 8 + 3]);
        w.z = pk_bf16(v[c * 8 + 4], v[c * 8 + 5]);
        w.w = pk_bf16(v[c * 8 + 6], v[c * 8 + 7]);
        *(u32x4*)(d + c * 8) = w;
    }
}

__device__ __forceinline__ void phase_prep(const Params& p, unsigned char* smem) {
    const int ntb = (int)gridDim.x * 5 / 8, nmb = (int)gridDim.x - ntb;
    const int NTI = 2 * 11 * 32, NTO = 2 * 4 * 32;
    if ((int)blockIdx.x < ntb) {
        for (int it = blockIdx.x; it < NTI + NTO; it += ntb) {
            if (it < NTI) {
                const int l = it / 352, r = it % 352, kt = r / 11, nt = r % 11;
                prep_transpose_item(p.w_in + (size_t)l * 1024 * INW, p.WinT + (size_t)l * INW * 1024, INW, kt * 32, nt * 256);
            } else {
                const int t = it - NTI, l = t / 128, r = t % 128, kt = r / 4, nt = r % 4;
                prep_transpose_item(p.w_out + (size_t)l * 1024 * 1024, p.WoutT + (size_t)l * 1024 * 1024, 1024, kt * 32, nt * 256);
            }
        }
    } else {
        for (int it = (int)blockIdx.x - ntb; it < 192; it += nmb) prep_mod_item(p, it, smem);
    }
    const int gsz = gridDim.x * 256;
    for (int i = blockIdx.x * 256 + otid(); i < 131072; i += gsz) {
        const int which = i >> 16, j4 = (i & 65535) * 4;
        const int d = j4 & 63, t = (j4 >> 6) & 255, kvh = (j4 >> 14) & 1, bl = j4 >> 15;
        const size_t si = ((size_t)(bl * 256 + t) * 2 + kvh) * 64 + d;
        const f32x4 v = *(const f32x4*)((which ? p.cache_v : p.cache_k) + si);
        u32x2 w;
        w.x = pk_bf16(v[0], v[1]);
        w.y = pk_bf16(v[2], v[3]);
        *(u32x2*)((which ? p.vc : p.kc) + j4) = w;
    }
    for (int j = blockIdx.x * 256 + otid(); j < 32768; j += gsz) {
        const int cc = j & 63, d = (j >> 6) & 63, lg = j >> 12;
        const float v = p.pool_w[((size_t)lg * 64 + cc) * 64 + d];
        p.PoolT[j] = (bf16_t)(pk_bf16(v, 0.f) & 0xffffu);
    }
    for (int j = blockIdx.x * 256 + otid(); j < 1024; j += gsz) {
        const int a = j & 15, r = j >> 4;
        const float inv = 1.0f / powf(10000.0f, (float)(2 * a) / 32.0f);
        const float ang = (float)r * inv;
        const float kf = rintf(ang * 0.15915494309189535f);
        float rr = fmaf(-kf, 6.2831854820251465f, ang);
        rr = fmaf(-kf, -1.7484555e-7f, rr);
        p.rope[j] = cosf(rr);
        p.rope[1024 + j] = sinf(rr);
    }
}

__device__ __forceinline__ float wave_sum(float v) {
#pragma unroll
    for (int o = 32; o >= 1; o >>= 1) v += __shfl_xor(v, o);
    return v;
}

__device__ __forceinline__ void phase_xn(const Params& p, int layer) {
    const int tid = otid(), lane = tid & 63, wave = tid >> 6;
    const int nw = gridDim.x * 4, w = blockIdx.x * 4 + wave;
    for (int t0 = w * 6; t0 < NTOK; t0 += nw * 6) {
        f32x4 x[6][4];
        if (layer == 0) {
#pragma unroll
            for (int u = 0; u < 6; ++u) {
                const int tok = t0 + u;
                const float* src = tok < NCTX ? p.x_prompt + (size_t)tok * DM : p.x_sample + (size_t)(tok - NCTX) * DM;
#pragma unroll
                for (int i = 0; i < 4; ++i) x[u][i] = *(const f32x4*)(src + i * 256 + lane * 4);
            }
        } else {
            u32x2 r[6][4];
#pragma unroll
            for (int u = 0; u < 6; ++u)
#pragma unroll
                for (int i = 0; i < 4; ++i) r[u][i] = *(const u32x2*)(p.h + (size_t)(t0 + u) * DM + i * 256 + lane * 4);
#pragma unroll
            for (int u = 0; u < 6; ++u)
#pragma unroll
                for (int i = 0; i < 4; ++i) x[u][i] = bf4_to_f32(r[u][i]);
        }
#pragma unroll
        for (int u = 0; u < 6; ++u) {
            const int tok = t0 + u;
            const int v = tok < NCTX ? 0 : 1 + ((tok - NCTX) >> 11);
            const float* mv = p.modv + (size_t)(layer * 5 + v) * 3072;
            float ss = 0.f;
#pragma unroll
            for (int i = 0; i < 4; ++i) ss += x[u][i][0] * x[u][i][0] + x[u][i][1] * x[u][i][1] + x[u][i][2] * x[u][i][2] + x[u][i][3] * x[u][i][3];
            ss = wave_sum(ss);
            const float rstd = rsqrtf(ss * (1.0f / 1024.0f) + EPSF);
#pragma unroll
            for (int i = 0; i < 4; ++i) {
                const int k = i * 256 + lane * 4;
                const f32x4 g = *(const f32x4*)(p.norm_g + layer * 1024 + k);
                const f32x4 sh = *(const f32x4*)(mv + k);
                const f32x4 sc = *(const f32x4*)(mv + 1024 + k);
                float o[4];
#pragma unroll
                for (int e = 0; e < 4; ++e) o[e] = x[u][i][e] * rstd * g[e] * (1.0f + sc[e]) + sh[e];
                u32x2 wv;
                wv.x = pk_bf16(o[0], o[1]);
                wv.y = pk_bf16(o[2], o[3]);
                *(u32x2*)(p.xn + (size_t)tok * DM + k) = wv;
            }
        }
    }
}

__device__ __forceinline__ void phase_final(const Params& p) {
    const int tid = otid(), lane = tid & 63, wave = tid >> 6;
    const int nw = gridDim.x * 4, w = blockIdx.x * 4 + wave;
    f32x4 g[4];
#pragma unroll
    for (int i = 0; i < 4; ++i) g[i] = *(const f32x4*)(p.final_g + i * 256 + lane * 4);
    for (int t0 = w * 6; t0 < NTOK; t0 += nw * 6) {
        u32x2 r[6][4];
#pragma unroll
        for (int u = 0; u < 6; ++u)
#pragma unroll
            for (int i = 0; i < 4; ++i) r[u][i] = *(const u32x2*)(p.xn + (size_t)(t0 + u) * DM + i * 256 + lane * 4);
#pragma unroll
        for (int u = 0; u < 6; ++u) {
            float* row = p.out + (size_t)(t0 + u) * DM;
            f32x4 x[4];
            float ss = 0.f;
#pragma unroll
            for (int i = 0; i < 4; ++i) {
                x[i] = bf4_to_f32(r[u][i]);
                ss += x[i][0] * x[i][0] + x[i][1] * x[i][1] + x[i][2] * x[i][2] + x[i][3] * x[i][3];
            }
            ss = wave_sum(ss);
            const float rstd = rsqrtf(ss * (1.0f / 1024.0f) + EPSF);
#pragma unroll
            for (int i = 0; i < 4; ++i) *(f32x4*)(row + i * 256 + lane * 4) = x[i] * rstd * g[i];
        }
    }
}

template <int MODE, int MI, int STG = 0>
__device__ __forceinline__ void gemm_epilogue(const Params& p, int layer, int mw, int nw, f32x4 (&acc)[MI][4], int fr, int fq,
                                              unsigned char* ct = nullptr, int m0t = 0, int n0t = 0) {
    if (MODE == 0) {
        const bool ctx = mw < NCTX;
        if (nw < 640) {
            const bool isq = nw < 512;
            const float* gp = (isq ? p.q_g : p.k_g) + layer * 64;
            f32x4 gv[4];
#pragma unroll
            for (int ni = 0; ni < 4; ++ni) gv[ni] = *(const f32x4*)(gp + ni * 16 + fq * 4);
#pragma unroll
            for (int mi = 0; mi < MI; ++mi) {
                const int tok = mw + mi * 16 + fr;
                float ss = 0.f;
#pragma unroll
                for (int ni = 0; ni < 4; ++ni)
#pragma unroll
                    for (int e = 0; e < 4; ++e) ss += acc[mi][ni][e] * acc[mi][ni][e];
                ss += __shfl_xor(ss, 16);
                ss += __shfl_xor(ss, 32);
                const float rstd = rsqrtf(ss * (1.0f / 64.0f) + EPSF);
                f32x4 val[4];
#pragma unroll
                for (int ni = 0; ni < 4; ++ni) val[ni] = acc[mi][ni] * rstd * gv[ni];
                if (!isq && ctx) {
                    float* nk = p.out + OUT_NK + ((size_t)((tok >> 8) * 2 + layer) * 256 + (tok & 255)) * 128 + (nw - 512) + fq * 4;
#pragma unroll
                    for (int ni = 0; ni < 4; ++ni) *(f32x4*)(nk + ni * 16) = val[ni];
                }
                if (!ctx) {
                    const int pos = (tok - NCTX) & 2047, prow = pos >> 6, pcol = pos & 63;
                    const f32x4 cr = *(const f32x4*)(p.rope + prow * 16 + fq * 4), sr = *(const f32x4*)(p.rope + 1024 + prow * 16 + fq * 4);
                    const f32x4 cc = *(const f32x4*)(p.rope + pcol * 16 + fq * 4), sn = *(const f32x4*)(p.rope + 1024 + pcol * 16 + fq * 4);
                    const f32x4 a0 = val[0], a1 = val[1], a2 = val[2], a3 = val[3];
                    val[0] = a0 * cr - a1 * sr;
                    val[1] = a1 * cr + a0 * sr;
                    val[2] = a2 * cc - a3 * sn;
                    val[3] = a3 * cc + a2 * sn;
                }
                if (isq) {
#pragma unroll
                    for (int ni = 0; ni < 4; ++ni) val[ni] = val[ni] * QSCALE;
                }
                bf16_t* pr = p.proj + (size_t)tok * INW + nw + fq * 4;
#pragma unroll
                for (int ni = 0; ni < 4; ++ni) {
                    u32x2 w;
                    w.x = pk_bf16(val[ni][0], val[ni][1]);
                    w.y = pk_bf16(val[ni][2], val[ni][3]);
                    if (STG) *(u32x2*)(ct + (tok - m0t) * 272 + (nw - n0t + fq * 4 + ni * 16) * 2) = w;
                    else *(u32x2*)(pr + ni * 16) = w;
                }
            }
        } else {
            const bool isv = nw < 768;
#pragma unroll
            for (int mi = 0; mi < MI; ++mi) {
                const int tok = mw + mi * 16 + fr;
                bf16_t* pr = p.proj + (size_t)tok * INW + nw + fq * 4;
#pragma unroll
                for (int ni = 0; ni < 4; ++ni) {
                    u32x2 w;
                    w.x = pk_bf16(acc[mi][ni][0], acc[mi][ni][1]);
                    w.y = pk_bf16(acc[mi][ni][2], acc[mi][ni][3]);
                    if (STG) *(u32x2*)(ct + (tok - m0t) * 272 + (nw - n0t + fq * 4 + ni * 16) * 2) = w;
                    else *(u32x2*)(pr + ni * 16) = w;
                }
                if (isv && ctx) {
                    float* nv = p.out + OUT_NV + ((size_t)((tok >> 8) * 2 + layer) * 256 + (tok & 255)) * 128 + (nw - 640) + fq * 4;
#pragma unroll
                    for (int ni = 0; ni < 4; ++ni) *(f32x4*)(nv + ni * 16) = acc[mi][ni];
                }
            }
        }
    } else {
        const int v = mw < NCTX ? 0 : 1 + ((mw - NCTX) >> 11);
        const float* gate = p.modv + (size_t)(layer * 5 + v) * 3072 + 2048 + nw + fq * 4;
        f32x4 gt[4];
#pragma unroll
        for (int ni = 0; ni < 4; ++ni) gt[ni] = *(const f32x4*)(gate + ni * 16);
#pragma unroll
        for (int mi = 0; mi < MI; ++mi) {
            const int tok = mw + mi * 16 + fr;
            const size_t eo = (size_t)tok * DM + nw + fq * 4;
            const float* xin = (tok < NCTX ? p.x_prompt + (size_t)tok * DM : p.x_sample + (size_t)(tok - NCTX) * DM) + nw + fq * 4;
#pragma unroll
            for (int ni = 0; ni < 4; ++ni) {
                if (layer == 0) {
                    const f32x4 r = *(const f32x4*)(xin + ni * 16) + gt[ni] * acc[mi][ni];
                    u32x2 w;
                    w.x = pk_bf16(r[0], r[1]);
                    w.y = pk_bf16(r[2], r[3]);
                    *(u32x2*)(p.h + eo + ni * 16) = w;
                } else {
                    const f32x4 r = bf4_to_f32(*(const u32x2*)(p.h + eo + ni * 16)) + gt[ni] * acc[mi][ni];
                    u32x2 w;
                    w.x = pk_bf16(r[0], r[1]);
                    w.y = pk_bf16(r[2], r[3]);
                    *(u32x2*)(p.xn + eo + ni * 16) = w;
                }
            }
        }
    }
}

template <int MODE>
__device__ __forceinline__ void gemm_tile(const Params& p, int layer, int mt, int nt, unsigned char* smem) {
    const int tid = otid(), lane = tid & 63, wave = tid >> 6, wm = wave >> 1, wn = wave & 1;
    const int fr = lane & 15, fq = lane >> 4;
    const int m0 = mt * 128, n0 = nt * 128;
    const bf16_t* A = (MODE == 0 ? p.xn : p.mix) + (size_t)m0 * 1024;
    const bf16_t* B = (MODE == 0 ? p.WinT + (size_t)layer * INW * 1024 : p.WoutT + (size_t)layer * 1024 * 1024) + (size_t)n0 * 1024;
    f32x4 acc[4][4];
#pragma unroll
    for (int i = 0; i < 4; ++i)
#pragma unroll
        for (int j = 0; j < 4; ++j) acc[i][j] = (f32x4){0.f, 0.f, 0.f, 0.f};

    const int srow = tid >> 3, scc = tid & 7;
    const bf16_t* ag = A + (size_t)srow * 1024 + scc * 8;
    const bf16_t* bg = B + (size_t)srow * 1024 + scc * 8;
    const int wofs = srow * 128 + ((scc ^ (srow & 7)) * 16);
    u32x4 raA[4], rbA[4], raB[4], rbB[4];
    auto gload = [&](int kt, u32x4* ra, u32x4* rb) {
#pragma unroll
        for (int i = 0; i < 4; ++i) {
            ra[i] = *(const u32x4*)(ag + (size_t)i * 32 * 1024 + kt * 64);
            rb[i] = *(const u32x4*)(bg + (size_t)i * 32 * 1024 + kt * 64);
        }
    };
    auto swrite = [&](int buf, const u32x4* ra, const u32x4* rb) {
        unsigned char* Aw = smem + buf * 32768;
#pragma unroll
        for (int i = 0; i < 4; ++i) {
            *(u32x4*)(Aw + wofs + i * 4096) = ra[i];
            *(u32x4*)(Aw + 16384 + wofs + i * 4096) = rb[i];
        }
    };
    gload(0, raA, rbA);
    gload(1, raB, rbB);
    swrite(0, raA, rbA);
    __syncthreads();
    const int aro = (wm * 64 + fr) * 128, bro = (wn * 64 + fr) * 128, sw = fr & 7;
    auto step = [&](int kt, u32x4* la, u32x4* lb, const u32x4* wa, const u32x4* wb) {
        const unsigned char* As = smem + (kt & 1) * 32768;
        const unsigned char* Bs = As + 16384;
        bf16x8 af[2][4], bf[2][4];
#pragma unroll
        for (int kk = 0; kk < 2; ++kk) {
            const int co = ((kk * 4 + fq) ^ sw) * 16;
#pragma unroll
            for (int i = 0; i < 4; ++i) {
                af[kk][i] = *(const bf16x8*)(As + aro + i * 2048 + co);
                bf[kk][i] = *(const bf16x8*)(Bs + bro + i * 2048 + co);
            }
        }
        if (kt + 2 < 16) gload(kt + 2, la, lb);
        __builtin_amdgcn_sched_barrier(0);
#pragma unroll
        for (int mi = 0; mi < 4; ++mi)
#pragma unroll
            for (int ni = 0; ni < 4; ++ni) acc[mi][ni] = __builtin_amdgcn_mfma_f32_16x16x32_bf16(bf[0][ni], af[0][mi], acc[mi][ni], 0, 0, 0);
        __builtin_amdgcn_sched_barrier(0);
        if (kt + 1 < 16) swrite((kt + 1) & 1, wa, wb);
        __builtin_amdgcn_sched_barrier(0);
#pragma unroll
        for (int mi = 0; mi < 4; ++mi)
#pragma unroll
            for (int ni = 0; ni < 4; ++ni) acc[mi][ni] = __builtin_amdgcn_mfma_f32_16x16x32_bf16(bf[1][ni], af[1][mi], acc[mi][ni], 0, 0, 0);
        __syncthreads();
    };
    for (int kt = 0; kt < 16; kt += 2) {
        step(kt, raA, rbA, raB, rbB);
        step(kt + 1, raB, rbB, raA, rbA);
    }

    gemm_epilogue<MODE, 4>(p, layer, m0 + wm * 64, n0 + wn * 64, acc, fr, fq);
}

template <int MODE>
__device__ __forceinline__ void gemm_tile256(const Params& p, int layer, int mt, int nt, unsigned char* smem) {
    const int tid = otid(), lane = tid & 63, wave = tid >> 6, wm = wave >> 1, wn = wave & 1;
    const int fr = lane & 15, fq = lane >> 4;
    const int m0 = mt * 256, n0 = nt * 128;
    const bf16_t* A = (MODE == 0 ? p.xn : p.mix) + (size_t)m0 * 1024;
    const bf16_t* B = (MODE == 0 ? p.WinT + (size_t)layer * INW * 1024 : p.WoutT + (size_t)layer * 1024 * 1024) + (size_t)n0 * 1024;
    f32x4 acc[8][4];
#pragma unroll
    for (int i = 0; i < 8; ++i)
#pragma unroll
        for (int j = 0; j < 4; ++j) acc[i][j] = (f32x4){0.f, 0.f, 0.f, 0.f};
    const int srow = tid >> 2, scc = tid & 3;
    const bf16_t* ag = A + (size_t)srow * 1024 + scc * 8;
    const bf16_t* bg = B + (size_t)srow * 1024 + scc * 8;
    const int wofs = srow * 64 + ((scc ^ ((4 - ((srow >> 2) & 3)) & 3)) * 16);
    u32x4 raA[4], rbA[2], raB[4], rbB[2];
    auto gload = [&](int kt, u32x4* ra, u32x4* rb) {
#pragma unroll
        for (int i = 0; i < 4; ++i) ra[i] = *(const u32x4*)(ag + (size_t)i * 64 * 1024 + kt * 32);
#pragma unroll
        for (int i = 0; i < 2; ++i) rb[i] = *(const u32x4*)(bg + (size_t)i * 64 * 1024 + kt * 32);
    };
    auto swrite = [&](int buf, const u32x4* ra, const u32x4* rb) {
        unsigned char* Aw = smem + buf * 24576;
#pragma unroll
        for (int i = 0; i < 4; ++i) *(u32x4*)(Aw + wofs + i * 4096) = ra[i];
#pragma unroll
        for (int i = 0; i < 2; ++i) *(u32x4*)(Aw + 16384 + wofs + i * 4096) = rb[i];
    };
    gload(0, raA, rbA);
    gload(1, raB, rbB);
    swrite(0, raA, rbA);
    __syncthreads();
    const int co = (fq ^ ((4 - ((fr >> 2) & 3)) & 3)) * 16;
    const int aro = (wm * 128 + fr) * 64 + co, bro = (wn * 64 + fr) * 64 + co;
    auto step = [&](int kt, u32x4* la, u32x4* lb, const u32x4* wa, const u32x4* wb) {
        const unsigned char* As = smem + (kt & 1) * 24576;
        const unsigned char* Bs = As + 16384;
        bf16x8 af[8], bf[4];
#pragma unroll
        for (int i = 0; i < 4; ++i) bf[i] = *(const bf16x8*)(Bs + bro + i * 1024);
#pragma unroll
        for (int i = 0; i < 8; ++i) af[i] = *(const bf16x8*)(As + aro + i * 1024);
        if (kt + 2 < 32) gload(kt + 2, la, lb);
        __builtin_amdgcn_sched_barrier(0);
#pragma unroll
        for (int mi = 0; mi < 4; ++mi)
#pragma unroll
            for (int ni = 0; ni < 4; ++ni) acc[mi][ni] = __builtin_amdgcn_mfma_f32_16x16x32_bf16(bf[ni], af[mi], acc[mi][ni], 0, 0, 0);
        __builtin_amdgcn_sched_barrier(0);
        if (kt + 1 < 32) swrite((kt + 1) & 1, wa, wb);
        __builtin_amdgcn_sched_barrier(0);
#pragma unroll
        for (int mi = 4; mi < 8; ++mi)
#pragma unroll
            for (int ni = 0; ni < 4; ++ni) acc[mi][ni] = __builtin_amdgcn_mfma_f32_16x16x32_bf16(bf[ni], af[mi], acc[mi][ni], 0, 0, 0);
        __syncthreads();
    };
    for (int kt = 0; kt < 32; kt += 2) {
        step(kt, raA, rbA, raB, rbB);
        step(kt + 1, raB, rbB, raA, rbA);
    }
    gemm_epilogue<MODE, 8>(p, layer, m0 + wm * 128, n0 + wn * 64, acc, fr, fq);
}

template <int MODE>
__device__ __forceinline__ void gemm_tile256_dma(const Params& p, int layer, int mt, int nt, unsigned char* smem) {
    const int tid = otid(), lane = tid & 63, wave = tid >> 6, wm = wave >> 1, wn = wave & 1;
    const int fr = lane & 15, fq = lane >> 4;
    const int m0 = mt * 256, n0 = nt * 128;
    const bf16_t* A = (MODE == 0 ? p.xn : p.mix) + (size_t)m0 * 1024;
    const bf16_t* B = (MODE == 0 ? p.WinT + (size_t)layer * INW * 1024 : p.WoutT + (size_t)layer * 1024 * 1024) + (size_t)n0 * 1024;
    f32x4 acc[8][4];
#pragma unroll
    for (int i = 0; i < 8; ++i)
#pragma unroll
        for (int j = 0; j < 4; ++j) acc[i][j] = (f32x4){0.f, 0.f, 0.f, 0.f};
    const int lrow = lane >> 2, lc = (lane & 3) ^ ((4 - ((lane >> 4) & 3)) & 3);
    const bf16_t* agp = A + (size_t)(wave * 64 + lrow) * 1024 + lc * 8;
    const bf16_t* bgp = B + (size_t)(wave * 32 + lrow) * 1024 + lc * 8;
    LAS unsigned char* lbase = (LAS unsigned char*)smem;
    const int la_off = wave * 4096 + lane * 16, lb_off = 16384 + wave * 2048 + lane * 16;
    auto dma = [&](int kt, int stage) {
        LAS unsigned char* sb = lbase + stage * 24576;
#pragma unroll
        for (int i = 0; i < 4; ++i)
            __builtin_amdgcn_global_load_lds((const void*)(agp + (size_t)i * 16 * 1024 + kt * 32), (LAS void*)(sb + la_off + i * 1024), 16, 0, 0);
#pragma unroll
        for (int i = 0; i < 2; ++i)
            __builtin_amdgcn_global_load_lds((const void*)(bgp + (size_t)i * 16 * 1024 + kt * 32), (LAS void*)(sb + lb_off + i * 1024), 16, 0, 0);
    };
    dma(0, 0);
    dma(1, 1);
    asm volatile("s_waitcnt vmcnt(6)" ::: "memory");
    __builtin_amdgcn_s_barrier();
    const int co = (fq ^ ((4 - ((fr >> 2) & 3)) & 3)) * 16;
    const int aro = (wm * 128 + fr) * 64 + co, bro = 16384 + (wn * 64 + fr) * 64 + co;
    int st = 0, st2 = 2;
    const unsigned lds0 = (unsigned)(uintptr_t)lbase;
#pragma unroll 1
    for (int kt = 0; kt < 32; ++kt) {
        const unsigned sa = lds0 + st * 24576 + aro, sbb = lds0 + st * 24576 + bro;
        bf16x8 af[8], bf[4];
#define FRAG_RD(dst, addr, OFF) asm volatile("ds_read_b128 %0, %1 offset:" #OFF : "=&v"(dst) : "v"(addr))
        FRAG_RD(bf[0], sbb, 0); FRAG_RD(bf[1], sbb, 1024); FRAG_RD(bf[2], sbb, 2048); FRAG_RD(bf[3], sbb, 3072);
        FRAG_RD(af[0], sa, 0); FRAG_RD(af[1], sa, 1024); FRAG_RD(af[2], sa, 2048); FRAG_RD(af[3], sa, 3072);
        FRAG_RD(af[4], sa, 4096); FRAG_RD(af[5], sa, 5120); FRAG_RD(af[6], sa, 6144); FRAG_RD(af[7], sa, 7168);
#undef FRAG_RD
        __builtin_amdgcn_sched_barrier(0);
        if (kt + 2 < 32) dma(kt + 2, st2);
        __builtin_amdgcn_sched_barrier(0);
        asm volatile("s_waitcnt lgkmcnt(4)" ::: "memory");
        __builtin_amdgcn_sched_barrier(0);
#pragma unroll
        for (int mi = 0; mi < 4; ++mi)
#pragma unroll
            for (int ni = 0; ni < 4; ++ni) acc[mi][ni] = __builtin_amdgcn_mfma_f32_16x16x32_bf16(bf[ni], af[mi], acc[mi][ni], 0, 0, 0);
        __builtin_amdgcn_sched_barrier(0);
        asm volatile("s_waitcnt lgkmcnt(0)" ::: "memory");
        __builtin_amdgcn_sched_barrier(0);
#pragma unroll
        for (int mi = 4; mi < 8; ++mi)
#pragma unroll
            for (int ni = 0; ni < 4; ++ni) acc[mi][ni] = __builtin_amdgcn_mfma_f32_16x16x32_bf16(bf[ni], af[mi], acc[mi][ni], 0, 0, 0);
        __builtin_amdgcn_sched_barrier(0);
        if (kt + 2 < 32) asm volatile("s_waitcnt vmcnt(6)" ::: "memory");
        else asm volatile("s_waitcnt vmcnt(0)" ::: "memory");
        __builtin_amdgcn_s_barrier();
        st = st == 2 ? 0 : st + 1;
        st2 = st2 == 2 ? 0 : st2 + 1;
    }
    if (MODE == 0) {
        gemm_epilogue<0, 8, 1>(p, layer, m0 + wm * 128, n0 + wn * 64, acc, fr, fq, smem, m0, n0);
        __syncthreads();
        u32x4 cv[16];
#pragma unroll
        for (int i = 0; i < 16; ++i) { const int e = tid + 256 * i; cv[i] = *(const u32x4*)(smem + (e >> 4) * 272 + (e & 15) * 16); }
#pragma unroll
        for (int i = 0; i < 16; ++i) { const int e = tid + 256 * i; *(u32x4*)(p.proj + (size_t)(m0 + (e >> 4)) * INW + n0 + (e & 15) * 8) = cv[i]; }
        __syncthreads();
    } else {
        {
            const int v = m0 < NCTX ? 0 : 1 + ((m0 - NCTX) >> 11);
            const float* gate = p.modv + (size_t)(layer * 5 + v) * 3072 + 2048 + n0 + wn * 64 + fq * 4;
            f32x4 gt[4];
#pragma unroll
            for (int ni = 0; ni < 4; ++ni) gt[ni] = *(const f32x4*)(gate + ni * 16);
#pragma unroll
            for (int mi = 0; mi < 8; ++mi)
#pragma unroll
                for (int ni = 0; ni < 4; ++ni) {
                    const f32x4 g = gt[ni] * acc[mi][ni];
                    u32x2 w;
                    w.x = pk_bf16(g[0], g[1]);
                    w.y = pk_bf16(g[2], g[3]);
                    *(u32x2*)(smem + (wm * 128 + mi * 16 + fr) * 272 + (wn * 64 + ni * 16 + fq * 4) * 2) = w;
                }
        }
        __syncthreads();
        bf16_t* dst = layer == 0 ? p.h : p.xn;
#pragma unroll 1
        for (int hf = 0; hf < 2; ++hf) {
            f32x4 ha[8], hb[8];
            u32x4 hv[8];
#pragma unroll
            for (int i = 0; i < 8; ++i) {
                const int e = tid + 256 * (hf * 8 + i), tok = m0 + (e >> 4), c8 = (e & 15) * 8;
                if (layer == 0) {
                    const float* xp = (tok < NCTX ? p.x_prompt + (size_t)tok * DM : p.x_sample + (size_t)(tok - NCTX) * DM) + n0 + c8;
                    ha[i] = *(const f32x4*)xp;
                    hb[i] = *(const f32x4*)(xp + 4);
                } else {
                    hv[i] = *(const u32x4*)(p.h + (size_t)tok * DM + n0 + c8);
                }
            }
#pragma unroll
            for (int i = 0; i < 8; ++i) {
                const int e = tid + 256 * (hf * 8 + i), tok = m0 + (e >> 4), c8 = (e & 15) * 8;
                float g[8], o[8];
                unpack8(*(const u32x4*)(smem + (e >> 4) * 272 + (e & 15) * 16), g);
                if (layer == 0) {
#pragma unroll
                    for (int q = 0; q < 4; ++q) { o[q] = ha[i][q]; o[4 + q] = hb[i][q]; }
                } else {
                    unpack8(hv[i], o);
                }
                u32x4 w;
                w.x = pk_bf16(o[0] + g[0], o[1] + g[1]);
                w.y = pk_bf16(o[2] + g[2], o[3] + g[3]);
                w.z = pk_bf16(o[4] + g[4], o[5] + g[5]);
                w.w = pk_bf16(o[6] + g[6], o[7] + g[7]);
                *(u32x4*)(dst + (size_t)tok * DM + n0 + c8) = w;
            }
        }
        __syncthreads();
    }
}

__device__ __forceinline__ void gemm_piece64_dma(const Params& p, int layer, int m0, int n0, unsigned char* smem) {
    const int tid = otid(), lane = tid & 63, wave = tid >> 6, wm = wave >> 1, wn = wave & 1;
    const int fr = lane & 15, fq = lane >> 4;
    const bf16_t* A = p.xn + (size_t)m0 * 1024;
    const bf16_t* B = p.WinT + (size_t)layer * INW * 1024 + (size_t)n0 * 1024;
    f32x4 acc[2][4];
#pragma unroll
    for (int i = 0; i < 2; ++i)
#pragma unroll
        for (int j = 0; j < 4; ++j) acc[i][j] = (f32x4){0.f, 0.f, 0.f, 0.f};
    const int lrow = lane >> 2, lc = (lane & 3) ^ ((4 - ((lane >> 4) & 3)) & 3);
    const bf16_t* agp = A + (size_t)(wave * 16 + lrow) * 1024 + lc * 8;
    const bf16_t* bgp = B + (size_t)(wave * 32 + lrow) * 1024 + lc * 8;
    LAS unsigned char* lbase = (LAS unsigned char*)smem;
    const int la_off = wave * 1024 + lane * 16, lb_off = 4096 + wave * 2048 + lane * 16;
    auto dma = [&](int kt, int stage) {
        LAS unsigned char* sb = lbase + stage * 12288;
        __builtin_amdgcn_global_load_lds((const void*)(agp + kt * 32), (LAS void*)(sb + la_off), 16, 0, 0);
#pragma unroll
        for (int i = 0; i < 2; ++i)
            __builtin_amdgcn_global_load_lds((const void*)(bgp + (size_t)i * 16 * 1024 + kt * 32), (LAS void*)(sb + lb_off + i * 1024), 16, 0, 0);
    };
    dma(0, 0);
    dma(1, 1);
    asm volatile("s_waitcnt vmcnt(3)" ::: "memory");
    __builtin_amdgcn_s_barrier();
    const int co = (fq ^ ((4 - ((fr >> 2) & 3)) & 3)) * 16;
    const int aro = (wm * 32 + fr) * 64 + co, bro = 4096 + (wn * 64 + fr) * 64 + co;
    int st = 0, st2 = 2;
    const unsigned lds0 = (unsigned)(uintptr_t)lbase;
#pragma unroll 1
    for (int kt = 0; kt < 32; ++kt) {
        const unsigned sa = lds0 + st * 12288 + aro, sbb = lds0 + st * 12288 + bro;
        bf16x8 af[2], bf[4];
#define FRAG_RD(dst, addr, OFF) asm volatile("ds_read_b128 %0, %1 offset:" #OFF : "=&v"(dst) : "v"(addr))
        FRAG_RD(bf[0], sbb, 0); FRAG_RD(bf[1], sbb, 1024); FRAG_RD(bf[2], sbb, 2048); FRAG_RD(bf[3], sbb, 3072);
        FRAG_RD(af[0], sa, 0); FRAG_RD(af[1], sa, 1024);
#undef FRAG_RD
        __builtin_amdgcn_sched_barrier(0);
        if (kt + 2 < 32) dma(kt + 2, st2);
        __builtin_amdgcn_sched_barrier(0);
        asm volatile("s_waitcnt lgkmcnt(0)" ::: "memory");
        __builtin_amdgcn_sched_barrier(0);
#pragma unroll
        for (int mi = 0; mi < 2; ++mi)
#pragma unroll
            for (int ni = 0; ni < 4; ++ni) acc[mi][ni] = __builtin_amdgcn_mfma_f32_16x16x32_bf16(bf[ni], af[mi], acc[mi][ni], 0, 0, 0);
        __builtin_amdgcn_sched_barrier(0);
        if (kt + 2 < 32) asm volatile("s_waitcnt vmcnt(3)" ::: "memory");
        else asm volatile("s_waitcnt vmcnt(0)" ::: "memory");
        __builtin_amdgcn_s_barrier();
        st = st == 2 ? 0 : st + 1;
        st2 = st2 == 2 ? 0 : st2 + 1;
    }
    gemm_epilogue<0, 2, 1>(p, layer, m0 + wm * 32, n0 + wn * 64, acc, fr, fq, smem, m0, n0);
    __syncthreads();
    u32x4 cv[4];
#pragma unroll
    for (int i = 0; i < 4; ++i) { const int e = tid + 256 * i; cv[i] = *(const u32x4*)(smem + (e >> 4) * 272 + (e & 15) * 16); }
#pragma unroll
    for (int i = 0; i < 4; ++i) { const int e = tid + 256 * i; *(u32x4*)(p.proj + (size_t)(m0 + (e >> 4)) * INW + n0 + (e & 15) * 8) = cv[i]; }
    __syncthreads();
}

template <int MODE>
__device__ __forceinline__ void phase_gemm(const Params& p, int layer, unsigned char* smem) {
    const int NT = MODE == 0 ? 22 : 8;
    const int total = 96 * NT;
    if (gridDim.x == 512) {
        const int xcd = blockIdx.x & 7, slot = blockIdx.x >> 3;
        if (MODE == 0) {
            if (slot < 16) gemm_piece64_dma(p, layer, (xcd * 6 + 2 + (slot >> 2)) * 256 + (slot & 3) * 64, 21 * 128, smem);
            for (int idx = slot; idx < 128; idx += 64) gemm_tile256_dma<MODE>(p, layer, xcd * 6 + idx % 6, idx / 6, smem);
        } else {
            if (slot < 32) gemm_tile256_dma<MODE>(p, layer, xcd * 6 + slot % 6, slot / 6, smem);
            else {
                const int d = 32 + ((slot - 32) >> 1);
                gemm_tile<MODE>(p, layer, (xcd * 6 + d % 6) * 2 + (slot & 1), d / 6, smem);
            }
        }
    } else {
        for (int t = blockIdx.x; t < total; t += gridDim.x) gemm_tile<MODE>(p, layer, t / NT, t % NT, smem);
    }
}

template <int VAR>
__device__ __forceinline__ void attn_unit(const Params& p, int layer, int unit, unsigned char* smem) {
    const int tid = otid(), lane = tid & 63, wave = tid >> 6;
    const int r31 = lane & 31, hh = lane >> 5;
    int b, head, qblk, tokbase, nself, ntiles;
    if (unit < 512) { b = unit >> 7; head = (unit >> 4) & 7; qblk = unit & 15; tokbase = NCTX + b * 2048; nself = 2048; ntiles = 36; }
    else { const int u = unit - 512; b = u >> 4; head = (u >> 1) & 7; qblk = u & 1; tokbase = b * 256; nself = 256; ntiles = 4; }
    const int kvh = head >> 2;
    const int qtok = tokbase + qblk * 128 + wave * 32 + r31;
    bf16x8 qf[4];
    {
        const bf16_t* qp = p.proj + (size_t)qtok * INW + head * 64 + hh * 8;
#pragma unroll
        for (int ks = 0; ks < 4; ++ks) qf[ks] = *(const bf16x8*)(qp + ks * 16);
    }
    const bf16_t* kself = p.proj + (size_t)tokbase * INW + 512 + kvh * 64;
    const bf16_t* vself = p.proj + (size_t)tokbase * INW + 640 + kvh * 64;
    const bf16_t* kcache = p.kc + (size_t)((b * 2 + layer) * 2 + kvh) * 256 * 64;
    const bf16_t* vcache = p.vc + (size_t)((b * 2 + layer) * 2 + kvh) * 256 * 64;
    const int srow = tid >> 3, scc = tid & 7;
    const int kwo = srow * 128 + ((scc ^ ((srow >> 1) & 7)) * 16);
    const int vwo = srow * 128 + ((scc ^ (((srow >> 1) & 1) << 2)) * 16);
    u32x4 rkA[2], rvA[2], rkB[2], rvB[2];
    auto gload = [&](int j, u32x4* rk, u32x4* rv) {
        const int key0 = j * 64;
#pragma unroll
        for (int i = 0; i < 2; ++i) {
            const int row = srow + 32 * i;
            if (key0 < nself) {
                rk[i] = *(const u32x4*)(kself + (size_t)(key0 + row) * INW + scc * 8);
                rv[i] = *(const u32x4*)(vself + (size_t)(key0 + row) * INW + scc * 8);
            } else {
                rk[i] = *(const u32x4*)(kcache + (size_t)(key0 - nself + row) * 64 + scc * 8);
                rv[i] = *(const u32x4*)(vcache + (size_t)(key0 - nself + row) * 64 + scc * 8);
            }
        }
    };
    auto swrite = [&](int buf, const u32x4* rk, const u32x4* rv) {
        unsigned char* kb = smem + buf * 16384;
        unsigned char* vb = kb + 8192;
#pragma unroll
        for (int i = 0; i < 2; ++i) {
            *(u32x4*)(kb + kwo + i * 32 * 128) = rk[i];
            *(u32x4*)(vb + vwo + i * 32 * 128) = rv[i];
        }
    };
    f32x16 o[2];
#pragma unroll
    for (int i = 0; i < 16; ++i) { o[0][i] = 0.f; o[1][i] = 0.f; }
    float mrun = 0.f, mmax = -1e30f, lrun = 0.f;
    f32x16 negm, zero16;
#pragma unroll
    for (int i = 0; i < 16; ++i) { negm[i] = 0.f; zero16[i] = 0.f; }
    bool shifted = false;
    gload(0, rkA, rvA);
    swrite(0, rkA, rvA);
    if (ntiles > 1) gload(1, rkB, rvB);
    __syncthreads();
    const int kro = r31 * 128, ksw = (r31 >> 1) & 7;
    const int vq = 4 * hh + ((lane & 15) >> 2);
    const int vsw = ((vq >> 1) & 1) << 2;
    const int vcl = ((lane >> 4) & 1) * 2 + ((lane & 3) >> 1);
    const int vro0 = vq * 128 + (((0 * 4 + vcl) ^ vsw) * 16) + (lane & 1) * 8;
    const int vro1 = vq * 128 + (((1 * 4 + vcl) ^ vsw) * 16) + (lane & 1) * 8;
    auto step = [&](int j, u32x4* lk, u32x4* lv, const u32x4* wk, const u32x4* wv) {
        const unsigned char* kb = smem + (j & 1) * 16384;
        const unsigned char* vb = kb + 8192;
        bf16x8 kf[2][4];
#pragma unroll
        for (int sb = 0; sb < 2; ++sb)
#pragma unroll
            for (int ks = 0; ks < 4; ++ks) kf[sb][ks] = *(const bf16x8*)(kb + sb * 4096 + kro + (((ks * 2 + hh) ^ ksw) * 16));
        bf16x8 vf[2][2][2];
#pragma unroll
        for (int sb = 0; sb < 2; ++sb)
#pragma unroll
            for (int s2 = 0; s2 < 2; ++s2)
#pragma unroll
                for (int dt = 0; dt < 2; ++dt) {
                    const LAS unsigned char* va = (const LAS unsigned char*)(vb) + (sb * 32 + s2 * 16) * 128 + (dt ? vro1 : vro0);
                    const s16x4 a0 = __builtin_amdgcn_ds_read_tr16_b64_v4i16((LAS s16x4*)(va));
                    const s16x4 a1 = __builtin_amdgcn_ds_read_tr16_b64_v4i16((LAS s16x4*)(va + 8 * 128));
                    vf[sb][s2][dt] = (bf16x8){a0[0], a0[1], a0[2], a0[3], a1[0], a1[1], a1[2], a1[3]};
                }
        if (VAR != 1 && j + 2 < ntiles) gload(j + 2, lk, lv);
        __builtin_amdgcn_sched_barrier(0);
        f32x16 s[2];
        float mloc, lsum = 0.f;
        bf16x8 pf[2][2];
#pragma unroll
        for (int sb = 0; sb < 2; ++sb)
#pragma unroll
            for (int ks = 0; ks < 4; ++ks) {
                if (ks == 0) {
                    if (shifted) s[sb] = __builtin_amdgcn_mfma_f32_32x32x16_bf16(kf[sb][ks], qf[ks], negm, 0, 0, 0);
                    else s[sb] = __builtin_amdgcn_mfma_f32_32x32x16_bf16(kf[sb][ks], qf[ks], zero16, 0, 0, 0);
                } else s[sb] = __builtin_amdgcn_mfma_f32_32x32x16_bf16(kf[sb][ks], qf[ks], s[sb], 0, 0, 0);
            }
#pragma unroll
        for (int sb = 0; sb < 2; ++sb) {
            float m0 = max3_f(s[sb][0], s[sb][1], s[sb][2]);
#pragma unroll
            for (int i = 3; i < 15; i += 2) m0 = max3_f(m0, s[sb][i], s[sb][i + 1]);
            m0 = fmaxf(m0, s[sb][15]);
            mloc = sb == 0 ? m0 : fmaxf(mloc, m0);
#pragma unroll
            for (int i = 0; i < 16; ++i) { if (VAR != 2) { s[sb][i] = __builtin_amdgcn_exp2f(s[sb][i]); lsum += s[sb][i]; } }
#pragma unroll
            for (int s2 = 0; s2 < 2; ++s2) {
                u32x4 pw;
                pw.x = pk_bf16(s[sb][s2 * 8 + 0], s[sb][s2 * 8 + 1]);
                pw.y = pk_bf16(s[sb][s2 * 8 + 2], s[sb][s2 * 8 + 3]);
                pw.z = pk_bf16(s[sb][s2 * 8 + 4], s[sb][s2 * 8 + 5]);
                pw.w = pk_bf16(s[sb][s2 * 8 + 6], s[sb][s2 * 8 + 7]);
                pf[sb][s2] = __builtin_bit_cast(bf16x8, pw);
            }
#pragma unroll
            for (int s2 = 0; s2 < 2; ++s2)
#pragma unroll
                for (int dt = 0; dt < 2; ++dt) o[dt] = __builtin_amdgcn_mfma_f32_32x32x16_bf16(vf[sb][s2][dt], pf[sb][s2], o[dt], 0, 0, 0);
        }
        lrun += lsum;
        __builtin_amdgcn_sched_barrier(0);
        mloc = fmaxf(mloc, __shfl_xor(mloc, 32));
        mmax = fmaxf(mmax, mrun + mloc);
        if (__builtin_expect(__any(fabsf(mmax - mrun) > 40.0f), 0)) {
            asm volatile("" ::: "memory");
            const float alpha = __builtin_amdgcn_exp2f(mrun - mmax);
            mrun = mmax;
            lrun *= alpha;
            shifted = true;
#pragma unroll
            for (int i = 0; i < 16; ++i) { o[0][i] *= alpha; o[1][i] *= alpha; negm[i] = -mrun; }
        }
        if (VAR != 1 && j + 1 < ntiles) swrite((j + 1) & 1, wk, wv);
        __syncthreads();
    };
    for (int j = 0; j < ntiles - 2; j += 2) {
        step(j, rkA, rvA, rkB, rvB);
        step(j + 1, rkB, rvB, rkA, rvA);
    }
    const bf16_t* zp = p.proj + (size_t)qtok * INW + 768 + head * 64;
    u32x2 zq[2][4];
#pragma unroll
    for (int dt = 0; dt < 2; ++dt)
#pragma unroll
        for (int rq = 0; rq < 4; ++rq) zq[dt][rq] = *(const u32x2*)(zp + dt * 32 + 8 * rq + 4 * hh);
    step(ntiles - 2, rkA, rvA, rkB, rvB);
    step(ntiles - 1, rkB, rvB, rkA, rvA);
    const float ltot = lrun + __shfl_xor(lrun, 32);
    const float inv = 1.0f / ltot;
    bf16_t* mp = (VAR == 0 ? p.mix : p.xn) + (size_t)qtok * DM + head * 64;
#pragma unroll
    for (int dt = 0; dt < 2; ++dt)
#pragma unroll
        for (int rq = 0; rq < 4; ++rq) {
            const int d0 = dt * 32 + 8 * rq + 4 * hh;
            const u32x2 zz = zq[dt][rq];
            const float z0 = bf_lo(zz.x), z1 = bf_hi(zz.x), z2 = bf_lo(zz.y), z3 = bf_hi(zz.y);
            u32x2 w;
            w.x = pk_bf16(o[dt][rq * 4 + 0] * inv * silu_f(z0), o[dt][rq * 4 + 1] * inv * silu_f(z1));
            w.y = pk_bf16(o[dt][rq * 4 + 2] * inv * silu_f(z2), o[dt][rq * 4 + 3] * inv * silu_f(z3));
            *(u32x2*)(mp + d0) = w;
        }
}


template <int WIN>
__device__ __forceinline__ void pool_group(const Params& p, int layer, int T0, int toff, int seqlen, int gi, int fr, int fq, const bf16x8 (&wf)[4][2],
                                           const f32x4 (&ps)[4], const unsigned char* smem) {
    constexpr int HALF = WIN / 2;
    u32x2 zz[2][4];
#pragma unroll
    for (int mi = 0; mi < 2; ++mi)
#pragma unroll
        for (int ni = 0; ni < 4; ++ni) zz[mi][ni] = *(const u32x2*)(p.proj + (size_t)(T0 + mi * 16 + fr) * INW + 2560 + gi * 64 + ni * 16 + fq * 4);
#pragma unroll
    for (int mi = 0; mi < 2; ++mi) {
        const int tt = mi * 16 + fr, ts = toff + tt, tok = T0 + tt;
        int lo = ts - HALF, hi = ts - HALF + WIN - 1;
        lo = lo < 0 ? 0 : lo;
        hi = hi > seqlen - 1 ? seqlen - 1 : hi;
        const float rc = 1.0f / (float)(hi - lo + 1);
        f32x4 acc[4];
#pragma unroll
        for (int j = 0; j < 4; ++j) acc[j] = (f32x4){0.f, 0.f, 0.f, 0.f};
#pragma unroll
        for (int kk = 0; kk < 2; ++kk) {
            const int co = (gi * 64 + kk * 32 + fq * 8) * 2;
            u32x4 rw[WIN];
#pragma unroll
            for (int j = 0; j < WIN; ++j) rw[j] = *(const u32x4*)(smem + (tt + 8 - HALF + j) * 528 + co);
            const u32x4 self = *(const u32x4*)(smem + (tt + 8) * 528 + co);
            float sum[8];
#pragma unroll
            for (int e = 0; e < 8; ++e) sum[e] = 0.f;
#pragma unroll
            for (int j = 0; j < WIN; ++j) {
                const int sq = ts - HALF + j;
                const float m = (sq >= 0 && sq < seqlen) ? 1.0f : 0.0f;
                float f[8];
                unpack8(rw[j], f);
#pragma unroll
                for (int e = 0; e < 8; ++e) sum[e] = fmaf(f[e], m, sum[e]);
            }
            float us[8];
            unpack8(self, us);
            u32x4 dw;
            dw.x = pk_bf16(sum[0] * rc - us[0], sum[1] * rc - us[1]);
            dw.y = pk_bf16(sum[2] * rc - us[2], sum[3] * rc - us[3]);
            dw.z = pk_bf16(sum[4] * rc - us[4], sum[5] * rc - us[5]);
            dw.w = pk_bf16(sum[6] * rc - us[6], sum[7] * rc - us[7]);
            const bf16x8 df = __builtin_bit_cast(bf16x8, dw);
#pragma unroll
            for (int ni = 0; ni < 4; ++ni) acc[ni] = __builtin_amdgcn_mfma_f32_16x16x32_bf16(wf[ni][kk], df, acc[ni], 0, 0, 0);
        }
#pragma unroll
        for (int ni = 0; ni < 4; ++ni) {
            const int ch = gi * 64 + ni * 16 + fq * 4;
            u32x2 w;
            w.x = pk_bf16(acc[ni][0] * ps[ni][0] * silu_f(bf_lo(zz[mi][ni].x)), acc[ni][1] * ps[ni][1] * silu_f(bf_hi(zz[mi][ni].x)));
            w.y = pk_bf16(acc[ni][2] * ps[ni][2] * silu_f(bf_lo(zz[mi][ni].y)), acc[ni][3] * ps[ni][3] * silu_f(bf_hi(zz[mi][ni].y)));
            *(u32x2*)(p.mix + (size_t)tok * DM + 768 + ch) = w;
        }
    }
}

__device__ __forceinline__ void pool_item(const Params& p, int layer, int pi, unsigned char* smem) {
    const int tid = otid(), lane = tid & 63, gi = tid >> 6;
    const int fr = lane & 15, fq = lane >> 4;
    const int T0 = pi * 32;
    int seqstart, seqlen;
    if (T0 < NCTX) { seqstart = T0 & ~255; seqlen = 256; } else { seqstart = NCTX + ((T0 - NCTX) & ~2047); seqlen = 2048; }
    const int toff = T0 - seqstart;
    u32x4 st[6];
#pragma unroll
    for (int i = 0; i < 6; ++i) {
        const int e = tid + 256 * i, r = e >> 5, c = e & 31;
        int sq = toff - 8 + r;
        sq = sq < 0 ? 0 : (sq > seqlen - 1 ? seqlen - 1 : sq);
        if (e < 47 * 32) st[i] = *(const u32x4*)(p.proj + (size_t)(seqstart + sq) * INW + 2304 + c * 8);
    }
    bf16x8 wf[4][2];
    f32x4 ps[4];
    {
        const bf16_t* wp = p.PoolT + (size_t)((layer * 4 + gi) * 64) * 64;
#pragma unroll
        for (int ni = 0; ni < 4; ++ni) {
#pragma unroll
            for (int kk = 0; kk < 2; ++kk) wf[ni][kk] = *(const bf16x8*)(wp + (ni * 16 + fr) * 64 + kk * 32 + fq * 8);
            ps[ni] = *(const f32x4*)(p.pool_scale + layer * 256 + gi * 64 + ni * 16 + fq * 4);
        }
    }
#pragma unroll
    for (int i = 0; i < 6; ++i) {
        const int e = tid + 256 * i, r = e >> 5, c = e & 31;
        if (e < 47 * 32) *(u32x4*)(smem + r * 528 + c * 16) = st[i];
    }
    __syncthreads();
    if (gi == 0) pool_group<2>(p, layer, T0, toff, seqlen, gi, fr, fq, wf, ps, smem);
    else if (gi == 1) pool_group<4>(p, layer, T0, toff, seqlen, gi, fr, fq, wf, ps, smem);
    else if (gi == 2) pool_group<8>(p, layer, T0, toff, seqlen, gi, fr, fq, wf, ps, smem);
    else pool_group<16>(p, layer, T0, toff, seqlen, gi, fr, fq, wf, ps, smem);
    __syncthreads();
}

__device__ __forceinline__ void conv_item(const Params& p, int layer, int ci) {
    const int tid = otid();
    const int ch = (tid & 31) * 8, tg = tid >> 5;
    const int T0 = ci * 32 + tg * 4;
    int seqstart, seqlen;
    if (T0 < NCTX) { seqstart = T0 & ~255; seqlen = 256; } else { seqstart = NCTX + ((T0 - NCTX) & ~2047); seqlen = 2048; }
    const int seqend = seqstart + seqlen;
    u32x4 rh[6], rc[6], rb[4], rz[4];
#pragma unroll
    for (int i = 0; i < 6; ++i) {
        int tok = T0 - 1 + i;
        tok = tok < seqstart ? seqstart : (tok > seqend - 1 ? seqend - 1 : tok);
        rh[i] = *(const u32x4*)(p.proj + (size_t)tok * INW + 1280 + ch);
        rc[i] = *(const u32x4*)(p.proj + (size_t)tok * INW + 1792 + ch);
    }
#pragma unroll
    for (int i = 0; i < 4; ++i) {
        rb[i] = *(const u32x4*)(p.proj + (size_t)(T0 + i) * INW + 1536 + ch);
        rz[i] = *(const u32x4*)(p.proj + (size_t)(T0 + i) * INW + 2048 + ch);
    }
    f32x4 wv[8];
    {
        const float* cw = p.conv_w + (size_t)layer * 768 + ch;
#pragma unroll
        for (int r = 0; r < 3; ++r) { wv[r * 2] = *(const f32x4*)(cw + r * 256); wv[r * 2 + 1] = *(const f32x4*)(cw + r * 256 + 4); }
        wv[6] = *(const f32x4*)(p.conv_b + layer * 256 + ch);
        wv[7] = *(const f32x4*)(p.conv_b + layer * 256 + ch + 4);
    }
    float x[6][8];
#pragma unroll
    for (int i = 0; i < 6; ++i) {
        const int tok = T0 - 1 + i;
        const float valid = (tok >= seqstart && tok < seqend) ? 1.0f : 0.0f;
        float hc[8], cc[8];
        unpack8(rh[i], hc);
        unpack8(rc[i], cc);
#pragma unroll
        for (int e = 0; e < 8; ++e) x[i][e] = hc[e] * cc[e] * valid;
    }
#pragma unroll
    for (int t = 0; t < 4; ++t) {
        float bc[8], zc[8], o[8];
        unpack8(rb[t], bc);
        unpack8(rz[t], zc);
#pragma unroll
        for (int e = 0; e < 8; ++e) {
            const float y = x[t][e] * wv[e >> 2][e & 3] + x[t + 1][e] * wv[2 + (e >> 2)][e & 3] + x[t + 2][e] * wv[4 + (e >> 2)][e & 3] + wv[6 + (e >> 2)][e & 3];
            o[e] = bc[e] * y * silu_f(zc[e]);
        }
        u32x4 w;
        w.x = pk_bf16(o[0], o[1]); w.y = pk_bf16(o[2], o[3]); w.z = pk_bf16(o[4], o[5]); w.w = pk_bf16(o[6], o[7]);
        *(u32x4*)(p.mix + (size_t)(T0 + t) * DM + 512 + ch) = w;
    }
}

__device__ __forceinline__ void phase_mixer(const Params& p, int layer, unsigned char* smem) {
    if (gridDim.x == 512) {
        const int b = blockIdx.x;
        if (b < 256) {
            const int xcd = b & 7, slot = b >> 3;
            attn_unit<0>(p, layer, 512 + ((((xcd << 1) | (slot >> 4)) << 4) | (slot & 15)), smem);
        }
        {
            const int xcd = b & 7, slot = b >> 3;
            attn_unit<0>(p, layer, ((xcd >> 1) << 7) | ((((xcd & 1) << 2) | (slot >> 4)) << 4) | (slot & 15), smem);
        }
        if (b >= 256) {
#pragma unroll 1
            for (int k = 0; k < 3; ++k) {
                const int idx = (b - 256) + 256 * k;
                if (idx < 384) pool_item(p, layer, idx, smem);
                else conv_item(p, layer, idx - 384);
            }
        }
    } else {
        for (int it = blockIdx.x; it < 768 + 384 + 384; it += gridDim.x) {
            if (it < 768) attn_unit<0>(p, layer, it, smem);
            else if (it < 1152) pool_item(p, layer, it - 768, smem);
            else conv_item(p, layer, it - 1152);
        }
    }
}

__global__ void __launch_bounds__(256, 2) mega(Params p, int lo, int hi) {
    __shared__ __attribute__((aligned(16))) unsigned char smem[73728];
    __shared__ uint4 xbw;
    if (p.use_cg) cg::this_grid().sync();
    if (threadIdx.x == 0) xbw = make_uint4(0u, 0u, 0u, 0u);
    __syncthreads();
    XcdBarrier xb = xcd_barrier_post(p.bar, (volatile LAS unsigned*)&xbw);
    for (int ph = lo; ph < hi; ++ph) {
        if (ph > lo) xcd_barrier(xb);
        if (ph == 0) phase_prep(p, smem);
        else if (ph == 9) phase_final(p);
        else {
            const int layer = (ph - 1) >> 2, ty = (ph - 1) & 3;
            if (ty == 0) phase_xn(p, layer);
            else if (ty == 1) phase_gemm<0>(p, layer, smem);
            else if (ty == 2) phase_mixer(p, layer, smem);
            else phase_gemm<1>(p, layer, smem);
        }
    }
}

#ifndef MK_MULTI
#define MK_MULTI 0
#endif

extern "C" void kernel_launch(void* const* d_in, const int* in_sizes, int n_in, void* d_out, int out_size, void* d_ws, size_t ws_size,
                              hipStream_t stream) {
    static int grid_blocks = 0;
    if (!grid_blocks) {
        int dev = 0, cus = 0, per_cu = 0;
        hipGetDevice(&dev);
        hipDeviceGetAttribute(&cus, hipDeviceAttributeMultiprocessorCount, dev);
        hipOccupancyMaxActiveBlocksPerMultiprocessor(&per_cu, mega, 256, 0);
        if (per_cu > 2) per_cu = 2;
        if (per_cu < 1) per_cu = 1;
        grid_blocks = cus * per_cu;
    }
    Params p{};
    const float* const* in = (const float* const*)d_in;
    p.x_prompt = in[0]; p.x_sample = in[1]; p.cache_k = in[2]; p.cache_v = in[3]; p.c = in[4]; p.c_ctx = in[5]; p.norm_g = in[6];
    p.w_ada = in[7]; p.b_ada = in[8]; p.w_in = in[9]; p.q_g = in[10]; p.k_g = in[11]; p.conv_w = in[12]; p.conv_b = in[13];
    p.pool_w = in[14]; p.pool_scale = in[15]; p.w_out = in[16]; p.final_g = in[17];
    p.out = (float*)d_out;
    unsigned char* ws = (unsigned char*)d_ws;
    size_t off = 0;
    auto take = [&](size_t bytes) { unsigned char* r = ws + off; off += (bytes + 255) & ~(size_t)255; return r; };
    p.bar = (unsigned*)take(XCD_BAR_WORDS * 4);
    p.modv = (float*)take(2 * 5 * 3072 * 4);
    p.rope = (float*)take(2048 * 4);
    p.WinT = (bf16_t*)take((size_t)2 * INW * 1024 * 2);
    p.WoutT = (bf16_t*)take((size_t)2 * 1024 * 1024 * 2);
    p.PoolT = (bf16_t*)take(2 * 4 * 64 * 64 * 2);
    p.kc = (bf16_t*)take(262144 * 2);
    p.vc = (bf16_t*)take(262144 * 2);
    p.h = (bf16_t*)take((size_t)NTOK * DM * 2);
    p.xn = (bf16_t*)take((size_t)NTOK * DM * 2);
    p.proj = (bf16_t*)take((size_t)NTOK * INW * 2);
    p.mix = (bf16_t*)take((size_t)NTOK * DM * 2);
    p.use_cg = 0;
    p.pad = 0;
    hipMemsetAsync(p.bar, 0, XCD_BAR_WORDS * 4, stream);
#if MK_MULTI
    for (int ph = 0; ph < 10; ++ph) {
        int lo = ph, hi = ph + 1;
        void* args[] = {&p, &lo, &hi};
        hipError_t e = hipLaunchCooperativeKernel((void*)mega, dim3(grid_blocks), dim3(256), args, 0, stream);
        if (e != hipSuccess) fprintf(stderr, "launch failed: %s\n", hipGetErrorString(e));
    }
#else
    int lo = 0, hi = 10;
    void* args[] = {&p, &lo, &hi};
    hipError_t e = hipLaunchCooperativeKernel((void*)mega, dim3(grid_blocks), dim3(256), args, 0, stream);
    if (e != hipSuccess) fprintf(stderr, "cooperative launch failed: %s (grid %d)\n", hipGetErrorString(e), grid_blocks);
#endif
}
```

```cpp
#include <hip/hip_runtime.h>
#include <hip/hip_cooperative_groups.h>
#include <cstdint>
#include <cstdio>
namespace cg = cooperative_groups;

#define LAS __attribute__((address_space(3)))
typedef unsigned short bf16_t;
typedef short bf16x8 __attribute__((ext_vector_type(8)));
typedef short s16x4 __attribute__((ext_vector_type(4)));
typedef float f32x4 __attribute__((ext_vector_type(4)));
typedef float f32x16 __attribute__((ext_vector_type(16)));
typedef unsigned u32x4 __attribute__((ext_vector_type(4)));
typedef unsigned u32x2 __attribute__((ext_vector_type(2)));

constexpr int NTOK = 12288, NCTX = 4096, DM = 1024, INW = 2816;
constexpr size_t OUT_NK = 12582912, OUT_NV = 13631488;
constexpr float EPSF = 1e-6f;
constexpr float QSCALE = 0.125f * 1.4426950408889634f;

struct Params {
    const float *x_prompt, *x_sample, *cache_k, *cache_v, *c, *c_ctx, *norm_g, *w_ada, *b_ada, *w_in, *q_g, *k_g, *conv_w, *conv_b,
        *pool_w, *pool_scale, *w_out, *final_g;
    float* out;
    unsigned* bar;
    float* modv;
    float* rope;
    bf16_t* WinT;
    bf16_t* WoutT;
    bf16_t* PoolT;
    bf16_t* kc;
    bf16_t* vc;
    bf16_t* h;
    bf16_t* xn;
    bf16_t* proj;
    bf16_t* mix;
    int use_cg;
    int pad;
};

__device__ __forceinline__ unsigned pk_bf16(float lo, float hi) {
    unsigned r;
    asm("v_cvt_pk_bf16_f32 %0, %1, %2" : "=v"(r) : "v"(lo), "v"(hi));
    return r;
}
__device__ __forceinline__ float bf_lo(unsigned u) { return __uint_as_float(u << 16); }
__device__ __forceinline__ float bf_hi(unsigned u) { return __uint_as_float(u & 0xffff0000u); }
__device__ __forceinline__ float silu_f(float z) { return z / (1.0f + __expf(-z)); }
__device__ __forceinline__ f32x4 bf4_to_f32(const u32x2 u) { return (f32x4){bf_lo(u.x), bf_hi(u.x), bf_lo(u.y), bf_hi(u.y)}; }
__device__ __forceinline__ void unpack8(const u32x4 u, float* f) {
    f[0] = bf_lo(u.x); f[1] = bf_hi(u.x); f[2] = bf_lo(u.y); f[3] = bf_hi(u.y);
    f[4] = bf_lo(u.z); f[5] = bf_hi(u.z); f[6] = bf_lo(u.w); f[7] = bf_hi(u.w);
}
__device__ __forceinline__ float max3_f(float a, float b, float c) { float r; asm("v_max3_f32 %0, %1, %2, %3" : "=v"(r) : "v"(a), "v"(b), "v"(c)); return r; }
__device__ __forceinline__ int otid() { int t = threadIdx.x; asm volatile("" : "+v"(t)); return t; }

#define XB_TMO 128
#define XB_XCNT(j) (256 + 64 * (j))
#define XB_XSUB(j) (1280 + 64 * (j))
#define XB_XGEN(j) (2304 + 64 * (j))
#define XB_TOP 3328
#define XB_TOPGEN 3392
#define XCD_BAR_WORDS 3456
#define XB_SPIN_CAP (1u << 20)

__device__ __forceinline__ unsigned xb_ld(unsigned* p) { return __hip_atomic_load(p, __ATOMIC_RELAXED, __HIP_MEMORY_SCOPE_AGENT); }
__device__ __forceinline__ unsigned xb_add(unsigned* p, unsigned v) { return __hip_atomic_fetch_add(p, v, __ATOMIC_RELAXED, __HIP_MEMORY_SCOPE_AGENT); }
__device__ __forceinline__ unsigned xb_xcc_id() { return (unsigned)__builtin_amdgcn_s_getreg((3 << 11) | 20) & 0xFu; }
#define XB_SPIN(cond, bar)                                                   \
    do {                                                                     \
        unsigned _sp = 0;                                                    \
        while (cond) {                                                       \
            __builtin_amdgcn_s_sleep(1);                                     \
            if ((++_sp & 255u) == 0u) {                                      \
                if (xb_ld(&(bar)[XB_TMO])) break;                            \
                if (_sp > XB_SPIN_CAP) { atomicAdd(&(bar)[XB_TMO], 1u); break; } \
            }                                                                \
        }                                                                    \
    } while (0)

struct XcdBarrier {
    unsigned* bar;
    unsigned x;
    volatile LAS unsigned* st;
};

__device__ __forceinline__ XcdBarrier xcd_barrier_post(unsigned* bar, volatile LAS unsigned* st) {
    XcdBarrier b;
    b.bar = bar;
    b.x = xb_xcc_id();
    b.st = st;
    if (threadIdx.x == 0) (void)xb_add(&bar[XB_XCNT(b.x)], 1u);
    return b;
}
__device__ __forceinline__ void xcd_barrier_complete(unsigned* bar, unsigned x, unsigned& nloc, unsigned& nx) {
    const unsigned G = gridDim.x * gridDim.y * gridDim.z;
    unsigned sum, cnt, mine, sp = 0u;
    for (;;) {
        sum = 0u; cnt = 0u; mine = 0u;
#pragma unroll
        for (unsigned j = 0; j < 16; ++j) {
            const unsigned c = xb_ld(&bar[XB_XCNT(j)]);
            sum += c; cnt += (c > 0u) ? 1u : 0u; mine = (j == x) ? c : mine;
        }
        if (sum == G) break;
        __builtin_amdgcn_s_sleep(1);
        if ((++sp & 255u) == 0u) {
            if (xb_ld(&bar[XB_TMO])) break;
            if (sp > XB_SPIN_CAP) { atomicAdd(&bar[XB_TMO], 1u); break; }
        }
    }
    nloc = mine > 0u ? mine : 1u;
    nx = cnt > 0u ? cnt : 1u;
}
__device__ __forceinline__ void xcd_barrier(const XcdBarrier& b) {
    asm volatile("s_waitcnt vmcnt(0)" ::: "memory");
    __syncthreads();
    if (threadIdx.x == 0) {
        unsigned* bar = b.bar;
        __builtin_amdgcn_s_waitcnt(0);
        unsigned nloc = b.st[0], nx = b.st[1];
        if (nloc == 0u) { xcd_barrier_complete(bar, b.x, nloc, nx); b.st[0] = nloc; b.st[1] = nx; }
        const unsigned old = xb_add(&bar[XB_XSUB(b.x)], 1u);
        const unsigned gen = old / nloc;
        if (old + 1u == (gen + 1u) * nloc) {
            __builtin_amdgcn_fence(__ATOMIC_RELEASE, "agent");
            asm volatile("s_waitcnt vmcnt(0)" ::: "memory");
            const unsigned og = xb_add(&bar[XB_TOP], 1u);
            const unsigned tg = og / nx;
            if (og + 1u == (tg + 1u) * nx) xb_add(&bar[XB_TOPGEN], 1u);
            else XB_SPIN(xb_ld(&bar[XB_TOPGEN]) == tg, bar);
            __builtin_amdgcn_fence(__ATOMIC_ACQUIRE, "agent");
            xb_add(&bar[XB_XGEN(b.x)], 1u);
            asm volatile("s_waitcnt vmcnt(0)" ::: "memory");
        } else {
            XB_SPIN(xb_ld(&bar[XB_XGEN(b.x)]) == gen, bar);
            __builtin_amdgcn_fence(__ATOMIC_ACQUIRE, "agent");
            asm volatile("s_waitcnt vmcnt(0)" ::: "memory");
        }
    }
    __syncthreads();
}

__device__ __forceinline__ void prep_mod_item(const Params& p, int item, unsigned char* smem) {
    const int tid = otid();
    float* sc = (float*)smem;
    float* red = (float*)(smem + 20480);
    const int l = item / 96, j0 = (item % 96) * 32;
    for (int idx = tid; idx < 5120; idx += 256) {
        const int v = idx >> 10, k = idx & 1023;
        const float cv = (v == 0) ? p.c_ctx[k] : p.c[(v - 1) * 1024 + k];
        sc[idx] = cv / (1.0f + expf(-cv));
    }
    __syncthreads();
    const int cgp = tid & 7, kg = tid >> 3;
    float acc[5][4];
#pragma unroll
    for (int v = 0; v < 5; ++v)
#pragma unroll
        for (int e = 0; e < 4; ++e) acc[v][e] = 0.f;
    const float* wp = p.w_ada + (size_t)l * 1024 * 3072 + j0 + cgp * 4;
    f32x4 wreg[32];
#pragma unroll
    for (int kk = 0; kk < 32; ++kk) wreg[kk] = *(const f32x4*)(wp + (size_t)(kk * 32 + kg) * 3072);
#pragma unroll
    for (int kk = 0; kk < 32; ++kk) {
        const int k = kk * 32 + kg;
        const f32x4 w = wreg[kk];
#pragma unroll
        for (int v = 0; v < 5; ++v) {
            const float s = sc[v * 1024 + k];
#pragma unroll
            for (int e = 0; e < 4; ++e) acc[v][e] += s * w[e];
        }
    }
#pragma unroll
    for (int v = 0; v < 5; ++v)
#pragma unroll
        for (int e = 0; e < 4; ++e) red[kg * 160 + v * 32 + cgp * 4 + e] = acc[v][e];
    __syncthreads();
    if (tid < 160) {
        float s = 0.f;
        for (int g = 0; g < 32; ++g) s += red[g * 160 + tid];
        const int v = tid >> 5, cc = tid & 31;
        p.modv[(size_t)(l * 5 + v) * 3072 + j0 + cc] = s + p.b_ada[l * 3072 + j0 + cc];
    }
    __syncthreads();
}

__device__ __forceinline__ void prep_transpose_item(const float* src, bf16_t* dst, int N, int k0, int n0) {
    const int n = n0 + otid();
    const float* sp = src + (size_t)k0 * N + n;
    float v[32];
#pragma unroll
    for (int i = 0; i < 32; ++i) v[i] = sp[(size_t)i * N];
    bf16_t* d = dst + (size_t)n * 1024 + k0;
#pragma unroll
    for (int c = 0; c < 4; ++c) {
        u32x4 w;
        w.x = pk_bf16(v[c * 8 + 0], v[c * 8 + 1]);
        w.y = pk_bf16(v[c * 8 + 2], v[c * 8 + 3]);
        w.z = pk_bf16(v[c * 8 + 4], v[c * 8 + 5]);
        w.w = pk_bf16(v[c * 8 + 6], v[c * 8 + 7]);
        *(u32x4*)(d + c * 8) = w;
    }
}

__device__ __forceinline__ void phase_prep(const Params& p, unsigned char* smem) {
    const int ntb = (int)gridDim.x * 5 / 8, nmb = (int)gridDim.x - ntb;
    const int NTI = 2 * 11 * 32, NTO = 2 * 4 * 32;
    if ((int)blockIdx.x < ntb) {
        for (int it = blockIdx.x; it < NTI + NTO; it += ntb) {
            if (it < NTI) {
                const int l = it / 352, r = it % 352, kt = r / 11, nt = r % 11;
                prep_transpose_item(p.w_in + (size_t)l * 1024 * INW, p.WinT + (size_t)l * INW * 1024, INW, kt * 32, nt * 256);
            } else {
                const int t = it - NTI, l = t / 128, r = t % 128, kt = r / 4, nt = r % 4;
                prep_transpose_item(p.w_out + (size_t)l * 1024 * 1024, p.WoutT + (size_t)l * 1024 * 1024, 1024, kt * 32, nt * 256);
            }
        }
    } else {
        for (int it = (int)blockIdx.x - ntb; it < 192; it += nmb) prep_mod_item(p, it, smem);
    }
    const int gsz = gridDim.x * 256;
    for (int i = blockIdx.x * 256 + otid(); i < 131072; i += gsz) {
        const int which = i >> 16, j4 = (i & 65535) * 4;
        const int d = j4 & 63, t = (j4 >> 6) & 255, kvh = (j4 >> 14) & 1, bl = j4 >> 15;
        const size_t si = ((size_t)(bl * 256 + t) * 2 + kvh) * 64 + d;
        const f32x4 v = *(const f32x4*)((which ? p.cache_v : p.cache_k) + si);
        u32x2 w;
        w.x = pk_bf16(v[0], v[1]);
        w.y = pk_bf16(v[2], v[3]);
        *(u32x2*)((which ? p.vc : p.kc) + j4) = w;
    }
    for (int j = blockIdx.x * 256 + otid(); j < 32768; j += gsz) {
        const int cc = j & 63, d = (j >> 6) & 63, lg = j >> 12;
        const float v = p.pool_w[((size_t)lg * 64 + cc) * 64 + d];
        p.PoolT[j] = (bf16_t)(pk_bf16(v, 0.f) & 0xffffu);
    }
    for (int j = blockIdx.x * 256 + otid(); j < 1024; j += gsz) {
        const int a = j & 15, r = j >> 4;
        const float inv = 1.0f / powf(10000.0f, (float)(2 * a) / 32.0f);
        const float ang = (float)r * inv;
        const float kf = rintf(ang * 0.15915494309189535f);
        float rr = fmaf(-kf, 6.2831854820251465f, ang);
        rr = fmaf(-kf, -1.7484555e-7f, rr);
        p.rope[j] = cosf(rr);
        p.rope[1024 + j] = sinf(rr);
    }
}

__device__ __forceinline__ float wave_sum(float v) {
#pragma unroll
    for (int o = 32; o >= 1; o >>= 1) v += __shfl_xor(v, o);
    return v;
}

__device__ __forceinline__ void phase_xn(const Params& p, int layer) {
    const int tid = otid(), lane = tid & 63, wave = tid >> 6;
    const int nw = gridDim.x * 4, w = blockIdx.x * 4 + wave;
    for (int t0 = w * 6; t0 < NTOK; t0 += nw * 6) {
        f32x4 x[6][4];
        if (layer == 0) {
#pragma unroll
            for (int u = 0; u < 6; ++u) {
                const int tok = t0 + u;
                const float* src = tok < NCTX ? p.x_prompt + (size_t)tok * DM : p.x_sample + (size_t)(tok - NCTX) * DM;
#pragma unroll
                for (int i = 0; i < 4; ++i) x[u][i] = *(const f32x4*)(src + i * 256 + lane * 4);
            }
        } else {
            u32x2 r[6][4];
#pragma unroll
            for (int u = 0; u < 6; ++u)
#pragma unroll
                for (int i = 0; i < 4; ++i) r[u][i] = *(const u32x2*)(p.h + (size_t)(t0 + u) * DM + i * 256 + lane * 4);
#pragma unroll
            for (int u = 0; u < 6; ++u)
#pragma unroll
                for (int i = 0; i < 4; ++i) x[u][i] = bf4_to_f32(r[u][i]);
        }
#pragma unroll
        for (int u = 0; u < 6; ++u) {
            const int tok = t0 + u;
            const int v = tok < NCTX ? 0 : 1 + ((tok - NCTX) >> 11);
            const float* mv = p.modv + (size_t)(layer * 5 + v) * 3072;
            float ss = 0.f;
#pragma unroll
            for (int i = 0; i < 4; ++i) ss += x[u][i][0] * x[u][i][0] + x[u][i][1] * x[u][i][1] + x[u][i][2] * x[u][i][2] + x[u][i][3] * x[u][i][3];
            ss = wave_sum(ss);
            const float rstd = rsqrtf(ss * (1.0f / 1024.0f) + EPSF);
#pragma unroll
            for (int i = 0; i < 4; ++i) {
                const int k = i * 256 + lane * 4;
                const f32x4 g = *(const f32x4*)(p.norm_g + layer * 1024 + k);
                const f32x4 sh = *(const f32x4*)(mv + k);
                const f32x4 sc = *(const f32x4*)(mv + 1024 + k);
                float o[4];
#pragma unroll
                for (int e = 0; e < 4; ++e) o[e] = x[u][i][e] * rstd * g[e] * (1.0f + sc[e]) + sh[e];
                u32x2 wv;
                wv.x = pk_bf16(o[0], o[1]);
                wv.y = pk_bf16(o[2], o[3]);
                *(u32x2*)(p.xn + (size_t)tok * DM + k) = wv;
            }
        }
    }
}

__device__ __forceinline__ void phase_final(const Params& p) {
    const int tid = otid(), lane = tid & 63, wave = tid >> 6;
    const int nw = gridDim.x * 4, w = blockIdx.x * 4 + wave;
    f32x4 g[4];
#pragma unroll
    for (int i = 0; i < 4; ++i) g[i] = *(const f32x4*)(p.final_g + i * 256 + lane * 4);
    for (int t0 = w * 6; t0 < NTOK; t0 += nw * 6) {
        u32x2 r[6][4];
#pragma unroll
        for (int u = 0; u < 6; ++u)
#pragma unroll
            for (int i = 0; i < 4; ++i) r[u][i] = *(const u32x2*)(p.xn + (size_t)(t0 + u) * DM + i * 256 + lane * 4);
#pragma unroll
        for (int u = 0; u < 6; ++u) {
            float* row = p.out + (size_t)(t0 + u) * DM;
            f32x4 x[4];
            float ss = 0.f;
#pragma unroll
            for (int i = 0; i < 4; ++i) {
                x[i] = bf4_to_f32(r[u][i]);
                ss += x[i][0] * x[i][0] + x[i][1] * x[i][1] + x[i][2] * x[i][2] + x[i][3] * x[i][3];
            }
            ss = wave_sum(ss);
            const float rstd = rsqrtf(ss * (1.0f / 1024.0f) + EPSF);
#pragma unroll
            for (int i = 0; i < 4; ++i) *(f32x4*)(row + i * 256 + lane * 4) = x[i] * rstd * g[i];
        }
    }
}

template <int MODE, int MI, int STG = 0>
__device__ __forceinline__ void gemm_epilogue(const Params& p, int layer, int mw, int nw, f32x4 (&acc)[MI][4], int fr, int fq,
                                              unsigned char* ct = nullptr, int m0t = 0, int n0t = 0) {
    if (MODE == 0) {
        const bool ctx = mw < NCTX;
        if (nw < 640) {
            const bool isq = nw < 512;
            const float* gp = (isq ? p.q_g : p.k_g) + layer * 64;
            f32x4 gv[4];
#pragma unroll
            for (int ni = 0; ni < 4; ++ni) gv[ni] = *(const f32x4*)(gp + ni * 16 + fq * 4);
#pragma unroll
            for (int mi = 0; mi < MI; ++mi) {
                const int tok = mw + mi * 16 + fr;
                float ss = 0.f;
#pragma unroll
                for (int ni = 0; ni < 4; ++ni)
#pragma unroll
                    for (int e = 0; e < 4; ++e) ss += acc[mi][ni][e] * acc[mi][ni][e];
                ss += __shfl_xor(ss, 16);
                ss += __shfl_xor(ss, 32);
                const float rstd = rsqrtf(ss * (1.0f / 64.0f) + EPSF);
                f32x4 val[4];
#pragma unroll
                for (int ni = 0; ni < 4; ++ni) val[ni] = acc[mi][ni] * rstd * gv[ni];
                if (!isq && ctx) {
                    float* nk = p.out + OUT_NK + ((size_t)((tok >> 8) * 2 + layer) * 256 + (tok & 255)) * 128 + (nw - 512) + fq * 4;
#pragma unroll
                    for (int ni = 0; ni < 4; ++ni) *(f32x4*)(nk + ni * 16) = val[ni];
                }
                if (!ctx) {
                    const int pos = (tok - NCTX) & 2047, prow = pos >> 6, pcol = pos & 63;
                    const f32x4 cr = *(const f32x4*)(p.rope + prow * 16 + fq * 4), sr = *(const f32x4*)(p.rope + 1024 + prow * 16 + fq * 4);
                    const f32x4 cc = *(const f32x4*)(p.rope + pcol * 16 + fq * 4), sn = *(const f32x4*)(p.rope + 1024 + pcol * 16 + fq * 4);
                    const f32x4 a0 = val[0], a1 = val[1], a2 = val[2], a3 = val[3];
                    val[0] = a0 * cr - a1 * sr;
                    val[1] = a1 * cr + a0 * sr;
                    val[2] = a2 * cc - a3 * sn;
                    val[3] = a3 * cc + a2 * sn;
                }
                if (isq) {
#pragma unroll
                    for (int ni = 0; ni < 4; ++ni) val[ni] = val[ni] * QSCALE;
                }
                bf16_t* pr = p.proj + (size_t)tok * INW + nw + fq * 4;
#pragma unroll
                for (int ni = 0; ni < 4; ++ni) {
                    u32x2 w;
                    w.x = pk_bf16(val[ni][0], val[ni][1]);
                    w.y = pk_bf16(val[ni][2], val[ni][3]);
                    if (STG) *(u32x2*)(ct + (tok - m0t) * 272 + (nw - n0t + fq * 4 + ni * 16) * 2) = w;
                    else *(u32x2*)(pr + ni * 16) = w;
                }
            }
        } else {
            const bool isv = nw < 768;
#pragma unroll
            for (int mi = 0; mi < MI; ++mi) {
                const int tok = mw + mi * 16 + fr;
                bf16_t* pr = p.proj + (size_t)tok * INW + nw + fq * 4;
#pragma unroll
                for (int ni = 0; ni < 4; ++ni) {
                    u32x2 w;
                    w.x = pk_bf16(acc[mi][ni][0], acc[mi][ni][1]);
                    w.y = pk_bf16(acc[mi][ni][2], acc[mi][ni][3]);
                    if (STG) *(u32x2*)(ct + (tok - m0t) * 272 + (nw - n0t + fq * 4 + ni * 16) * 2) = w;
                    else *(u32x2*)(pr + ni * 16) = w;
                }
                if (isv && ctx) {
                    float* nv = p.out + OUT_NV + ((size_t)((tok >> 8) * 2 + layer) * 256 + (tok & 255)) * 128 + (nw - 640) + fq * 4;
#pragma unroll
                    for (int ni = 0; ni < 4; ++ni) *(f32x4*)(nv + ni * 16) = acc[mi][ni];
                }
            }
        }
    } else {
        const int v = mw < NCTX ? 0 : 1 + ((mw - NCTX) >> 11);
        const float* gate = p.modv + (size_t)(layer * 5 + v) * 3072 + 2048 + nw + fq * 4;
        f32x4 gt[4];
#pragma unroll
        for (int ni = 0; ni < 4; ++ni) gt[ni] = *(const f32x4*)(gate + ni * 16);
#pragma unroll
        for (int mi = 0; mi < MI; ++mi) {
            const int tok = mw + mi * 16 + fr;
            const size_t eo = (size_t)tok * DM + nw + fq * 4;
            const float* xin = (tok < NCTX ? p.x_prompt + (size_t)tok * DM : p.x_sample + (size_t)(tok - NCTX) * DM) + nw + fq * 4;
#pragma unroll
            for (int ni = 0; ni < 4; ++ni) {
                if (layer == 0) {
                    const f32x4 r = *(const f32x4*)(xin + ni * 16) + gt[ni] * acc[mi][ni];
                    u32x2 w;
                    w.x = pk_bf16(r[0], r[1]);
                    w.y = pk_bf16(r[2], r[3]);
                    *(u32x2*)(p.h + eo + ni * 16) = w;
                } else {
                    const f32x4 r = bf4_to_f32(*(const u32x2*)(p.h + eo + ni * 16)) + gt[ni] * acc[mi][ni];
                    u32x2 w;
                    w.x = pk_bf16(r[0], r[1]);
                    w.y = pk_bf16(r[2], r[3]);
                    *(u32x2*)(p.xn + eo + ni * 16) = w;
                }
            }
        }
    }
}

template <int MODE>
__device__ __forceinline__ void gemm_tile(const Params& p, int layer, int mt, int nt, unsigned char* smem) {
    const int tid = otid(), lane = tid & 63, wave = tid >> 6, wm = wave >> 1, wn = wave & 1;
    const int fr = lane & 15, fq = lane >> 4;
    const int m0 = mt * 128, n0 = nt * 128;
    const bf16_t* A = (MODE == 0 ? p.xn : p.mix) + (size_t)m0 * 1024;
    const bf16_t* B = (MODE == 0 ? p.WinT + (size_t)layer * INW * 1024 : p.WoutT + (size_t)layer * 1024 * 1024) + (size_t)n0 * 1024;
    f32x4 acc[4][4];
#pragma unroll
    for (int i = 0; i < 4; ++i)
#pragma unroll
        for (int j = 0; j < 4; ++j) acc[i][j] = (f32x4){0.f, 0.f, 0.f, 0.f};

    const int srow = tid >> 3, scc = tid & 7;
    const bf16_t* ag = A + (size_t)srow * 1024 + scc * 8;
    const bf16_t* bg = B + (size_t)srow * 1024 + scc * 8;
    const int wofs = srow * 128 + ((scc ^ (srow & 7)) * 16);
    u32x4 raA[4], rbA[4], raB[4], rbB[4];
    auto gload = [&](int kt, u32x4* ra, u32x4* rb) {
#pragma unroll
        for (int i = 0; i < 4; ++i) {
            ra[i] = *(const u32x4*)(ag + (size_t)i * 32 * 1024 + kt * 64);
            rb[i] = *(const u32x4*)(bg + (size_t)i * 32 * 1024 + kt * 64);
        }
    };
    auto swrite = [&](int buf, const u32x4* ra, const u32x4* rb) {
        unsigned char* Aw = smem + buf * 32768;
#pragma unroll
        for (int i = 0; i < 4; ++i) {
            *(u32x4*)(Aw + wofs + i * 4096) = ra[i];
            *(u32x4*)(Aw + 16384 + wofs + i * 4096) = rb[i];
        }
    };
    gload(0, raA, rbA);
    gload(1, raB, rbB);
    swrite(0, raA, rbA);
    __syncthreads();
    const int aro = (wm * 64 + fr) * 128, bro = (wn * 64 + fr) * 128, sw = fr & 7;
    auto step = [&](int kt, u32x4* la, u32x4* lb, const u32x4* wa, const u32x4* wb) {
        const unsigned char* As = smem + (kt & 1) * 32768;
        const unsigned char* Bs = As + 16384;
        bf16x8 af[2][4], bf[2][4];
#pragma unroll
        for (int kk = 0; kk < 2; ++kk) {
            const int co = ((kk * 4 + fq) ^ sw) * 16;
#pragma unroll
            for (int i = 0; i < 4; ++i) {
                af[kk][i] = *(const bf16x8*)(As + aro + i * 2048 + co);
                bf[kk][i] = *(const bf16x8*)(Bs + bro + i * 2048 + co);
            }
        }
        if (kt + 2 < 16) gload(kt + 2, la, lb);
        __builtin_amdgcn_sched_barrier(0);
#pragma unroll
        for (int mi = 0; mi < 4; ++mi)
#pragma unroll
            for (int ni = 0; ni < 4; ++ni) acc[mi][ni] = __builtin_amdgcn_mfma_f32_16x16x32_bf16(bf[0][ni], af[0][mi], acc[mi][ni], 0, 0, 0);
        __builtin_amdgcn_sched_barrier(0);
        if (kt + 1 < 16) swrite((kt + 1) & 1, wa, wb);
        __builtin_amdgcn_sched_barrier(0);
#pragma unroll
        for (int mi = 0; mi < 4; ++mi)
#pragma unroll
            for (int ni = 0; ni < 4; ++ni) acc[mi][ni] = __builtin_amdgcn_mfma_f32_16x16x32_bf16(bf[1][ni], af[1][mi], acc[mi][ni], 0, 0, 0);
        __syncthreads();
    };
    for (int kt = 0; kt < 16; kt += 2) {
        step(kt, raA, rbA, raB, rbB);
        step(kt + 1, raB, rbB, raA, rbA);
    }

    gemm_epilogue<MODE, 4>(p, layer, m0 + wm * 64, n0 + wn * 64, acc, fr, fq);
}

template <int MODE>
__device__ __forceinline__ void gemm_tile256(const Params& p, int layer, int mt, int nt, unsigned char* smem) {
    const int tid = otid(), lane = tid & 63, wave = tid >> 6, wm = wave >> 1, wn = wave & 1;
    const int fr = lane & 15, fq = lane >> 4;
    const int m0 = mt * 256, n0 = nt * 128;
    const bf16_t* A = (MODE == 0 ? p.xn : p.mix) + (size_t)m0 * 1024;
    const bf16_t* B = (MODE == 0 ? p.WinT + (size_t)layer * INW * 1024 : p.WoutT + (size_t)layer * 1024 * 1024) + (size_t)n0 * 1024;
    f32x4 acc[8][4];
#pragma unroll
    for (int i = 0; i < 8; ++i)
#pragma unroll
        for (int j = 0; j < 4; ++j) acc[i][j] = (f32x4){0.f, 0.f, 0.f, 0.f};
    const int srow = tid >> 2, scc = tid & 3;
    const bf16_t* ag = A + (size_t)srow * 1024 + scc * 8;
    const bf16_t* bg = B + (size_t)srow * 1024 + scc * 8;
    const int wofs = srow * 64 + ((scc ^ ((4 - ((srow >> 2) & 3)) & 3)) * 16);
    u32x4 raA[4], rbA[2], raB[4], rbB[2];
    auto gload = [&](int kt, u32x4* ra, u32x4* rb) {
#pragma unroll
        for (int i = 0; i < 4; ++i) ra[i] = *(const u32x4*)(ag + (size_t)i * 64 * 1024 + kt * 32);
#pragma unroll
        for (int i = 0; i < 2; ++i) rb[i] = *(const u32x4*)(bg + (size_t)i * 64 * 1024 + kt * 32);
    };
    auto swrite = [&](int buf, const u32x4* ra, const u32x4* rb) {
        unsigned char* Aw = smem + buf * 24576;
#pragma unroll
        for (int i = 0; i < 4; ++i) *(u32x4*)(Aw + wofs + i * 4096) = ra[i];
#pragma unroll
        for (int i = 0; i < 2; ++i) *(u32x4*)(Aw + 16384 + wofs + i * 4096) = rb[i];
    };
    gload(0, raA, rbA);
    gload(1, raB, rbB);
    swrite(0, raA, rbA);
    __syncthreads();
    const int co = (fq ^ ((4 - ((fr >> 2) & 3)) & 3)) * 16;
    const int aro = (wm * 128 + fr) * 64 + co, bro = (wn * 64 + fr) * 64 + co;
    auto step = [&](int kt, u32x4* la, u32x4* lb, const u32x4* wa, const u32x4* wb) {
        const unsigned char* As = smem + (kt & 1) * 24576;
        const unsigned char* Bs = As + 16384;
        bf16x8 af[8], bf[4];
#pragma unroll
        for (int i = 0; i < 4; ++i) bf[i] = *(const bf16x8*)(Bs + bro + i * 1024);
#pragma unroll
        for (int i = 0; i < 8; ++i) af[i] = *(const bf16x8*)(As + aro + i * 1024);
        if (kt + 2 < 32) gload(kt + 2, la, lb);
        __builtin_amdgcn_sched_barrier(0);
#pragma unroll
        for (int mi = 0; mi < 4; ++mi)
#pragma unroll
            for (int ni = 0; ni < 4; ++ni) acc[mi][ni] = __builtin_amdgcn_mfma_f32_16x16x32_bf16(bf[ni], af[mi], acc[mi][ni], 0, 0, 0);
        __builtin_amdgcn_sched_barrier(0);
        if (kt + 1 < 32) swrite((kt + 1) & 1, wa, wb);
        __builtin_amdgcn_sched_barrier(0);
#pragma unroll
        for (int mi = 4; mi < 8; ++mi)
#pragma unroll
            for (int ni = 0; ni < 4; ++ni) acc[mi][ni] = __builtin_amdgcn_mfma_f32_16x16x32_bf16(bf[ni], af[mi], acc[mi][ni], 0, 0, 0);
        __syncthreads();
    };
    for (int kt = 0; kt < 32; kt += 2) {
        step(kt, raA, rbA, raB, rbB);
        step(kt + 1, raB, rbB, raA, rbA);
    }
    gemm_epilogue<MODE, 8>(p, layer, m0 + wm * 128, n0 + wn * 64, acc, fr, fq);
}

template <int MODE>
__device__ __forceinline__ void gemm_tile256_dma(const Params& p, int layer, int mt, int nt, unsigned char* smem) {
    const int tid = otid(), lane = tid & 63, wave = tid >> 6, wm = wave >> 1, wn = wave & 1;
    const int fr = lane & 15, fq = lane >> 4;
    const int m0 = mt * 256, n0 = nt * 128;
    const bf16_t* A = (MODE == 0 ? p.xn : p.mix) + (size_t)m0 * 1024;
    const bf16_t* B = (MODE == 0 ? p.WinT + (size_t)layer * INW * 1024 : p.WoutT + (size_t)layer * 1024 * 1024) + (size_t)n0 * 1024;
    f32x4 acc[8][4];
#pragma unroll
    for (int i = 0; i < 8; ++i)
#pragma unroll
        for (int j = 0; j < 4; ++j) acc[i][j] = (f32x4){0.f, 0.f, 0.f, 0.f};
    const int lrow = lane >> 2, lc = (lane & 3) ^ ((4 - ((lane >> 4) & 3)) & 3);
    const bf16_t* agp = A + (size_t)(wave * 64 + lrow) * 1024 + lc * 8;
    const bf16_t* bgp = B + (size_t)(wave * 32 + lrow) * 1024 + lc * 8;
    LAS unsigned char* lbase = (LAS unsigned char*)smem;
    const int la_off = wave * 4096 + lane * 16, lb_off = 16384 + wave * 2048 + lane * 16;
    auto dma = [&](int kt, int stage) {
        LAS unsigned char* sb = lbase + stage * 24576;
#pragma unroll
        for (int i = 0; i < 4; ++i)
            __builtin_amdgcn_global_load_lds((const void*)(agp + (size_t)i * 16 * 1024 + kt * 32), (LAS void*)(sb + la_off + i * 1024), 16, 0, 0);
#pragma unroll
        for (int i = 0; i < 2; ++i)
            __builtin_amdgcn_global_load_lds((const void*)(bgp + (size_t)i * 16 * 1024 + kt * 32), (LAS void*)(sb + lb_off + i * 1024), 16, 0, 0);
    };
    dma(0, 0);
    dma(1, 1);
    asm volatile("s_waitcnt vmcnt(6)" ::: "memory");
    __builtin_amdgcn_s_barrier();
    const int co = (fq ^ ((4 - ((fr >> 2) & 3)) & 3)) * 16;
    const int aro = (wm * 128 + fr) * 64 + co, bro = 16384 + (wn * 64 + fr) * 64 + co;
    int st = 0, st2 = 2;
    const unsigned lds0 = (unsigned)(uintptr_t)lbase;
#pragma unroll 1
    for (int kt = 0; kt < 32; ++kt) {
        const unsigned sa = lds0 + st * 24576 + aro, sbb = lds0 + st * 24576 + bro;
        bf16x8 af[8], bf[4];
#define FRAG_RD(dst, addr, OFF) asm volatile("ds_read_b128 %0, %1 offset:" #OFF : "=&v"(dst) : "v"(addr))
        FRAG_RD(bf[0], sbb, 0); FRAG_RD(bf[1], sbb, 1024); FRAG_RD(bf[2], sbb, 2048); FRAG_RD(bf[3], sbb, 3072);
        FRAG_RD(af[0], sa, 0); FRAG_RD(af[1], sa, 1024); FRAG_RD(af[2], sa, 2048); FRAG_RD(af[3], sa, 3072);
        FRAG_RD(af[4], sa, 4096); FRAG_RD(af[5], sa, 5120); FRAG_RD(af[6], sa, 6144); FRAG_RD(af[7], sa, 7168);
#undef FRAG_RD
        __builtin_amdgcn_sched_barrier(0);
        if (kt + 2 < 32) dma(kt + 2, st2);
        __builtin_amdgcn_sched_barrier(0);
        asm volatile("s_waitcnt lgkmcnt(4)" ::: "memory");
        __builtin_amdgcn_sched_barrier(0);
#pragma unroll
        for (int mi = 0; mi < 4; ++mi)
#pragma unroll
            for (int ni = 0; ni < 4; ++ni) acc[mi][ni] = __builtin_amdgcn_mfma_f32_16x16x32_bf16(bf[ni], af[mi], acc[mi][ni], 0, 0, 0);
        __builtin_amdgcn_sched_barrier(0);
        asm volatile("s_waitcnt lgkmcnt(0)" ::: "memory");
        __builtin_amdgcn_sched_barrier(0);
#pragma unroll
        for (int mi = 4; mi < 8; ++mi)
#pragma unroll
            for (int ni = 0; ni < 4; ++ni) acc[mi][ni] = __builtin_amdgcn_mfma_f32_16x16x32_bf16(bf[ni], af[mi], acc[mi][ni], 0, 0, 0);
        __builtin_amdgcn_sched_barrier(0);
        if (kt + 2 < 32) asm volatile("s_waitcnt vmcnt(6)" ::: "memory");
        else asm volatile("s_waitcnt vmcnt(0)" ::: "memory");
        __builtin_amdgcn_s_barrier();
        st = st == 2 ? 0 : st + 1;
        st2 = st2 == 2 ? 0 : st2 + 1;
    }
    if (MODE == 0) {
        gemm_epilogue<0, 8, 1>(p, layer, m0 + wm * 128, n0 + wn * 64, acc, fr, fq, smem, m0, n0);
        __syncthreads();
        u32x4 cv[16];
#pragma unroll
        for (int i = 0; i < 16; ++i) { const int e = tid + 256 * i; cv[i] = *(const u32x4*)(smem + (e >> 4) * 272 + (e & 15) * 16); }
#pragma unroll
        for (int i = 0; i < 16; ++i) { const int e = tid + 256 * i; *(u32x4*)(p.proj + (size_t)(m0 + (e >> 4)) * INW + n0 + (e & 15) * 8) = cv[i]; }
        __syncthreads();
    } else {
        {
            const int v = m0 < NCTX ? 0 : 1 + ((m0 - NCTX) >> 11);
            const float* gate = p.modv + (size_t)(layer * 5 + v) * 3072 + 2048 + n0 + wn * 64 + fq * 4;
            f32x4 gt[4];
#pragma unroll
            for (int ni = 0; ni < 4; ++ni) gt[ni] = *(const f32x4*)(gate + ni * 16);
#pragma unroll
            for (int mi = 0; mi < 8; ++mi)
#pragma unroll
                for (int ni = 0; ni < 4; ++ni) {
                    const f32x4 g = gt[ni] * acc[mi][ni];
                    u32x2 w;
                    w.x = pk_bf16(g[0], g[1]);
                    w.y = pk_bf16(g[2], g[3]);
                    *(u32x2*)(smem + (wm * 128 + mi * 16 + fr) * 272 + (wn * 64 + ni * 16 + fq * 4) * 2) = w;
                }
        }
        __syncthreads();
        bf16_t* dst = layer == 0 ? p.h : p.xn;
#pragma unroll 1
        for (int hf = 0; hf < 2; ++hf) {
            f32x4 ha[8], hb[8];
            u32x4 hv[8];
#pragma unroll
            for (int i = 0; i < 8; ++i) {
                const int e = tid + 256 * (hf * 8 + i), tok = m0 + (e >> 4), c8 = (e & 15) * 8;
                if (layer == 0) {
                    const float* xp = (tok < NCTX ? p.x_prompt + (size_t)tok * DM : p.x_sample + (size_t)(tok - NCTX) * DM) + n0 + c8;
                    ha[i] = *(const f32x4*)xp;
                    hb[i] = *(const f32x4*)(xp + 4);
                } else {
                    hv[i] = *(const u32x4*)(p.h + (size_t)tok * DM + n0 + c8);
                }
            }
#pragma unroll
            for (int i = 0; i < 8; ++i) {
                const int e = tid + 256 * (hf * 8 + i), tok = m0 + (e >> 4), c8 = (e & 15) * 8;
                float g[8], o[8];
                unpack8(*(const u32x4*)(smem + (e >> 4) * 272 + (e & 15) * 16), g);
                if (layer == 0) {
#pragma unroll
                    for (int q = 0; q < 4; ++q) { o[q] = ha[i][q]; o[4 + q] = hb[i][q]; }
                } else {
                    unpack8(hv[i], o);
                }
                u32x4 w;
                w.x = pk_bf16(o[0] + g[0], o[1] + g[1]);
                w.y = pk_bf16(o[2] + g[2], o[3] + g[3]);
                w.z = pk_bf16(o[4] + g[4], o[5] + g[5]);
                w.w = pk_bf16(o[6] + g[6], o[7] + g[7]);
                *(u32x4*)(dst + (size_t)tok * DM + n0 + c8) = w;
            }
        }
        __syncthreads();
    }
}

__device__ __forceinline__ void gemm_piece64_dma(const Params& p, int layer, int m0, int n0, unsigned char* smem) {
    const int tid = otid(), lane = tid & 63, wave = tid >> 6, wm = wave >> 1, wn = wave & 1;
    const int fr = lane & 15, fq = lane >> 4;
    const bf16_t* A = p.xn + (size_t)m0 * 1024;
    const bf16_t* B = p.WinT + (size_t)layer * INW * 1024 + (size_t)n0 * 1024;
    f32x4 acc[2][4];
#pragma unroll
    for (int i = 0; i < 2; ++i)
#pragma unroll
        for (int j = 0; j < 4; ++j) acc[i][j] = (f32x4){0.f, 0.f, 0.f, 0.f};
    const int lrow = lane >> 2, lc = (lane & 3) ^ ((4 - ((lane >> 4) & 3)) & 3);
    const bf16_t* agp = A + (size_t)(wave * 16 + lrow) * 1024 + lc * 8;
    const bf16_t* bgp = B + (size_t)(wave * 32 + lrow) * 1024 + lc * 8;
    LAS unsigned char* lbase = (LAS unsigned char*)smem;
    const int la_off = wave * 1024 + lane * 16, lb_off = 4096 + wave * 2048 + lane * 16;
    auto dma = [&](int kt, int stage) {
        LAS unsigned char* sb = lbase + stage * 12288;
        __builtin_amdgcn_global_load_lds((const void*)(agp + kt * 32), (LAS void*)(sb + la_off), 16, 0, 0);
#pragma unroll
        for (int i = 0; i < 2; ++i)
            __builtin_amdgcn_global_load_lds((const void*)(bgp + (size_t)i * 16 * 1024 + kt * 32), (LAS void*)(sb + lb_off + i * 1024), 16, 0, 0);
    };
    dma(0, 0);
    dma(1, 1);
    asm volatile("s_waitcnt vmcnt(3)" ::: "memory");
    __builtin_amdgcn_s_barrier();
    const int co = (fq ^ ((4 - ((fr >> 2) & 3)) & 3)) * 16;
    const int aro = (wm * 32 + fr) * 64 + co, bro = 4096 + (wn * 64 + fr) * 64 + co;
    int st = 0, st2 = 2;
    const unsigned lds0 = (unsigned)(uintptr_t)lbase;
#pragma unroll 1
    for (int kt = 0; kt < 32; ++kt) {
        const unsigned sa = lds0 + st * 12288 + aro, sbb = lds0 + st * 12288 + bro;
        bf16x8 af[2], bf[4];
#define FRAG_RD(dst, addr, OFF) asm volatile("ds_read_b128 %0, %1 offset:" #OFF : "=&v"(dst) : "v"(addr))
        FRAG_RD(bf[0], sbb, 0); FRAG_RD(bf[1], sbb, 1024); FRAG_RD(bf[2], sbb, 2048); FRAG_RD(bf[3], sbb, 3072);
        FRAG_RD(af[0], sa, 0); FRAG_RD(af[1], sa, 1024);
#undef FRAG_RD
        __builtin_amdgcn_sched_barrier(0);
        if (kt + 2 < 32) dma(kt + 2, st2);
        __builtin_amdgcn_sched_barrier(0);
        asm volatile("s_waitcnt lgkmcnt(0)" ::: "memory");
        __builtin_amdgcn_sched_barrier(0);
#pragma unroll
        for (int mi = 0; mi < 2; ++mi)
#pragma unroll
            for (int ni = 0; ni < 4; ++ni) acc[mi][ni] = __builtin_amdgcn_mfma_f32_16x16x32_bf16(bf[ni], af[mi], acc[mi][ni], 0, 0, 0);
        __builtin_amdgcn_sched_barrier(0);
        if (kt + 2 < 32) asm volatile("s_waitcnt vmcnt(3)" ::: "memory");
        else asm volatile("s_waitcnt vmcnt(0)" ::: "memory");
        __builtin_amdgcn_s_barrier();
        st = st == 2 ? 0 : st + 1;
        st2 = st2 == 2 ? 0 : st2 + 1;
    }
    gemm_epilogue<0, 2, 1>(p, layer, m0 + wm * 32, n0 + wn * 64, acc, fr, fq, smem, m0, n0);
    __syncthreads();
    u32x4 cv[4];
#pragma unroll
    for (int i = 0; i < 4; ++i) { const int e = tid + 256 * i; cv[i] = *(const u32x4*)(smem + (e >> 4) * 272 + (e & 15) * 16); }
#pragma unroll
    for (int i = 0; i < 4; ++i) { const int e = tid + 256 * i; *(u32x4*)(p.proj + (size_t)(m0 + (e >> 4)) * INW + n0 + (e & 15) * 8) = cv[i]; }
    __syncthreads();
}

template <int MODE>
__device__ __forceinline__ void phase_gemm(const Params& p, int layer, unsigned char* smem) {
    const int NT = MODE == 0 ? 22 : 8;
    const int total = 96 * NT;
    if (gridDim.x == 512) {
        const int xcd = blockIdx.x & 7, slot = blockIdx.x >> 3;
        if (MODE == 0) {
            if (slot < 16) {
                __builtin_amdgcn_s_setprio(3);
                gemm_piece64_dma(p, layer, (xcd * 6 + 2 + (slot >> 2)) * 256 + (slot & 3) * 64, 21 * 128, smem);
            }
            for (int idx = slot; idx < 128; idx += 64) gemm_tile256_dma<MODE>(p, layer, xcd * 6 + idx % 6, idx / 6, smem);
            __builtin_amdgcn_s_setprio(0);
        } else {
            if (slot < 32) {
                __builtin_amdgcn_s_setprio(3);
                gemm_tile256_dma<MODE>(p, layer, xcd * 6 + slot % 6, slot / 6, smem);
                __builtin_amdgcn_s_setprio(0);
            }
            else {
                const int d = 32 + ((slot - 32) >> 1);
                gemm_tile<MODE>(p, layer, (xcd * 6 + d % 6) * 2 + (slot & 1), d / 6, smem);
            }
        }
    } else {
        for (int t = blockIdx.x; t < total; t += gridDim.x) gemm_tile<MODE>(p, layer, t / NT, t % NT, smem);
    }
}

template <int VAR>
__device__ __forceinline__ void attn_unit(const Params& p, int layer, int unit, unsigned char* smem) {
    const int tid = otid(), lane = tid & 63, wave = tid >> 6;
    const int r31 = lane & 31, hh = lane >> 5;
    int b, head, qblk, tokbase, nself, ntiles;
    if (unit < 512) { b = unit >> 7; head = (unit >> 4) & 7; qblk = unit & 15; tokbase = NCTX + b * 2048; nself = 2048; ntiles = 36; }
    else { const int u = unit - 512; b = u >> 4; head = (u >> 1) & 7; qblk = u & 1; tokbase = b * 256; nself = 256; ntiles = 4; }
    const int kvh = head >> 2;
    const int qtok = tokbase + qblk * 128 + wave * 32 + r31;
    bf16x8 qf[4];
    {
        const bf16_t* qp = p.proj + (size_t)qtok * INW + head * 64 + hh * 8;
#pragma unroll
        for (int ks = 0; ks < 4; ++ks) qf[ks] = *(const bf16x8*)(qp + ks * 16);
    }
    const bf16_t* kself = p.proj + (size_t)tokbase * INW + 512 + kvh * 64;
    const bf16_t* vself = p.proj + (size_t)tokbase * INW + 640 + kvh * 64;
    const bf16_t* kcache = p.kc + (size_t)((b * 2 + layer) * 2 + kvh) * 256 * 64;
    const bf16_t* vcache = p.vc + (size_t)((b * 2 + layer) * 2 + kvh) * 256 * 64;
    const int srow = tid >> 3, scc = tid & 7;
    const int kwo = srow * 128 + ((scc ^ ((srow >> 1) & 7)) * 16);
    const int vwo = srow * 128 + ((scc ^ (((srow >> 1) & 1) << 2)) * 16);
    u32x4 rkA[2], rvA[2], rkB[2], rvB[2];
    auto gload = [&](int j, u32x4* rk, u32x4* rv) {
        const int key0 = j * 64;
#pragma unroll
        for (int i = 0; i < 2; ++i) {
            const int row = srow + 32 * i;
            if (key0 < nself) {
                rk[i] = *(const u32x4*)(kself + (size_t)(key0 + row) * INW + scc * 8);
                rv[i] = *(const u32x4*)(vself + (size_t)(key0 + row) * INW + scc * 8);
            } else {
                rk[i] = *(const u32x4*)(kcache + (size_t)(key0 - nself + row) * 64 + scc * 8);
                rv[i] = *(const u32x4*)(vcache + (size_t)(key0 - nself + row) * 64 + scc * 8);
            }
        }
    };
    auto swrite = [&](int buf, const u32x4* rk, const u32x4* rv) {
        unsigned char* kb = smem + buf * 16384;
        unsigned char* vb = kb + 8192;
#pragma unroll
        for (int i = 0; i < 2; ++i) {
            *(u32x4*)(kb + kwo + i * 32 * 128) = rk[i];
            *(u32x4*)(vb + vwo + i * 32 * 128) = rv[i];
        }
    };
    f32x16 o[2];
#pragma unroll
    for (int i = 0; i < 16; ++i) { o[0][i] = 0.f; o[1][i] = 0.f; }
    float mrun = 0.f, mmax = -1e30f, lrun = 0.f;
    f32x16 negm, zero16;
#pragma unroll
    for (int i = 0; i < 16; ++i) { negm[i] = 0.f; zero16[i] = 0.f; }
    bool shifted = false;
    gload(0, rkA, rvA);
    swrite(0, rkA, rvA);
    if (ntiles > 1) gload(1, rkB, rvB);
    __syncthreads();
    const int kro = r31 * 128, ksw = (r31 >> 1) & 7;
    const int vq = 4 * hh + ((lane & 15) >> 2);
    const int vsw = ((vq >> 1) & 1) << 2;
    const int vcl = ((lane >> 4) & 1) * 2 + ((lane & 3) >> 1);
    const int vro0 = vq * 128 + (((0 * 4 + vcl) ^ vsw) * 16) + (lane & 1) * 8;
    const int vro1 = vq * 128 + (((1 * 4 + vcl) ^ vsw) * 16) + (lane & 1) * 8;
    auto step = [&](int j, u32x4* lk, u32x4* lv, const u32x4* wk, const u32x4* wv) {
        const unsigned char* kb = smem + (j & 1) * 16384;
        const unsigned char* vb = kb + 8192;
        bf16x8 kf[2][4];
#pragma unroll
        for (int sb = 0; sb < 2; ++sb)
#pragma unroll
            for (int ks = 0; ks < 4; ++ks) kf[sb][ks] = *(const bf16x8*)(kb + sb * 4096 + kro + (((ks * 2 + hh) ^ ksw) * 16));
        bf16x8 vf[2][2][2];
#pragma unroll
        for (int sb = 0; sb < 2; ++sb)
#pragma unroll
            for (int s2 = 0; s2 < 2; ++s2)
#pragma unroll
                for (int dt = 0; dt < 2; ++dt) {
                    const LAS unsigned char* va = (const LAS unsigned char*)(vb) + (sb * 32 + s2 * 16) * 128 + (dt ? vro1 : vro0);
                    const s16x4 a0 = __builtin_amdgcn_ds_read_tr16_b64_v4i16((LAS s16x4*)(va));
                    const s16x4 a1 = __builtin_amdgcn_ds_read_tr16_b64_v4i16((LAS s16x4*)(va + 8 * 128));
                    vf[sb][s2][dt] = (bf16x8){a0[0], a0[1], a0[2], a0[3], a1[0], a1[1], a1[2], a1[3]};
                }
        if (VAR != 1 && j + 2 < ntiles) gload(j + 2, lk, lv);
        __builtin_amdgcn_sched_barrier(0);
        f32x16 s[2];
        float mloc, lsum = 0.f;
        bf16x8 pf[2][2];
#pragma unroll
        for (int sb = 0; sb < 2; ++sb)
#pragma unroll
            for (int ks = 0; ks < 4; ++ks) {
                if (ks == 0) {
                    if (shifted) s[sb] = __builtin_amdgcn_mfma_f32_32x32x16_bf16(kf[sb][ks], qf[ks], negm, 0, 0, 0);
                    else s[sb] = __builtin_amdgcn_mfma_f32_32x32x16_bf16(kf[sb][ks], qf[ks], zero16, 0, 0, 0);
                } else s[sb] = __builtin_amdgcn_mfma_f32_32x32x16_bf16(kf[sb][ks], qf[ks], s[sb], 0, 0, 0);
            }
#pragma unroll
        for (int sb = 0; sb < 2; ++sb) {
            float m0 = max3_f(s[sb][0], s[sb][1], s[sb][2]);
#pragma unroll
            for (int i = 3; i < 15; i += 2) m0 = max3_f(m0, s[sb][i], s[sb][i + 1]);
            m0 = fmaxf(m0, s[sb][15]);
            mloc = sb == 0 ? m0 : fmaxf(mloc, m0);
#pragma unroll
            for (int i = 0; i < 16; ++i) { if (VAR != 2) { s[sb][i] = __builtin_amdgcn_exp2f(s[sb][i]); lsum += s[sb][i]; } }
#pragma unroll
            for (int s2 = 0; s2 < 2; ++s2) {
                u32x4 pw;
                pw.x = pk_bf16(s[sb][s2 * 8 + 0], s[sb][s2 * 8 + 1]);
                pw.y = pk_bf16(s[sb][s2 * 8 + 2], s[sb][s2 * 8 + 3]);
                pw.z = pk_bf16(s[sb][s2 * 8 + 4], s[sb][s2 * 8 + 5]);
                pw.w = pk_bf16(s[sb][s2 * 8 + 6], s[sb][s2 * 8 + 7]);
                pf[sb][s2] = __builtin_bit_cast(bf16x8, pw);
            }
#pragma unroll
            for (int s2 = 0; s2 < 2; ++s2)
#pragma unroll
                for (int dt = 0; dt < 2; ++dt) o[dt] = __builtin_amdgcn_mfma_f32_32x32x16_bf16(vf[sb][s2][dt], pf[sb][s2], o[dt], 0, 0, 0);
        }
        lrun += lsum;
        __builtin_amdgcn_sched_barrier(0);
        mloc = fmaxf(mloc, __shfl_xor(mloc, 32));
        mmax = fmaxf(mmax, mrun + mloc);
        if (__builtin_expect(__any(fabsf(mmax - mrun) > 40.0f), 0)) {
            asm volatile("" ::: "memory");
            const float alpha = __builtin_amdgcn_exp2f(mrun - mmax);
            mrun = mmax;
            lrun *= alpha;
            shifted = true;
#pragma unroll
            for (int i = 0; i < 16; ++i) { o[0][i] *= alpha; o[1][i] *= alpha; negm[i] = -mrun; }
        }
        if (VAR != 1 && j + 1 < ntiles) swrite((j + 1) & 1, wk, wv);
        __syncthreads();
    };
    for (int j = 0; j < ntiles - 2; j += 2) {
        step(j, rkA, rvA, rkB, rvB);
        step(j + 1, rkB, rvB, rkA, rvA);
    }
    const bf16_t* zp = p.proj + (size_t)qtok * INW + 768 + head * 64;
    u32x2 zq[2][4];
#pragma unroll
    for (int dt = 0; dt < 2; ++dt)
#pragma unroll
        for (int rq = 0; rq < 4; ++rq) zq[dt][rq] = *(const u32x2*)(zp + dt * 32 + 8 * rq + 4 * hh);
    step(ntiles - 2, rkA, rvA, rkB, rvB);
    step(ntiles - 1, rkB, rvB, rkA, rvA);
    const float ltot = lrun + __shfl_xor(lrun, 32);
    const float inv = 1.0f / ltot;
    bf16_t* mp = (VAR == 0 ? p.mix : p.xn) + (size_t)qtok * DM + head * 64;
#pragma unroll
    for (int dt = 0; dt < 2; ++dt)
#pragma unroll
        for (int rq = 0; rq < 4; ++rq) {
            const int d0 = dt * 32 + 8 * rq + 4 * hh;
            const u32x2 zz = zq[dt][rq];
            const float z0 = bf_lo(zz.x), z1 = bf_hi(zz.x), z2 = bf_lo(zz.y), z3 = bf_hi(zz.y);
            u32x2 w;
            w.x = pk_bf16(o[dt][rq * 4 + 0] * inv * silu_f(z0), o[dt][rq * 4 + 1] * inv * silu_f(z1));
            w.y = pk_bf16(o[dt][rq * 4 + 2] * inv * silu_f(z2), o[dt][rq * 4 + 3] * inv * silu_f(z3));
            *(u32x2*)(mp + d0) = w;
        }
}


template <int WIN>
__device__ __forceinline__ void pool_group(const Params& p, int layer, int T0, int toff, int seqlen, int gi, int fr, int fq, const bf16x8 (&wf)[4][2],
                                           const f32x4 (&ps)[4], const unsigned char* smem) {
    constexpr int HALF = WIN / 2;
    u32x2 zz[2][4];
#pragma unroll
    for (int mi = 0; mi < 2; ++mi)
#pragma unroll
        for (int ni = 0; ni < 4; ++ni) zz[mi][ni] = *(const u32x2*)(p.proj + (size_t)(T0 + mi * 16 + fr) * INW + 2560 + gi * 64 + ni * 16 + fq * 4);
#pragma unroll
    for (int mi = 0; mi < 2; ++mi) {
        const int tt = mi * 16 + fr, ts = toff + tt, tok = T0 + tt;
        int lo = ts - HALF, hi = ts - HALF + WIN - 1;
        lo = lo < 0 ? 0 : lo;
        hi = hi > seqlen - 1 ? seqlen - 1 : hi;
        const float rc = 1.0f / (float)(hi - lo + 1);
        f32x4 acc[4];
#pragma unroll
        for (int j = 0; j < 4; ++j) acc[j] = (f32x4){0.f, 0.f, 0.f, 0.f};
#pragma unroll
        for (int kk = 0; kk < 2; ++kk) {
            const int co = (gi * 64 + kk * 32 + fq * 8) * 2;
            u32x4 rw[WIN];
#pragma unroll
            for (int j = 0; j < WIN; ++j) rw[j] = *(const u32x4*)(smem + (tt + 8 - HALF + j) * 528 + co);
            const u32x4 self = *(const u32x4*)(smem + (tt + 8) * 528 + co);
            float sum[8];
#pragma unroll
            for (int e = 0; e < 8; ++e) sum[e] = 0.f;
#pragma unroll
            for (int j = 0; j < WIN; ++j) {
                const int sq = ts - HALF + j;
                const float m = (sq >= 0 && sq < seqlen) ? 1.0f : 0.0f;
                float f[8];
                unpack8(rw[j], f);
#pragma unroll
                for (int e = 0; e < 8; ++e) sum[e] = fmaf(f[e], m, sum[e]);
            }
            float us[8];
            unpack8(self, us);
            u32x4 dw;
            dw.x = pk_bf16(sum[0] * rc - us[0], sum[1] * rc - us[1]);
            dw.y = pk_bf16(sum[2] * rc - us[2], sum[3] * rc - us[3]);
            dw.z = pk_bf16(sum[4] * rc - us[4], sum[5] * rc - us[5]);
            dw.w = pk_bf16(sum[6] * rc - us[6], sum[7] * rc - us[7]);
            const bf16x8 df = __builtin_bit_cast(bf16x8, dw);
#pragma unroll
            for (int ni = 0; ni < 4; ++ni) acc[ni] = __builtin_amdgcn_mfma_f32_16x16x32_bf16(wf[ni][kk], df, acc[ni], 0, 0, 0);
        }
#pragma unroll
        for (int ni = 0; ni < 4; ++ni) {
            const int ch = gi * 64 + ni * 16 + fq * 4;
            u32x2 w;
            w.x = pk_bf16(acc[ni][0] * ps[ni][0] * silu_f(bf_lo(zz[mi][ni].x)), acc[ni][1] * ps[ni][1] * silu_f(bf_hi(zz[mi][ni].x)));
            w.y = pk_bf16(acc[ni][2] * ps[ni][2] * silu_f(bf_lo(zz[mi][ni].y)), acc[ni][3] * ps[ni][3] * silu_f(bf_hi(zz[mi][ni].y)));
            *(u32x2*)(p.mix + (size_t)tok * DM + 768 + ch) = w;
        }
    }
}

__device__ __forceinline__ void pool_item(const Params& p, int layer, int pi, unsigned char* smem) {
    const int tid = otid(), lane = tid & 63, gi = tid >> 6;
    const int fr = lane & 15, fq = lane >> 4;
    const int T0 = pi * 32;
    int seqstart, seqlen;
    if (T0 < NCTX) { seqstart = T0 & ~255; seqlen = 256; } else { seqstart = NCTX + ((T0 - NCTX) & ~2047); seqlen = 2048; }
    const int toff = T0 - seqstart;
    u32x4 st[6];
#pragma unroll
    for (int i = 0; i < 6; ++i) {
        const int e = tid + 256 * i, r = e >> 5, c = e & 31;
        int sq = toff - 8 + r;
        sq = sq < 0 ? 0 : (sq > seqlen - 1 ? seqlen - 1 : sq);
        if (e < 47 * 32) st[i] = *(const u32x4*)(p.proj + (size_t)(seqstart + sq) * INW + 2304 + c * 8);
    }
    bf16x8 wf[4][2];
    f32x4 ps[4];
    {
        const bf16_t* wp = p.PoolT + (size_t)((layer * 4 + gi) * 64) * 64;
#pragma unroll
        for (int ni = 0; ni < 4; ++ni) {
#pragma unroll
            for (int kk = 0; kk < 2; ++kk) wf[ni][kk] = *(const bf16x8*)(wp + (ni * 16 + fr) * 64 + kk * 32 + fq * 8);
            ps[ni] = *(const f32x4*)(p.pool_scale + layer * 256 + gi * 64 + ni * 16 + fq * 4);
        }
    }
#pragma unroll
    for (int i = 0; i < 6; ++i) {
        const int e = tid + 256 * i, r = e >> 5, c = e & 31;
        if (e < 47 * 32) *(u32x4*)(smem + r * 528 + c * 16) = st[i];
    }
    __syncthreads();
    if (gi == 0) pool_group<2>(p, layer, T0, toff, seqlen, gi, fr, fq, wf, ps, smem);
    else if (gi == 1) pool_group<4>(p, layer, T0, toff, seqlen, gi, fr, fq, wf, ps, smem);
    else if (gi == 2) pool_group<8>(p, layer, T0, toff, seqlen, gi, fr, fq, wf, ps, smem);
    else pool_group<16>(p, layer, T0, toff, seqlen, gi, fr, fq, wf, ps, smem);
    __syncthreads();
}

__device__ __forceinline__ void conv_item(const Params& p, int layer, int ci) {
    const int tid = otid();
    const int ch = (tid & 31) * 8, tg = tid >> 5;
    const int T0 = ci * 32 + tg * 4;
    int seqstart, seqlen;
    if (T0 < NCTX) { seqstart = T0 & ~255; seqlen = 256; } else { seqstart = NCTX + ((T0 - NCTX) & ~2047); seqlen = 2048; }
    const int seqend = seqstart + seqlen;
    u32x4 rh[6], rc[6], rb[4], rz[4];
#pragma unroll
    for (int i = 0; i < 6; ++i) {
        int tok = T0 - 1 + i;
        tok = tok < seqstart ? seqstart : (tok > seqend - 1 ? seqend - 1 : tok);
        rh[i] = *(const u32x4*)(p.proj + (size_t)tok * INW + 1280 + ch);
        rc[i] = *(const u32x4*)(p.proj + (size_t)tok * INW + 1792 + ch);
    }
#pragma unroll
    for (int i = 0; i < 4; ++i) {
        rb[i] = *(const u32x4*)(p.proj + (size_t)(T0 + i) * INW + 1536 + ch);
        rz[i] = *(const u32x4*)(p.proj + (size_t)(T0 + i) * INW + 2048 + ch);
    }
    f32x4 wv[8];
    {
        const float* cw = p.conv_w + (size_t)layer * 768 + ch;
#pragma unroll
        for (int r = 0; r < 3; ++r) { wv[r * 2] = *(const f32x4*)(cw + r * 256); wv[r * 2 + 1] = *(const f32x4*)(cw + r * 256 + 4); }
        wv[6] = *(const f32x4*)(p.conv_b + layer * 256 + ch);
        wv[7] = *(const f32x4*)(p.conv_b + layer * 256 + ch + 4);
    }
    float x[6][8];
#pragma unroll
    for (int i = 0; i < 6; ++i) {
        const int tok = T0 - 1 + i;
        const float valid = (tok >= seqstart && tok < seqend) ? 1.0f : 0.0f;
        float hc[8], cc[8];
        unpack8(rh[i], hc);
        unpack8(rc[i], cc);
#pragma unroll
        for (int e = 0; e < 8; ++e) x[i][e] = hc[e] * cc[e] * valid;
    }
#pragma unroll
    for (int t = 0; t < 4; ++t) {
        float bc[8], zc[8], o[8];
        unpack8(rb[t], bc);
        unpack8(rz[t], zc);
#pragma unroll
        for (int e = 0; e < 8; ++e) {
            const float y = x[t][e] * wv[e >> 2][e & 3] + x[t + 1][e] * wv[2 + (e >> 2)][e & 3] + x[t + 2][e] * wv[4 + (e >> 2)][e & 3] + wv[6 + (e >> 2)][e & 3];
            o[e] = bc[e] * y * silu_f(zc[e]);
        }
        u32x4 w;
        w.x = pk_bf16(o[0], o[1]); w.y = pk_bf16(o[2], o[3]); w.z = pk_bf16(o[4], o[5]); w.w = pk_bf16(o[6], o[7]);
        *(u32x4*)(p.mix + (size_t)(T0 + t) * DM + 512 + ch) = w;
    }
}

__device__ __forceinline__ void phase_mixer(const Params& p, int layer, unsigned char* smem) {
    if (gridDim.x == 512) {
        const int b = blockIdx.x;
        if (b >= 256) __builtin_amdgcn_s_setprio(2);
        if (b < 256) {
            const int xcd = b & 7, slot = b >> 3;
            attn_unit<0>(p, layer, 512 + ((((xcd << 1) | (slot >> 4)) << 4) | (slot & 15)), smem);
        }
        {
            const int xcd = b & 7, slot = b >> 3;
            attn_unit<0>(p, layer, ((xcd >> 1) << 7) | ((((xcd & 1) << 2) | (slot >> 4)) << 4) | (slot & 15), smem);
        }
        if (b >= 256) {
#pragma unroll 1
            for (int k = 0; k < 3; ++k) {
                const int idx = (b - 256) + 256 * k;
                if (idx < 384) pool_item(p, layer, idx, smem);
                else conv_item(p, layer, idx - 384);
            }
        }
        __builtin_amdgcn_s_setprio(0);
    } else {
        for (int it = blockIdx.x; it < 768 + 384 + 384; it += gridDim.x) {
            if (it < 768) attn_unit<0>(p, layer, it, smem);
            else if (it < 1152) pool_item(p, layer, it - 768, smem);
            else conv_item(p, layer, it - 1152);
        }
    }
}

__global__ void __launch_bounds__(256, 2) mega(Params p, int lo, int hi) {
    __shared__ __attribute__((aligned(16))) unsigned char smem[73728];
    __shared__ uint4 xbw;
    if (p.use_cg) cg::this_grid().sync();
    if (threadIdx.x == 0) xbw = make_uint4(0u, 0u, 0u, 0u);
    __syncthreads();
    XcdBarrier xb = xcd_barrier_post(p.bar, (volatile LAS unsigned*)&xbw);
    for (int ph = lo; ph < hi; ++ph) {
        if (ph > lo) xcd_barrier(xb);
        if (ph == 0) phase_prep(p, smem);
        else if (ph == 9) phase_final(p);
        else {
            const int layer = (ph - 1) >> 2, ty = (ph - 1) & 3;
            if (ty == 0) phase_xn(p, layer);
            else if (ty == 1) phase_gemm<0>(p, layer, smem);
            else if (ty == 2) phase_mixer(p, layer, smem);
            else phase_gemm<1>(p, layer, smem);
        }
    }
}

#ifndef MK_MULTI
#define MK_MULTI 0
#endif

extern "C" void kernel_launch(void* const* d_in, const int* in_sizes, int n_in, void* d_out, int out_size, void* d_ws, size_t ws_size,
                              hipStream_t stream) {
    static int grid_blocks = 0;
    if (!grid_blocks) {
        int dev = 0, cus = 0, per_cu = 0;
        hipGetDevice(&dev);
        hipDeviceGetAttribute(&cus, hipDeviceAttributeMultiprocessorCount, dev);
        hipOccupancyMaxActiveBlocksPerMultiprocessor(&per_cu, mega, 256, 0);
        if (per_cu > 2) per_cu = 2;
        if (per_cu < 1) per_cu = 1;
        grid_blocks = cus * per_cu;
    }
    Params p{};
    const float* const* in = (const float* const*)d_in;
    p.x_prompt = in[0]; p.x_sample = in[1]; p.cache_k = in[2]; p.cache_v = in[3]; p.c = in[4]; p.c_ctx = in[5]; p.norm_g = in[6];
    p.w_ada = in[7]; p.b_ada = in[8]; p.w_in = in[9]; p.q_g = in[10]; p.k_g = in[11]; p.conv_w = in[12]; p.conv_b = in[13];
    p.pool_w = in[14]; p.pool_scale = in[15]; p.w_out = in[16]; p.final_g = in[17];
    p.out = (float*)d_out;
    unsigned char* ws = (unsigned char*)d_ws;
    size_t off = 0;
    auto take = [&](size_t bytes) { unsigned char* r = ws + off; off += (bytes + 255) & ~(size_t)255; return r; };
    p.bar = (unsigned*)take(XCD_BAR_WORDS * 4);
    p.modv = (float*)take(2 * 5 * 3072 * 4);
    p.rope = (float*)take(2048 * 4);
    p.WinT = (bf16_t*)take((size_t)2 * INW * 1024 * 2);
    p.WoutT = (bf16_t*)take((size_t)2 * 1024 * 1024 * 2);
    p.PoolT = (bf16_t*)take(2 * 4 * 64 * 64 * 2);
    p.kc = (bf16_t*)take(262144 * 2);
    p.vc = (bf16_t*)take(262144 * 2);
    p.h = (bf16_t*)take((size_t)NTOK * DM * 2);
    p.xn = (bf16_t*)take((size_t)NTOK * DM * 2);
    p.proj = (bf16_t*)take((size_t)NTOK * INW * 2);
    p.mix = (bf16_t*)take((size_t)NTOK * DM * 2);
    p.use_cg = 0;
    p.pad = 0;
    hipMemsetAsync(p.bar, 0, XCD_BAR_WORDS * 4, stream);
#if MK_MULTI
    for (int ph = 0; ph < 10; ++ph) {
        int lo = ph, hi = ph + 1;
        void* args[] = {&p, &lo, &hi};
        hipError_t e = hipLaunchCooperativeKernel((void*)mega, dim3(grid_blocks), dim3(256), args, 0, stream);
        if (e != hipSuccess) fprintf(stderr, "launch failed: %s\n", hipGetErrorString(e));
    }
#else
    int lo = 0, hi = 10;
    void* args[] = {&p, &lo, &hi};
    hipError_t e = hipLaunchCooperativeKernel((void*)mega, dim3(grid_blocks), dim3(256), args, 0, stream);
    if (e != hipSuccess) fprintf(stderr, "cooperative launch failed: %s (grid %d)\n", hipGetErrorString(e), grid_blocks);
#endif
}
```

```cpp
#include <hip/hip_runtime.h>
#include <hip/hip_cooperative_groups.h>
#include <cstdint>
#include <cstdio>
namespace cg = cooperative_groups;

#define LAS __attribute__((address_space(3)))
typedef unsigned short bf16_t;
typedef short bf16x8 __attribute__((ext_vector_type(8)));
typedef short s16x4 __attribute__((ext_vector_type(4)));
typedef float f32x4 __attribute__((ext_vector_type(4)));
typedef float f32x16 __attribute__((ext_vector_type(16)));
typedef unsigned u32x4 __attribute__((ext_vector_type(4)));
typedef unsigned u32x2 __attribute__((ext_vector_type(2)));

constexpr int NTOK = 12288, NCTX = 4096, DM = 1024, INW = 2816;
constexpr size_t OUT_NK = 12582912, OUT_NV = 13631488;
constexpr float EPSF = 1e-6f;
constexpr float QSCALE = 0.125f * 1.4426950408889634f;

struct Params {
    const float *x_prompt, *x_sample, *cache_k, *cache_v, *c, *c_ctx, *norm_g, *w_ada, *b_ada, *w_in, *q_g, *k_g, *conv_w, *conv_b,
        *pool_w, *pool_scale, *w_out, *final_g;
    float* out;
    unsigned* bar;
    float* modv;
    float* rope;
    bf16_t* WinT;
    bf16_t* WoutT;
    bf16_t* PoolT;
    bf16_t* kc;
    bf16_t* vc;
    bf16_t* h;
    bf16_t* xn;
    bf16_t* proj;
    bf16_t* mix;
    int use_cg;
    int pad;
};

__device__ __forceinline__ unsigned pk_bf16(float lo, float hi) {
    unsigned r;
    asm("v_cvt_pk_bf16_f32 %0, %1, %2" : "=v"(r) : "v"(lo), "v"(hi));
    return r;
}
__device__ __forceinline__ float bf_lo(unsigned u) { return __uint_as_float(u << 16); }
__device__ __forceinline__ float bf_hi(unsigned u) { return __uint_as_float(u & 0xffff0000u); }
__device__ __forceinline__ float silu_f(float z) { return z / (1.0f + __expf(-z)); }
__device__ __forceinline__ f32x4 bf4_to_f32(const u32x2 u) { return (f32x4){bf_lo(u.x), bf_hi(u.x), bf_lo(u.y), bf_hi(u.y)}; }
__device__ __forceinline__ void unpack8(const u32x4 u, float* f) {
    f[0] = bf_lo(u.x); f[1] = bf_hi(u.x); f[2] = bf_lo(u.y); f[3] = bf_hi(u.y);
    f[4] = bf_lo(u.z); f[5] = bf_hi(u.z); f[6] = bf_lo(u.w); f[7] = bf_hi(u.w);
}
__device__ __forceinline__ float max3_f(float a, float b, float c) { float r; asm("v_max3_f32 %0, %1, %2, %3" : "=v"(r) : "v"(a), "v"(b), "v"(c)); return r; }
__device__ __forceinline__ int otid() { int t = threadIdx.x; asm volatile("" : "+v"(t)); return t; }

#define XB_TMO 128
#define XB_XCNT(j) (256 + 64 * (j))
#define XB_XSUB(j) (1280 + 64 * (j))
#define XB_XGEN(j) (2304 + 64 * (j))
#define XB_TOP 3328
#define XB_TOPGEN 3392
#define XCD_BAR_WORDS 3456
#define XB_SPIN_CAP (1u << 20)

__device__ __forceinline__ unsigned xb_ld(unsigned* p) { return __hip_atomic_load(p, __ATOMIC_RELAXED, __HIP_MEMORY_SCOPE_AGENT); }
__device__ __forceinline__ unsigned xb_add(unsigned* p, unsigned v) { return __hip_atomic_fetch_add(p, v, __ATOMIC_RELAXED, __HIP_MEMORY_SCOPE_AGENT); }
__device__ __forceinline__ unsigned xb_xcc_id() { return (unsigned)__builtin_amdgcn_s_getreg((3 << 11) | 20) & 0xFu; }
#define XB_SPIN(cond, bar)                                                   \
    do {                                                                     \
        unsigned _sp = 0;                                                    \
        while (cond) {                                                       \
            __builtin_amdgcn_s_sleep(1);                                     \
            if ((++_sp & 255u) == 0u) {                                      \
                if (xb_ld(&(bar)[XB_TMO])) break;                            \
                if (_sp > XB_SPIN_CAP) { atomicAdd(&(bar)[XB_TMO], 1u); break; } \
            }                                                                \
        }                                                                    \
    } while (0)

struct XcdBarrier {
    unsigned* bar;
    unsigned x;
    volatile LAS unsigned* st;
};

__device__ __forceinline__ XcdBarrier xcd_barrier_post(unsigned* bar, volatile LAS unsigned* st) {
    XcdBarrier b;
    b.bar = bar;
    b.x = xb_xcc_id();
    b.st = st;
    if (threadIdx.x == 0) (void)xb_add(&bar[XB_XCNT(b.x)], 1u);
    return b;
}
__device__ __forceinline__ void xcd_barrier_complete(unsigned* bar, unsigned x, unsigned& nloc, unsigned& nx) {
    const unsigned G = gridDim.x * gridDim.y * gridDim.z;
    unsigned sum, cnt, mine, sp = 0u;
    for (;;) {
        sum = 0u; cnt = 0u; mine = 0u;
#pragma unroll
        for (unsigned j = 0; j < 16; ++j) {
            const unsigned c = xb_ld(&bar[XB_XCNT(j)]);
            sum += c; cnt += (c > 0u) ? 1u : 0u; mine = (j == x) ? c : mine;
        }
        if (sum == G) break;
        __builtin_amdgcn_s_sleep(1);
        if ((++sp & 255u) == 0u) {
            if (xb_ld(&bar[XB_TMO])) break;
            if (sp > XB_SPIN_CAP) { atomicAdd(&bar[XB_TMO], 1u); break; }
        }
    }
    nloc = mine > 0u ? mine : 1u;
    nx = cnt > 0u ? cnt : 1u;
}
__device__ __forceinline__ void xcd_barrier(const XcdBarrier& b) {
    asm volatile("s_waitcnt vmcnt(0)" ::: "memory");
    __syncthreads();
    if (threadIdx.x == 0) {
        unsigned* bar = b.bar;
        __builtin_amdgcn_s_waitcnt(0);
        unsigned nloc = b.st[0], nx = b.st[1];
        if (nloc == 0u) { xcd_barrier_complete(bar, b.x, nloc, nx); b.st[0] = nloc; b.st[1] = nx; }
        const unsigned old = xb_add(&bar[XB_XSUB(b.x)], 1u);
        const unsigned gen = old / nloc;
        if (old + 1u == (gen + 1u) * nloc) {
            __builtin_amdgcn_fence(__ATOMIC_RELEASE, "agent");
            asm volatile("s_waitcnt vmcnt(0)" ::: "memory");
            const unsigned og = xb_add(&bar[XB_TOP], 1u);
            const unsigned tg = og / nx;
            if (og + 1u == (tg + 1u) * nx) xb_add(&bar[XB_TOPGEN], 1u);
            else XB_SPIN(xb_ld(&bar[XB_TOPGEN]) == tg, bar);
            __builtin_amdgcn_fence(__ATOMIC_ACQUIRE, "agent");
            xb_add(&bar[XB_XGEN(b.x)], 1u);
            asm volatile("s_waitcnt vmcnt(0)" ::: "memory");
        } else {
            XB_SPIN(xb_ld(&bar[XB_XGEN(b.x)]) == gen, bar);
            __builtin_amdgcn_fence(__ATOMIC_ACQUIRE, "agent");
            asm volatile("s_waitcnt vmcnt(0)" ::: "memory");
        }
    }
    __syncthreads();
}

__device__ __forceinline__ void prep_mod_item(const Params& p, int item, unsigned char* smem) {
    const int tid = otid();
    float* sc = (float*)smem;
    float* red = (float*)(smem + 20480);
    const int l = item / 96, j0 = (item % 96) * 32;
    for (int idx = tid; idx < 5120; idx += 256) {
        const int v = idx >> 10, k = idx & 1023;
        const float cv = (v == 0) ? p.c_ctx[k] : p.c[(v - 1) * 1024 + k];
        sc[idx] = cv / (1.0f + expf(-cv));
    }
    __syncthreads();
    const int cgp = tid & 7, kg = tid >> 3;
    float acc[5][4];
#pragma unroll
    for (int v = 0; v < 5; ++v)
#pragma unroll
        for (int e = 0; e < 4; ++e) acc[v][e] = 0.f;
    const float* wp = p.w_ada + (size_t)l * 1024 * 3072 + j0 + cgp * 4;
    f32x4 wreg[32];
#pragma unroll
    for (int kk = 0; kk < 32; ++kk) wreg[kk] = *(const f32x4*)(wp + (size_t)(kk * 32 + kg) * 3072);
#pragma unroll
    for (int kk = 0; kk < 32; ++kk) {
        const int k = kk * 32 + kg;
        const f32x4 w = wreg[kk];
#pragma unroll
        for (int v = 0; v < 5; ++v) {
            const float s = sc[v * 1024 + k];
#pragma unroll
            for (int e = 0; e < 4; ++e) acc[v][e] += s * w[e];
        }
    }
#pragma unroll
    for (int v = 0; v < 5; ++v)
#pragma unroll
        for (int e = 0; e < 4; ++e) red[kg * 160 + v * 32 + cgp * 4 + e] = acc[v][e];
    __syncthreads();
    if (tid < 160) {
        float s = 0.f;
        for (int g = 0; g < 32; ++g) s += red[g * 160 + tid];
        const int v = tid >> 5, cc = tid & 31;
        p.modv[(size_t)(l * 5 + v) * 3072 + j0 + cc] = s + p.b_ada[l * 3072 + j0 + cc];
    }
    __syncthreads();
}

__device__ __forceinline__ void prep_transpose_item(const float* src, bf16_t* dst, int N, int k0, int n0) {
    const int n = n0 + otid();
    const float* sp = src + (size_t)k0 * N + n;
    float v[32];
#pragma unroll
    for (int i = 0; i < 32; ++i) v[i] = sp[(size_t)i * N];
    bf16_t* d = dst + (size_t)n * 1024 + k0;
#pragma unroll
    for (int c = 0; c < 4; ++c) {
        u32x4 w;
        w.x = pk_bf16(v[c * 8 + 0], v[c * 8 + 1]);
        w.y = pk_bf16(v[c * 8 + 2], v[c * 8 + 3]);
        w.z = pk_bf16(v[c * 8 + 4], v[c * 8 + 5]);
        w.w = pk_bf16(v[c * 8 + 6], v[c * 8 + 7]);
        *(u32x4*)(d + c * 8) = w;
    }
}

__device__ __forceinline__ void phase_prep(const Params& p, unsigned char* smem) {
    const int ntb = (int)gridDim.x * 5 / 8, nmb = (int)gridDim.x - ntb;
    const int NTI = 2 * 11 * 32, NTO = 2 * 4 * 32;
    if ((int)blockIdx.x < ntb) {
        for (int it = blockIdx.x; it < NTI + NTO; it += ntb) {
            if (it < NTI) {
                const int l = it / 352, r = it % 352, kt = r / 11, nt = r % 11;
                prep_transpose_item(p.w_in + (size_t)l * 1024 * INW, p.WinT + (size_t)l * INW * 1024, INW, kt * 32, nt * 256);
            } else {
                const int t = it - NTI, l = t / 128, r = t % 128, kt = r / 4, nt = r % 4;
                prep_transpose_item(p.w_out + (size_t)l * 1024 * 1024, p.WoutT + (size_t)l * 1024 * 1024, 1024, kt * 32, nt * 256);
            }
        }
    } else {
        for (int it = (int)blockIdx.x - ntb; it < 192; it += nmb) prep_mod_item(p, it, smem);
    }
    const int gsz = gridDim.x * 256;
    for (int i = blockIdx.x * 256 + otid(); i < 131072; i += gsz) {
        const int which = i >> 16, j4 = (i & 65535) * 4;
        const int d = j4 & 63, t = (j4 >> 6) & 255, kvh = (j4 >> 14) & 1, bl = j4 >> 15;
        const size_t si = ((size_t)(bl * 256 + t) * 2 + kvh) * 64 + d;
        const f32x4 v = *(const f32x4*)((which ? p.cache_v : p.cache_k) + si);
        u32x2 w;
        w.x = pk_bf16(v[0], v[1]);
        w.y = pk_bf16(v[2], v[3]);
        *(u32x2*)((which ? p.vc : p.kc) + j4) = w;
    }
    for (int j = blockIdx.x * 256 + otid(); j < 32768; j += gsz) {
        const int cc = j & 63, d = (j >> 6) & 63, lg = j >> 12;
        const float v = p.pool_w[((size_t)lg * 64 + cc) * 64 + d];
        p.PoolT[j] = (bf16_t)(pk_bf16(v, 0.f) & 0xffffu);
    }
    for (int j = blockIdx.x * 256 + otid(); j < 1024; j += gsz) {
        const int a = j & 15, r = j >> 4;
        const float inv = 1.0f / powf(10000.0f, (float)(2 * a) / 32.0f);
        const float ang = (float)r * inv;
        const float kf = rintf(ang * 0.15915494309189535f);
        float rr = fmaf(-kf, 6.2831854820251465f, ang);
        rr = fmaf(-kf, -1.7484555e-7f, rr);
        p.rope[j] = cosf(rr);
        p.rope[1024 + j] = sinf(rr);
    }
}

__device__ __forceinline__ float wave_sum(float v) {
#pragma unroll
    for (int o = 32; o >= 1; o >>= 1) v += __shfl_xor(v, o);
    return v;
}

__device__ __forceinline__ void phase_xn(const Params& p, int layer) {
    const int tid = otid(), lane = tid & 63, wave = tid >> 6;
    const int nw = gridDim.x * 4, w = blockIdx.x * 4 + wave;
    for (int t0 = w * 6; t0 < NTOK; t0 += nw * 6) {
        f32x4 x[6][4];
        if (layer == 0) {
#pragma unroll
            for (int u = 0; u < 6; ++u) {
                const int tok = t0 + u;
                const float* src = tok < NCTX ? p.x_prompt + (size_t)tok * DM : p.x_sample + (size_t)(tok - NCTX) * DM;
#pragma unroll
                for (int i = 0; i < 4; ++i) x[u][i] = *(const f32x4*)(src + i * 256 + lane * 4);
            }
        } else {
            u32x2 r[6][4];
#pragma unroll
            for (int u = 0; u < 6; ++u)
#pragma unroll
                for (int i = 0; i < 4; ++i) r[u][i] = *(const u32x2*)(p.h + (size_t)(t0 + u) * DM + i * 256 + lane * 4);
#pragma unroll
            for (int u = 0; u < 6; ++u)
#pragma unroll
                for (int i = 0; i < 4; ++i) x[u][i] = bf4_to_f32(r[u][i]);
        }
#pragma unroll
        for (int u = 0; u < 6; ++u) {
            const int tok = t0 + u;
            const int v = tok < NCTX ? 0 : 1 + ((tok - NCTX) >> 11);
            const float* mv = p.modv + (size_t)(layer * 5 + v) * 3072;
            float ss = 0.f;
#pragma unroll
            for (int i = 0; i < 4; ++i) ss += x[u][i][0] * x[u][i][0] + x[u][i][1] * x[u][i][1] + x[u][i][2] * x[u][i][2] + x[u][i][3] * x[u][i][3];
            ss = wave_sum(ss);
            const float rstd = rsqrtf(ss * (1.0f / 1024.0f) + EPSF);
#pragma unroll
            for (int i = 0; i < 4; ++i) {
                const int k = i * 256 + lane * 4;
                const f32x4 g = *(const f32x4*)(p.norm_g + layer * 1024 + k);
                const f32x4 sh = *(const f32x4*)(mv + k);
                const f32x4 sc = *(const f32x4*)(mv + 1024 + k);
                float o[4];
#pragma unroll
                for (int e = 0; e < 4; ++e) o[e] = x[u][i][e] * rstd * g[e] * (1.0f + sc[e]) + sh[e];
                u32x2 wv;
                wv.x = pk_bf16(o[0], o[1]);
                wv.y = pk_bf16(o[2], o[3]);
                *(u32x2*)(p.xn + (size_t)tok * DM + k) = wv;
            }
        }
    }
}

__device__ __forceinline__ void phase_final(const Params& p) {
    const int tid = otid(), lane = tid & 63, wave = tid >> 6;
    const int nw = gridDim.x * 4, w = blockIdx.x * 4 + wave;
    f32x4 g[4];
#pragma unroll
    for (int i = 0; i < 4; ++i) g[i] = *(const f32x4*)(p.final_g + i * 256 + lane * 4);
    for (int t0 = w * 6; t0 < NTOK; t0 += nw * 6) {
        u32x2 r[6][4];
#pragma unroll
        for (int u = 0; u < 6; ++u)
#pragma unroll
            for (int i = 0; i < 4; ++i) r[u][i] = *(const u32x2*)(p.xn + (size_t)(t0 + u) * DM + i * 256 + lane * 4);
#pragma unroll
        for (int u = 0; u < 6; ++u) {
            float* row = p.out + (size_t)(t0 + u) * DM;
            f32x4 x[4];
            float ss = 0.f;
#pragma unroll
            for (int i = 0; i < 4; ++i) {
                x[i] = bf4_to_f32(r[u][i]);
                ss += x[i][0] * x[i][0] + x[i][1] * x[i][1] + x[i][2] * x[i][2] + x[i][3] * x[i][3];
            }
            ss = wave_sum(ss);
            const float rstd = rsqrtf(ss * (1.0f / 1024.0f) + EPSF);
#pragma unroll
            for (int i = 0; i < 4; ++i) *(f32x4*)(row + i * 256 + lane * 4) = x[i] * rstd * g[i];
        }
    }
}

template <int MODE, int MI, int STG = 0>
__device__ __forceinline__ void gemm_epilogue(const Params& p, int layer, int mw, int nw, f32x4 (&acc)[MI][4], int fr, int fq,
                                              unsigned char* ct = nullptr, int m0t = 0, int n0t = 0) {
    if (MODE == 0) {
        const bool ctx = mw < NCTX;
        if (nw < 640) {
            const bool isq = nw < 512;
            const float* gp = (isq ? p.q_g : p.k_g) + layer * 64;
            f32x4 gv[4];
#pragma unroll
            for (int ni = 0; ni < 4; ++ni) gv[ni] = *(const f32x4*)(gp + ni * 16 + fq * 4);
#pragma unroll
            for (int mi = 0; mi < MI; ++mi) {
                const int tok = mw + mi * 16 + fr;
                float ss = 0.f;
#pragma unroll
                for (int ni = 0; ni < 4; ++ni)
#pragma unroll
                    for (int e = 0; e < 4; ++e) ss += acc[mi][ni][e] * acc[mi][ni][e];
                ss += __shfl_xor(ss, 16);
                ss += __shfl_xor(ss, 32);
                const float rstd = rsqrtf(ss * (1.0f / 64.0f) + EPSF);
                f32x4 val[4];
#pragma unroll
                for (int ni = 0; ni < 4; ++ni) val[ni] = acc[mi][ni] * rstd * gv[ni];
                if (!isq && ctx) {
                    float* nk = p.out + OUT_NK + ((size_t)((tok >> 8) * 2 + layer) * 256 + (tok & 255)) * 128 + (nw - 512) + fq * 4;
#pragma unroll
                    for (int ni = 0; ni < 4; ++ni) *(f32x4*)(nk + ni * 16) = val[ni];
                }
                if (!ctx) {
                    const int pos = (tok - NCTX) & 2047, prow = pos >> 6, pcol = pos & 63;
                    const f32x4 cr = *(const f32x4*)(p.rope + prow * 16 + fq * 4), sr = *(const f32x4*)(p.rope + 1024 + prow * 16 + fq * 4);
                    const f32x4 cc = *(const f32x4*)(p.rope + pcol * 16 + fq * 4), sn = *(const f32x4*)(p.rope + 1024 + pcol * 16 + fq * 4);
                    const f32x4 a0 = val[0], a1 = val[1], a2 = val[2], a3 = val[3];
                    val[0] = a0 * cr - a1 * sr;
                    val[1] = a1 * cr + a0 * sr;
                    val[2] = a2 * cc - a3 * sn;
                    val[3] = a3 * cc + a2 * sn;
                }
                if (isq) {
#pragma unroll
                    for (int ni = 0; ni < 4; ++ni) val[ni] = val[ni] * QSCALE;
                }
                bf16_t* pr = p.proj + (size_t)tok * INW + nw + fq * 4;
#pragma unroll
                for (int ni = 0; ni < 4; ++ni) {
                    u32x2 w;
                    w.x = pk_bf16(val[ni][0], val[ni][1]);
                    w.y = pk_bf16(val[ni][2], val[ni][3]);
                    if (STG) *(u32x2*)(ct + (tok - m0t) * 272 + (nw - n0t + fq * 4 + ni * 16) * 2) = w;
                    else *(u32x2*)(pr + ni * 16) = w;
                }
            }
        } else {
            const bool isv = nw < 768;
#pragma unroll
            for (int mi = 0; mi < MI; ++mi) {
                const int tok = mw + mi * 16 + fr;
                bf16_t* pr = p.proj + (size_t)tok * INW + nw + fq * 4;
#pragma unroll
                for (int ni = 0; ni < 4; ++ni) {
                    u32x2 w;
                    w.x = pk_bf16(acc[mi][ni][0], acc[mi][ni][1]);
                    w.y = pk_bf16(acc[mi][ni][2], acc[mi][ni][3]);
                    if (STG) *(u32x2*)(ct + (tok - m0t) * 272 + (nw - n0t + fq * 4 + ni * 16) * 2) = w;
                    else *(u32x2*)(pr + ni * 16) = w;
                }
                if (isv && ctx) {
                    float* nv = p.out + OUT_NV + ((size_t)((tok >> 8) * 2 + layer) * 256 + (tok & 255)) * 128 + (nw - 640) + fq * 4;
#pragma unroll
                    for (int ni = 0; ni < 4; ++ni) *(f32x4*)(nv + ni * 16) = acc[mi][ni];
                }
            }
        }
    } else {
        const int v = mw < NCTX ? 0 : 1 + ((mw - NCTX) >> 11);
        const float* gate = p.modv + (size_t)(layer * 5 + v) * 3072 + 2048 + nw + fq * 4;
        f32x4 gt[4];
#pragma unroll
        for (int ni = 0; ni < 4; ++ni) gt[ni] = *(const f32x4*)(gate + ni * 16);
#pragma unroll
        for (int mi = 0; mi < MI; ++mi) {
            const int tok = mw + mi * 16 + fr;
            const size_t eo = (size_t)tok * DM + nw + fq * 4;
            const float* xin = (tok < NCTX ? p.x_prompt + (size_t)tok * DM : p.x_sample + (size_t)(tok - NCTX) * DM) + nw + fq * 4;
#pragma unroll
            for (int ni = 0; ni < 4; ++ni) {
                if (layer == 0) {
                    const f32x4 r = *(const f32x4*)(xin + ni * 16) + gt[ni] * acc[mi][ni];
                    u32x2 w;
                    w.x = pk_bf16(r[0], r[1]);
                    w.y = pk_bf16(r[2], r[3]);
                    *(u32x2*)(p.h + eo + ni * 16) = w;
                } else {
                    const f32x4 r = bf4_to_f32(*(const u32x2*)(p.h + eo + ni * 16)) + gt[ni] * acc[mi][ni];
                    u32x2 w;
                    w.x = pk_bf16(r[0], r[1]);
                    w.y = pk_bf16(r[2], r[3]);
                    *(u32x2*)(p.xn + eo + ni * 16) = w;
                }
            }
        }
    }
}

template <int MODE>
__device__ __forceinline__ void gemm_tile(const Params& p, int layer, int mt, int nt, unsigned char* smem) {
    const int tid = otid(), lane = tid & 63, wave = tid >> 6, wm = wave >> 1, wn = wave & 1;
    const int fr = lane & 15, fq = lane >> 4;
    const int m0 = mt * 128, n0 = nt * 128;
    const bf16_t* A = (MODE == 0 ? p.xn : p.mix) + (size_t)m0 * 1024;
    const bf16_t* B = (MODE == 0 ? p.WinT + (size_t)layer * INW * 1024 : p.WoutT + (size_t)layer * 1024 * 1024) + (size_t)n0 * 1024;
    f32x4 acc[4][4];
#pragma unroll
    for (int i = 0; i < 4; ++i)
#pragma unroll
        for (int j = 0; j < 4; ++j) acc[i][j] = (f32x4){0.f, 0.f, 0.f, 0.f};

    const int srow = tid >> 3, scc = tid & 7;
    const bf16_t* ag = A + (size_t)srow * 1024 + scc * 8;
    const bf16_t* bg = B + (size_t)srow * 1024 + scc * 8;
    const int wofs = srow * 128 + ((scc ^ (srow & 7)) * 16);
    u32x4 raA[4], rbA[4], raB[4], rbB[4];
    auto gload = [&](int kt, u32x4* ra, u32x4* rb) {
#pragma unroll
        for (int i = 0; i < 4; ++i) {
            ra[i] = *(const u32x4*)(ag + (size_t)i * 32 * 1024 + kt * 64);
            rb[i] = *(const u32x4*)(bg + (size_t)i * 32 * 1024 + kt * 64);
        }
    };
    auto swrite = [&](int buf, const u32x4* ra, const u32x4* rb) {
        unsigned char* Aw = smem + buf * 32768;
#pragma unroll
        for (int i = 0; i < 4; ++i) {
            *(u32x4*)(Aw + wofs + i * 4096) = ra[i];
            *(u32x4*)(Aw + 16384 + wofs + i * 4096) = rb[i];
        }
    };
    gload(0, raA, rbA);
    gload(1, raB, rbB);
    swrite(0, raA, rbA);
    __syncthreads();
    const int aro = (wm * 64 + fr) * 128, bro = (wn * 64 + fr) * 128, sw = fr & 7;
    auto step = [&](int kt, u32x4* la, u32x4* lb, const u32x4* wa, const u32x4* wb) {
        const unsigned char* As = smem + (kt & 1) * 32768;
        const unsigned char* Bs = As + 16384;
        bf16x8 af[2][4], bf[2][4];
#pragma unroll
        for (int kk = 0; kk < 2; ++kk) {
            const int co = ((kk * 4 + fq) ^ sw) * 16;
#pragma unroll
            for (int i = 0; i < 4; ++i) {
                af[kk][i] = *(const bf16x8*)(As + aro + i * 2048 + co);
                bf[kk][i] = *(const bf16x8*)(Bs + bro + i * 2048 + co);
            }
        }
        if (kt + 2 < 16) gload(kt + 2, la, lb);
        __builtin_amdgcn_sched_barrier(0);
#pragma unroll
        for (int mi = 0; mi < 4; ++mi)
#pragma unroll
            for (int ni = 0; ni < 4; ++ni) acc[mi][ni] = __builtin_amdgcn_mfma_f32_16x16x32_bf16(bf[0][ni], af[0][mi], acc[mi][ni], 0, 0, 0);
        __builtin_amdgcn_sched_barrier(0);
        if (kt + 1 < 16) swrite((kt + 1) & 1, wa, wb);
        __builtin_amdgcn_sched_barrier(0);
#pragma unroll
        for (int mi = 0; mi < 4; ++mi)
#pragma unroll
            for (int ni = 0; ni < 4; ++ni) acc[mi][ni] = __builtin_amdgcn_mfma_f32_16x16x32_bf16(bf[1][ni], af[1][mi], acc[mi][ni], 0, 0, 0);
        __syncthreads();
    };
    for (int kt = 0; kt < 16; kt += 2) {
        step(kt, raA, rbA, raB, rbB);
        step(kt + 1, raB, rbB, raA, rbA);
    }

    gemm_epilogue<MODE, 4>(p, layer, m0 + wm * 64, n0 + wn * 64, acc, fr, fq);
}

template <int MODE>
__device__ __forceinline__ void gemm_tile256(const Params& p, int layer, int mt, int nt, unsigned char* smem) {
    const int tid = otid(), lane = tid & 63, wave = tid >> 6, wm = wave >> 1, wn = wave & 1;
    const int fr = lane & 15, fq = lane >> 4;
    const int m0 = mt * 256, n0 = nt * 128;
    const bf16_t* A = (MODE == 0 ? p.xn : p.mix) + (size_t)m0 * 1024;
    const bf16_t* B = (MODE == 0 ? p.WinT + (size_t)layer * INW * 1024 : p.WoutT + (size_t)layer * 1024 * 1024) + (size_t)n0 * 1024;
    f32x4 acc[8][4];
#pragma unroll
    for (int i = 0; i < 8; ++i)
#pragma unroll
        for (int j = 0; j < 4; ++j) acc[i][j] = (f32x4){0.f, 0.f, 0.f, 0.f};
    const int srow = tid >> 2, scc = tid & 3;
    const bf16_t* ag = A + (size_t)srow * 1024 + scc * 8;
    const bf16_t* bg = B + (size_t)srow * 1024 + scc * 8;
    const int wofs = srow * 64 + ((scc ^ ((4 - ((srow >> 2) & 3)) & 3)) * 16);
    u32x4 raA[4], rbA[2], raB[4], rbB[2];
    auto gload = [&](int kt, u32x4* ra, u32x4* rb) {
#pragma unroll
        for (int i = 0; i < 4; ++i) ra[i] = *(const u32x4*)(ag + (size_t)i * 64 * 1024 + kt * 32);
#pragma unroll
        for (int i = 0; i < 2; ++i) rb[i] = *(const u32x4*)(bg + (size_t)i * 64 * 1024 + kt * 32);
    };
    auto swrite = [&](int buf, const u32x4* ra, const u32x4* rb) {
        unsigned char* Aw = smem + buf * 24576;
#pragma unroll
        for (int i = 0; i < 4; ++i) *(u32x4*)(Aw + wofs + i * 4096) = ra[i];
#pragma unroll
        for (int i = 0; i < 2; ++i) *(u32x4*)(Aw + 16384 + wofs + i * 4096) = rb[i];
    };
    gload(0, raA, rbA);
    gload(1, raB, rbB);
    swrite(0, raA, rbA);
    __syncthreads();
    const int co = (fq ^ ((4 - ((fr >> 2) & 3)) & 3)) * 16;
    const int aro = (wm * 128 + fr) * 64 + co, bro = (wn * 64 + fr) * 64 + co;
    auto step = [&](int kt, u32x4* la, u32x4* lb, const u32x4* wa, const u32x4* wb) {
        const unsigned char* As = smem + (kt & 1) * 24576;
        const unsigned char* Bs = As + 16384;
        bf16x8 af[8], bf[4];
#pragma unroll
        for (int i = 0; i < 4; ++i) bf[i] = *(const bf16x8*)(Bs + bro + i * 1024);
#pragma unroll
        for (int i = 0; i < 8; ++i) af[i] = *(const bf16x8*)(As + aro + i * 1024);
        if (kt + 2 < 32) gload(kt + 2, la, lb);
        __builtin_amdgcn_sched_barrier(0);
#pragma unroll
        for (int mi = 0; mi < 4; ++mi)
#pragma unroll
            for (int ni = 0; ni < 4; ++ni) acc[mi][ni] = __builtin_amdgcn_mfma_f32_16x16x32_bf16(bf[ni], af[mi], acc[mi][ni], 0, 0, 0);
        __builtin_amdgcn_sched_barrier(0);
        if (kt + 1 < 32) swrite((kt + 1) & 1, wa, wb);
        __builtin_amdgcn_sched_barrier(0);
#pragma unroll
        for (int mi = 4; mi < 8; ++mi)
#pragma unroll
            for (int ni = 0; ni < 4; ++ni) acc[mi][ni] = __builtin_amdgcn_mfma_f32_16x16x32_bf16(bf[ni], af[mi], acc[mi][ni], 0, 0, 0);
        __syncthreads();
    };
    for (int kt = 0; kt < 32; kt += 2) {
        step(kt, raA, rbA, raB, rbB);
        step(kt + 1, raB, rbB, raA, rbA);
    }
    gemm_epilogue<MODE, 8>(p, layer, m0 + wm * 128, n0 + wn * 64, acc, fr, fq);
}

template <int MODE>
__device__ __forceinline__ void gemm_tile256_dma(const Params& p, int layer, int mt, int nt, unsigned char* smem) {
    const int tid = otid(), lane = tid & 63, wave = tid >> 6, wm = wave >> 1, wn = wave & 1;
    const int fr = lane & 15, fq = lane >> 4;
    const int m0 = mt * 256, n0 = nt * 128;
    const bf16_t* A = (MODE == 0 ? p.xn : p.mix) + (size_t)m0 * 1024;
    const bf16_t* B = (MODE == 0 ? p.WinT + (size_t)layer * INW * 1024 : p.WoutT + (size_t)layer * 1024 * 1024) + (size_t)n0 * 1024;
    f32x4 acc[8][4];
#pragma unroll
    for (int i = 0; i < 8; ++i)
#pragma unroll
        for (int j = 0; j < 4; ++j) acc[i][j] = (f32x4){0.f, 0.f, 0.f, 0.f};
    const int lrow = lane >> 2, lc = (lane & 3) ^ ((4 - ((lane >> 4) & 3)) & 3);
    const bf16_t* agp = A + (size_t)(wave * 64 + lrow) * 1024 + lc * 8;
    const bf16_t* bgp = B + (size_t)(wave * 32 + lrow) * 1024 + lc * 8;
    LAS unsigned char* lbase = (LAS unsigned char*)smem;
    const int la_off = wave * 4096 + lane * 16, lb_off = 16384 + wave * 2048 + lane * 16;
    auto dma = [&](int kt, int stage) {
        LAS unsigned char* sb = lbase + stage * 24576;
#pragma unroll
        for (int i = 0; i < 4; ++i)
            __builtin_amdgcn_global_load_lds((const void*)(agp + (size_t)i * 16 * 1024 + kt * 32), (LAS void*)(sb + la_off + i * 1024), 16, 0, 0);
#pragma unroll
        for (int i = 0; i < 2; ++i)
            __builtin_amdgcn_global_load_lds((const void*)(bgp + (size_t)i * 16 * 1024 + kt * 32), (LAS void*)(sb + lb_off + i * 1024), 16, 0, 0);
    };
    dma(0, 0);
    dma(1, 1);
    asm volatile("s_waitcnt vmcnt(6)" ::: "memory");
    __builtin_amdgcn_s_barrier();
    const int co = (fq ^ ((4 - ((fr >> 2) & 3)) & 3)) * 16;
    const int aro = (wm * 128 + fr) * 64 + co, bro = 16384 + (wn * 64 + fr) * 64 + co;
    int st = 0, st2 = 2;
    const unsigned lds0 = (unsigned)(uintptr_t)lbase;
#pragma unroll 1
    for (int kt = 0; kt < 32; ++kt) {
        const unsigned sa = lds0 + st * 24576 + aro, sbb = lds0 + st * 24576 + bro;
        bf16x8 af[8], bf[4];
#define FRAG_RD(dst, addr, OFF) asm volatile("ds_read_b128 %0, %1 offset:" #OFF : "=&v"(dst) : "v"(addr))
        FRAG_RD(bf[0], sbb, 0); FRAG_RD(bf[1], sbb, 1024); FRAG_RD(bf[2], sbb, 2048); FRAG_RD(bf[3], sbb, 3072);
        FRAG_RD(af[0], sa, 0); FRAG_RD(af[1], sa, 1024); FRAG_RD(af[2], sa, 2048); FRAG_RD(af[3], sa, 3072);
        FRAG_RD(af[4], sa, 4096); FRAG_RD(af[5], sa, 5120); FRAG_RD(af[6], sa, 6144); FRAG_RD(af[7], sa, 7168);
#undef FRAG_RD
        __builtin_amdgcn_sched_barrier(0);
        if (kt + 2 < 32) dma(kt + 2, st2);
        __builtin_amdgcn_sched_barrier(0);
        asm volatile("s_waitcnt lgkmcnt(4)" ::: "memory");
        __builtin_amdgcn_sched_barrier(0);
#pragma unroll
        for (int mi = 0; mi < 4; ++mi)
#pragma unroll
            for (int ni = 0; ni < 4; ++ni) acc[mi][ni] = __builtin_amdgcn_mfma_f32_16x16x32_bf16(bf[ni], af[mi], acc[mi][ni], 0, 0, 0);
        __builtin_amdgcn_sched_barrier(0);
        asm volatile("s_waitcnt lgkmcnt(0)" ::: "memory");
        __builtin_amdgcn_sched_barrier(0);
#pragma unroll
        for (int mi = 4; mi < 8; ++mi)
#pragma unroll
            for (int ni = 0; ni < 4; ++ni) acc[mi][ni] = __builtin_amdgcn_mfma_f32_16x16x32_bf16(bf[ni], af[mi], acc[mi][ni], 0, 0, 0);
        __builtin_amdgcn_sched_barrier(0);
        if (kt + 2 < 32) asm volatile("s_waitcnt vmcnt(6)" ::: "memory");
        else asm volatile("s_waitcnt vmcnt(0)" ::: "memory");
        __builtin_amdgcn_s_barrier();
        st = st == 2 ? 0 : st + 1;
        st2 = st2 == 2 ? 0 : st2 + 1;
    }
    if (MODE == 0) {
        gemm_epilogue<0, 8, 1>(p, layer, m0 + wm * 128, n0 + wn * 64, acc, fr, fq, smem, m0, n0);
        __syncthreads();
        u32x4 cv[16];
#pragma unroll
        for (int i = 0; i < 16; ++i) { const int e = tid + 256 * i; cv[i] = *(const u32x4*)(smem + (e >> 4) * 272 + (e & 15) * 16); }
#pragma unroll
        for (int i = 0; i < 16; ++i) { const int e = tid + 256 * i; *(u32x4*)(p.proj + (size_t)(m0 + (e >> 4)) * INW + n0 + (e & 15) * 8) = cv[i]; }
        __syncthreads();
    } else {
        {
            const int v = m0 < NCTX ? 0 : 1 + ((m0 - NCTX) >> 11);
            const float* gate = p.modv + (size_t)(layer * 5 + v) * 3072 + 2048 + n0 + wn * 64 + fq * 4;
            f32x4 gt[4];
#pragma unroll
            for (int ni = 0; ni < 4; ++ni) gt[ni] = *(const f32x4*)(gate + ni * 16);
#pragma unroll
            for (int mi = 0; mi < 8; ++mi)
#pragma unroll
                for (int ni = 0; ni < 4; ++ni) {
                    const f32x4 g = gt[ni] * acc[mi][ni];
                    u32x2 w;
                    w.x = pk_bf16(g[0], g[1]);
                    w.y = pk_bf16(g[2], g[3]);
                    *(u32x2*)(smem + (wm * 128 + mi * 16 + fr) * 272 + (wn * 64 + ni * 16 + fq * 4) * 2) = w;
                }
        }
        __syncthreads();
        bf16_t* dst = layer == 0 ? p.h : p.xn;
#pragma unroll 1
        for (int hf = 0; hf < 2; ++hf) {
            f32x4 ha[8], hb[8];
            u32x4 hv[8];
#pragma unroll
            for (int i = 0; i < 8; ++i) {
                const int e = tid + 256 * (hf * 8 + i), tok = m0 + (e >> 4), c8 = (e & 15) * 8;
                if (layer == 0) {
                    const float* xp = (tok < NCTX ? p.x_prompt + (size_t)tok * DM : p.x_sample + (size_t)(tok - NCTX) * DM) + n0 + c8;
                    ha[i] = *(const f32x4*)xp;
                    hb[i] = *(const f32x4*)(xp + 4);
                } else {
                    hv[i] = *(const u32x4*)(p.h + (size_t)tok * DM + n0 + c8);
                }
            }
#pragma unroll
            for (int i = 0; i < 8; ++i) {
                const int e = tid + 256 * (hf * 8 + i), tok = m0 + (e >> 4), c8 = (e & 15) * 8;
                float g[8], o[8];
                unpack8(*(const u32x4*)(smem + (e >> 4) * 272 + (e & 15) * 16), g);
                if (layer == 0) {
#pragma unroll
                    for (int q = 0; q < 4; ++q) { o[q] = ha[i][q]; o[4 + q] = hb[i][q]; }
                } else {
                    unpack8(hv[i], o);
                }
                u32x4 w;
                w.x = pk_bf16(o[0] + g[0], o[1] + g[1]);
                w.y = pk_bf16(o[2] + g[2], o[3] + g[3]);
                w.z = pk_bf16(o[4] + g[4], o[5] + g[5]);
                w.w = pk_bf16(o[6] + g[6], o[7] + g[7]);
                *(u32x4*)(dst + (size_t)tok * DM + n0 + c8) = w;
            }
        }
        __syncthreads();
    }
}

__device__ __forceinline__ void gemm_piece64_dma(const Params& p, int layer, int m0, int n0, unsigned char* smem) {
    const int tid = otid(), lane = tid & 63, wave = tid >> 6, wm = wave >> 1, wn = wave & 1;
    const int fr = lane & 15, fq = lane >> 4;
    const bf16_t* A = p.xn + (size_t)m0 * 1024;
    const bf16_t* B = p.WinT + (size_t)layer * INW * 1024 + (size_t)n0 * 1024;
    f32x4 acc[2][4];
#pragma unroll
    for (int i = 0; i < 2; ++i)
#pragma unroll
        for (int j = 0; j < 4; ++j) acc[i][j] = (f32x4){0.f, 0.f, 0.f, 0.f};
    const int lrow = lane >> 2, lc = (lane & 3) ^ ((4 - ((lane >> 4) & 3)) & 3);
    const bf16_t* agp = A + (size_t)(wave * 16 + lrow) * 1024 + lc * 8;
    const bf16_t* bgp = B + (size_t)(wave * 32 + lrow) * 1024 + lc * 8;
    LAS unsigned char* lbase = (LAS unsigned char*)smem;
    const int la_off = wave * 1024 + lane * 16, lb_off = 4096 + wave * 2048 + lane * 16;
    auto dma = [&](int kt, int stage) {
        LAS unsigned char* sb = lbase + stage * 12288;
        __builtin_amdgcn_global_load_lds((const void*)(agp + kt * 32), (LAS void*)(sb + la_off), 16, 0, 0);
#pragma unroll
        for (int i = 0; i < 2; ++i)
            __builtin_amdgcn_global_load_lds((const void*)(bgp + (size_t)i * 16 * 1024 + kt * 32), (LAS void*)(sb + lb_off + i * 1024), 16, 0, 0);
    };
    dma(0, 0);
    dma(1, 1);
    asm volatile("s_waitcnt vmcnt(3)" ::: "memory");
    __builtin_amdgcn_s_barrier();
    const int co = (fq ^ ((4 - ((fr >> 2) & 3)) & 3)) * 16;
    const int aro = (wm * 32 + fr) * 64 + co, bro = 4096 + (wn * 64 + fr) * 64 + co;
    int st = 0, st2 = 2;
    const unsigned lds0 = (unsigned)(uintptr_t)lbase;
#pragma unroll 1
    for (int kt = 0; kt < 32; ++kt) {
        const unsigned sa = lds0 + st * 12288 + aro, sbb = lds0 + st * 12288 + bro;
        bf16x8 af[2], bf[4];
#define FRAG_RD(dst, addr, OFF) asm volatile("ds_read_b128 %0, %1 offset:" #OFF : "=&v"(dst) : "v"(addr))
        FRAG_RD(bf[0], sbb, 0); FRAG_RD(bf[1], sbb, 1024); FRAG_RD(bf[2], sbb, 2048); FRAG_RD(bf[3], sbb, 3072);
        FRAG_RD(af[0], sa, 0); FRAG_RD(af[1], sa, 1024);
#undef FRAG_RD
        __builtin_amdgcn_sched_barrier(0);
        if (kt + 2 < 32) dma(kt + 2, st2);
        __builtin_amdgcn_sched_barrier(0);
        asm volatile("s_waitcnt lgkmcnt(0)" ::: "memory");
        __builtin_amdgcn_sched_barrier(0);
#pragma unroll
        for (int mi = 0; mi < 2; ++mi)
#pragma unroll
            for (int ni = 0; ni < 4; ++ni) acc[mi][ni] = __builtin_amdgcn_mfma_f32_16x16x32_bf16(bf[ni], af[mi], acc[mi][ni], 0, 0, 0);
        __builtin_amdgcn_sched_barrier(0);
        if (kt + 2 < 32) asm volatile("s_waitcnt vmcnt(3)" ::: "memory");
        else asm volatile("s_waitcnt vmcnt(0)" ::: "memory");
        __builtin_amdgcn_s_barrier();
        st = st == 2 ? 0 : st + 1;
        st2 = st2 == 2 ? 0 : st2 + 1;
    }
    gemm_epilogue<0, 2, 1>(p, layer, m0 + wm * 32, n0 + wn * 64, acc, fr, fq, smem, m0, n0);
    __syncthreads();
    u32x4 cv[4];
#pragma unroll
    for (int i = 0; i < 4; ++i) { const int e = tid + 256 * i; cv[i] = *(const u32x4*)(smem + (e >> 4) * 272 + (e & 15) * 16); }
#pragma unroll
    for (int i = 0; i < 4; ++i) { const int e = tid + 256 * i; *(u32x4*)(p.proj + (size_t)(m0 + (e >> 4)) * INW + n0 + (e & 15) * 8) = cv[i]; }
    __syncthreads();
}

template <int MODE>
__device__ __forceinline__ void phase_gemm(const Params& p, int layer, unsigned char* smem) {
    const int NT = MODE == 0 ? 22 : 8;
    const int total = 96 * NT;
    if (gridDim.x == 512) {
        const int xcd = blockIdx.x & 7, slot = blockIdx.x >> 3;
        if (MODE == 0) {
            if (slot < 16) {
                __builtin_amdgcn_s_setprio(3);
                gemm_piece64_dma(p, layer, (xcd * 6 + 2 + (slot >> 2)) * 256 + (slot & 3) * 64, 21 * 128, smem);
            }
            for (int idx = slot ^ 32; idx < 128; idx += 64) gemm_tile256_dma<MODE>(p, layer, xcd * 6 + idx % 6, idx / 6, smem);
            __builtin_amdgcn_s_setprio(0);
        } else {
            if (slot < 32) {
                __builtin_amdgcn_s_setprio(3);
                gemm_tile256_dma<MODE>(p, layer, xcd * 6 + slot % 6, slot / 6, smem);
                __builtin_amdgcn_s_setprio(0);
            }
            else {
                const int d = 32 + ((slot - 32) >> 1);
                gemm_tile<MODE>(p, layer, (xcd * 6 + d % 6) * 2 + (slot & 1), d / 6, smem);
            }
        }
    } else {
        for (int t = blockIdx.x; t < total; t += gridDim.x) gemm_tile<MODE>(p, layer, t / NT, t % NT, smem);
    }
}

template <int VAR>
__device__ __forceinline__ void attn_unit(const Params& p, int layer, int unit, unsigned char* smem) {
    const int tid = otid(), lane = tid & 63, wave = tid >> 6;
    const int r31 = lane & 31, hh = lane >> 5;
    int b, head, qblk, tokbase, nself, ntiles;
    if (unit < 512) { b = unit >> 7; head = (unit >> 4) & 7; qblk = unit & 15; tokbase = NCTX + b * 2048; nself = 2048; ntiles = 36; }
    else { const int u = unit - 512; b = u >> 4; head = (u >> 1) & 7; qblk = u & 1; tokbase = b * 256; nself = 256; ntiles = 4; }
    const int kvh = head >> 2;
    const int qtok = tokbase + qblk * 128 + wave * 32 + r31;
    bf16x8 qf[4];
    {
        const bf16_t* qp = p.proj + (size_t)qtok * INW + head * 64 + hh * 8;
#pragma unroll
        for (int ks = 0; ks < 4; ++ks) qf[ks] = *(const bf16x8*)(qp + ks * 16);
    }
    const bf16_t* kself = p.proj + (size_t)tokbase * INW + 512 + kvh * 64;
    const bf16_t* vself = p.proj + (size_t)tokbase * INW + 640 + kvh * 64;
    const bf16_t* kcache = p.kc + (size_t)((b * 2 + layer) * 2 + kvh) * 256 * 64;
    const bf16_t* vcache = p.vc + (size_t)((b * 2 + layer) * 2 + kvh) * 256 * 64;
    const int srow = tid >> 3, scc = tid & 7;
    const int kwo = srow * 128 + ((scc ^ ((srow >> 1) & 7)) * 16);
    const int vwo = srow * 128 + ((scc ^ (((srow >> 1) & 1) << 2)) * 16);
    u32x4 rkA[2], rvA[2], rkB[2], rvB[2];
    auto gload = [&](int j, u32x4* rk, u32x4* rv) {
        const int key0 = j * 64;
#pragma unroll
        for (int i = 0; i < 2; ++i) {
            const int row = srow + 32 * i;
            if (key0 < nself) {
                rk[i] = *(const u32x4*)(kself + (size_t)(key0 + row) * INW + scc * 8);
                rv[i] = *(const u32x4*)(vself + (size_t)(key0 + row) * INW + scc * 8);
            } else {
                rk[i] = *(const u32x4*)(kcache + (size_t)(key0 - nself + row) * 64 + scc * 8);
                rv[i] = *(const u32x4*)(vcache + (size_t)(key0 - nself + row) * 64 + scc * 8);
            }
        }
    };
    auto swrite = [&](int buf, const u32x4* rk, const u32x4* rv) {
        unsigned char* kb = smem + buf * 16384;
        unsigned char* vb = kb + 8192;
#pragma unroll
        for (int i = 0; i < 2; ++i) {
            *(u32x4*)(kb + kwo + i * 32 * 128) = rk[i];
            *(u32x4*)(vb + vwo + i * 32 * 128) = rv[i];
        }
    };
    f32x16 o[2];
#pragma unroll
    for (int i = 0; i < 16; ++i) { o[0][i] = 0.f; o[1][i] = 0.f; }
    float mrun = 0.f, mmax = -1e30f, lrun = 0.f;
    f32x16 negm, zero16;
#pragma unroll
    for (int i = 0; i < 16; ++i) { negm[i] = 0.f; zero16[i] = 0.f; }
    bool shifted = false;
    gload(0, rkA, rvA);
    swrite(0, rkA, rvA);
    if (ntiles > 1) gload(1, rkB, rvB);
    __syncthreads();
    const int kro = r31 * 128, ksw = (r31 >> 1) & 7;
    const int vq = 4 * hh + ((lane & 15) >> 2);
    const int vsw = ((vq >> 1) & 1) << 2;
    const int vcl = ((lane >> 4) & 1) * 2 + ((lane & 3) >> 1);
    const int vro0 = vq * 128 + (((0 * 4 + vcl) ^ vsw) * 16) + (lane & 1) * 8;
    const int vro1 = vq * 128 + (((1 * 4 + vcl) ^ vsw) * 16) + (lane & 1) * 8;
    auto step = [&](int j, u32x4* lk, u32x4* lv, const u32x4* wk, const u32x4* wv) {
        const unsigned char* kb = smem + (j & 1) * 16384;
        const unsigned char* vb = kb + 8192;
        bf16x8 kf[2][4];
#pragma unroll
        for (int sb = 0; sb < 2; ++sb)
#pragma unroll
            for (int ks = 0; ks < 4; ++ks) kf[sb][ks] = *(const bf16x8*)(kb + sb * 4096 + kro + (((ks * 2 + hh) ^ ksw) * 16));
        bf16x8 vf[2][2][2];
#pragma unroll
        for (int sb = 0; sb < 2; ++sb)
#pragma unroll
            for (int s2 = 0; s2 < 2; ++s2)
#pragma unroll
                for (int dt = 0; dt < 2; ++dt) {
                    const LAS unsigned char* va = (const LAS unsigned char*)(vb) + (sb * 32 + s2 * 16) * 128 + (dt ? vro1 : vro0);
                    const s16x4 a0 = __builtin_amdgcn_ds_read_tr16_b64_v4i16((LAS s16x4*)(va));
                    const s16x4 a1 = __builtin_amdgcn_ds_read_tr16_b64_v4i16((LAS s16x4*)(va + 8 * 128));
                    vf[sb][s2][dt] = (bf16x8){a0[0], a0[1], a0[2], a0[3], a1[0], a1[1], a1[2], a1[3]};
                }
        if (VAR != 1 && j + 2 < ntiles) gload(j + 2, lk, lv);
        __builtin_amdgcn_sched_barrier(0);
        f32x16 s[2];
        float mloc, lsum = 0.f;
        bf16x8 pf[2][2];
#pragma unroll
        for (int sb = 0; sb < 2; ++sb)
#pragma unroll
            for (int ks = 0; ks < 4; ++ks) {
                if (ks == 0) {
                    if (shifted) s[sb] = __builtin_amdgcn_mfma_f32_32x32x16_bf16(kf[sb][ks], qf[ks], negm, 0, 0, 0);
                    else s[sb] = __builtin_amdgcn_mfma_f32_32x32x16_bf16(kf[sb][ks], qf[ks], zero16, 0, 0, 0);
                } else s[sb] = __builtin_amdgcn_mfma_f32_32x32x16_bf16(kf[sb][ks], qf[ks], s[sb], 0, 0, 0);
            }
#pragma unroll
        for (int sb = 0; sb < 2; ++sb) {
            float m0 = max3_f(s[sb][0], s[sb][1], s[sb][2]);
#pragma unroll
            for (int i = 3; i < 15; i += 2) m0 = max3_f(m0, s[sb][i], s[sb][i + 1]);
            m0 = fmaxf(m0, s[sb][15]);
            mloc = sb == 0 ? m0 : fmaxf(mloc, m0);
#pragma unroll
            for (int i = 0; i < 16; ++i) { if (VAR != 2) { s[sb][i] = __builtin_amdgcn_exp2f(s[sb][i]); lsum += s[sb][i]; } }
#pragma unroll
            for (int s2 = 0; s2 < 2; ++s2) {
                u32x4 pw;
                pw.x = pk_bf16(s[sb][s2 * 8 + 0], s[sb][s2 * 8 + 1]);
                pw.y = pk_bf16(s[sb][s2 * 8 + 2], s[sb][s2 * 8 + 3]);
                pw.z = pk_bf16(s[sb][s2 * 8 + 4], s[sb][s2 * 8 + 5]);
                pw.w = pk_bf16(s[sb][s2 * 8 + 6], s[sb][s2 * 8 + 7]);
                pf[sb][s2] = __builtin_bit_cast(bf16x8, pw);
            }
#pragma unroll
            for (int s2 = 0; s2 < 2; ++s2)
#pragma unroll
                for (int dt = 0; dt < 2; ++dt) o[dt] = __builtin_amdgcn_mfma_f32_32x32x16_bf16(vf[sb][s2][dt], pf[sb][s2], o[dt], 0, 0, 0);
        }
        lrun += lsum;
        __builtin_amdgcn_sched_barrier(0);
        mloc = fmaxf(mloc, __shfl_xor(mloc, 32));
        mmax = fmaxf(mmax, mrun + mloc);
        if (__builtin_expect(__any(fabsf(mmax - mrun) > 40.0f), 0)) {
            asm volatile("" ::: "memory");
            const float alpha = __builtin_amdgcn_exp2f(mrun - mmax);
            mrun = mmax;
            lrun *= alpha;
            shifted = true;
#pragma unroll
            for (int i = 0; i < 16; ++i) { o[0][i] *= alpha; o[1][i] *= alpha; negm[i] = -mrun; }
        }
        if (VAR != 1 && j + 1 < ntiles) swrite((j + 1) & 1, wk, wv);
        __syncthreads();
    };
    for (int j = 0; j < ntiles - 2; j += 2) {
        step(j, rkA, rvA, rkB, rvB);
        step(j + 1, rkB, rvB, rkA, rvA);
    }
    const bf16_t* zp = p.proj + (size_t)qtok * INW + 768 + head * 64;
    u32x2 zq[2][4];
#pragma unroll
    for (int dt = 0; dt < 2; ++dt)
#pragma unroll
        for (int rq = 0; rq < 4; ++rq) zq[dt][rq] = *(const u32x2*)(zp + dt * 32 + 8 * rq + 4 * hh);
    step(ntiles - 2, rkA, rvA, rkB, rvB);
    step(ntiles - 1, rkB, rvB, rkA, rvA);
    const float ltot = lrun + __shfl_xor(lrun, 32);
    const float inv = 1.0f / ltot;
    bf16_t* mp = (VAR == 0 ? p.mix : p.xn) + (size_t)qtok * DM + head * 64;
#pragma unroll
    for (int dt = 0; dt < 2; ++dt)
#pragma unroll
        for (int rq = 0; rq < 4; ++rq) {
            const int d0 = dt * 32 + 8 * rq + 4 * hh;
            const u32x2 zz = zq[dt][rq];
            const float z0 = bf_lo(zz.x), z1 = bf_hi(zz.x), z2 = bf_lo(zz.y), z3 = bf_hi(zz.y);
            u32x2 w;
            w.x = pk_bf16(o[dt][rq * 4 + 0] * inv * silu_f(z0), o[dt][rq * 4 + 1] * inv * silu_f(z1));
            w.y = pk_bf16(o[dt][rq * 4 + 2] * inv * silu_f(z2), o[dt][rq * 4 + 3] * inv * silu_f(z3));
            *(u32x2*)(mp + d0) = w;
        }
}


template <int WIN>
__device__ __forceinline__ void pool_group(const Params& p, int layer, int T0, int toff, int seqlen, int gi, int fr, int fq, const bf16x8 (&wf)[4][2],
                                           const f32x4 (&ps)[4], const unsigned char* smem) {
    constexpr int HALF = WIN / 2;
    u32x2 zz[2][4];
#pragma unroll
    for (int mi = 0; mi < 2; ++mi)
#pragma unroll
        for (int ni = 0; ni < 4; ++ni) zz[mi][ni] = *(const u32x2*)(p.proj + (size_t)(T0 + mi * 16 + fr) * INW + 2560 + gi * 64 + ni * 16 + fq * 4);
#pragma unroll
    for (int mi = 0; mi < 2; ++mi) {
        const int tt = mi * 16 + fr, ts = toff + tt, tok = T0 + tt;
        int lo = ts - HALF, hi = ts - HALF + WIN - 1;
        lo = lo < 0 ? 0 : lo;
        hi = hi > seqlen - 1 ? seqlen - 1 : hi;
        const float rc = 1.0f / (float)(hi - lo + 1);
        f32x4 acc[4];
#pragma unroll
        for (int j = 0; j < 4; ++j) acc[j] = (f32x4){0.f, 0.f, 0.f, 0.f};
#pragma unroll
        for (int kk = 0; kk < 2; ++kk) {
            const int co = (gi * 64 + kk * 32 + fq * 8) * 2;
            u32x4 rw[WIN];
#pragma unroll
            for (int j = 0; j < WIN; ++j) rw[j] = *(const u32x4*)(smem + (tt + 8 - HALF + j) * 528 + co);
            const u32x4 self = *(const u32x4*)(smem + (tt + 8) * 528 + co);
            float sum[8];
#pragma unroll
            for (int e = 0; e < 8; ++e) sum[e] = 0.f;
#pragma unroll
            for (int j = 0; j < WIN; ++j) {
                const int sq = ts - HALF + j;
                const float m = (sq >= 0 && sq < seqlen) ? 1.0f : 0.0f;
                float f[8];
                unpack8(rw[j], f);
#pragma unroll
                for (int e = 0; e < 8; ++e) sum[e] = fmaf(f[e], m, sum[e]);
            }
            float us[8];
            unpack8(self, us);
            u32x4 dw;
            dw.x = pk_bf16(sum[0] * rc - us[0], sum[1] * rc - us[1]);
            dw.y = pk_bf16(sum[2] * rc - us[2], sum[3] * rc - us[3]);
            dw.z = pk_bf16(sum[4] * rc - us[4], sum[5] * rc - us[5]);
            dw.w = pk_bf16(sum[6] * rc - us[6], sum[7] * rc - us[7]);
            const bf16x8 df = __builtin_bit_cast(bf16x8, dw);
#pragma unroll
            for (int ni = 0; ni < 4; ++ni) acc[ni] = __builtin_amdgcn_mfma_f32_16x16x32_bf16(wf[ni][kk], df, acc[ni], 0, 0, 0);
        }
#pragma unroll
        for (int ni = 0; ni < 4; ++ni) {
            const int ch = gi * 64 + ni * 16 + fq * 4;
            u32x2 w;
            w.x = pk_bf16(acc[ni][0] * ps[ni][0] * silu_f(bf_lo(zz[mi][ni].x)), acc[ni][1] * ps[ni][1] * silu_f(bf_hi(zz[mi][ni].x)));
            w.y = pk_bf16(acc[ni][2] * ps[ni][2] * silu_f(bf_lo(zz[mi][ni].y)), acc[ni][3] * ps[ni][3] * silu_f(bf_hi(zz[mi][ni].y)));
            *(u32x2*)(p.mix + (size_t)tok * DM + 768 + ch) = w;
        }
    }
}

__device__ __forceinline__ void pool_item(const Params& p, int layer, int pi, unsigned char* smem) {
    const int tid = otid(), lane = tid & 63, gi = tid >> 6;
    const int fr = lane & 15, fq = lane >> 4;
    const int T0 = pi * 32;
    int seqstart, seqlen;
    if (T0 < NCTX) { seqstart = T0 & ~255; seqlen = 256; } else { seqstart = NCTX + ((T0 - NCTX) & ~2047); seqlen = 2048; }
    const int toff = T0 - seqstart;
    u32x4 st[6];
#pragma unroll
    for (int i = 0; i < 6; ++i) {
        const int e = tid + 256 * i, r = e >> 5, c = e & 31;
        int sq = toff - 8 + r;
        sq = sq < 0 ? 0 : (sq > seqlen - 1 ? seqlen - 1 : sq);
        if (e < 47 * 32) st[i] = *(const u32x4*)(p.proj + (size_t)(seqstart + sq) * INW + 2304 + c * 8);
    }
    bf16x8 wf[4][2];
    f32x4 ps[4];
    {
        const bf16_t* wp = p.PoolT + (size_t)((layer * 4 + gi) * 64) * 64;
#pragma unroll
        for (int ni = 0; ni < 4; ++ni) {
#pragma unroll
            for (int kk = 0; kk < 2; ++kk) wf[ni][kk] = *(const bf16x8*)(wp + (ni * 16 + fr) * 64 + kk * 32 + fq * 8);
            ps[ni] = *(const f32x4*)(p.pool_scale + layer * 256 + gi * 64 + ni * 16 + fq * 4);
        }
    }
#pragma unroll
    for (int i = 0; i < 6; ++i) {
        const int e = tid + 256 * i, r = e >> 5, c = e & 31;
        if (e < 47 * 32) *(u32x4*)(smem + r * 528 + c * 16) = st[i];
    }
    __syncthreads();
    if (gi == 0) pool_group<2>(p, layer, T0, toff, seqlen, gi, fr, fq, wf, ps, smem);
    else if (gi == 1) pool_group<4>(p, layer, T0, toff, seqlen, gi, fr, fq, wf, ps, smem);
    else if (gi == 2) pool_group<8>(p, layer, T0, toff, seqlen, gi, fr, fq, wf, ps, smem);
    else pool_group<16>(p, layer, T0, toff, seqlen, gi, fr, fq, wf, ps, smem);
    __syncthreads();
}

__device__ __forceinline__ void conv_item(const Params& p, int layer, int ci) {
    const int tid = otid();
    const int ch = (tid & 31) * 8, tg = tid >> 5;
    const int T0 = ci * 32 + tg * 4;
    int seqstart, seqlen;
    if (T0 < NCTX) { seqstart = T0 & ~255; seqlen = 256; } else { seqstart = NCTX + ((T0 - NCTX) & ~2047); seqlen = 2048; }
    const int seqend = seqstart + seqlen;
    u32x4 rh[6], rc[6], rb[4], rz[4];
#pragma unroll
    for (int i = 0; i < 6; ++i) {
        int tok = T0 - 1 + i;
        tok = tok < seqstart ? seqstart : (tok > seqend - 1 ? seqend - 1 : tok);
        rh[i] = *(const u32x4*)(p.proj + (size_t)tok * INW + 1280 + ch);
        rc[i] = *(const u32x4*)(p.proj + (size_t)tok * INW + 1792 + ch);
    }
#pragma unroll
    for (int i = 0; i < 4; ++i) {
        rb[i] = *(const u32x4*)(p.proj + (size_t)(T0 + i) * INW + 1536 + ch);
        rz[i] = *(const u32x4*)(p.proj + (size_t)(T0 + i) * INW + 2048 + ch);
    }
    f32x4 wv[8];
    {
        const float* cw = p.conv_w + (size_t)layer * 768 + ch;
#pragma unroll
        for (int r = 0; r < 3; ++r) { wv[r * 2] = *(const f32x4*)(cw + r * 256); wv[r * 2 + 1] = *(const f32x4*)(cw + r * 256 + 4); }
        wv[6] = *(const f32x4*)(p.conv_b + layer * 256 + ch);
        wv[7] = *(const f32x4*)(p.conv_b + layer * 256 + ch + 4);
    }
    float x[6][8];
#pragma unroll
    for (int i = 0; i < 6; ++i) {
        const int tok = T0 - 1 + i;
        const float valid = (tok >= seqstart && tok < seqend) ? 1.0f : 0.0f;
        float hc[8], cc[8];
        unpack8(rh[i], hc);
        unpack8(rc[i], cc);
#pragma unroll
        for (int e = 0; e < 8; ++e) x[i][e] = hc[e] * cc[e] * valid;
    }
#pragma unroll
    for (int t = 0; t < 4; ++t) {
        float bc[8], zc[8], o[8];
        unpack8(rb[t], bc);
        unpack8(rz[t], zc);
#pragma unroll
        for (int e = 0; e < 8; ++e) {
            const float y = x[t][e] * wv[e >> 2][e & 3] + x[t + 1][e] * wv[2 + (e >> 2)][e & 3] + x[t + 2][e] * wv[4 + (e >> 2)][e & 3] + wv[6 + (e >> 2)][e & 3];
            o[e] = bc[e] * y * silu_f(zc[e]);
        }
        u32x4 w;
        w.x = pk_bf16(o[0], o[1]); w.y = pk_bf16(o[2], o[3]); w.z = pk_bf16(o[4], o[5]); w.w = pk_bf16(o[6], o[7]);
        *(u32x4*)(p.mix + (size_t)(T0 + t) * DM + 512 + ch) = w;
    }
}

__device__ __forceinline__ void phase_mixer(const Params& p, int layer, unsigned char* smem) {
    if (gridDim.x == 512) {
        const int b = blockIdx.x;
        if (b >= 256) __builtin_amdgcn_s_setprio(2);
        if (b < 256) {
            const int xcd = b & 7, slot = b >> 3;
            attn_unit<0>(p, layer, 512 + ((((xcd << 1) | (slot >> 4)) << 4) | (slot & 15)), smem);
        }
        {
            const int xcd = b & 7, slot = b >> 3;
            attn_unit<0>(p, layer, ((xcd >> 1) << 7) | ((((xcd & 1) << 2) | (slot >> 4)) << 4) | (slot & 15), smem);
        }
        if (b >= 256) {
#pragma unroll 1
            for (int k = 0; k < 3; ++k) {
                const int idx = (b - 256) + 256 * k;
                if (idx < 384) pool_item(p, layer, idx, smem);
                else conv_item(p, layer, idx - 384);
            }
        }
        __builtin_amdgcn_s_setprio(0);
    } else {
        for (int it = blockIdx.x; it < 768 + 384 + 384; it += gridDim.x) {
            if (it < 768) attn_unit<0>(p, layer, it, smem);
            else if (it < 1152) pool_item(p, layer, it - 768, smem);
            else conv_item(p, layer, it - 1152);
        }
    }
}

__global__ void __launch_bounds__(256, 2) mega(Params p, int lo, int hi) {
    __shared__ __attribute__((aligned(16))) unsigned char smem[73728];
    __shared__ uint4 xbw;
    if (p.use_cg) cg::this_grid().sync();
    if (threadIdx.x == 0) xbw = make_uint4(0u, 0u, 0u, 0u);
    __syncthreads();
    XcdBarrier xb = xcd_barrier_post(p.bar, (volatile LAS unsigned*)&xbw);
    for (int ph = lo; ph < hi; ++ph) {
        if (ph > lo) xcd_barrier(xb);
        if (ph == 0) phase_prep(p, smem);
        else if (ph == 9) phase_final(p);
        else {
            const int layer = (ph - 1) >> 2, ty = (ph - 1) & 3;
            if (ty == 0) phase_xn(p, layer);
            else if (ty == 1) phase_gemm<0>(p, layer, smem);
            else if (ty == 2) phase_mixer(p, layer, smem);
            else phase_gemm<1>(p, layer, smem);
        }
    }
}

#ifndef MK_MULTI
#define MK_MULTI 0
#endif

extern "C" void kernel_launch(void* const* d_in, const int* in_sizes, int n_in, void* d_out, int out_size, void* d_ws, size_t ws_size,
                              hipStream_t stream) {
    static int grid_blocks = 0;
    if (!grid_blocks) {
        int dev = 0, cus = 0, per_cu = 0;
        hipGetDevice(&dev);
        hipDeviceGetAttribute(&cus, hipDeviceAttributeMultiprocessorCount, dev);
        hipOccupancyMaxActiveBlocksPerMultiprocessor(&per_cu, mega, 256, 0);
        if (per_cu > 2) per_cu = 2;
        if (per_cu < 1) per_cu = 1;
        grid_blocks = cus * per_cu;
    }
    Params p{};
    const float* const* in = (const float* const*)d_in;
    p.x_prompt = in[0]; p.x_sample = in[1]; p.cache_k = in[2]; p.cache_v = in[3]; p.c = in[4]; p.c_ctx = in[5]; p.norm_g = in[6];
    p.w_ada = in[7]; p.b_ada = in[8]; p.w_in = in[9]; p.q_g = in[10]; p.k_g = in[11]; p.conv_w = in[12]; p.conv_b = in[13];
    p.pool_w = in[14]; p.pool_scale = in[15]; p.w_out = in[16]; p.final_g = in[17];
    p.out = (float*)d_out;
    unsigned char* ws = (unsigned char*)d_ws;
    size_t off = 0;
    auto take = [&](size_t bytes) { unsigned char* r = ws + off; off += (bytes + 255) & ~(size_t)255; return r; };
    p.bar = (unsigned*)take(XCD_BAR_WORDS * 4);
    p.modv = (float*)take(2 * 5 * 3072 * 4);
    p.rope = (float*)take(2048 * 4);
    p.WinT = (bf16_t*)take((size_t)2 * INW * 1024 * 2);
    p.WoutT = (bf16_t*)take((size_t)2 * 1024 * 1024 * 2);
    p.PoolT = (bf16_t*)take(2 * 4 * 64 * 64 * 2);
    p.kc = (bf16_t*)take(262144 * 2);
    p.vc = (bf16_t*)take(262144 * 2);
    p.h = (bf16_t*)take((size_t)NTOK * DM * 2);
    p.xn = (bf16_t*)take((size_t)NTOK * DM * 2);
    p.proj = (bf16_t*)take((size_t)NTOK * INW * 2);
    p.mix = (bf16_t*)take((size_t)NTOK * DM * 2);
    p.use_cg = 0;
    p.pad = 0;
    hipMemsetAsync(p.bar, 0, XCD_BAR_WORDS * 4, stream);
#if MK_MULTI
    for (int ph = 0; ph < 10; ++ph) {
        int lo = ph, hi = ph + 1;
        void* args[] = {&p, &lo, &hi};
        hipError_t e = hipLaunchCooperativeKernel((void*)mega, dim3(grid_blocks), dim3(256), args, 0, stream);
        if (e != hipSuccess) fprintf(stderr, "launch failed: %s\n", hipGetErrorString(e));
    }
#else
    int lo = 0, hi = 10;
    void* args[] = {&p, &lo, &hi};
    hipError_t e = hipLaunchCooperativeKernel((void*)mega, dim3(grid_blocks), dim3(256), args, 0, stream);
    if (e != hipSuccess) fprintf(stderr, "cooperative launch failed: %s (grid %d)\n", hipGetErrorString(e), grid_blocks);
#endif
}
```

```cpp
#include <hip/hip_runtime.h>
#include <hip/hip_cooperative_groups.h>
#include <cstdint>
#include <cstdio>
namespace cg = cooperative_groups;

#define LAS __attribute__((address_space(3)))
typedef unsigned short bf16_t;
typedef short bf16x8 __attribute__((ext_vector_type(8)));
typedef short s16x4 __attribute__((ext_vector_type(4)));
typedef float f32x4 __attribute__((ext_vector_type(4)));
typedef float f32x16 __attribute__((ext_vector_type(16)));
typedef unsigned u32x4 __attribute__((ext_vector_type(4)));
typedef unsigned u32x2 __attribute__((ext_vector_type(2)));

constexpr int NTOK = 12288, NCTX = 4096, DM = 1024, INW = 2816;
constexpr size_t OUT_NK = 12582912, OUT_NV = 13631488;
constexpr float EPSF = 1e-6f;
constexpr float QSCALE = 0.125f * 1.4426950408889634f;

struct Params {
    const float *x_prompt, *x_sample, *cache_k, *cache_v, *c, *c_ctx, *norm_g, *w_ada, *b_ada, *w_in, *q_g, *k_g, *conv_w, *conv_b,
        *pool_w, *pool_scale, *w_out, *final_g;
    float* out;
    unsigned* bar;
    float* modv;
    float* rope;
    bf16_t* WinT;
    bf16_t* WoutT;
    bf16_t* PoolT;
    bf16_t* kc;
    bf16_t* vc;
    bf16_t* h;
    bf16_t* xn;
    bf16_t* proj;
    bf16_t* mix;
    int use_cg;
    int pad;
};

__device__ __forceinline__ unsigned pk_bf16(float lo, float hi) {
    unsigned r;
    asm("v_cvt_pk_bf16_f32 %0, %1, %2" : "=v"(r) : "v"(lo), "v"(hi));
    return r;
}
__device__ __forceinline__ float bf_lo(unsigned u) { return __uint_as_float(u << 16); }
__device__ __forceinline__ float bf_hi(unsigned u) { return __uint_as_float(u & 0xffff0000u); }
__device__ __forceinline__ float silu_f(float z) { return z / (1.0f + __expf(-z)); }
__device__ __forceinline__ f32x4 bf4_to_f32(const u32x2 u) { return (f32x4){bf_lo(u.x), bf_hi(u.x), bf_lo(u.y), bf_hi(u.y)}; }
__device__ __forceinline__ void unpack8(const u32x4 u, float* f) {
    f[0] = bf_lo(u.x); f[1] = bf_hi(u.x); f[2] = bf_lo(u.y); f[3] = bf_hi(u.y);
    f[4] = bf_lo(u.z); f[5] = bf_hi(u.z); f[6] = bf_lo(u.w); f[7] = bf_hi(u.w);
}
__device__ __forceinline__ float max3_f(float a, float b, float c) { float r; asm("v_max3_f32 %0, %1, %2, %3" : "=v"(r) : "v"(a), "v"(b), "v"(c)); return r; }
__device__ __forceinline__ int otid() { int t = threadIdx.x; asm volatile("" : "+v"(t)); return t; }

#define XB_TMO 128
#define XB_XCNT(j) (256 + 64 * (j))
#define XB_XSUB(j) (1280 + 64 * (j))
#define XB_XGEN(j) (2304 + 64 * (j))
#define XB_TOP 3328
#define XB_TOPGEN 3392
#define XCD_BAR_WORDS 3456
#define XB_SPIN_CAP (1u << 20)

__device__ __forceinline__ unsigned xb_ld(unsigned* p) { return __hip_atomic_load(p, __ATOMIC_RELAXED, __HIP_MEMORY_SCOPE_AGENT); }
__device__ __forceinline__ unsigned xb_add(unsigned* p, unsigned v) { return __hip_atomic_fetch_add(p, v, __ATOMIC_RELAXED, __HIP_MEMORY_SCOPE_AGENT); }
__device__ __forceinline__ unsigned xb_xcc_id() { return (unsigned)__builtin_amdgcn_s_getreg((3 << 11) | 20) & 0xFu; }
#define XB_SPIN(cond, bar)                                                   \
    do {                                                                     \
        unsigned _sp = 0;                                                    \
        while (cond) {                                                       \
            __builtin_amdgcn_s_sleep(1);                                     \
            if ((++_sp & 255u) == 0u) {                                      \
                if (xb_ld(&(bar)[XB_TMO])) break;                            \
                if (_sp > XB_SPIN_CAP) { atomicAdd(&(bar)[XB_TMO], 1u); break; } \
            }                                                                \
        }                                                                    \
    } while (0)

struct XcdBarrier {
    unsigned* bar;
    unsigned x;
    volatile LAS unsigned* st;
};

__device__ __forceinline__ XcdBarrier xcd_barrier_post(unsigned* bar, volatile LAS unsigned* st) {
    XcdBarrier b;
    b.bar = bar;
    b.x = xb_xcc_id();
    b.st = st;
    if (threadIdx.x == 0) (void)xb_add(&bar[XB_XCNT(b.x)], 1u);
    return b;
}
__device__ __forceinline__ void xcd_barrier_complete(unsigned* bar, unsigned x, unsigned& nloc, unsigned& nx) {
    const unsigned G = gridDim.x * gridDim.y * gridDim.z;
    unsigned sum, cnt, mine, sp = 0u;
    for (;;) {
        sum = 0u; cnt = 0u; mine = 0u;
#pragma unroll
        for (unsigned j = 0; j < 16; ++j) {
            const unsigned c = xb_ld(&bar[XB_XCNT(j)]);
            sum += c; cnt += (c > 0u) ? 1u : 0u; mine = (j == x) ? c : mine;
        }
        if (sum == G) break;
        __builtin_amdgcn_s_sleep(1);
        if ((++sp & 255u) == 0u) {
            if (xb_ld(&bar[XB_TMO])) break;
            if (sp > XB_SPIN_CAP) { atomicAdd(&bar[XB_TMO], 1u); break; }
        }
    }
    nloc = mine > 0u ? mine : 1u;
    nx = cnt > 0u ? cnt : 1u;
}
__device__ __forceinline__ void xcd_barrier(const XcdBarrier& b) {
    asm volatile("s_waitcnt vmcnt(0)" ::: "memory");
    __syncthreads();
    if (threadIdx.x == 0) {
        unsigned* bar = b.bar;
        __builtin_amdgcn_s_waitcnt(0);
        unsigned nloc = b.st[0], nx = b.st[1];
        if (nloc == 0u) { xcd_barrier_complete(bar, b.x, nloc, nx); b.st[0] = nloc; b.st[1] = nx; }
        const unsigned old = xb_add(&bar[XB_XSUB(b.x)], 1u);
        const unsigned gen = old / nloc;
        if (old + 1u == (gen + 1u) * nloc) {
            __builtin_amdgcn_fence(__ATOMIC_RELEASE, "agent");
            asm volatile("s_waitcnt vmcnt(0)" ::: "memory");
            const unsigned og = xb_add(&bar[XB_TOP], 1u);
            const unsigned tg = og / nx;
            if (og + 1u == (tg + 1u) * nx) xb_add(&bar[XB_TOPGEN], 1u);
            else XB_SPIN(xb_ld(&bar[XB_TOPGEN]) == tg, bar);
            __builtin_amdgcn_fence(__ATOMIC_ACQUIRE, "agent");
            xb_add(&bar[XB_XGEN(b.x)], 1u);
            asm volatile("s_waitcnt vmcnt(0)" ::: "memory");
        } else {
            XB_SPIN(xb_ld(&bar[XB_XGEN(b.x)]) == gen, bar);
            __builtin_amdgcn_fence(__ATOMIC_ACQUIRE, "agent");
            asm volatile("s_waitcnt vmcnt(0)" ::: "memory");
        }
    }
    __syncthreads();
}

__device__ __forceinline__ void prep_mod_item(const Params& p, int item, unsigned char* smem) {
    const int tid = otid();
    float* sc = (float*)smem;
    float* red = (float*)(smem + 20480);
    const int l = item / 96, j0 = (item % 96) * 32;
    for (int idx = tid; idx < 5120; idx += 256) {
        const int v = idx >> 10, k = idx & 1023;
        const float cv = (v == 0) ? p.c_ctx[k] : p.c[(v - 1) * 1024 + k];
        sc[idx] = cv / (1.0f + expf(-cv));
    }
    __syncthreads();
    const int cgp = tid & 7, kg = tid >> 3;
    float acc[5][4];
#pragma unroll
    for (int v = 0; v < 5; ++v)
#pragma unroll
        for (int e = 0; e < 4; ++e) acc[v][e] = 0.f;
    const float* wp = p.w_ada + (size_t)l * 1024 * 3072 + j0 + cgp * 4;
    f32x4 wreg[32];
#pragma unroll
    for (int kk = 0; kk < 32; ++kk) wreg[kk] = *(const f32x4*)(wp + (size_t)(kk * 32 + kg) * 3072);
#pragma unroll
    for (int kk = 0; kk < 32; ++kk) {
        const int k = kk * 32 + kg;
        const f32x4 w = wreg[kk];
#pragma unroll
        for (int v = 0; v < 5; ++v) {
            const float s = sc[v * 1024 + k];
#pragma unroll
            for (int e = 0; e < 4; ++e) acc[v][e] += s * w[e];
        }
    }
#pragma unroll
    for (int v = 0; v < 5; ++v)
#pragma unroll
        for (int e = 0; e < 4; ++e) red[kg * 160 + v * 32 + cgp * 4 + e] = acc[v][e];
    __syncthreads();
    if (tid < 160) {
        float s = 0.f;
        for (int g = 0; g < 32; ++g) s += red[g * 160 + tid];
        const int v = tid >> 5, cc = tid & 31;
        p.modv[(size_t)(l * 5 + v) * 3072 + j0 + cc] = s + p.b_ada[l * 3072 + j0 + cc];
    }
    __syncthreads();
}

__device__ __forceinline__ void prep_transpose_item(const float* src, bf16_t* dst, int N, int k0, int n0) {
    const int n = n0 + otid();
    const float* sp = src + (size_t)k0 * N + n;
    float v[32];
#pragma unroll
    for (int i = 0; i < 32; ++i) v[i] = sp[(size_t)i * N];
    bf16_t* d = dst + (size_t)n * 1024 + k0;
#pragma unroll
    for (int c = 0; c < 4; ++c) {
        u32x4 w;
        w.x = pk_bf16(v[c * 8 + 0], v[c * 8 + 1]);
        w.y = pk_bf16(v[c * 8 + 2], v[c * 8 + 3]);
        w.z = pk_bf16(v[c * 8 + 4], v[c * 8 + 5]);
        w.w = pk_bf16(v[c * 8 + 6], v[c * 8 + 7]);
        *(u32x4*)(d + c * 8) = w;
    }
}

__device__ __forceinline__ void phase_prep(const Params& p, unsigned char* smem) {
    const int ntb = (int)gridDim.x * 5 / 8, nmb = (int)gridDim.x - ntb;
    const int NTI = 2 * 11 * 32, NTO = 2 * 4 * 32;
    if ((int)blockIdx.x < ntb) {
        for (int it = blockIdx.x; it < NTI + NTO; it += ntb) {
            if (it < NTI) {
                const int l = it / 352, r = it % 352, kt = r / 11, nt = r % 11;
                prep_transpose_item(p.w_in + (size_t)l * 1024 * INW, p.WinT + (size_t)l * INW * 1024, INW, kt * 32, nt * 256);
            } else {
                const int t = it - NTI, l = t / 128, r = t % 128, kt = r / 4, nt = r % 4;
                prep_transpose_item(p.w_out + (size_t)l * 1024 * 1024, p.WoutT + (size_t)l * 1024 * 1024, 1024, kt * 32, nt * 256);
            }
        }
    } else {
        for (int it = (int)blockIdx.x - ntb; it < 192; it += nmb) prep_mod_item(p, it, smem);
    }
    const int gsz = gridDim.x * 256;
    for (int i = blockIdx.x * 256 + otid(); i < 131072; i += gsz) {
        const int which = i >> 16, j4 = (i & 65535) * 4;
        const int d = j4 & 63, t = (j4 >> 6) & 255, kvh = (j4 >> 14) & 1, bl = j4 >> 15;
        const size_t si = ((size_t)(bl * 256 + t) * 2 + kvh) * 64 + d;
        const f32x4 v = *(const f32x4*)((which ? p.cache_v : p.cache_k) + si);
        u32x2 w;
        w.x = pk_bf16(v[0], v[1]);
        w.y = pk_bf16(v[2], v[3]);
        *(u32x2*)((which ? p.vc : p.kc) + j4) = w;
    }
    for (int j = blockIdx.x * 256 + otid(); j < 32768; j += gsz) {
        const int cc = j & 63, d = (j >> 6) & 63, lg = j >> 12;
        const float v = p.pool_w[((size_t)lg * 64 + cc) * 64 + d];
        p.PoolT[j] = (bf16_t)(pk_bf16(v, 0.f) & 0xffffu);
    }
    for (int j = blockIdx.x * 256 + otid(); j < 1024; j += gsz) {
        const int a = j & 15, r = j >> 4;
        const float inv = 1.0f / powf(10000.0f, (float)(2 * a) / 32.0f);
        const float ang = (float)r * inv;
        const float kf = rintf(ang * 0.15915494309189535f);
        float rr = fmaf(-kf, 6.2831854820251465f, ang);
        rr = fmaf(-kf, -1.7484555e-7f, rr);
        p.rope[j] = cosf(rr);
        p.rope[1024 + j] = sinf(rr);
    }
}

__device__ __forceinline__ float wave_sum(float v) {
#pragma unroll
    for (int o = 32; o >= 1; o >>= 1) v += __shfl_xor(v, o);
    return v;
}

__device__ __forceinline__ void phase_xn(const Params& p, int layer) {
    const int tid = otid(), lane = tid & 63, wave = tid >> 6;
    const int nw = gridDim.x * 4, w = blockIdx.x * 4 + wave;
    for (int t0 = w * 6; t0 < NTOK; t0 += nw * 6) {
        f32x4 x[6][4];
        if (layer == 0) {
#pragma unroll
            for (int u = 0; u < 6; ++u) {
                const int tok = t0 + u;
                const float* src = tok < NCTX ? p.x_prompt + (size_t)tok * DM : p.x_sample + (size_t)(tok - NCTX) * DM;
#pragma unroll
                for (int i = 0; i < 4; ++i) x[u][i] = *(const f32x4*)(src + i * 256 + lane * 4);
            }
        } else {
            u32x2 r[6][4];
#pragma unroll
            for (int u = 0; u < 6; ++u)
#pragma unroll
                for (int i = 0; i < 4; ++i) r[u][i] = *(const u32x2*)(p.h + (size_t)(t0 + u) * DM + i * 256 + lane * 4);
#pragma unroll
            for (int u = 0; u < 6; ++u)
#pragma unroll
                for (int i = 0; i < 4; ++i) x[u][i] = bf4_to_f32(r[u][i]);
        }
#pragma unroll
        for (int u = 0; u < 6; ++u) {
            const int tok = t0 + u;
            const int v = tok < NCTX ? 0 : 1 + ((tok - NCTX) >> 11);
            const float* mv = p.modv + (size_t)(layer * 5 + v) * 3072;
            float ss = 0.f;
#pragma unroll
            for (int i = 0; i < 4; ++i) ss += x[u][i][0] * x[u][i][0] + x[u][i][1] * x[u][i][1] + x[u][i][2] * x[u][i][2] + x[u][i][3] * x[u][i][3];
            ss = wave_sum(ss);
            const float rstd = rsqrtf(ss * (1.0f / 1024.0f) + EPSF);
#pragma unroll
            for (int i = 0; i < 4; ++i) {
                const int k = i * 256 + lane * 4;
                const f32x4 g = *(const f32x4*)(p.norm_g + layer * 1024 + k);
                const f32x4 sh = *(const f32x4*)(mv + k);
                const f32x4 sc = *(const f32x4*)(mv + 1024 + k);
                float o[4];
#pragma unroll
                for (int e = 0; e < 4; ++e) o[e] = x[u][i][e] * rstd * g[e] * (1.0f + sc[e]) + sh[e];
                u32x2 wv;
                wv.x = pk_bf16(o[0], o[1]);
                wv.y = pk_bf16(o[2], o[3]);
                *(u32x2*)(p.xn + (size_t)tok * DM + k) = wv;
            }
        }
    }
}

__device__ __forceinline__ void phase_final(const Params& p) {
    const int tid = otid(), lane = tid & 63, wave = tid >> 6;
    const int nw = gridDim.x * 4, w = blockIdx.x * 4 + wave;
    f32x4 g[4];
#pragma unroll
    for (int i = 0; i < 4; ++i) g[i] = *(const f32x4*)(p.final_g + i * 256 + lane * 4);
    for (int t0 = w * 6; t0 < NTOK; t0 += nw * 6) {
        u32x2 r[6][4];
#pragma unroll
        for (int u = 0; u < 6; ++u)
#pragma unroll
            for (int i = 0; i < 4; ++i) r[u][i] = *(const u32x2*)(p.xn + (size_t)(t0 + u) * DM + i * 256 + lane * 4);
#pragma unroll
        for (int u = 0; u < 6; ++u) {
            float* row = p.out + (size_t)(t0 + u) * DM;
            f32x4 x[4];
            float ss = 0.f;
#pragma unroll
            for (int i = 0; i < 4; ++i) {
                x[i] = bf4_to_f32(r[u][i]);
                ss += x[i][0] * x[i][0] + x[i][1] * x[i][1] + x[i][2] * x[i][2] + x[i][3] * x[i][3];
            }
            ss = wave_sum(ss);
            const float rstd = rsqrtf(ss * (1.0f / 1024.0f) + EPSF);
#pragma unroll
            for (int i = 0; i < 4; ++i) *(f32x4*)(row + i * 256 + lane * 4) = x[i] * rstd * g[i];
        }
    }
}

template <int MODE, int MI, int STG = 0>
__device__ __forceinline__ void gemm_epilogue(const Params& p, int layer, int mw, int nw, f32x4 (&acc)[MI][4], int fr, int fq,
                                              unsigned char* ct = nullptr, int m0t = 0, int n0t = 0) {
    if (MODE == 0) {
        const bool ctx = mw < NCTX;
        if (nw < 640) {
            const bool isq = nw < 512;
            const float* gp = (isq ? p.q_g : p.k_g) + layer * 64;
            f32x4 gv[4];
#pragma unroll
            for (int ni = 0; ni < 4; ++ni) gv[ni] = *(const f32x4*)(gp + ni * 16 + fq * 4);
#pragma unroll
            for (int mi = 0; mi < MI; ++mi) {
                const int tok = mw + mi * 16 + fr;
                float ss = 0.f;
#pragma unroll
                for (int ni = 0; ni < 4; ++ni)
#pragma unroll
                    for (int e = 0; e < 4; ++e) ss += acc[mi][ni][e] * acc[mi][ni][e];
                ss += __shfl_xor(ss, 16);
                ss += __shfl_xor(ss, 32);
                const float rstd = rsqrtf(ss * (1.0f / 64.0f) + EPSF);
                f32x4 val[4];
#pragma unroll
                for (int ni = 0; ni < 4; ++ni) val[ni] = acc[mi][ni] * rstd * gv[ni];
                if (!isq && ctx) {
                    float* nk = p.out + OUT_NK + ((size_t)((tok >> 8) * 2 + layer) * 256 + (tok & 255)) * 128 + (nw - 512) + fq * 4;
#pragma unroll
                    for (int ni = 0; ni < 4; ++ni) *(f32x4*)(nk + ni * 16) = val[ni];
                }
                if (!ctx) {
                    const int pos = (tok - NCTX) & 2047, prow = pos >> 6, pcol = pos & 63;
                    const f32x4 cr = *(const f32x4*)(p.rope + prow * 16 + fq * 4), sr = *(const f32x4*)(p.rope + 1024 + prow * 16 + fq * 4);
                    const f32x4 cc = *(const f32x4*)(p.rope + pcol * 16 + fq * 4), sn = *(const f32x4*)(p.rope + 1024 + pcol * 16 + fq * 4);
                    const f32x4 a0 = val[0], a1 = val[1], a2 = val[2], a3 = val[3];
                    val[0] = a0 * cr - a1 * sr;
                    val[1] = a1 * cr + a0 * sr;
                    val[2] = a2 * cc - a3 * sn;
                    val[3] = a3 * cc + a2 * sn;
                }
                if (isq) {
#pragma unroll
                    for (int ni = 0; ni < 4; ++ni) val[ni] = val[ni] * QSCALE;
                }
                bf16_t* pr = p.proj + (size_t)tok * INW + nw + fq * 4;
#pragma unroll
                for (int ni = 0; ni < 4; ++ni) {
                    u32x2 w;
                    w.x = pk_bf16(val[ni][0], val[ni][1]);
                    w.y = pk_bf16(val[ni][2], val[ni][3]);
                    if (STG) *(u32x2*)(ct + (tok - m0t) * 272 + (nw - n0t + fq * 4 + ni * 16) * 2) = w;
                    else *(u32x2*)(pr + ni * 16) = w;
                }
            }
        } else {
            const bool isv = nw < 768;
#pragma unroll
            for (int mi = 0; mi < MI; ++mi) {
                const int tok = mw + mi * 16 + fr;
                bf16_t* pr = p.proj + (size_t)tok * INW + nw + fq * 4;
#pragma unroll
                for (int ni = 0; ni < 4; ++ni) {
                    u32x2 w;
                    w.x = pk_bf16(acc[mi][ni][0], acc[mi][ni][1]);
                    w.y = pk_bf16(acc[mi][ni][2], acc[mi][ni][3]);
                    if (STG) *(u32x2*)(ct + (tok - m0t) * 272 + (nw - n0t + fq * 4 + ni * 16) * 2) = w;
                    else *(u32x2*)(pr + ni * 16) = w;
                }
                if (isv && ctx) {
                    float* nv = p.out + OUT_NV + ((size_t)((tok >> 8) * 2 + layer) * 256 + (tok & 255)) * 128 + (nw - 640) + fq * 4;
#pragma unroll
                    for (int ni = 0; ni < 4; ++ni) *(f32x4*)(nv + ni * 16) = acc[mi][ni];
                }
            }
        }
    } else {
        const int v = mw < NCTX ? 0 : 1 + ((mw - NCTX) >> 11);
        const float* gate = p.modv + (size_t)(layer * 5 + v) * 3072 + 2048 + nw + fq * 4;
        f32x4 gt[4];
#pragma unroll
        for (int ni = 0; ni < 4; ++ni) gt[ni] = *(const f32x4*)(gate + ni * 16);
#pragma unroll
        for (int mi = 0; mi < MI; ++mi) {
            const int tok = mw + mi * 16 + fr;
            const size_t eo = (size_t)tok * DM + nw + fq * 4;
            const float* xin = (tok < NCTX ? p.x_prompt + (size_t)tok * DM : p.x_sample + (size_t)(tok - NCTX) * DM) + nw + fq * 4;
#pragma unroll
            for (int ni = 0; ni < 4; ++ni) {
                if (layer == 0) {
                    const f32x4 r = *(const f32x4*)(xin + ni * 16) + gt[ni] * acc[mi][ni];
                    u32x2 w;
                    w.x = pk_bf16(r[0], r[1]);
                    w.y = pk_bf16(r[2], r[3]);
                    *(u32x2*)(p.h + eo + ni * 16) = w;
                } else {
                    const f32x4 r = bf4_to_f32(*(const u32x2*)(p.h + eo + ni * 16)) + gt[ni] * acc[mi][ni];
                    u32x2 w;
                    w.x = pk_bf16(r[0], r[1]);
                    w.y = pk_bf16(r[2], r[3]);
                    *(u32x2*)(p.xn + eo + ni * 16) = w;
                }
            }
        }
    }
}

template <int MODE>
__device__ __forceinline__ void gemm_tile(const Params& p, int layer, int mt, int nt, unsigned char* smem) {
    const int tid = otid(), lane = tid & 63, wave = tid >> 6, wm = wave >> 1, wn = wave & 1;
    const int fr = lane & 15, fq = lane >> 4;
    const int m0 = mt * 128, n0 = nt * 128;
    const bf16_t* A = (MODE == 0 ? p.xn : p.mix) + (size_t)m0 * 1024;
    const bf16_t* B = (MODE == 0 ? p.WinT + (size_t)layer * INW * 1024 : p.WoutT + (size_t)layer * 1024 * 1024) + (size_t)n0 * 1024;
    f32x4 acc[4][4];
#pragma unroll
    for (int i = 0; i < 4; ++i)
#pragma unroll
        for (int j = 0; j < 4; ++j) acc[i][j] = (f32x4){0.f, 0.f, 0.f, 0.f};

    const int srow = tid >> 3, scc = tid & 7;
    const bf16_t* ag = A + (size_t)srow * 1024 + scc * 8;
    const bf16_t* bg = B + (size_t)srow * 1024 + scc * 8;
    const int wofs = srow * 128 + ((scc ^ (srow & 7)) * 16);
    u32x4 raA[4], rbA[4], raB[4], rbB[4];
    auto gload = [&](int kt, u32x4* ra, u32x4* rb) {
#pragma unroll
        for (int i = 0; i < 4; ++i) {
            ra[i] = *(const u32x4*)(ag + (size_t)i * 32 * 1024 + kt * 64);
            rb[i] = *(const u32x4*)(bg + (size_t)i * 32 * 1024 + kt * 64);
        }
    };
    auto swrite = [&](int buf, const u32x4* ra, const u32x4* rb) {
        unsigned char* Aw = smem + buf * 32768;
#pragma unroll
        for (int i = 0; i < 4; ++i) {
            *(u32x4*)(Aw + wofs + i * 4096) = ra[i];
            *(u32x4*)(Aw + 16384 + wofs + i * 4096) = rb[i];
        }
    };
    gload(0, raA, rbA);
    gload(1, raB, rbB);
    swrite(0, raA, rbA);
    __syncthreads();
    const int aro = (wm * 64 + fr) * 128, bro = (wn * 64 + fr) * 128, sw = fr & 7;
    auto step = [&](int kt, u32x4* la, u32x4* lb, const u32x4* wa, const u32x4* wb) {
        const unsigned char* As = smem + (kt & 1) * 32768;
        const unsigned char* Bs = As + 16384;
        bf16x8 af[2][4], bf[2][4];
#pragma unroll
        for (int kk = 0; kk < 2; ++kk) {
            const int co = ((kk * 4 + fq) ^ sw) * 16;
#pragma unroll
            for (int i = 0; i < 4; ++i) {
                af[kk][i] = *(const bf16x8*)(As + aro + i * 2048 + co);
                bf[kk][i] = *(const bf16x8*)(Bs + bro + i * 2048 + co);
            }
        }
        if (kt + 2 < 16) gload(kt + 2, la, lb);
        __builtin_amdgcn_sched_barrier(0);
#pragma unroll
        for (int mi = 0; mi < 4; ++mi)
#pragma unroll
            for (int ni = 0; ni < 4; ++ni) acc[mi][ni] = __builtin_amdgcn_mfma_f32_16x16x32_bf16(bf[0][ni], af[0][mi], acc[mi][ni], 0, 0, 0);
        __builtin_amdgcn_sched_barrier(0);
        if (kt + 1 < 16) swrite((kt + 1) & 1, wa, wb);
        __builtin_amdgcn_sched_barrier(0);
#pragma unroll
        for (int mi = 0; mi < 4; ++mi)
#pragma unroll
            for (int ni = 0; ni < 4; ++ni) acc[mi][ni] = __builtin_amdgcn_mfma_f32_16x16x32_bf16(bf[1][ni], af[1][mi], acc[mi][ni], 0, 0, 0);
        __syncthreads();
    };
    for (int kt = 0; kt < 16; kt += 2) {
        step(kt, raA, rbA, raB, rbB);
        step(kt + 1, raB, rbB, raA, rbA);
    }

    gemm_epilogue<MODE, 4>(p, layer, m0 + wm * 64, n0 + wn * 64, acc, fr, fq);
}

template <int MODE>
__device__ __forceinline__ void gemm_tile256(const Params& p, int layer, int mt, int nt, unsigned char* smem) {
    const int tid = otid(), lane = tid & 63, wave = tid >> 6, wm = wave >> 1, wn = wave & 1;
    const int fr = lane & 15, fq = lane >> 4;
    const int m0 = mt * 256, n0 = nt * 128;
    const bf16_t* A = (MODE == 0 ? p.xn : p.mix) + (size_t)m0 * 1024;
    const bf16_t* B = (MODE == 0 ? p.WinT + (size_t)layer * INW * 1024 : p.WoutT + (size_t)layer * 1024 * 1024) + (size_t)n0 * 1024;
    f32x4 acc[8][4];
#pragma unroll
    for (int i = 0; i < 8; ++i)
#pragma unroll
        for (int j = 0; j < 4; ++j) acc[i][j] = (f32x4){0.f, 0.f, 0.f, 0.f};
    const int srow = tid >> 2, scc = tid & 3;
    const bf16_t* ag = A + (size_t)srow * 1024 + scc * 8;
    const bf16_t* bg = B + (size_t)srow * 1024 + scc * 8;
    const int wofs = srow * 64 + ((scc ^ ((4 - ((srow >> 2) & 3)) & 3)) * 16);
    u32x4 raA[4], rbA[2], raB[4], rbB[2];
    auto gload = [&](int kt, u32x4* ra, u32x4* rb) {
#pragma unroll
        for (int i = 0; i < 4; ++i) ra[i] = *(const u32x4*)(ag + (size_t)i * 64 * 1024 + kt * 32);
#pragma unroll
        for (int i = 0; i < 2; ++i) rb[i] = *(const u32x4*)(bg + (size_t)i * 64 * 1024 + kt * 32);
    };
    auto swrite = [&](int buf, const u32x4* ra, const u32x4* rb) {
        unsigned char* Aw = smem + buf * 24576;
#pragma unroll
        for (int i = 0; i < 4; ++i) *(u32x4*)(Aw + wofs + i * 4096) = ra[i];
#pragma unroll
        for (int i = 0; i < 2; ++i) *(u32x4*)(Aw + 16384 + wofs + i * 4096) = rb[i];
    };
    gload(0, raA, rbA);
    gload(1, raB, rbB);
    swrite(0, raA, rbA);
    __syncthreads();
    const int co = (fq ^ ((4 - ((fr >> 2) & 3)) & 3)) * 16;
    const int aro = (wm * 128 + fr) * 64 + co, bro = (wn * 64 + fr) * 64 + co;
    auto step = [&](int kt, u32x4* la, u32x4* lb, const u32x4* wa, const u32x4* wb) {
        const unsigned char* As = smem + (kt & 1) * 24576;
        const unsigned char* Bs = As + 16384;
        bf16x8 af[8], bf[4];
#pragma unroll
        for (int i = 0; i < 4; ++i) bf[i] = *(const bf16x8*)(Bs + bro + i * 1024);
#pragma unroll
        for (int i = 0; i < 8; ++i) af[i] = *(const bf16x8*)(As + aro + i * 1024);
        if (kt + 2 < 32) gload(kt + 2, la, lb);
        __builtin_amdgcn_sched_barrier(0);
#pragma unroll
        for (int mi = 0; mi < 4; ++mi)
#pragma unroll
            for (int ni = 0; ni < 4; ++ni) acc[mi][ni] = __builtin_amdgcn_mfma_f32_16x16x32_bf16(bf[ni], af[mi], acc[mi][ni], 0, 0, 0);
        __builtin_amdgcn_sched_barrier(0);
        if (kt + 1 < 32) swrite((kt + 1) & 1, wa, wb);
        __builtin_amdgcn_sched_barrier(0);
#pragma unroll
        for (int mi = 4; mi < 8; ++mi)
#pragma unroll
            for (int ni = 0; ni < 4; ++ni) acc[mi][ni] = __builtin_amdgcn_mfma_f32_16x16x32_bf16(bf[ni], af[mi], acc[mi][ni], 0, 0, 0);
        __syncthreads();
    };
    for (int kt = 0; kt < 32; kt += 2) {
        step(kt, raA, rbA, raB, rbB);
        step(kt + 1, raB, rbB, raA, rbA);
    }
    gemm_epilogue<MODE, 8>(p, layer, m0 + wm * 128, n0 + wn * 64, acc, fr, fq);
}

template <int MODE>
__device__ __forceinline__ void gemm_tile256_dma(const Params& p, int layer, int mt, int nt, unsigned char* smem) {
    const int tid = otid(), lane = tid & 63, wave = tid >> 6, wm = wave >> 1, wn = wave & 1;
    const int fr = lane & 15, fq = lane >> 4;
    const int m0 = mt * 256, n0 = nt * 128;
    const bf16_t* A = (MODE == 0 ? p.xn : p.mix) + (size_t)m0 * 1024;
    const bf16_t* B = (MODE == 0 ? p.WinT + (size_t)layer * INW * 1024 : p.WoutT + (size_t)layer * 1024 * 1024) + (size_t)n0 * 1024;
    f32x4 acc[8][4];
#pragma unroll
    for (int i = 0; i < 8; ++i)
#pragma unroll
        for (int j = 0; j < 4; ++j) acc[i][j] = (f32x4){0.f, 0.f, 0.f, 0.f};
    const int lrow = lane >> 2, lc = (lane & 3) ^ ((4 - ((lane >> 4) & 3)) & 3);
    const bf16_t* agp = A + (size_t)(wave * 64 + lrow) * 1024 + lc * 8;
    const bf16_t* bgp = B + (size_t)(wave * 32 + lrow) * 1024 + lc * 8;
    LAS unsigned char* lbase = (LAS unsigned char*)smem;
    const int la_off = wave * 4096 + lane * 16, lb_off = 16384 + wave * 2048 + lane * 16;
    auto dma = [&](int kt, int stage) {
        LAS unsigned char* sb = lbase + stage * 24576;
#pragma unroll
        for (int i = 0; i < 4; ++i)
            __builtin_amdgcn_global_load_lds((const void*)(agp + (size_t)i * 16 * 1024 + kt * 32), (LAS void*)(sb + la_off + i * 1024), 16, 0, 0);
#pragma unroll
        for (int i = 0; i < 2; ++i)
            __builtin_amdgcn_global_load_lds((const void*)(bgp + (size_t)i * 16 * 1024 + kt * 32), (LAS void*)(sb + lb_off + i * 1024), 16, 0, 0);
    };
    dma(0, 0);
    dma(1, 1);
    asm volatile("s_waitcnt vmcnt(6)" ::: "memory");
    __builtin_amdgcn_s_barrier();
    const int co = (fq ^ ((4 - ((fr >> 2) & 3)) & 3)) * 16;
    const int aro = (wm * 128 + fr) * 64 + co, bro = 16384 + (wn * 64 + fr) * 64 + co;
    int st = 0, st2 = 2;
    const unsigned lds0 = (unsigned)(uintptr_t)lbase;
#pragma unroll 1
    for (int kt = 0; kt < 32; ++kt) {
        const unsigned sa = lds0 + st * 24576 + aro, sbb = lds0 + st * 24576 + bro;
        bf16x8 af[8], bf[4];
#define FRAG_RD(dst, addr, OFF) asm volatile("ds_read_b128 %0, %1 offset:" #OFF : "=&v"(dst) : "v"(addr))
        FRAG_RD(bf[0], sbb, 0); FRAG_RD(bf[1], sbb, 1024); FRAG_RD(bf[2], sbb, 2048); FRAG_RD(bf[3], sbb, 3072);
        FRAG_RD(af[0], sa, 0); FRAG_RD(af[1], sa, 1024); FRAG_RD(af[2], sa, 2048); FRAG_RD(af[3], sa, 3072);
        FRAG_RD(af[4], sa, 4096); FRAG_RD(af[5], sa, 5120); FRAG_RD(af[6], sa, 6144); FRAG_RD(af[7], sa, 7168);
#undef FRAG_RD
        __builtin_amdgcn_sched_barrier(0);
        if (kt + 2 < 32) dma(kt + 2, st2);
        __builtin_amdgcn_sched_barrier(0);
        asm volatile("s_waitcnt lgkmcnt(4)" ::: "memory");
        __builtin_amdgcn_sched_barrier(0);
#pragma unroll
        for (int mi = 0; mi < 4; ++mi)
#pragma unroll
            for (int ni = 0; ni < 4; ++ni) acc[mi][ni] = __builtin_amdgcn_mfma_f32_16x16x32_bf16(bf[ni], af[mi], acc[mi][ni], 0, 0, 0);
        __builtin_amdgcn_sched_barrier(0);
        asm volatile("s_waitcnt lgkmcnt(0)" ::: "memory");
        __builtin_amdgcn_sched_barrier(0);
#pragma unroll
        for (int mi = 4; mi < 8; ++mi)
#pragma unroll
            for (int ni = 0; ni < 4; ++ni) acc[mi][ni] = __builtin_amdgcn_mfma_f32_16x16x32_bf16(bf[ni], af[mi], acc[mi][ni], 0, 0, 0);
        __builtin_amdgcn_sched_barrier(0);
        if (kt + 2 < 32) asm volatile("s_waitcnt vmcnt(6)" ::: "memory");
        else asm volatile("s_waitcnt vmcnt(0)" ::: "memory");
        __builtin_amdgcn_s_barrier();
        st = st == 2 ? 0 : st + 1;
        st2 = st2 == 2 ? 0 : st2 + 1;
    }
    if (MODE == 0) {
        gemm_epilogue<0, 8, 1>(p, layer, m0 + wm * 128, n0 + wn * 64, acc, fr, fq, smem, m0, n0);
        __syncthreads();
        u32x4 cv[16];
#pragma unroll
        for (int i = 0; i < 16; ++i) { const int e = tid + 256 * i; cv[i] = *(const u32x4*)(smem + (e >> 4) * 272 + (e & 15) * 16); }
#pragma unroll
        for (int i = 0; i < 16; ++i) { const int e = tid + 256 * i; *(u32x4*)(p.proj + (size_t)(m0 + (e >> 4)) * INW + n0 + (e & 15) * 8) = cv[i]; }
        __syncthreads();
    } else {
        {
            const int v = m0 < NCTX ? 0 : 1 + ((m0 - NCTX) >> 11);
            const float* gate = p.modv + (size_t)(layer * 5 + v) * 3072 + 2048 + n0 + wn * 64 + fq * 4;
            f32x4 gt[4];
#pragma unroll
            for (int ni = 0; ni < 4; ++ni) gt[ni] = *(const f32x4*)(gate + ni * 16);
#pragma unroll
            for (int mi = 0; mi < 8; ++mi)
#pragma unroll
                for (int ni = 0; ni < 4; ++ni) {
                    const f32x4 g = gt[ni] * acc[mi][ni];
                    u32x2 w;
                    w.x = pk_bf16(g[0], g[1]);
                    w.y = pk_bf16(g[2], g[3]);
                    *(u32x2*)(smem + (wm * 128 + mi * 16 + fr) * 272 + (wn * 64 + ni * 16 + fq * 4) * 2) = w;
                }
        }
        __syncthreads();
        bf16_t* dst = layer == 0 ? p.h : p.xn;
#pragma unroll 1
        for (int hf = 0; hf < 2; ++hf) {
            f32x4 ha[8], hb[8];
            u32x4 hv[8];
#pragma unroll
            for (int i = 0; i < 8; ++i) {
                const int e = tid + 256 * (hf * 8 + i), tok = m0 + (e >> 4), c8 = (e & 15) * 8;
                if (layer == 0) {
                    const float* xp = (tok < NCTX ? p.x_prompt + (size_t)tok * DM : p.x_sample + (size_t)(tok - NCTX) * DM) + n0 + c8;
                    ha[i] = *(const f32x4*)xp;
                    hb[i] = *(const f32x4*)(xp + 4);
                } else {
                    hv[i] = *(const u32x4*)(p.h + (size_t)tok * DM + n0 + c8);
                }
            }
#pragma unroll
            for (int i = 0; i < 8; ++i) {
                const int e = tid + 256 * (hf * 8 + i), tok = m0 + (e >> 4), c8 = (e & 15) * 8;
                float g[8], o[8];
                unpack8(*(const u32x4*)(smem + (e >> 4) * 272 + (e & 15) * 16), g);
                if (layer == 0) {
#pragma unroll
                    for (int q = 0; q < 4; ++q) { o[q] = ha[i][q]; o[4 + q] = hb[i][q]; }
                } else {
                    unpack8(hv[i], o);
                }
                u32x4 w;
                w.x = pk_bf16(o[0] + g[0], o[1] + g[1]);
                w.y = pk_bf16(o[2] + g[2], o[3] + g[3]);
                w.z = pk_bf16(o[4] + g[4], o[5] + g[5]);
                w.w = pk_bf16(o[6] + g[6], o[7] + g[7]);
                *(u32x4*)(dst + (size_t)tok * DM + n0 + c8) = w;
            }
        }
        __syncthreads();
    }
}

__device__ __forceinline__ void gemm_piece64_dma(const Params& p, int layer, int m0, int n0, unsigned char* smem) {
    const int tid = otid(), lane = tid & 63, wave = tid >> 6, wm = wave >> 1, wn = wave & 1;
    const int fr = lane & 15, fq = lane >> 4;
    const bf16_t* A = p.xn + (size_t)m0 * 1024;
    const bf16_t* B = p.WinT + (size_t)layer * INW * 1024 + (size_t)n0 * 1024;
    f32x4 acc[2][4];
#pragma unroll
    for (int i = 0; i < 2; ++i)
#pragma unroll
        for (int j = 0; j < 4; ++j) acc[i][j] = (f32x4){0.f, 0.f, 0.f, 0.f};
    const int lrow = lane >> 2, lc = (lane & 3) ^ ((4 - ((lane >> 4) & 3)) & 3);
    const bf16_t* agp = A + (size_t)(wave * 16 + lrow) * 1024 + lc * 8;
    const bf16_t* bgp = B + (size_t)(wave * 32 + lrow) * 1024 + lc * 8;
    LAS unsigned char* lbase = (LAS unsigned char*)smem;
    const int la_off = wave * 1024 + lane * 16, lb_off = 4096 + wave * 2048 + lane * 16;
    auto dma = [&](int kt, int stage) {
        LAS unsigned char* sb = lbase + stage * 12288;
        __builtin_amdgcn_global_load_lds((const void*)(agp + kt * 32), (LAS void*)(sb + la_off), 16, 0, 0);
#pragma unroll
        for (int i = 0; i < 2; ++i)
            __builtin_amdgcn_global_load_lds((const void*)(bgp + (size_t)i * 16 * 1024 + kt * 32), (LAS void*)(sb + lb_off + i * 1024), 16, 0, 0);
    };
    dma(0, 0);
    dma(1, 1);
    asm volatile("s_waitcnt vmcnt(3)" ::: "memory");
    __builtin_amdgcn_s_barrier();
    const int co = (fq ^ ((4 - ((fr >> 2) & 3)) & 3)) * 16;
    const int aro = (wm * 32 + fr) * 64 + co, bro = 4096 + (wn * 64 + fr) * 64 + co;
    int st = 0, st2 = 2;
    const unsigned lds0 = (unsigned)(uintptr_t)lbase;
#pragma unroll 1
    for (int kt = 0; kt < 32; ++kt) {
        const unsigned sa = lds0 + st * 12288 + aro, sbb = lds0 + st * 12288 + bro;
        bf16x8 af[2], bf[4];
#define FRAG_RD(dst, addr, OFF) asm volatile("ds_read_b128 %0, %1 offset:" #OFF : "=&v"(dst) : "v"(addr))
        FRAG_RD(bf[0], sbb, 0); FRAG_RD(bf[1], sbb, 1024); FRAG_RD(bf[2], sbb, 2048); FRAG_RD(bf[3], sbb, 3072);
        FRAG_RD(af[0], sa, 0); FRAG_RD(af[1], sa, 1024);
#undef FRAG_RD
        __builtin_amdgcn_sched_barrier(0);
        if (kt + 2 < 32) dma(kt + 2, st2);
        __builtin_amdgcn_sched_barrier(0);
        asm volatile("s_waitcnt lgkmcnt(0)" ::: "memory");
        __builtin_amdgcn_sched_barrier(0);
#pragma unroll
        for (int mi = 0; mi < 2; ++mi)
#pragma unroll
            for (int ni = 0; ni < 4; ++ni) acc[mi][ni] = __builtin_amdgcn_mfma_f32_16x16x32_bf16(bf[ni], af[mi], acc[mi][ni], 0, 0, 0);
        __builtin_amdgcn_sched_barrier(0);
        if (kt + 2 < 32) asm volatile("s_waitcnt vmcnt(3)" ::: "memory");
        else asm volatile("s_waitcnt vmcnt(0)" ::: "memory");
        __builtin_amdgcn_s_barrier();
        st = st == 2 ? 0 : st + 1;
        st2 = st2 == 2 ? 0 : st2 + 1;
    }
    gemm_epilogue<0, 2, 1>(p, layer, m0 + wm * 32, n0 + wn * 64, acc, fr, fq, smem, m0, n0);
    __syncthreads();
    u32x4 cv[4];
#pragma unroll
    for (int i = 0; i < 4; ++i) { const int e = tid + 256 * i; cv[i] = *(const u32x4*)(smem + (e >> 4) * 272 + (e & 15) * 16); }
#pragma unroll
    for (int i = 0; i < 4; ++i) { const int e = tid + 256 * i; *(u32x4*)(p.proj + (size_t)(m0 + (e >> 4)) * INW + n0 + (e & 15) * 8) = cv[i]; }
    __syncthreads();
}

template <int MODE>
__device__ __forceinline__ void phase_gemm(const Params& p, int layer, unsigned char* smem) {
    const int NT = MODE == 0 ? 22 : 8;
    const int total = 96 * NT;
    if (gridDim.x == 512) {
        const int xcd = blockIdx.x & 7, slot = blockIdx.x >> 3;
        if (MODE == 0) {
            if (slot < 16) {
                __builtin_amdgcn_s_setprio(3);
                gemm_piece64_dma(p, layer, (xcd * 6 + 2 + (slot >> 2)) * 256 + (slot & 3) * 64, 21 * 128, smem);
            }
            if (slot >= 48) __builtin_amdgcn_s_sleep(100);
            for (int idx = slot ^ 32; idx < 128; idx += 64) gemm_tile256_dma<MODE>(p, layer, xcd * 6 + idx % 6, idx / 6, smem);
            __builtin_amdgcn_s_setprio(0);
        } else {
            if (slot < 32) {
                __builtin_amdgcn_s_setprio(3);
                gemm_tile256_dma<MODE>(p, layer, xcd * 6 + slot % 6, slot / 6, smem);
                __builtin_amdgcn_s_setprio(0);
            }
            else {
                const int d = 32 + ((slot - 32) >> 1);
                gemm_tile<MODE>(p, layer, (xcd * 6 + d % 6) * 2 + (slot & 1), d / 6, smem);
            }
        }
    } else {
        for (int t = blockIdx.x; t < total; t += gridDim.x) gemm_tile<MODE>(p, layer, t / NT, t % NT, smem);
    }
}

template <int VAR>
__device__ __forceinline__ void attn_unit(const Params& p, int layer, int unit, unsigned char* smem) {
    const int tid = otid(), lane = tid & 63, wave = tid >> 6;
    const int r31 = lane & 31, hh = lane >> 5;
    int b, head, qblk, tokbase, nself, ntiles;
    if (unit < 512) { b = unit >> 7; head = (unit >> 4) & 7; qblk = unit & 15; tokbase = NCTX + b * 2048; nself = 2048; ntiles = 36; }
    else { const int u = unit - 512; b = u >> 4; head = (u >> 1) & 7; qblk = u & 1; tokbase = b * 256; nself = 256; ntiles = 4; }
    const int kvh = head >> 2;
    const int qtok = tokbase + qblk * 128 + wave * 32 + r31;
    bf16x8 qf[4];
    {
        const bf16_t* qp = p.proj + (size_t)qtok * INW + head * 64 + hh * 8;
#pragma unroll
        for (int ks = 0; ks < 4; ++ks) qf[ks] = *(const bf16x8*)(qp + ks * 16);
    }
    const bf16_t* kself = p.proj + (size_t)tokbase * INW + 512 + kvh * 64;
    const bf16_t* vself = p.proj + (size_t)tokbase * INW + 640 + kvh * 64;
    const bf16_t* kcache = p.kc + (size_t)((b * 2 + layer) * 2 + kvh) * 256 * 64;
    const bf16_t* vcache = p.vc + (size_t)((b * 2 + layer) * 2 + kvh) * 256 * 64;
    const int srow = tid >> 3, scc = tid & 7;
    const int kwo = srow * 128 + ((scc ^ ((srow >> 1) & 7)) * 16);
    const int vwo = srow * 128 + ((scc ^ (((srow >> 1) & 1) << 2)) * 16);
    u32x4 rkA[2], rvA[2], rkB[2], rvB[2];
    auto gload = [&](int j, u32x4* rk, u32x4* rv) {
        const int key0 = j * 64;
#pragma unroll
        for (int i = 0; i < 2; ++i) {
            const int row = srow + 32 * i;
            if (key0 < nself) {
                rk[i] = *(const u32x4*)(kself + (size_t)(key0 + row) * INW + scc * 8);
                rv[i] = *(const u32x4*)(vself + (size_t)(key0 + row) * INW + scc * 8);
            } else {
                rk[i] = *(const u32x4*)(kcache + (size_t)(key0 - nself + row) * 64 + scc * 8);
                rv[i] = *(const u32x4*)(vcache + (size_t)(key0 - nself + row) * 64 + scc * 8);
            }
        }
    };
    auto swrite = [&](int buf, const u32x4* rk, const u32x4* rv) {
        unsigned char* kb = smem + buf * 16384;
        unsigned char* vb = kb + 8192;
#pragma unroll
        for (int i = 0; i < 2; ++i) {
            *(u32x4*)(kb + kwo + i * 32 * 128) = rk[i];
            *(u32x4*)(vb + vwo + i * 32 * 128) = rv[i];
        }
    };
    f32x16 o[2];
#pragma unroll
    for (int i = 0; i < 16; ++i) { o[0][i] = 0.f; o[1][i] = 0.f; }
    float mrun = 0.f, mmax = -1e30f, lrun = 0.f;
    f32x16 negm, zero16;
#pragma unroll
    for (int i = 0; i < 16; ++i) { negm[i] = 0.f; zero16[i] = 0.f; }
    bool shifted = false;
    gload(0, rkA, rvA);
    swrite(0, rkA, rvA);
    if (ntiles > 1) gload(1, rkB, rvB);
    __syncthreads();
    const int kro = r31 * 128, ksw = (r31 >> 1) & 7;
    const int vq = 4 * hh + ((lane & 15) >> 2);
    const int vsw = ((vq >> 1) & 1) << 2;
    const int vcl = ((lane >> 4) & 1) * 2 + ((lane & 3) >> 1);
    const int vro0 = vq * 128 + (((0 * 4 + vcl) ^ vsw) * 16) + (lane & 1) * 8;
    const int vro1 = vq * 128 + (((1 * 4 + vcl) ^ vsw) * 16) + (lane & 1) * 8;
    auto step = [&](int j, u32x4* lk, u32x4* lv, const u32x4* wk, const u32x4* wv) {
        const unsigned char* kb = smem + (j & 1) * 16384;
        const unsigned char* vb = kb + 8192;
        bf16x8 kf[2][4];
#pragma unroll
        for (int sb = 0; sb < 2; ++sb)
#pragma unroll
            for (int ks = 0; ks < 4; ++ks) kf[sb][ks] = *(const bf16x8*)(kb + sb * 4096 + kro + (((ks * 2 + hh) ^ ksw) * 16));
        bf16x8 vf[2][2][2];
#pragma unroll
        for (int sb = 0; sb < 2; ++sb)
#pragma unroll
            for (int s2 = 0; s2 < 2; ++s2)
#pragma unroll
                for (int dt = 0; dt < 2; ++dt) {
                    const LAS unsigned char* va = (const LAS unsigned char*)(vb) + (sb * 32 + s2 * 16) * 128 + (dt ? vro1 : vro0);
                    const s16x4 a0 = __builtin_amdgcn_ds_read_tr16_b64_v4i16((LAS s16x4*)(va));
                    const s16x4 a1 = __builtin_amdgcn_ds_read_tr16_b64_v4i16((LAS s16x4*)(va + 8 * 128));
                    vf[sb][s2][dt] = (bf16x8){a0[0], a0[1], a0[2], a0[3], a1[0], a1[1], a1[2], a1[3]};
                }
        if (VAR != 1 && j + 2 < ntiles) gload(j + 2, lk, lv);
        __builtin_amdgcn_sched_barrier(0);
        f32x16 s[2];
        float mloc, lsum = 0.f;
        bf16x8 pf[2][2];
#pragma unroll
        for (int sb = 0; sb < 2; ++sb)
#pragma unroll
            for (int ks = 0; ks < 4; ++ks) {
                if (ks == 0) {
                    if (shifted) s[sb] = __builtin_amdgcn_mfma_f32_32x32x16_bf16(kf[sb][ks], qf[ks], negm, 0, 0, 0);
                    else s[sb] = __builtin_amdgcn_mfma_f32_32x32x16_bf16(kf[sb][ks], qf[ks], zero16, 0, 0, 0);
                } else s[sb] = __builtin_amdgcn_mfma_f32_32x32x16_bf16(kf[sb][ks], qf[ks], s[sb], 0, 0, 0);
            }
#pragma unroll
        for (int sb = 0; sb < 2; ++sb) {
            float m0 = max3_f(s[sb][0], s[sb][1], s[sb][2]);
#pragma unroll
            for (int i = 3; i < 15; i += 2) m0 = max3_f(m0, s[sb][i], s[sb][i + 1]);
            m0 = fmaxf(m0, s[sb][15]);
            mloc = sb == 0 ? m0 : fmaxf(mloc, m0);
#pragma unroll
            for (int i = 0; i < 16; ++i) { if (VAR != 2) { s[sb][i] = __builtin_amdgcn_exp2f(s[sb][i]); lsum += s[sb][i]; } }
#pragma unroll
            for (int s2 = 0; s2 < 2; ++s2) {
                u32x4 pw;
                pw.x = pk_bf16(s[sb][s2 * 8 + 0], s[sb][s2 * 8 + 1]);
                pw.y = pk_bf16(s[sb][s2 * 8 + 2], s[sb][s2 * 8 + 3]);
                pw.z = pk_bf16(s[sb][s2 * 8 + 4], s[sb][s2 * 8 + 5]);
                pw.w = pk_bf16(s[sb][s2 * 8 + 6], s[sb][s2 * 8 + 7]);
                pf[sb][s2] = __builtin_bit_cast(bf16x8, pw);
            }
#pragma unroll
            for (int s2 = 0; s2 < 2; ++s2)
#pragma unroll
                for (int dt = 0; dt < 2; ++dt) o[dt] = __builtin_amdgcn_mfma_f32_32x32x16_bf16(vf[sb][s2][dt], pf[sb][s2], o[dt], 0, 0, 0);
        }
        lrun += lsum;
        __builtin_amdgcn_sched_barrier(0);
        mloc = fmaxf(mloc, __shfl_xor(mloc, 32));
        mmax = fmaxf(mmax, mrun + mloc);
        if (__builtin_expect(__any(fabsf(mmax - mrun) > 40.0f), 0)) {
            asm volatile("" ::: "memory");
            const float alpha = __builtin_amdgcn_exp2f(mrun - mmax);
            mrun = mmax;
            lrun *= alpha;
            shifted = true;
#pragma unroll
            for (int i = 0; i < 16; ++i) { o[0][i] *= alpha; o[1][i] *= alpha; negm[i] = -mrun; }
        }
        if (VAR != 1 && j + 1 < ntiles) swrite((j + 1) & 1, wk, wv);
        __syncthreads();
    };
    for (int j = 0; j < ntiles - 2; j += 2) {
        step(j, rkA, rvA, rkB, rvB);
        step(j + 1, rkB, rvB, rkA, rvA);
    }
    const bf16_t* zp = p.proj + (size_t)qtok * INW + 768 + head * 64;
    u32x2 zq[2][4];
#pragma unroll
    for (int dt = 0; dt < 2; ++dt)
#pragma unroll
        for (int rq = 0; rq < 4; ++rq) zq[dt][rq] = *(const u32x2*)(zp + dt * 32 + 8 * rq + 4 * hh);
    step(ntiles - 2, rkA, rvA, rkB, rvB);
    step(ntiles - 1, rkB, rvB, rkA, rvA);
    const float ltot = lrun + __shfl_xor(lrun, 32);
    const float inv = 1.0f / ltot;
    bf16_t* mp = (VAR == 0 ? p.mix : p.xn) + (size_t)qtok * DM + head * 64;
#pragma unroll
    for (int dt = 0; dt < 2; ++dt)
#pragma unroll
        for (int rq = 0; rq < 4; ++rq) {
            const int d0 = dt * 32 + 8 * rq + 4 * hh;
            const u32x2 zz = zq[dt][rq];
            const float z0 = bf_lo(zz.x), z1 = bf_hi(zz.x), z2 = bf_lo(zz.y), z3 = bf_hi(zz.y);
            u32x2 w;
            w.x = pk_bf16(o[dt][rq * 4 + 0] * inv * silu_f(z0), o[dt][rq * 4 + 1] * inv * silu_f(z1));
            w.y = pk_bf16(o[dt][rq * 4 + 2] * inv * silu_f(z2), o[dt][rq * 4 + 3] * inv * silu_f(z3));
            *(u32x2*)(mp + d0) = w;
        }
}


template <int WIN>
__device__ __forceinline__ void pool_group(const Params& p, int layer, int T0, int toff, int seqlen, int gi, int fr, int fq, const bf16x8 (&wf)[4][2],
                                           const f32x4 (&ps)[4], const unsigned char* smem) {
    constexpr int HALF = WIN / 2;
    u32x2 zz[2][4];
#pragma unroll
    for (int mi = 0; mi < 2; ++mi)
#pragma unroll
        for (int ni = 0; ni < 4; ++ni) zz[mi][ni] = *(const u32x2*)(p.proj + (size_t)(T0 + mi * 16 + fr) * INW + 2560 + gi * 64 + ni * 16 + fq * 4);
#pragma unroll
    for (int mi = 0; mi < 2; ++mi) {
        const int tt = mi * 16 + fr, ts = toff + tt, tok = T0 + tt;
        int lo = ts - HALF, hi = ts - HALF + WIN - 1;
        lo = lo < 0 ? 0 : lo;
        hi = hi > seqlen - 1 ? seqlen - 1 : hi;
        const float rc = 1.0f / (float)(hi - lo + 1);
        f32x4 acc[4];
#pragma unroll
        for (int j = 0; j < 4; ++j) acc[j] = (f32x4){0.f, 0.f, 0.f, 0.f};
#pragma unroll
        for (int kk = 0; kk < 2; ++kk) {
            const int co = (gi * 64 + kk * 32 + fq * 8) * 2;
            u32x4 rw[WIN];
#pragma unroll
            for (int j = 0; j < WIN; ++j) rw[j] = *(const u32x4*)(smem + (tt + 8 - HALF + j) * 528 + co);
            const u32x4 self = *(const u32x4*)(smem + (tt + 8) * 528 + co);
            float sum[8];
#pragma unroll
            for (int e = 0; e < 8; ++e) sum[e] = 0.f;
#pragma unroll
            for (int j = 0; j < WIN; ++j) {
                const int sq = ts - HALF + j;
                const float m = (sq >= 0 && sq < seqlen) ? 1.0f : 0.0f;
                float f[8];
                unpack8(rw[j], f);
#pragma unroll
                for (int e = 0; e < 8; ++e) sum[e] = fmaf(f[e], m, sum[e]);
            }
            float us[8];
            unpack8(self, us);
            u32x4 dw;
            dw.x = pk_bf16(sum[0] * rc - us[0], sum[1] * rc - us[1]);
            dw.y = pk_bf16(sum[2] * rc - us[2], sum[3] * rc - us[3]);
            dw.z = pk_bf16(sum[4] * rc - us[4], sum[5] * rc - us[5]);
            dw.w = pk_bf16(sum[6] * rc - us[6], sum[7] * rc - us[7]);
            const bf16x8 df = __builtin_bit_cast(bf16x8, dw);
#pragma unroll
            for (int ni = 0; ni < 4; ++ni) acc[ni] = __builtin_amdgcn_mfma_f32_16x16x32_bf16(wf[ni][kk], df, acc[ni], 0, 0, 0);
        }
#pragma unroll
        for (int ni = 0; ni < 4; ++ni) {
            const int ch = gi * 64 + ni * 16 + fq * 4;
            u32x2 w;
            w.x = pk_bf16(acc[ni][0] * ps[ni][0] * silu_f(bf_lo(zz[mi][ni].x)), acc[ni][1] * ps[ni][1] * silu_f(bf_hi(zz[mi][ni].x)));
            w.y = pk_bf16(acc[ni][2] * ps[ni][2] * silu_f(bf_lo(zz[mi][ni].y)), acc[ni][3] * ps[ni][3] * silu_f(bf_hi(zz[mi][ni].y)));
            *(u32x2*)(p.mix + (size_t)tok * DM + 768 + ch) = w;
        }
    }
}

__device__ __forceinline__ void pool_item(const Params& p, int layer, int pi, unsigned char* smem) {
    const int tid = otid(), lane = tid & 63, gi = tid >> 6;
    const int fr = lane & 15, fq = lane >> 4;
    const int T0 = pi * 32;
    int seqstart, seqlen;
    if (T0 < NCTX) { seqstart = T0 & ~255; seqlen = 256; } else { seqstart = NCTX + ((T0 - NCTX) & ~2047); seqlen = 2048; }
    const int toff = T0 - seqstart;
    u32x4 st[6];
#pragma unroll
    for (int i = 0; i < 6; ++i) {
        const int e = tid + 256 * i, r = e >> 5, c = e & 31;
        int sq = toff - 8 + r;
        sq = sq < 0 ? 0 : (sq > seqlen - 1 ? seqlen - 1 : sq);
        if (e < 47 * 32) st[i] = *(const u32x4*)(p.proj + (size_t)(seqstart + sq) * INW + 2304 + c * 8);
    }
    bf16x8 wf[4][2];
    f32x4 ps[4];
    {
        const bf16_t* wp = p.PoolT + (size_t)((layer * 4 + gi) * 64) * 64;
#pragma unroll
        for (int ni = 0; ni < 4; ++ni) {
#pragma unroll
            for (int kk = 0; kk < 2; ++kk) wf[ni][kk] = *(const bf16x8*)(wp + (ni * 16 + fr) * 64 + kk * 32 + fq * 8);
            ps[ni] = *(const f32x4*)(p.pool_scale + layer * 256 + gi * 64 + ni * 16 + fq * 4);
        }
    }
#pragma unroll
    for (int i = 0; i < 6; ++i) {
        const int e = tid + 256 * i, r = e >> 5, c = e & 31;
        if (e < 47 * 32) *(u32x4*)(smem + r * 528 + c * 16) = st[i];
    }
    __syncthreads();
    if (gi == 0) pool_group<2>(p, layer, T0, toff, seqlen, gi, fr, fq, wf, ps, smem);
    else if (gi == 1) pool_group<4>(p, layer, T0, toff, seqlen, gi, fr, fq, wf, ps, smem);
    else if (gi == 2) pool_group<8>(p, layer, T0, toff, seqlen, gi, fr, fq, wf, ps, smem);
    else pool_group<16>(p, layer, T0, toff, seqlen, gi, fr, fq, wf, ps, smem);
    __syncthreads();
}

__device__ __forceinline__ void conv_item(const Params& p, int layer, int ci) {
    const int tid = otid();
    const int ch = (tid & 31) * 8, tg = tid >> 5;
    const int T0 = ci * 32 + tg * 4;
    int seqstart, seqlen;
    if (T0 < NCTX) { seqstart = T0 & ~255; seqlen = 256; } else { seqstart = NCTX + ((T0 - NCTX) & ~2047); seqlen = 2048; }
    const int seqend = seqstart + seqlen;
    u32x4 rh[6], rc[6], rb[4], rz[4];
#pragma unroll
    for (int i = 0; i < 6; ++i) {
        int tok = T0 - 1 + i;
        tok = tok < seqstart ? seqstart : (tok > seqend - 1 ? seqend - 1 : tok);
        rh[i] = *(const u32x4*)(p.proj + (size_t)tok * INW + 1280 + ch);
        rc[i] = *(const u32x4*)(p.proj + (size_t)tok * INW + 1792 + ch);
    }
#pragma unroll
    for (int i = 0; i < 4; ++i) {
        rb[i] = *(const u32x4*)(p.proj + (size_t)(T0 + i) * INW + 1536 + ch);
        rz[i] = *(const u32x4*)(p.proj + (size_t)(T0 + i) * INW + 2048 + ch);
    }
    f32x4 wv[8];
    {
        const float* cw = p.conv_w + (size_t)layer * 768 + ch;
#pragma unroll
        for (int r = 0; r < 3; ++r) { wv[r * 2] = *(const f32x4*)(cw + r * 256); wv[r * 2 + 1] = *(const f32x4*)(cw + r * 256 + 4); }
        wv[6] = *(const f32x4*)(p.conv_b + layer * 256 + ch);
        wv[7] = *(const f32x4*)(p.conv_b + layer * 256 + ch + 4);
    }
    float x[6][8];
#pragma unroll
    for (int i = 0; i < 6; ++i) {
        const int tok = T0 - 1 + i;
        const float valid = (tok >= seqstart && tok < seqend) ? 1.0f : 0.0f;
        float hc[8], cc[8];
        unpack8(rh[i], hc);
        unpack8(rc[i], cc);
#pragma unroll
        for (int e = 0; e < 8; ++e) x[i][e] = hc[e] * cc[e] * valid;
    }
#pragma unroll
    for (int t = 0; t < 4; ++t) {
        float bc[8], zc[8], o[8];
        unpack8(rb[t], bc);
        unpack8(rz[t], zc);
#pragma unroll
        for (int e = 0; e < 8; ++e) {
            const float y = x[t][e] * wv[e >> 2][e & 3] + x[t + 1][e] * wv[2 + (e >> 2)][e & 3] + x[t + 2][e] * wv[4 + (e >> 2)][e & 3] + wv[6 + (e >> 2)][e & 3];
            o[e] = bc[e] * y * silu_f(zc[e]);
        }
        u32x4 w;
        w.x = pk_bf16(o[0], o[1]); w.y = pk_bf16(o[2], o[3]); w.z = pk_bf16(o[4], o[5]); w.w = pk_bf16(o[6], o[7]);
        *(u32x4*)(p.mix + (size_t)(T0 + t) * DM + 512 + ch) = w;
    }
}

__device__ __forceinline__ void phase_mixer(const Params& p, int layer, unsigned char* smem) {
    if (gridDim.x == 512) {
        const int b = blockIdx.x;
        if (b >= 256) __builtin_amdgcn_s_setprio(2);
        if (b < 256) {
            const int xcd = b & 7, slot = b >> 3;
            attn_unit<0>(p, layer, 512 + ((((xcd << 1) | (slot >> 4)) << 4) | (slot & 15)), smem);
        }
        {
            const int xcd = b & 7, slot = b >> 3;
            attn_unit<0>(p, layer, ((xcd >> 1) << 7) | ((((xcd & 1) << 2) | (slot >> 4)) << 4) | (slot & 15), smem);
        }
        if (b >= 256) {
#pragma unroll 1
            for (int k = 0; k < 3; ++k) {
                const int idx = (b - 256) + 256 * k;
                if (idx < 384) pool_item(p, layer, idx, smem);
                else conv_item(p, layer, idx - 384);
            }
        }
        __builtin_amdgcn_s_setprio(0);
    } else {
        for (int it = blockIdx.x; it < 768 + 384 + 384; it += gridDim.x) {
            if (it < 768) attn_unit<0>(p, layer, it, smem);
            else if (it < 1152) pool_item(p, layer, it - 768, smem);
            else conv_item(p, layer, it - 1152);
        }
    }
}

__global__ void __launch_bounds__(256, 2) mega(Params p, int lo, int hi) {
    __shared__ __attribute__((aligned(16))) unsigned char smem[73728];
    __shared__ uint4 xbw;
    if (p.use_cg) cg::this_grid().sync();
    if (threadIdx.x == 0) xbw = make_uint4(0u, 0u, 0u, 0u);
    __syncthreads();
    XcdBarrier xb = xcd_barrier_post(p.bar, (volatile LAS unsigned*)&xbw);
    for (int ph = lo; ph < hi; ++ph) {
        if (ph > lo) xcd_barrier(xb);
        if (ph == 0) phase_prep(p, smem);
        else if (ph == 9) phase_final(p);
        else {
            const int layer = (ph - 1) >> 2, ty = (ph - 1) & 3;
            if (ty == 0) phase_xn(p, layer);
            else if (ty == 1) phase_gemm<0>(p, layer, smem);
            else if (ty == 2) phase_mixer(p, layer, smem);
            else phase_gemm<1>(p, layer, smem);
        }
    }
}

#ifndef MK_MULTI
#define MK_MULTI 0
#endif

extern "C" void kernel_launch(void* const* d_in, const int* in_sizes, int n_in, void* d_out, int out_size, void* d_ws, size_t ws_size,
                              hipStream_t stream) {
    static int grid_blocks = 0;
    if (!grid_blocks) {
        int dev = 0, cus = 0, per_cu = 0;
        hipGetDevice(&dev);
        hipDeviceGetAttribute(&cus, hipDeviceAttributeMultiprocessorCount, dev);
        hipOccupancyMaxActiveBlocksPerMultiprocessor(&per_cu, mega, 256, 0);
        if (per_cu > 2) per_cu = 2;
        if (per_cu < 1) per_cu = 1;
        grid_blocks = cus * per_cu;
    }
    Params p{};
    const float* const* in = (const float* const*)d_in;
    p.x_prompt = in[0]; p.x_sample = in[1]; p.cache_k = in[2]; p.cache_v = in[3]; p.c = in[4]; p.c_ctx = in[5]; p.norm_g = in[6];
    p.w_ada = in[7]; p.b_ada = in[8]; p.w_in = in[9]; p.q_g = in[10]; p.k_g = in[11]; p.conv_w = in[12]; p.conv_b = in[13];
    p.pool_w = in[14]; p.pool_scale = in[15]; p.w_out = in[16]; p.final_g = in[17];
    p.out = (float*)d_out;
    unsigned char* ws = (unsigned char*)d_ws;
    size_t off = 0;
    auto take = [&](size_t bytes) { unsigned char* r = ws + off; off += (bytes + 255) & ~(size_t)255; return r; };
    p.bar = (unsigned*)take(XCD_BAR_WORDS * 4);
    p.modv = (float*)take(2 * 5 * 3072 * 4);
    p.rope = (float*)take(2048 * 4);
    p.WinT = (bf16_t*)take((size_t)2 * INW * 1024 * 2);
    p.WoutT = (bf16_t*)take((size_t)2 * 1024 * 1024 * 2);
    p.PoolT = (bf16_t*)take(2 * 4 * 64 * 64 * 2);
    p.kc = (bf16_t*)take(262144 * 2);
    p.vc = (bf16_t*)take(262144 * 2);
    p.h = (bf16_t*)take((size_t)NTOK * DM * 2);
    p.xn = (bf16_t*)take((size_t)NTOK * DM * 2);
    p.proj = (bf16_t*)take((size_t)NTOK * INW * 2);
    p.mix = (bf16_t*)take((size_t)NTOK * DM * 2);
    p.use_cg = 0;
    p.pad = 0;
    hipMemsetAsync(p.bar, 0, XCD_BAR_WORDS * 4, stream);
#if MK_MULTI
    for (int ph = 0; ph < 10; ++ph) {
        int lo = ph, hi = ph + 1;
        void* args[] = {&p, &lo, &hi};
        hipError_t e = hipLaunchCooperativeKernel((void*)mega, dim3(grid_blocks), dim3(256), args, 0, stream);
        if (e != hipSuccess) fprintf(stderr, "launch failed: %s\n", hipGetErrorString(e));
    }
#else
    int lo = 0, hi = 10;
    void* args[] = {&p, &lo, &hi};
    hipError_t e = hipLaunchCooperativeKernel((void*)mega, dim3(grid_blocks), dim3(256), args, 0, stream);
    if (e != hipSuccess) fprintf(stderr, "cooperative launch failed: %s (grid %d)\n", hipGetErrorString(e), grid_blocks);
#endif
}
```
